# Optimizing an MI355X kernel written in HIP

```python
import jax
import jax.numpy as jnp
from jax import lax
import numpy as np

D_MODEL = 1024
BATCH = 16
SEQ = 2048
DEPTH = 1

GRID_W = 64
CTX_LEN = 256
HEAD_DIM = 64
N_Q_HEADS = 8
N_KV_HEADS = 2
Q_PER_KV = N_Q_HEADS // N_KV_HEADS
ATTN_WIDTH = N_Q_HEADS * HEAD_DIM
KV_WIDTH = N_KV_HEADS * HEAD_DIM
WINDOW = 128
BLOCK = 128
ROPE_BASE = 10000.0
ROPE_PAIRS = HEAD_DIM // 4
CONV_WIDTH = D_MODEL // 2
CONV_K = 3
PEER_HEADS = 8
PEER_KEY_DIM = 256
PEER_N_KEYS = 128
PEER_N_EXPERTS = PEER_N_KEYS * PEER_N_KEYS
PEER_TOPK = 16
PEER_CHUNK = 128
N_MOD = 6
EPS = 1e-6
NEG_INF = -1e30

PROJ_SIZES = (ATTN_WIDTH, KV_WIDTH, KV_WIDTH, CONV_WIDTH, CONV_WIDTH, CONV_WIDTH, D_MODEL, D_MODEL)
PROJ_WIDTH = sum(PROJ_SIZES)
PROJ_SPLITS = tuple(int(s) for s in np.cumsum(PROJ_SIZES)[:-1])
KV_START = ATTN_WIDTH
KV_END = ATTN_WIDTH + 2 * KV_WIDTH

kernel_name = "hybrid_swa_shortconv_peer_dit_layer"


def rmsnorm(x, g):
    xf = x.astype(jnp.float32)
    y = xf * lax.rsqrt(jnp.mean(xf * xf, axis=-1, keepdims=True) + EPS)
    return (y * g.astype(jnp.float32)).astype(x.dtype)


def adaln_params(cond, w_mod, b_mod):
    m = jax.nn.silu(cond) @ w_mod + b_mod
    return jnp.split(m, N_MOD, axis=-1)


def axial_rope_tables(length):
    rows = length // GRID_W
    row = jnp.repeat(jnp.arange(rows, dtype=jnp.float32), GRID_W)
    col = jnp.tile(jnp.arange(GRID_W, dtype=jnp.float32), rows)
    inv_freq = ROPE_BASE ** (-jnp.arange(ROPE_PAIRS, dtype=jnp.float32) / ROPE_PAIRS)
    ang_r = row[:, None] * inv_freq
    ang_c = col[:, None] * inv_freq
    return (jnp.cos(ang_r), jnp.sin(ang_r), jnp.cos(ang_c), jnp.sin(ang_c))


def _rotate(xp, cos, sin):
    x1, x2 = jnp.split(xp, 2, axis=-1)
    c = cos[:, None, :]
    s = sin[:, None, :]
    return jnp.concatenate([x1 * c - x2 * s, x1 * s + x2 * c], axis=-1)


def apply_axial_rope(x, tables):
    cos_r, sin_r, cos_c, sin_c = tables
    xr, xc = jnp.split(x.astype(jnp.float32), 2, axis=-1)
    out = jnp.concatenate([_rotate(xr, cos_r, sin_r), _rotate(xc, cos_c, sin_c)], axis=-1)
    return out.astype(x.dtype)


def split_proj(z):
    return jnp.split(z, PROJ_SPLITS, axis=-1)


def windowed_attention(q, k, v, k_ctx, v_ctx, sink):
    B, L = q.shape[0], q.shape[1]
    nb = L // BLOCK
    scale = HEAD_DIM ** -0.5
    qb = q.reshape(B, nb, BLOCK, N_KV_HEADS, Q_PER_KV, HEAD_DIM)
    pad = ((0, 0), (BLOCK, BLOCK), (0, 0), (0, 0))
    kp = jnp.pad(k, pad).reshape(B, nb + 2, BLOCK, N_KV_HEADS, HEAD_DIM)
    vp = jnp.pad(v, pad).reshape(B, nb + 2, BLOCK, N_KV_HEADS, HEAD_DIM)
    kb = jnp.concatenate([kp[:, :-2], kp[:, 1:-1], kp[:, 2:]], axis=2)
    vb = jnp.concatenate([vp[:, :-2], vp[:, 1:-1], vp[:, 2:]], axis=2)
    s_loc = jnp.einsum('bnqhgd,bnkhd->bhgnqk', qb, kb, preferred_element_type=jnp.float32) * scale
    s_ctx = jnp.einsum('bnqhgd,bchd->bhgnqc', qb, k_ctx, preferred_element_type=jnp.float32) * scale
    blk = jnp.arange(nb)[:, None]
    qpos = blk * BLOCK + jnp.arange(BLOCK)[None, :]
    kpos = (blk - 1) * BLOCK + jnp.arange(3 * BLOCK)[None, :]
    valid = ((kpos[:, None, :] >= 0) & (kpos[:, None, :] < L)
             & (jnp.abs(qpos[:, :, None] - kpos[:, None, :]) <= WINDOW))
    s_loc = jnp.where(valid, s_loc, NEG_INF)
    sink_l = jnp.broadcast_to(
        sink.astype(jnp.float32).reshape(N_KV_HEADS, Q_PER_KV)[None, :, :, None, None, None],
        s_loc.shape[:-1] + (1,))
    p = jax.nn.softmax(jnp.concatenate([s_loc, s_ctx, sink_l], axis=-1), axis=-1)
    n_loc = 3 * BLOCK
    n_ctx = k_ctx.shape[1]
    p_loc = p[..., :n_loc].astype(v.dtype)
    p_ctx = p[..., n_loc:n_loc + n_ctx].astype(v.dtype)
    out = (jnp.einsum('bhgnqk,bnkhd->bnqhgd', p_loc, vb)
           + jnp.einsum('bhgnqc,bchd->bnqhgd', p_ctx, v_ctx))
    return out.reshape(B, L, ATTN_WIDTH)


def context_attention(q, k, v, sink):
    B, C = q.shape[0], q.shape[1]
    qg = q.reshape(B, C, N_KV_HEADS, Q_PER_KV, HEAD_DIM)
    s = jnp.einsum('bqhgd,bkhd->bhgqk', qg, k, preferred_element_type=jnp.float32) * HEAD_DIM ** -0.5
    sink_l = jnp.broadcast_to(
        sink.astype(jnp.float32).reshape(N_KV_HEADS, Q_PER_KV)[None, :, :, None, None],
        s.shape[:-1] + (1,))
    p = jax.nn.softmax(jnp.concatenate([s, sink_l], axis=-1), axis=-1)[..., :C].astype(v.dtype)
    out = jnp.einsum('bhgqk,bkhd->bqhgd', p, v)
    return out.reshape(B, C, ATTN_WIDTH)


def short_conv(z, w):
    L = z.shape[1]
    zp = jnp.pad(z, ((0, 0), (1, 1), (0, 0)))
    return zp[:, :L] * w[0] + zp[:, 1:L + 1] * w[1] + zp[:, 2:] * w[2]


def conv_branch(gate_b, gate_c, u, conv_w, w_conv_out):
    return (gate_b * short_conv(gate_c * u, conv_w)) @ w_conv_out


def merge_branches(y_attn, y_conv, ga, gc, w_mix_out):
    return (jax.nn.sigmoid(ga) * y_attn + jax.nn.sigmoid(gc) * y_conv) @ w_mix_out


def peer(h, w_q, sub_keys, u_tab, v_tab):
    B, L, D = h.shape
    tok = h.reshape(-1, PEER_CHUNK, D)

    def chunk(t):
        T = t.shape[0]
        qh = (t @ w_q).reshape(T, PEER_HEADS, 2, PEER_KEY_DIM // 2)
        s = jnp.einsum('thpd,hpnd->thpn', qh, sub_keys, preferred_element_type=jnp.float32)
        s_top, i_top = lax.top_k(s, PEER_TOPK)
        cand = s_top[:, :, 0, :, None] + s_top[:, :, 1, None, :]
        cand_idx = i_top[:, :, 0, :, None] * PEER_N_KEYS + i_top[:, :, 1, None, :]
        best, pos = lax.top_k(cand.reshape(T, PEER_HEADS, PEER_TOPK * PEER_TOPK), PEER_TOPK)
        idx = jnp.take_along_axis(cand_idx.reshape(T, PEER_HEADS, PEER_TOPK * PEER_TOPK), pos, axis=-1)
        g = jax.nn.softmax(best, axis=-1)
        ue = jnp.take(u_tab, idx, axis=0)
        ve = jnp.take(v_tab, idx, axis=0)
        act = jax.nn.gelu(jnp.einsum('thkd,td->thk', ue, t, preferred_element_type=jnp.float32),
                          approximate=False)
        return jnp.einsum('thk,thkd->td', (g * act).astype(t.dtype), ve)

    return lax.map(chunk, tok).reshape(B, L, D)


def trunk_layer(x, xc, c, c_ctx, w_mod, b_mod, n1, n2, w_in, sink, conv_w,
                w_attn_out, w_conv_out, w_mix_out, pw_q, p_keys, p_u, p_v, rope, update_ctx):
    B, L, _ = x.shape
    C = xc.shape[1]
    sh1, sc1, g1, sh2, sc2, g2 = [m[:, None, :] for m in adaln_params(c, w_mod, b_mod)]
    csh1, csc1, cg1, csh2, csc2, cg2 = adaln_params(c_ctx, w_mod, b_mod)

    hc = rmsnorm(xc, n1) * (1 + csc1) + csh1
    if update_ctx:
        qc, kc, vc, gbc, gcc, uc, gac, gvc = split_proj(hc @ w_in)
    else:
        kc, vc = jnp.split(hc @ w_in[:, KV_START:KV_END], 2, axis=-1)
    kc = kc.reshape(B, C, N_KV_HEADS, HEAD_DIM)
    vc = vc.reshape(B, C, N_KV_HEADS, HEAD_DIM)

    h = rmsnorm(x, n1) * (1 + sc1) + sh1
    q, k, v, gb, gcv, u, ga, gv = split_proj(h @ w_in)
    q = apply_axial_rope(q.reshape(B, L, N_Q_HEADS, HEAD_DIM), rope)
    k = apply_axial_rope(k.reshape(B, L, N_KV_HEADS, HEAD_DIM), rope)
    v = v.reshape(B, L, N_KV_HEADS, HEAD_DIM)
    y_attn = windowed_attention(q, k, v, kc, vc, sink) @ w_attn_out
    y_conv = conv_branch(gb, gcv, u, conv_w, w_conv_out)
    x = x + g1 * merge_branches(y_attn, y_conv, ga, gv, w_mix_out)
    h2 = rmsnorm(x, n2) * (1 + sc2) + sh2
    x = x + g2 * peer(h2, pw_q, p_keys, p_u, p_v)

    if update_ctx:
        yc_attn = context_attention(qc.reshape(B, C, N_Q_HEADS, HEAD_DIM), kc, vc, sink) @ w_attn_out
        yc_conv = conv_branch(gbc, gcc, uc, conv_w, w_conv_out)
        xc = xc + cg1 * merge_branches(yc_attn, yc_conv, gac, gvc, w_mix_out)
        hc2 = rmsnorm(xc, n2) * (1 + csc2) + csh2
        xc = xc + cg2 * peer(hc2, pw_q, p_keys, p_u, p_v)
    return x, xc


def setup_inputs(seed: int = 0) -> dict:
    key = jax.random.key(seed)
    ks = jax.random.split(key, 19)

    def nrm(k, shape, s):
        return jax.random.normal(k, shape, jnp.float32) * s

    return {
        "x": nrm(ks[0], (BATCH, SEQ, D_MODEL), 1.0),
        "c": nrm(ks[1], (BATCH, D_MODEL), 1.0),
        "ctx": nrm(ks[2], (BATCH, CTX_LEN, D_MODEL), 1.0),
        "c_ctx": nrm(ks[3], (D_MODEL,), 1.0),
        "w_mod": nrm(ks[4], (DEPTH, D_MODEL, N_MOD * D_MODEL), D_MODEL ** -0.5),
        "b_mod": nrm(ks[5], (DEPTH, N_MOD * D_MODEL), 0.02),
        "norm1_g": 1.0 + nrm(ks[6], (DEPTH, D_MODEL), 0.02),
        "norm2_g": 1.0 + nrm(ks[7], (DEPTH, D_MODEL), 0.02),
        "w_in": nrm(ks[8], (DEPTH, D_MODEL, PROJ_WIDTH), D_MODEL ** -0.5),
        "attn_sink": nrm(ks[9], (DEPTH, N_Q_HEADS), 1.0),
        "conv_w": nrm(ks[10], (DEPTH, CONV_K, CONV_WIDTH), CONV_K ** -0.5),
        "w_attn_out": nrm(ks[11], (DEPTH, ATTN_WIDTH, D_MODEL), ATTN_WIDTH ** -0.5),
        "w_conv_out": nrm(ks[12], (DEPTH, CONV_WIDTH, D_MODEL), CONV_WIDTH ** -0.5),
        "w_mix_out": nrm(ks[13], (DEPTH, D_MODEL, D_MODEL), D_MODEL ** -0.5),
        "peer_w_q": nrm(ks[14], (DEPTH, D_MODEL, PEER_HEADS * PEER_KEY_DIM), D_MODEL ** -0.5),
        "peer_sub_keys": nrm(ks[15], (DEPTH, PEER_HEADS, 2, PEER_N_KEYS, PEER_KEY_DIM // 2),
                             (PEER_KEY_DIM // 2) ** -0.5),
        "peer_u": nrm(ks[16], (DEPTH, PEER_N_EXPERTS, D_MODEL), D_MODEL ** -0.5),
        "peer_v": nrm(ks[17], (DEPTH, PEER_N_EXPERTS, D_MODEL), 0.5),
        "final_g": 1.0 + nrm(ks[18], (D_MODEL,), 0.02),
    }


def reference(x, c, ctx, c_ctx, w_mod, b_mod, norm1_g, norm2_g, w_in, attn_sink, conv_w,
              w_attn_out, w_conv_out, w_mix_out, peer_w_q, peer_sub_keys, peer_u, peer_v, final_g):
    rope = axial_rope_tables(x.shape[1])
    xc = ctx
    for l in range(DEPTH):
        x, xc = trunk_layer(x, xc, c, c_ctx, w_mod[l], b_mod[l], norm1_g[l], norm2_g[l], w_in[l],
                            attn_sink[l], conv_w[l], w_attn_out[l], w_conv_out[l], w_mix_out[l],
                            peer_w_q[l], peer_sub_keys[l], peer_u[l], peer_v[l], rope,
                            l < DEPTH - 1)
    return rmsnorm(x, final_g)
```

```cpp
#include <hip/hip_runtime.h>
#include <cstdio>
#include <cstdint>

typedef unsigned short bf16_t;
typedef short bf16x8 __attribute__((ext_vector_type(8)));
typedef float f32x4 __attribute__((ext_vector_type(4)));
typedef unsigned u32x4 __attribute__((ext_vector_type(4)));
typedef unsigned u32x2 __attribute__((ext_vector_type(2)));

constexpr int DM = 1024, NB = 16, SEQ = 2048, NTOK = NB * SEQ, CTXL = 256, NCTX = NB * CTXL;
constexpr int PROJW = 4352;
constexpr int NMOD = 6 * DM;
constexpr int NEXP = 16384;

__device__ __forceinline__ float bf2f(bf16_t x) { return __uint_as_float(((unsigned)x) << 16); }
__device__ __forceinline__ bf16_t f2bf(float f) {
    unsigned u = __float_as_uint(f);
    u += 0x7fffu + ((u >> 16) & 1u);
    return (bf16_t)(u >> 16);
}
__device__ __forceinline__ unsigned pk2(float lo, float hi) { return (unsigned)f2bf(lo) | ((unsigned)f2bf(hi) << 16); }
__device__ __forceinline__ float sigmoidf_(float x) { return 1.f / (1.f + __expf(-x)); }
__device__ __forceinline__ float wave_sum(float v) {
#pragma unroll
    for (int o = 1; o < 64; o <<= 1) v += __shfl_xor(v, o);
    return v;
}

struct Params {
    const float *x, *c, *ctx, *c_ctx, *w_mod, *b_mod, *n1, *n2, *w_in, *sink, *conv_w, *w_ao, *w_co, *w_mix, *pw_q, *keys, *pu, *pv, *fg;
    float* out;
    float *modp, *mod, *rope;
    bf16_t *WinT, *WaoT, *WcoT, *WmixT, *PwqT, *KeysB, *Ub, *Vb;
    bf16_t *H, *HC, *Q, *K, *VT, *Kc, *VcT, *GB, *GC, *U, *GA, *GV, *AO, *CA, *M1, *YG, *H2, *QH;
    float* TKv; int* TKi;
    int* sel_idx; float* sel_g;
};

__global__ void __launch_bounds__(256) k_modp(Params P) {
    __shared__ float s[17][128];
    for (int item = blockIdx.x; item < 8 * 24; item += gridDim.x) {
        const int kc = item / 24, nc = item % 24;
        __syncthreads();
        for (int i = threadIdx.x; i < 17 * 128; i += 256) {
            const int r = i / 128, k = i % 128;
            const float v = (r < 16) ? P.c[r * DM + kc * 128 + k] : P.c_ctx[kc * 128 + k];
            s[r][k] = v / (1.f + __expf(-v));
        }
        __syncthreads();
        const int n = nc * 256 + threadIdx.x;
        float acc[17];
#pragma unroll
        for (int r = 0; r < 17; ++r) acc[r] = 0.f;
        for (int k = 0; k < 128; ++k) {
            const float w = P.w_mod[(size_t)(kc * 128 + k) * NMOD + n];
#pragma unroll
            for (int r = 0; r < 17; ++r) acc[r] += s[r][k] * w;
        }
#pragma unroll
        for (int r = 0; r < 17; ++r) P.modp[((size_t)kc * 17 + r) * NMOD + n] = acc[r];
    }
}
__global__ void k_modfinal(Params P) {
    for (int i = blockIdx.x * blockDim.x + threadIdx.x; i < 17 * NMOD; i += gridDim.x * blockDim.x) {
        float v = P.b_mod[i % NMOD];
#pragma unroll
        for (int kc = 0; kc < 8; ++kc) v += P.modp[(size_t)kc * 17 * NMOD + i];
        P.mod[i] = v;
    }
}
__device__ __forceinline__ void transpose_tile(const float* W, int K, int N, bf16_t* Wt, int item, float (*tile)[65]) {
    const int ntn = N / 64, kt = item / ntn, nt = item % ntn, k0 = kt * 64, n0 = nt * 64;
    const int tx = threadIdx.x & 63, ty = threadIdx.x >> 6;
    __syncthreads();
#pragma unroll
    for (int i = 0; i < 16; ++i) { const int k = i * 4 + ty; tile[k][tx] = W[(size_t)(k0 + k) * N + n0 + tx]; }
    __syncthreads();
#pragma unroll
    for (int i = 0; i < 16; ++i) { const int n = i * 4 + ty; Wt[(size_t)(n0 + n) * K + k0 + tx] = f2bf(tile[tx][n]); }
}
__global__ void __launch_bounds__(256) k_transpose(const float* W, int K, int N, bf16_t* Wt) {
    __shared__ float tile[64][65];
    const int items = (K / 64) * (N / 64);
    for (int it = blockIdx.x; it < items; it += gridDim.x) transpose_tile(W, K, N, Wt, it, tile);
}
__global__ void k_cvt(const float* src, bf16_t* dst, size_t n8) {
    for (size_t i = (size_t)blockIdx.x * blockDim.x + threadIdx.x; i < n8; i += (size_t)gridDim.x * blockDim.x) {
        const f32x4 a = *(const f32x4*)(src + i * 8), b = *(const f32x4*)(src + i * 8 + 4);
        u32x4 o; o.x = pk2(a.x, a.y); o.y = pk2(a.z, a.w); o.z = pk2(b.x, b.y); o.w = pk2(b.z, b.w);
        *(u32x4*)(dst + i * 8) = o;
    }
}
__global__ void k_rope(Params P) {
    for (int i = blockIdx.x * blockDim.x + threadIdx.x; i < 1536; i += gridDim.x * blockDim.x) {
        int pos, f; bool isc;
        if (i < 512) { pos = i / 16; f = i % 16; isc = false; } else { pos = (i - 512) / 16; f = (i - 512) % 16; isc = true; }
        const double inv = pow(10000.0, -(double)f / 16.0);
        const double ang = (double)pos * inv;
        const float cv = (float)cos(ang), sv = (float)sin(ang);
        if (!isc) { P.rope[pos * 16 + f] = cv; P.rope[512 + pos * 16 + f] = sv; }
        else { P.rope[1024 + pos * 16 + f] = cv; P.rope[2048 + pos * 16 + f] = sv; }
    }
}

__device__ __forceinline__ void norm_row(const float* xr, const float* g, const float* scale, const float* shift, bf16_t* dst, int lane) {
    f32x4 v[4]; float s = 0.f;
#pragma unroll
    for (int j = 0; j < 4; ++j) { v[j] = *(const f32x4*)(xr + j * 256 + lane * 4); s += v[j].x * v[j].x + v[j].y * v[j].y + v[j].z * v[j].z + v[j].w * v[j].w; }
    s = wave_sum(s);
    const float rstd = rsqrtf(s * (1.f / DM) + 1e-6f);
#pragma unroll
    for (int j = 0; j < 4; ++j) {
        const int d = j * 256 + lane * 4;
        const f32x4 gg = *(const f32x4*)(g + d), sc = *(const f32x4*)(scale + d), sh = *(const f32x4*)(shift + d);
        const float y0 = v[j].x * rstd * gg.x * (1.f + sc.x) + sh.x;
        const float y1 = v[j].y * rstd * gg.y * (1.f + sc.y) + sh.y;
        const float y2 = v[j].z * rstd * gg.z * (1.f + sc.z) + sh.z;
        const float y3 = v[j].w * rstd * gg.w * (1.f + sc.w) + sh.w;
        u32x2 o; o.x = pk2(y0, y1); o.y = pk2(y2, y3);
        *(u32x2*)(dst + d) = o;
    }
}
__global__ void __launch_bounds__(256) k_norm(Params P, int which) {
    const int lane = threadIdx.x & 63, wid = threadIdx.x >> 6;
    const int nrows = (which == 1) ? NCTX : NTOK;
    for (int row = blockIdx.x * 4 + wid; row < nrows; row += gridDim.x * 4) {
        if (which == 0) { const int b = row / SEQ; norm_row(P.x + (size_t)row * DM, P.n1, P.mod + (size_t)b * NMOD + 1 * DM, P.mod + (size_t)b * NMOD + 0 * DM, P.H + (size_t)row * DM, lane); }
        else if (which == 1) { norm_row(P.ctx + (size_t)row * DM, P.n1, P.mod + (size_t)16 * NMOD + 1 * DM, P.mod + (size_t)16 * NMOD + 0 * DM, P.HC + (size_t)row * DM, lane); }
        else { const int b = row / SEQ; norm_row(P.out + (size_t)row * DM, P.n2, P.mod + (size_t)b * NMOD + 4 * DM, P.mod + (size_t)b * NMOD + 3 * DM, P.H2 + (size_t)row * DM, lane); }
    }
}

enum { MODE_INPROJ = 0, MODE_CTXKV = 1, MODE_AO1 = 2, MODE_CO2 = 3, MODE_MIX = 4, MODE_QH = 5 };

__device__ __forceinline__ void st8bf(bf16_t* p, const float* v) {
    u32x4 o; o.x = pk2(v[0], v[1]); o.y = pk2(v[2], v[3]); o.z = pk2(v[4], v[5]); o.w = pk2(v[6], v[7]);
    *(u32x4*)p = o;
}
__device__ __forceinline__ void st4bf(bf16_t* p, const float* v) {
    u32x2 o; o.x = pk2(v[0], v[1]); o.y = pk2(v[2], v[3]);
    *(u32x2*)p = o;
}
template <int MODE> __device__ __forceinline__ void epi8(const Params& P, int m, int n, const float* v) {
    if (MODE == MODE_INPROJ) {
        if (n < 1280) st8bf(P.GB + (size_t)m * 512 + (n - 768), v);
        else if (n < 1792) st8bf(P.GC + (size_t)m * 512 + (n - 1280), v);
        else if (n < 2304) st8bf(P.U + (size_t)m * 512 + (n - 1792), v);
        else {
            float s[8];
#pragma unroll
            for (int j = 0; j < 8; ++j) s[j] = sigmoidf_(v[j]);
            if (n < 3328) st8bf(P.GA + (size_t)m * DM + (n - 2304), s);
            else st8bf(P.GV + (size_t)m * DM + (n - 3328), s);
        }
    } else if (MODE == MODE_CTXKV) {
        st8bf(P.Kc + (size_t)m * 128 + n, v);
    } else if (MODE == MODE_AO1) {
        const u32x4 g = *(const u32x4*)(P.GA + (size_t)m * DM + n);
        float o[8];
        o[0] = v[0] * bf2f(g.x & 0xffff); o[1] = v[1] * bf2f(g.x >> 16); o[2] = v[2] * bf2f(g.y & 0xffff); o[3] = v[3] * bf2f(g.y >> 16);
        o[4] = v[4] * bf2f(g.z & 0xffff); o[5] = v[5] * bf2f(g.z >> 16); o[6] = v[6] * bf2f(g.w & 0xffff); o[7] = v[7] * bf2f(g.w >> 16);
        st8bf(P.M1 + (size_t)m * DM + n, o);
    } else if (MODE == MODE_CO2) {
        const u32x4 g = *(const u32x4*)(P.GV + (size_t)m * DM + n);
        const u32x4 a = *(const u32x4*)(P.M1 + (size_t)m * DM + n);
        float o[8];
        o[0] = bf2f(a.x & 0xffff) + v[0] * bf2f(g.x & 0xffff); o[1] = bf2f(a.x >> 16) + v[1] * bf2f(g.x >> 16);
        o[2] = bf2f(a.y & 0xffff) + v[2] * bf2f(g.y & 0xffff); o[3] = bf2f(a.y >> 16) + v[3] * bf2f(g.y >> 16);
        o[4] = bf2f(a.z & 0xffff) + v[4] * bf2f(g.z & 0xffff); o[5] = bf2f(a.z >> 16) + v[5] * bf2f(g.z >> 16);
        o[6] = bf2f(a.w & 0xffff) + v[6] * bf2f(g.w & 0xffff); o[7] = bf2f(a.w >> 16) + v[7] * bf2f(g.w >> 16);
        st8bf(P.YG + (size_t)m * DM + n, o);
    } else if (MODE == MODE_MIX) {
        const int b = m / SEQ;
        const float* g1 = P.mod + (size_t)b * NMOD + 2 * DM + n;
        const float* xr = P.x + (size_t)m * DM + n;
        float* o = P.out + (size_t)m * DM + n;
        const f32x4 x0 = *(const f32x4*)xr, x1 = *(const f32x4*)(xr + 4), g0 = *(const f32x4*)g1, g1v = *(const f32x4*)(g1 + 4);
        f32x4 o0, o1;
        o0.x = x0.x + g0.x * v[0]; o0.y = x0.y + g0.y * v[1]; o0.z = x0.z + g0.z * v[2]; o0.w = x0.w + g0.w * v[3];
        o1.x = x1.x + g1v.x * v[4]; o1.y = x1.y + g1v.y * v[5]; o1.z = x1.z + g1v.z * v[6]; o1.w = x1.w + g1v.w * v[7];
        *(f32x4*)o = o0; *(f32x4*)(o + 4) = o1;
    } else if (MODE == MODE_QH) {
        st8bf(P.QH + (size_t)m * 2048 + n, v);
    }
}
__device__ __forceinline__ void epi_rope(const Params& P, int m, int n, const float* lo, const float* hi) {
    const int d0 = n & 63;
    const int l = m % SEQ;
    const float *ct, *st;
    if (d0 < 16) { const int row = l >> 6; ct = P.rope + row * 16 + d0; st = P.rope + 512 + row * 16 + d0; }
    else { const int col = l & 63; ct = P.rope + 1024 + col * 16 + (d0 - 32); st = P.rope + 2048 + col * 16 + (d0 - 32); }
    float a[4], b[4];
    const float sc = (n < 512) ? 0.125f : 1.f;
#pragma unroll
    for (int j = 0; j < 4; ++j) { const float cc = ct[j], ss = st[j]; a[j] = (lo[j] * cc - hi[j] * ss) * sc; b[j] = (lo[j] * ss + hi[j] * cc) * sc; }
    if (n < 512) { st4bf(P.Q + (size_t)m * 512 + n, a); st4bf(P.Q + (size_t)m * 512 + n + 16, b); }
    else { st4bf(P.K + (size_t)m * 128 + (n - 512), a); st4bf(P.K + (size_t)m * 128 + (n - 512) + 16, b); }
}
__device__ __forceinline__ void epi_v4(const Params& P, int m, int dcol, const float* v, bool ctx) {
    const int kvh = dcol >> 6, dd = dcol & 63;
    if (!ctx) { const int b = m / SEQ, l = m % SEQ;
#pragma unroll
        for (int j = 0; j < 4; ++j) P.VT[((size_t)(b * 2 + kvh) * 64 + dd + j) * SEQ + l] = f2bf(v[j]);
    } else { const int b = m / CTXL, cpos = m % CTXL;
#pragma unroll
        for (int j = 0; j < 4; ++j) P.VcT[((size_t)(b * 2 + kvh) * 64 + dd + j) * CTXL + cpos] = f2bf(v[j]);
    }
}

template <int MODE> __global__ void __launch_bounds__(256) k_gemm_naive(Params P, const bf16_t* A, int lda, const bf16_t* Bt, int ldb, int M, int N, int K) {
    const int groups = N / 8;
    for (size_t idx = (size_t)blockIdx.x * 256 + threadIdx.x; idx < (size_t)M * groups; idx += (size_t)gridDim.x * 256) {
        const int m = (int)(idx / groups), g = (int)(idx % groups);
        int ncol[8];
        bool rope = false, vreg = false;
        if (MODE == MODE_INPROJ && g * 8 < 640) {
            rope = true; const int hb = g >> 3, sub = g & 7; const int dlo = (sub >> 2) * 32 + (sub & 3) * 4;
#pragma unroll
            for (int j = 0; j < 4; ++j) { ncol[j] = hb * 64 + dlo + j; ncol[4 + j] = hb * 64 + dlo + 16 + j; }
        } else {
#pragma unroll
            for (int j = 0; j < 8; ++j) ncol[j] = g * 8 + j;
            if (MODE == MODE_INPROJ && g * 8 < 768) vreg = true;
            if (MODE == MODE_CTXKV && g * 8 >= 128) vreg = true;
        }
        float acc[8];
#pragma unroll
        for (int j = 0; j < 8; ++j) acc[j] = 0.f;
        const bf16_t* ar = A + (size_t)m * lda;
        for (int k = 0; k < K; k += 8) {
            const u32x4 av = *(const u32x4*)(ar + k);
            float af[8] = { bf2f(av.x & 0xffff), bf2f(av.x >> 16), bf2f(av.y & 0xffff), bf2f(av.y >> 16), bf2f(av.z & 0xffff), bf2f(av.z >> 16), bf2f(av.w & 0xffff), bf2f(av.w >> 16) };
#pragma unroll
            for (int j = 0; j < 8; ++j) {
                const u32x4 bv = *(const u32x4*)(Bt + (size_t)ncol[j] * ldb + k);
                acc[j] += af[0] * bf2f(bv.x & 0xffff) + af[1] * bf2f(bv.x >> 16) + af[2] * bf2f(bv.y & 0xffff) + af[3] * bf2f(bv.y >> 16)
                        + af[4] * bf2f(bv.z & 0xffff) + af[5] * bf2f(bv.z >> 16) + af[6] * bf2f(bv.w & 0xffff) + af[7] * bf2f(bv.w >> 16);
            }
        }
        if (rope) epi_rope(P, m, ncol[0], acc, acc + 4);
        else if (vreg) {
            if (MODE == MODE_INPROJ) { epi_v4(P, m, ncol[0] - 640, acc, false); epi_v4(P, m, ncol[4] - 640, acc + 4, false); }
            else { epi_v4(P, m, ncol[0] - 128, acc, true); epi_v4(P, m, ncol[4] - 128, acc + 4, true); }
        } else epi8<MODE>(P, m, ncol[0], acc);
    }
}

__global__ void __launch_bounds__(64) k_attn_naive(Params P) {
    const int head = blockIdx.y, kvh = head >> 2;
    const int tok = blockIdx.x * 64 + threadIdx.x;
    const int b = tok / SEQ, l = tok % SEQ, qb = l >> 7;
    float q[64], o[64];
    {
        const bf16_t* qp = P.Q + (size_t)tok * 512 + head * 64;
#pragma unroll
        for (int d = 0; d < 64; d += 8) { const u32x4 v = *(const u32x4*)(qp + d);
            q[d] = bf2f(v.x & 0xffff); q[d + 1] = bf2f(v.x >> 16); q[d + 2] = bf2f(v.y & 0xffff); q[d + 3] = bf2f(v.y >> 16);
            q[d + 4] = bf2f(v.z & 0xffff); q[d + 5] = bf2f(v.z >> 16); q[d + 6] = bf2f(v.w & 0xffff); q[d + 7] = bf2f(v.w >> 16); }
    }
#pragma unroll
    for (int d = 0; d < 64; ++d) o[d] = 0.f;
    float mrun = P.sink[head], lrun = 1.f;
    for (int jj = 0; jj < 384 + 256; ++jj) {
        const bf16_t* kp; const bf16_t* vp; size_t vstride; bool valid;
        if (jj < 384) {
            const int kpos = (qb - 1) * 128 + jj;
            if (kpos < 0 || kpos >= SEQ) continue;
            int dlt = l - kpos; if (dlt < 0) dlt = -dlt;
            valid = dlt <= 128;
            kp = P.K + (size_t)(b * SEQ + kpos) * 128 + kvh * 64;
            vp = P.VT + (size_t)(b * 2 + kvh) * 64 * SEQ + kpos; vstride = SEQ;
        } else {
            const int cpos = jj - 384; valid = true;
            kp = P.Kc + (size_t)(b * CTXL + cpos) * 128 + kvh * 64;
            vp = P.VcT + (size_t)(b * 2 + kvh) * 64 * CTXL + cpos; vstride = CTXL;
        }
        float s = 0.f;
#pragma unroll
        for (int d = 0; d < 64; d += 8) { const u32x4 v = *(const u32x4*)(kp + d);
            s += q[d] * bf2f(v.x & 0xffff) + q[d + 1] * bf2f(v.x >> 16) + q[d + 2] * bf2f(v.y & 0xffff) + q[d + 3] * bf2f(v.y >> 16)
               + q[d + 4] * bf2f(v.z & 0xffff) + q[d + 5] * bf2f(v.z >> 16) + q[d + 6] * bf2f(v.w & 0xffff) + q[d + 7] * bf2f(v.w >> 16); }
        const float mn = valid ? fmaxf(mrun, s) : mrun;
        const float alpha = __expf(mrun - mn);
        const float p = valid ? __expf(s - mn) : 0.f;
        lrun = lrun * alpha + p; mrun = mn;
#pragma unroll
        for (int d = 0; d < 64; ++d) o[d] = o[d] * alpha + p * bf2f(vp[(size_t)d * vstride]);
    }
    const float inv = 1.f / lrun;
    bf16_t* op = P.AO + (size_t)tok * 512 + head * 64;
#pragma unroll
    for (int d = 0; d < 64; d += 8) { float t[8];
#pragma unroll
        for (int j = 0; j < 8; ++j) t[j] = o[d + j] * inv;
        st8bf(op + d, t); }
}

__global__ void __launch_bounds__(256) k_conv(Params P) {
    for (size_t idx = (size_t)blockIdx.x * 256 + threadIdx.x; idx < (size_t)NTOK * 64; idx += (size_t)gridDim.x * 256) {
        const int m = (int)(idx >> 6), c0 = (int)(idx & 63) * 8, l = m % SEQ;
        float cu[3][8];
#pragma unroll
        for (int t = 0; t < 3; ++t) {
            const int ll = l + t - 1;
            if (ll < 0 || ll >= SEQ) {
#pragma unroll
                for (int j = 0; j < 8; ++j) cu[t][j] = 0.f;
            } else {
                const u32x4 g = *(const u32x4*)(P.GC + (size_t)(m + t - 1) * 512 + c0), u = *(const u32x4*)(P.U + (size_t)(m + t - 1) * 512 + c0);
                cu[t][0] = bf2f(g.x & 0xffff) * bf2f(u.x & 0xffff); cu[t][1] = bf2f(g.x >> 16) * bf2f(u.x >> 16);
                cu[t][2] = bf2f(g.y & 0xffff) * bf2f(u.y & 0xffff); cu[t][3] = bf2f(g.y >> 16) * bf2f(u.y >> 16);
                cu[t][4] = bf2f(g.z & 0xffff) * bf2f(u.z & 0xffff); cu[t][5] = bf2f(g.z >> 16) * bf2f(u.z >> 16);
                cu[t][6] = bf2f(g.w & 0xffff) * bf2f(u.w & 0xffff); cu[t][7] = bf2f(g.w >> 16) * bf2f(u.w >> 16);
            }
        }
        const u32x4 gbv = *(const u32x4*)(P.GB + (size_t)m * 512 + c0);
        const float gb[8] = { bf2f(gbv.x & 0xffff), bf2f(gbv.x >> 16), bf2f(gbv.y & 0xffff), bf2f(gbv.y >> 16), bf2f(gbv.z & 0xffff), bf2f(gbv.z >> 16), bf2f(gbv.w & 0xffff), bf2f(gbv.w >> 16) };
        float o[8];
#pragma unroll
        for (int j = 0; j < 8; ++j) o[j] = gb[j] * (P.conv_w[c0 + j] * cu[0][j] + P.conv_w[512 + c0 + j] * cu[1][j] + P.conv_w[1024 + c0 + j] * cu[2][j]);
        st8bf(P.CA + (size_t)m * 512 + c0, o);
    }
}

__global__ void __launch_bounds__(64) k_scores_topk_naive(Params P) {
    __shared__ float sc[64][129];
    const int hp = blockIdx.y, t = blockIdx.x * 64 + threadIdx.x, lane = threadIdx.x;
    float q[128];
    {
        const bf16_t* qp = P.QH + (size_t)t * 2048 + hp * 128;
#pragma unroll
        for (int d = 0; d < 128; d += 8) { const u32x4 v = *(const u32x4*)(qp + d);
            q[d] = bf2f(v.x & 0xffff); q[d + 1] = bf2f(v.x >> 16); q[d + 2] = bf2f(v.y & 0xffff); q[d + 3] = bf2f(v.y >> 16);
            q[d + 4] = bf2f(v.z & 0xffff); q[d + 5] = bf2f(v.z >> 16); q[d + 6] = bf2f(v.w & 0xffff); q[d + 7] = bf2f(v.w >> 16); }
    }
    for (int n = 0; n < 128; ++n) {
        const bf16_t* kp = P.KeysB + (size_t)(hp * 128 + n) * 128;
        float s = 0.f;
#pragma unroll
        for (int d = 0; d < 128; d += 8) { const u32x4 v = *(const u32x4*)(kp + d);
            s += q[d] * bf2f(v.x & 0xffff) + q[d + 1] * bf2f(v.x >> 16) + q[d + 2] * bf2f(v.y & 0xffff) + q[d + 3] * bf2f(v.y >> 16)
               + q[d + 4] * bf2f(v.z & 0xffff) + q[d + 5] * bf2f(v.z >> 16) + q[d + 6] * bf2f(v.w & 0xffff) + q[d + 7] * bf2f(v.w >> 16); }
        sc[lane][n] = s;
    }
    float pv = 3.0e38f; int pi = -1;
    for (int r = 0; r < 16; ++r) {
        float bv = -3.0e38f; int bi = 1 << 20;
        for (int n = 0; n < 128; ++n) {
            const float v = sc[lane][n];
            const bool elig = (v < pv) || (v == pv && n > pi);
            const bool better = (v > bv) || (v == bv && n < bi);
            if (elig && better) { bv = v; bi = n; }
        }
        P.TKv[((size_t)t * 16 + hp) * 16 + r] = bv; P.TKi[((size_t)t * 16 + hp) * 16 + r] = bi;
        pv = bv; pi = bi;
    }
}
__global__ void __launch_bounds__(256) k_combine(Params P) {
    for (int idx = blockIdx.x * 256 + threadIdx.x; idx < NTOK * 8; idx += gridDim.x * 256) {
        const int t = idx >> 3, h = idx & 7;
        float av[16], bv[16]; int ai[16], bi[16];
        const size_t ba = ((size_t)t * 16 + h * 2) * 16, bb = ba + 16;
#pragma unroll
        for (int i = 0; i < 16; ++i) { av[i] = P.TKv[ba + i]; ai[i] = P.TKi[ba + i]; bv[i] = P.TKv[bb + i]; bi[i] = P.TKi[bb + i]; }
        float pv = 3.0e38f; int pp = -1;
        float best[16]; int bidx[16];
#pragma unroll
        for (int r = 0; r < 16; ++r) {
            float cv = -3.0e38f; int cp = 1 << 20, ce = 0;
#pragma unroll
            for (int i = 0; i < 16; ++i) {
#pragma unroll
                for (int j = 0; j < 16; ++j) {
                    if ((i + 1) * (j + 1) <= 16) {
                        const float v = av[i] + bv[j]; const int pos = i * 16 + j;
                        const bool elig = (v < pv) || (v == pv && pos > pp);
                        const bool better = (v > cv) || (v == cv && pos < cp);
                        if (elig && better) { cv = v; cp = pos; ce = ai[i] * 128 + bi[j]; }
                    }
                }
            }
            best[r] = cv; bidx[r] = ce; pv = cv; pp = cp;
        }
        float den = 0.f, e[16];
#pragma unroll
        for (int r = 0; r < 16; ++r) { e[r] = __expf(best[r] - best[0]); den += e[r]; }
        const float inv = 1.f / den;
#pragma unroll
        for (int r = 0; r < 16; ++r) { P.sel_idx[(size_t)t * 128 + h * 16 + r] = bidx[r]; P.sel_g[(size_t)t * 128 + h * 16 + r] = e[r] * inv; }
    }
}

__device__ __forceinline__ void unpack8(const u32x4 v, float* f) {
    f[0] = bf2f(v.x & 0xffff); f[1] = bf2f(v.x >> 16); f[2] = bf2f(v.y & 0xffff); f[3] = bf2f(v.y >> 16);
    f[4] = bf2f(v.z & 0xffff); f[5] = bf2f(v.z >> 16); f[6] = bf2f(v.w & 0xffff); f[7] = bf2f(v.w >> 16);
}
__global__ void __launch_bounds__(256) k_peer_final(Params P) {
    const int lane = threadIdx.x & 63, wid = threadIdx.x >> 6;
    for (int t = blockIdx.x * 4 + wid; t < NTOK; t += gridDim.x * 4) {
        const int b = t / SEQ;
        float h[16];
        { const bf16_t* hp = P.H2 + (size_t)t * DM; unpack8(*(const u32x4*)(hp + lane * 8), h); unpack8(*(const u32x4*)(hp + 512 + lane * 8), h + 8); }
        float acc[16];
#pragma unroll
        for (int j = 0; j < 16; ++j) acc[j] = 0.f;
        for (int k = 0; k < 128; ++k) {
            const int e = P.sel_idx[(size_t)t * 128 + k];
            const float g = P.sel_g[(size_t)t * 128 + k];
            float u[16];
            { const bf16_t* up = P.Ub + (size_t)e * DM; unpack8(*(const u32x4*)(up + lane * 8), u); unpack8(*(const u32x4*)(up + 512 + lane * 8), u + 8); }
            float d = 0.f;
#pragma unroll
            for (int j = 0; j < 16; ++j) d += u[j] * h[j];
            d = wave_sum(d);
            const float act = 0.5f * d * (1.f + erff(d * 0.70710678118654752f));
            const float w = g * act;
            float v[16];
            { const bf16_t* vp = P.Vb + (size_t)e * DM; unpack8(*(const u32x4*)(vp + lane * 8), v); unpack8(*(const u32x4*)(vp + 512 + lane * 8), v + 8); }
#pragma unroll
            for (int j = 0; j < 16; ++j) acc[j] += w * v[j];
        }
        float x2[16]; float ss = 0.f;
        const float* x1 = P.out + (size_t)t * DM; const float* g2 = P.mod + (size_t)b * NMOD + 5 * DM;
#pragma unroll
        for (int half = 0; half < 2; ++half) {
            const int d0 = half * 512 + lane * 8;
#pragma unroll
            for (int j = 0; j < 8; ++j) { const float v = x1[d0 + j] + g2[d0 + j] * acc[half * 8 + j]; x2[half * 8 + j] = v; ss += v * v; }
        }
        ss = wave_sum(ss);
        const float rstd = rsqrtf(ss * (1.f / DM) + 1e-6f);
        float* op = P.out + (size_t)t * DM;
#pragma unroll
        for (int half = 0; half < 2; ++half) {
            const int d0 = half * 512 + lane * 8;
#pragma unroll
            for (int j = 0; j < 8; ++j) op[d0 + j] = x2[half * 8 + j] * rstd * P.fg[d0 + j];
        }
    }
}

static size_t carve(size_t& off, size_t bytes) { const size_t o = off; off += (bytes + 255) & ~(size_t)255; return o; }

extern "C" void kernel_launch(void* const* d_in, const int* in_sizes, int n_in, void* d_out, int out_size, void* d_ws, size_t ws_size, hipStream_t stream) {
    Params P{};
    P.x = (const float*)d_in[0]; P.c = (const float*)d_in[1]; P.ctx = (const float*)d_in[2]; P.c_ctx = (const float*)d_in[3];
    P.w_mod = (const float*)d_in[4]; P.b_mod = (const float*)d_in[5]; P.n1 = (const float*)d_in[6]; P.n2 = (const float*)d_in[7];
    P.w_in = (const float*)d_in[8]; P.sink = (const float*)d_in[9]; P.conv_w = (const float*)d_in[10]; P.w_ao = (const float*)d_in[11];
    P.w_co = (const float*)d_in[12]; P.w_mix = (const float*)d_in[13]; P.pw_q = (const float*)d_in[14]; P.keys = (const float*)d_in[15];
    P.pu = (const float*)d_in[16]; P.pv = (const float*)d_in[17]; P.fg = (const float*)d_in[18];
    P.out = (float*)d_out;
    char* ws = (char*)d_ws; size_t off = 0;
    P.modp = (float*)(ws + carve(off, (size_t)8 * 17 * NMOD * 4));
    P.mod = (float*)(ws + carve(off, (size_t)17 * NMOD * 4));
    P.rope = (float*)(ws + carve(off, 3072 * 4));
    P.WinT = (bf16_t*)(ws + carve(off, (size_t)PROJW * DM * 2));
    P.WaoT = (bf16_t*)(ws + carve(off, (size_t)DM * 512 * 2));
    P.WcoT = (bf16_t*)(ws + carve(off, (size_t)DM * 512 * 2));
    P.WmixT = (bf16_t*)(ws + carve(off, (size_t)DM * DM * 2));
    P.PwqT = (bf16_t*)(ws + carve(off, (size_t)2048 * DM * 2));
    P.KeysB = (bf16_t*)(ws + carve(off, (size_t)16 * 128 * 128 * 2));
    P.Ub = (bf16_t*)(ws + carve(off, (size_t)NEXP * DM * 2));
    P.Vb = (bf16_t*)(ws + carve(off, (size_t)NEXP * DM * 2));
    P.HC = (bf16_t*)(ws + carve(off, (size_t)NCTX * DM * 2));
    const size_t regA = carve(off, (size_t)NTOK * DM * 2);
    P.H = (bf16_t*)(ws + regA); P.YG = (bf16_t*)(ws + regA); P.H2 = (bf16_t*)(ws + regA);
    const size_t regB = off;
    P.Q = (bf16_t*)(ws + carve(off, (size_t)NTOK * 512 * 2));
    P.K = (bf16_t*)(ws + carve(off, (size_t)NTOK * 128 * 2));
    P.VT = (bf16_t*)(ws + carve(off, (size_t)NTOK * 128 * 2));
    P.Kc = (bf16_t*)(ws + carve(off, (size_t)NCTX * 128 * 2));
    P.VcT = (bf16_t*)(ws + carve(off, (size_t)NCTX * 128 * 2));
    const size_t regC = off;
    P.GB = (bf16_t*)(ws + carve(off, (size_t)NTOK * 512 * 2));
    P.GC = (bf16_t*)(ws + carve(off, (size_t)NTOK * 512 * 2));
    P.U = (bf16_t*)(ws + carve(off, (size_t)NTOK * 512 * 2));
    P.M1 = (bf16_t*)(ws + regC);
    const size_t regD = off;
    P.GA = (bf16_t*)(ws + carve(off, (size_t)NTOK * DM * 2));
    P.GV = (bf16_t*)(ws + carve(off, (size_t)NTOK * DM * 2));
    P.AO = (bf16_t*)(ws + carve(off, (size_t)NTOK * 512 * 2));
    P.CA = (bf16_t*)(ws + carve(off, (size_t)NTOK * 512 * 2));
    const size_t need = off;
    P.QH = (bf16_t*)(ws + regD);
    { size_t o2 = regB;
      P.TKv = (float*)(ws + carve(o2, (size_t)NTOK * 256 * 4));
      P.TKi = (int*)(ws + carve(o2, (size_t)NTOK * 256 * 4));
      P.sel_idx = (int*)(ws + carve(o2, (size_t)NTOK * 128 * 4));
      P.sel_g = (float*)(ws + carve(o2, (size_t)NTOK * 128 * 4));
      if (o2 > regD) { fprintf(stderr, "kernel_launch: late buffers overflow\n"); return; } }
    if (need > ws_size) { fprintf(stderr, "kernel_launch: workspace too small: need %zu have %zu\n", need, ws_size); return; }

    const int G = 2048;
    k_modp<<<192, 256, 0, stream>>>(P);
    k_modfinal<<<408, 256, 0, stream>>>(P);
    k_rope<<<6, 256, 0, stream>>>(P);
    k_transpose<<<G, 256, 0, stream>>>(P.w_in, DM, PROJW, P.WinT);
    k_transpose<<<G, 256, 0, stream>>>(P.w_ao, 512, DM, P.WaoT);
    k_transpose<<<G, 256, 0, stream>>>(P.w_co, 512, DM, P.WcoT);
    k_transpose<<<G, 256, 0, stream>>>(P.w_mix, DM, DM, P.WmixT);
    k_transpose<<<G, 256, 0, stream>>>(P.pw_q, DM, 2048, P.PwqT);
    k_cvt<<<G, 256, 0, stream>>>(P.keys, P.KeysB, (size_t)16 * 128 * 128 / 8);
    k_cvt<<<G, 256, 0, stream>>>(P.pu, P.Ub, (size_t)NEXP * DM / 8);
    k_cvt<<<G, 256, 0, stream>>>(P.pv, P.Vb, (size_t)NEXP * DM / 8);
    k_norm<<<G, 256, 0, stream>>>(P, 0);
    k_norm<<<G, 256, 0, stream>>>(P, 1);
    k_gemm_naive<MODE_INPROJ><<<4096, 256, 0, stream>>>(P, P.H, DM, P.WinT, DM, NTOK, PROJW, DM);
    k_gemm_naive<MODE_CTXKV><<<1024, 256, 0, stream>>>(P, P.HC, DM, P.WinT + (size_t)512 * DM, DM, NCTX, 256, DM);
    k_attn_naive<<<dim3(NTOK / 64, 8), 64, 0, stream>>>(P);
    k_conv<<<G, 256, 0, stream>>>(P);
    k_gemm_naive<MODE_AO1><<<4096, 256, 0, stream>>>(P, P.AO, 512, P.WaoT, 512, NTOK, DM, 512);
    k_gemm_naive<MODE_CO2><<<4096, 256, 0, stream>>>(P, P.CA, 512, P.WcoT, 512, NTOK, DM, 512);
    k_gemm_naive<MODE_MIX><<<4096, 256, 0, stream>>>(P, P.YG, DM, P.WmixT, DM, NTOK, DM, DM);
    k_norm<<<G, 256, 0, stream>>>(P, 2);
    k_gemm_naive<MODE_QH><<<4096, 256, 0, stream>>>(P, P.H2, DM, P.PwqT, DM, NTOK, 2048, DM);
    k_scores_topk_naive<<<dim3(NTOK / 64, 16), 64, 0, stream>>>(P);
    k_combine<<<1024, 256, 0, stream>>>(P);
    k_peer_final<<<G, 256, 0, stream>>>(P);
}
```

```cpp
#include <hip/hip_runtime.h>
#include <cstdio>
#include <cstdint>
#include <hip/hip_cooperative_groups.h>
namespace cg = cooperative_groups;

typedef unsigned short bf16_t;
typedef short bf16x8 __attribute__((ext_vector_type(8)));
typedef float f32x4 __attribute__((ext_vector_type(4)));
typedef unsigned u32x4 __attribute__((ext_vector_type(4)));
typedef unsigned u32x2 __attribute__((ext_vector_type(2)));

constexpr int DM = 1024, NB = 16, SEQ = 2048, NTOK = NB * SEQ, CTXL = 256, NCTX = NB * CTXL;
constexpr int PROJW = 4352;
constexpr int NMOD = 6 * DM;
constexpr int NEXP = 16384;

__device__ __forceinline__ float bf2f(bf16_t x) { return __uint_as_float(((unsigned)x) << 16); }
__device__ __forceinline__ bf16_t f2bf(float f) {
    unsigned u = __float_as_uint(f);
    u += 0x7fffu + ((u >> 16) & 1u);
    return (bf16_t)(u >> 16);
}
__device__ __forceinline__ unsigned pk2(float lo, float hi) { return (unsigned)f2bf(lo) | ((unsigned)f2bf(hi) << 16); }
__device__ __forceinline__ float sigmoidf_(float x) { return 1.f / (1.f + __expf(-x)); }
__device__ __forceinline__ float wave_sum(float v) {
#pragma unroll
    for (int o = 1; o < 64; o <<= 1) v += __shfl_xor(v, o);
    return v;
}

struct Params {
    const float *x, *c, *ctx, *c_ctx, *w_mod, *b_mod, *n1, *n2, *w_in, *sink, *conv_w, *w_ao, *w_co, *w_mix, *pw_q, *keys, *pu, *pv, *fg;
    float* out;
    float *modp, *mod, *rope;
    bf16_t *WinT, *WaoT, *WcoT, *WmixT, *PwqT, *KeysB, *Ub, *Vb;
    bf16_t *H, *HC, *Q, *K, *VT, *Kc, *VcT, *GB, *GC, *U, *GA, *GV, *AO, *CA, *M1, *YG, *H2, *QH;
    float* TKv; int* TKi;
    int* sel_idx; float* sel_g;
};

__device__ __forceinline__ void modp_item(const Params& P, int item, char* smem) {
    float (*s)[128] = (float (*)[128])smem;
    const int kc = item / 24, nc = item % 24;
    __syncthreads();
    for (int i = threadIdx.x; i < 17 * 128; i += 256) {
        const int r = i / 128, k = i % 128;
        const float v = (r < 16) ? P.c[r * DM + kc * 128 + k] : P.c_ctx[kc * 128 + k];
        s[r][k] = v / (1.f + __expf(-v));
    }
    __syncthreads();
    const int n = nc * 256 + threadIdx.x;
    float acc[17];
#pragma unroll
    for (int r = 0; r < 17; ++r) acc[r] = 0.f;
    for (int k = 0; k < 128; ++k) {
        const float w = P.w_mod[(size_t)(kc * 128 + k) * NMOD + n];
#pragma unroll
        for (int r = 0; r < 17; ++r) acc[r] += s[r][k] * w;
    }
#pragma unroll
    for (int r = 0; r < 17; ++r) P.modp[((size_t)kc * 17 + r) * NMOD + n] = acc[r];
}
__device__ __forceinline__ void cvt_range(const float* src, bf16_t* dst, size_t n8, size_t gtid, size_t gsize) {
    for (size_t i = gtid; i < n8; i += gsize) {
        const f32x4 a = *(const f32x4*)(src + i * 8), b = *(const f32x4*)(src + i * 8 + 4);
        u32x4 o; o.x = pk2(a.x, a.y); o.y = pk2(a.z, a.w); o.z = pk2(b.x, b.y); o.w = pk2(b.z, b.w);
        *(u32x4*)(dst + i * 8) = o;
    }
}
__device__ __forceinline__ void rope_tab(const Params& P, int gtid, int gsize) {
    for (int i = gtid; i < 1536; i += gsize) {
        int pos, f; bool isc;
        if (i < 512) { pos = i / 16; f = i % 16; isc = false; } else { pos = (i - 512) / 16; f = (i - 512) % 16; isc = true; }
        const double inv = pow(10000.0, -(double)f / 16.0);
        const double ang = (double)pos * inv;
        const float cv = (float)cos(ang), sv = (float)sin(ang);
        if (!isc) { P.rope[pos * 16 + f] = cv; P.rope[512 + pos * 16 + f] = sv; }
        else { P.rope[1024 + pos * 16 + f] = cv; P.rope[2048 + pos * 16 + f] = sv; }
    }
}
__device__ __forceinline__ void transpose_tile(const float* W, int K, int N, bf16_t* Wt, int item, float (*tile)[65]) {
    const int ntn = N / 64, kt = item / ntn, nt = item % ntn, k0 = kt * 64, n0 = nt * 64;
    const int tx = threadIdx.x & 63, ty = threadIdx.x >> 6;
    __syncthreads();
#pragma unroll
    for (int i = 0; i < 16; ++i) { const int k = i * 4 + ty; tile[k][tx] = W[(size_t)(k0 + k) * N + n0 + tx]; }
    __syncthreads();
#pragma unroll
    for (int i = 0; i < 16; ++i) { const int n = i * 4 + ty; Wt[(size_t)(n0 + n) * K + k0 + tx] = f2bf(tile[tx][n]); }
}

__device__ __forceinline__ void norm_row(const float* xr, const float* g, const float* scale, const float* shift, bf16_t* dst, int lane) {
    f32x4 v[4]; float s = 0.f;
#pragma unroll
    for (int j = 0; j < 4; ++j) { v[j] = *(const f32x4*)(xr + j * 256 + lane * 4); s += v[j].x * v[j].x + v[j].y * v[j].y + v[j].z * v[j].z + v[j].w * v[j].w; }
    s = wave_sum(s);
    const float rstd = rsqrtf(s * (1.f / DM) + 1e-6f);
#pragma unroll
    for (int j = 0; j < 4; ++j) {
        const int d = j * 256 + lane * 4;
        const f32x4 gg = *(const f32x4*)(g + d), sc = *(const f32x4*)(scale + d), sh = *(const f32x4*)(shift + d);
        const float y0 = v[j].x * rstd * gg.x * (1.f + sc.x) + sh.x;
        const float y1 = v[j].y * rstd * gg.y * (1.f + sc.y) + sh.y;
        const float y2 = v[j].z * rstd * gg.z * (1.f + sc.z) + sh.z;
        const float y3 = v[j].w * rstd * gg.w * (1.f + sc.w) + sh.w;
        u32x2 o; o.x = pk2(y0, y1); o.y = pk2(y2, y3);
        *(u32x2*)(dst + d) = o;
    }
}

__device__ __forceinline__ void norm1_item(const Params& P, int item, char* smem) {
    float* sc = (float*)smem; float* sh = sc + DM;
    const bool isctx = item >= 1024;
    const int row0 = isctx ? (item - 1024) * 32 : item * 32;
    const int r = isctx ? 16 : row0 / SEQ;
    __syncthreads();
    for (int d = threadIdx.x; d < DM; d += 256) {
        float a = P.b_mod[DM + d], b = P.b_mod[d];
#pragma unroll
        for (int kc = 0; kc < 8; ++kc) { a += P.modp[((size_t)kc * 17 + r) * NMOD + DM + d]; b += P.modp[((size_t)kc * 17 + r) * NMOD + d]; }
        sc[d] = a; sh[d] = b;
    }
    __syncthreads();
    const int lane = threadIdx.x & 63, wid = threadIdx.x >> 6;
    for (int i = wid; i < 32; i += 4) {
        const int row = row0 + i;
        if (!isctx) norm_row(P.x + (size_t)row * DM, P.n1, sc, sh, P.H + (size_t)row * DM, lane);
        else norm_row(P.ctx + (size_t)row * DM, P.n1, sc, sh, P.HC + (size_t)row * DM, lane);
    }
}
enum { MODE_INPROJ = 0, MODE_CTXKV = 1, MODE_AO1 = 2, MODE_CO2 = 3, MODE_MIX = 4, MODE_QH = 5 };

__device__ __forceinline__ void st8bf(bf16_t* p, const float* v) {
    u32x4 o; o.x = pk2(v[0], v[1]); o.y = pk2(v[2], v[3]); o.z = pk2(v[4], v[5]); o.w = pk2(v[6], v[7]);
    *(u32x4*)p = o;
}
__device__ __forceinline__ void st4bf(bf16_t* p, const float* v) {
    u32x2 o; o.x = pk2(v[0], v[1]); o.y = pk2(v[2], v[3]);
    *(u32x2*)p = o;
}
template <int MODE> __device__ __forceinline__ void epi8(const Params& P, int m, int n, const float* v) {
    if (MODE == MODE_INPROJ) {
        if (n < 1280) st8bf(P.GB + (size_t)m * 512 + (n - 768), v);
        else if (n < 1792) st8bf(P.GC + (size_t)m * 512 + (n - 1280), v);
        else if (n < 2304) st8bf(P.U + (size_t)m * 512 + (n - 1792), v);
        else {
            float s[8];
#pragma unroll
            for (int j = 0; j < 8; ++j) s[j] = sigmoidf_(v[j]);
            if (n < 3328) st8bf(P.GA + (size_t)m * DM + (n - 2304), s);
            else st8bf(P.GV + (size_t)m * DM + (n - 3328), s);
        }
    } else if (MODE == MODE_CTXKV) {
        st8bf(P.Kc + (size_t)m * 128 + n, v);
    } else if (MODE == MODE_AO1) {
        const u32x4 g = *(const u32x4*)(P.GA + (size_t)m * DM + n);
        float o[8];
        o[0] = v[0] * bf2f(g.x & 0xffff); o[1] = v[1] * bf2f(g.x >> 16); o[2] = v[2] * bf2f(g.y & 0xffff); o[3] = v[3] * bf2f(g.y >> 16);
        o[4] = v[4] * bf2f(g.z & 0xffff); o[5] = v[5] * bf2f(g.z >> 16); o[6] = v[6] * bf2f(g.w & 0xffff); o[7] = v[7] * bf2f(g.w >> 16);
        st8bf(P.M1 + (size_t)m * DM + n, o);
    } else if (MODE == MODE_CO2) {
        const u32x4 g = *(const u32x4*)(P.GV + (size_t)m * DM + n);
        const u32x4 a = *(const u32x4*)(P.M1 + (size_t)m * DM + n);
        float o[8];
        o[0] = bf2f(a.x & 0xffff) + v[0] * bf2f(g.x & 0xffff); o[1] = bf2f(a.x >> 16) + v[1] * bf2f(g.x >> 16);
        o[2] = bf2f(a.y & 0xffff) + v[2] * bf2f(g.y & 0xffff); o[3] = bf2f(a.y >> 16) + v[3] * bf2f(g.y >> 16);
        o[4] = bf2f(a.z & 0xffff) + v[4] * bf2f(g.z & 0xffff); o[5] = bf2f(a.z >> 16) + v[5] * bf2f(g.z >> 16);
        o[6] = bf2f(a.w & 0xffff) + v[6] * bf2f(g.w & 0xffff); o[7] = bf2f(a.w >> 16) + v[7] * bf2f(g.w >> 16);
        st8bf(P.YG + (size_t)m * DM + n, o);
    } else if (MODE == MODE_MIX) {
        const int b = m / SEQ;
        const float* g1 = P.mod + (size_t)b * NMOD + 2 * DM + n;
        const float* xr = P.x + (size_t)m * DM + n;
        float* o = P.out + (size_t)m * DM + n;
        const f32x4 x0 = *(const f32x4*)xr, x1 = *(const f32x4*)(xr + 4), g0 = *(const f32x4*)g1, g1v = *(const f32x4*)(g1 + 4);
        f32x4 o0, o1;
        o0.x = x0.x + g0.x * v[0]; o0.y = x0.y + g0.y * v[1]; o0.z = x0.z + g0.z * v[2]; o0.w = x0.w + g0.w * v[3];
        o1.x = x1.x + g1v.x * v[4]; o1.y = x1.y + g1v.y * v[5]; o1.z = x1.z + g1v.z * v[6]; o1.w = x1.w + g1v.w * v[7];
        *(f32x4*)o = o0; *(f32x4*)(o + 4) = o1;
    } else if (MODE == MODE_QH) {
        st8bf(P.QH + (size_t)m * 2048 + n, v);
    }
}
__device__ __forceinline__ void epi_rope(const Params& P, int m, int n, const float* lo, const float* hi) {
    const int d0 = n & 63;
    const int l = m % SEQ;
    const float *ct, *st;
    if (d0 < 16) { const int row = l >> 6; ct = P.rope + row * 16 + d0; st = P.rope + 512 + row * 16 + d0; }
    else { const int col = l & 63; ct = P.rope + 1024 + col * 16 + (d0 - 32); st = P.rope + 2048 + col * 16 + (d0 - 32); }
    float a[4], b[4];
    const float sc = (n < 512) ? 0.125f : 1.f;
#pragma unroll
    for (int j = 0; j < 4; ++j) { const float cc = ct[j], ss = st[j]; a[j] = (lo[j] * cc - hi[j] * ss) * sc; b[j] = (lo[j] * ss + hi[j] * cc) * sc; }
    if (n < 512) { st4bf(P.Q + (size_t)m * 512 + n, a); st4bf(P.Q + (size_t)m * 512 + n + 16, b); }
    else { st4bf(P.K + (size_t)m * 128 + (n - 512), a); st4bf(P.K + (size_t)m * 128 + (n - 512) + 16, b); }
}
__device__ __forceinline__ void epi_v4(const Params& P, int m, int dcol, const float* v, bool ctx) {
    const int kvh = dcol >> 6, dd = dcol & 63;
    if (!ctx) { const int b = m / SEQ, l = m % SEQ;
#pragma unroll
        for (int j = 0; j < 4; ++j) P.VT[((size_t)(b * 2 + kvh) * 64 + dd + j) * SEQ + l] = f2bf(v[j]);
    } else { const int b = m / CTXL, cpos = m % CTXL;
#pragma unroll
        for (int j = 0; j < 4; ++j) P.VcT[((size_t)(b * 2 + kvh) * 64 + dd + j) * CTXL + cpos] = f2bf(v[j]);
    }
}

constexpr int GEMM_LDS = 65536;
constexpr int RETR_LDS = 128 * 130 * 4;
__device__ __forceinline__ int lds_off(int row, int chunk) { return row * 128 + ((chunk ^ ((row >> 1) & 7)) << 4); }

__device__ __forceinline__ void mma_from_lds(const char* As, const char* Bs, f32x4 (&acc)[4][4], int wm, int wn, int fr, int fq, int sw) {
#pragma unroll
    for (int ks = 0; ks < 2; ++ks) {
        bf16x8 af[4], bfr[4];
        const int coff = ((ks * 4 + fq) ^ sw) << 4;
#pragma unroll
        for (int mt = 0; mt < 4; ++mt) af[mt] = *(const bf16x8*)(As + (wm * 64 + mt * 16 + fr) * 128 + coff);
#pragma unroll
        for (int nt = 0; nt < 4; ++nt) bfr[nt] = *(const bf16x8*)(Bs + (wn * 64 + nt * 16 + fr) * 128 + coff);
#pragma unroll
        for (int mt = 0; mt < 4; ++mt)
#pragma unroll
            for (int nt = 0; nt < 4; ++nt) acc[mt][nt] = __builtin_amdgcn_mfma_f32_16x16x32_bf16(bfr[nt], af[mt], acc[mt][nt], 0, 0, 0);
    }
}
__device__ __forceinline__ void gemm_mainloop(const bf16_t* __restrict__ A, int lda, const bf16_t* __restrict__ Bt, int ldb, int K, int m0, int n0, bool perm, char* smem, f32x4 (&acc)[4][4]) {
    const int tid = threadIdx.x, lane = tid & 63, wid = tid >> 6;
    const int wm = wid >> 1, wn = wid & 1, fr = lane & 15, fq = lane >> 4;
    const int srow = tid >> 3, schunk = tid & 7;
    const bf16_t* ag[4]; const bf16_t* bg[4]; int soff[4];
#pragma unroll
    for (int p = 0; p < 4; ++p) {
        const int row = p * 32 + srow;
        ag[p] = A + (size_t)(m0 + row) * lda + schunk * 8;
        int brow = row;
        if (perm) { const int g = row >> 5, rr = row & 31, nn = rr >> 4, i = rr & 15; brow = 32 * g + 8 * (i >> 2) + 4 * nn + (i & 3); }
        bg[p] = Bt + (size_t)(n0 + brow) * ldb + schunk * 8;
        soff[p] = lds_off(row, schunk);
    }
#pragma unroll
    for (int i = 0; i < 4; ++i)
#pragma unroll
        for (int j = 0; j < 4; ++j) acc[i][j] = (f32x4){0.f, 0.f, 0.f, 0.f};
    u32x4 ra[4], rb[4];
#pragma unroll
    for (int p = 0; p < 4; ++p) { ra[p] = *(const u32x4*)(ag[p]); rb[p] = *(const u32x4*)(bg[p]); }
#pragma unroll
    for (int p = 0; p < 4; ++p) { *(u32x4*)(smem + soff[p]) = ra[p]; *(u32x4*)(smem + 16384 + soff[p]) = rb[p]; }
    __syncthreads();
    const int nk = K / 64;
    const int sw = (fr >> 1) & 7;
    for (int kt = 0; kt < nk; ++kt) {
        const int cur = kt & 1;
        if (kt + 1 < nk) {
            const int k0 = (kt + 1) * 64;
#pragma unroll
            for (int p = 0; p < 4; ++p) { ra[p] = *(const u32x4*)(ag[p] + k0); rb[p] = *(const u32x4*)(bg[p] + k0); }
        }
        mma_from_lds(smem + cur * 32768, smem + cur * 32768 + 16384, acc, wm, wn, fr, fq, sw);
        if (kt + 1 < nk) {
            char* dst = smem + (cur ^ 1) * 32768;
#pragma unroll
            for (int p = 0; p < 4; ++p) { *(u32x4*)(dst + soff[p]) = ra[p]; *(u32x4*)(dst + 16384 + soff[p]) = rb[p]; }
        }
        __syncthreads();
    }
}
template <int MODE>
__device__ __forceinline__ void gemm_tile(const Params& P, const bf16_t* __restrict__ A, int lda, const bf16_t* __restrict__ Bt, int ldb, int K, int m0, int n0, bool perm, char* smem) {
    const int lane = threadIdx.x & 63, wid = threadIdx.x >> 6;
    const int wm = wid >> 1, wn = wid & 1, fr = lane & 15, fq = lane >> 4;
    f32x4 acc[4][4];
    gemm_mainloop(A, lda, Bt, ldb, K, m0, n0, perm, smem, acc);
#pragma unroll
    for (int mt = 0; mt < 4; ++mt) {
        const int m = m0 + wm * 64 + mt * 16 + fr;
        if (perm) {
#pragma unroll
            for (int p = 0; p < 2; ++p) {
                float v[8] = { acc[mt][2 * p][0], acc[mt][2 * p][1], acc[mt][2 * p][2], acc[mt][2 * p][3], acc[mt][2 * p + 1][0], acc[mt][2 * p + 1][1], acc[mt][2 * p + 1][2], acc[mt][2 * p + 1][3] };
                epi8<MODE>(P, m, n0 + wn * 64 + 32 * p + 8 * fq, v);
            }
        } else if (MODE == MODE_INPROJ && n0 < 640) {
#pragma unroll
            for (int p = 0; p < 2; ++p) {
                float lo[4] = { acc[mt][2 * p][0], acc[mt][2 * p][1], acc[mt][2 * p][2], acc[mt][2 * p][3] };
                float hi[4] = { acc[mt][2 * p + 1][0], acc[mt][2 * p + 1][1], acc[mt][2 * p + 1][2], acc[mt][2 * p + 1][3] };
                epi_rope(P, m, n0 + wn * 64 + 32 * p + 4 * fq, lo, hi);
            }
        } else if (MODE == MODE_INPROJ || MODE == MODE_CTXKV) {
            const int dbase = (MODE == MODE_INPROJ) ? (n0 - 640) : (n0 - 128);
#pragma unroll
            for (int nt = 0; nt < 4; ++nt) {
                float v[4] = { acc[mt][nt][0], acc[mt][nt][1], acc[mt][nt][2], acc[mt][nt][3] };
                epi_v4(P, m, dbase + wn * 64 + 16 * nt + 4 * fq, v, MODE == MODE_CTXKV);
            }
        }
    }
}
__device__ __forceinline__ void tile_coords(int t, int ntm, int ntn, int& mt, int& nt) {
    const int per = 8 * ntn, g = t / per, r = t % per;
    mt = g * 8 + (r & 7); nt = r >> 3;
}
#define CEU(a, b) { const unsigned _t = (a) > (b) ? (a) : (b); (b) = (a) > (b) ? (b) : (a); (a) = _t; }
__device__ __forceinline__ void sort16_desc(unsigned (&v)[16]) {
    CEU(v[0], v[1]); CEU(v[2], v[3]); CEU(v[0], v[2]); CEU(v[1], v[3]); CEU(v[1], v[2]); CEU(v[4], v[5]);
    CEU(v[6], v[7]); CEU(v[4], v[6]); CEU(v[5], v[7]); CEU(v[5], v[6]); CEU(v[0], v[4]); CEU(v[2], v[6]);
    CEU(v[2], v[4]); CEU(v[1], v[5]); CEU(v[3], v[7]); CEU(v[3], v[5]); CEU(v[1], v[2]); CEU(v[3], v[4]);
    CEU(v[5], v[6]); CEU(v[8], v[9]); CEU(v[10], v[11]); CEU(v[8], v[10]); CEU(v[9], v[11]); CEU(v[9], v[10]);
    CEU(v[12], v[13]); CEU(v[14], v[15]); CEU(v[12], v[14]); CEU(v[13], v[15]); CEU(v[13], v[14]); CEU(v[8], v[12]);
    CEU(v[10], v[14]); CEU(v[10], v[12]); CEU(v[9], v[13]); CEU(v[11], v[15]); CEU(v[11], v[13]); CEU(v[9], v[10]);
    CEU(v[11], v[12]); CEU(v[13], v[14]); CEU(v[0], v[8]); CEU(v[4], v[12]); CEU(v[4], v[8]); CEU(v[2], v[10]);
    CEU(v[6], v[14]); CEU(v[6], v[10]); CEU(v[2], v[4]); CEU(v[6], v[8]); CEU(v[10], v[12]); CEU(v[1], v[9]);
    CEU(v[5], v[13]); CEU(v[5], v[9]); CEU(v[3], v[11]); CEU(v[7], v[15]); CEU(v[7], v[11]); CEU(v[3], v[5]);
    CEU(v[7], v[9]); CEU(v[11], v[13]); CEU(v[1], v[2]); CEU(v[3], v[4]); CEU(v[5], v[6]); CEU(v[7], v[8]);
    CEU(v[9], v[10]); CEU(v[11], v[12]); CEU(v[13], v[14]);
}
__device__ __forceinline__ void bitonic16_desc(unsigned (&v)[16]) {
    CEU(v[0], v[8]); CEU(v[1], v[9]); CEU(v[2], v[10]); CEU(v[3], v[11]); CEU(v[4], v[12]); CEU(v[5], v[13]);
    CEU(v[6], v[14]); CEU(v[7], v[15]); CEU(v[0], v[4]); CEU(v[1], v[5]); CEU(v[2], v[6]); CEU(v[3], v[7]);
    CEU(v[8], v[12]); CEU(v[9], v[13]); CEU(v[10], v[14]); CEU(v[11], v[15]); CEU(v[0], v[2]); CEU(v[1], v[3]);
    CEU(v[4], v[6]); CEU(v[5], v[7]); CEU(v[8], v[10]); CEU(v[9], v[11]); CEU(v[12], v[14]); CEU(v[13], v[15]);
    CEU(v[0], v[1]); CEU(v[2], v[3]); CEU(v[4], v[5]); CEU(v[6], v[7]); CEU(v[8], v[9]); CEU(v[10], v[11]);
    CEU(v[12], v[13]); CEU(v[14], v[15]);
}

__device__ __forceinline__ unsigned enc_key(float f) { const unsigned b = __float_as_uint(f); return b ^ ((unsigned)((int)b >> 31) | 0x80000000u); }
__device__ __forceinline__ float dec_key(unsigned k) { const unsigned b = (k & 0x80000000u) ? (k & 0x7fffffffu) : ~k; return __uint_as_float(b); }
__device__ __forceinline__ void topmerge16(unsigned (&top)[16], const unsigned (&L)[16]) {
#pragma unroll
    for (int i = 0; i < 16; ++i) top[i] = top[i] > L[15 - i] ? top[i] : L[15 - i];
    bitonic16_desc(top);
}
__device__ __forceinline__ unsigned cand_key(float a, float b, int i, int j) { return (enc_key(a + b) & ~0xFFu) | (unsigned)(i << 4) | (unsigned)j; }

__device__ __forceinline__ void peer_retrieve_item(const Params& P, int mtile, int h, char* smem) {
    const int tid = threadIdx.x, lane = tid & 63, wid = tid >> 6;
    const int wm = wid >> 1, wn = wid & 1, fr = lane & 15, fq = lane >> 4;
    const int sw = (fr >> 1) & 7;
    const int m0 = mtile * 128;
    unsigned T0[16], T1[16];
#pragma unroll 1
    for (int p = 0; p < 2; ++p) {
        const int hp = h * 2 + p;
        f32x4 acc[4][4];
        gemm_mainloop(P.H2, DM, P.PwqT, DM, DM, m0, hp * 128, false, smem, acc);
#pragma unroll
        for (int mt = 0; mt < 4; ++mt)
#pragma unroll
            for (int nt = 0; nt < 4; ++nt) {
                const int row = wm * 64 + mt * 16 + fr;
                u32x2 o; o.x = pk2(acc[mt][nt][0], acc[mt][nt][1]); o.y = pk2(acc[mt][nt][2], acc[mt][nt][3]);
                *(u32x2*)(smem + wn * 32768 + lds_off(row, 2 * nt + (fq >> 1)) + (fq & 1) * 8) = o;
            }
        {
            const int srow = tid >> 3, schunk = tid & 7;
            const bf16_t* kb = P.KeysB + (size_t)hp * 128 * 128;
#pragma unroll
            for (int hf = 0; hf < 2; ++hf)
#pragma unroll
                for (int q = 0; q < 4; ++q) {
                    const int row = q * 32 + srow;
                    const u32x4 v = *(const u32x4*)(kb + (size_t)row * 128 + hf * 64 + schunk * 8);
                    *(u32x4*)(smem + hf * 32768 + 16384 + lds_off(row, schunk)) = v;
                }
        }
        __syncthreads();
#pragma unroll
        for (int i = 0; i < 4; ++i)
#pragma unroll
            for (int j = 0; j < 4; ++j) acc[i][j] = (f32x4){0.f, 0.f, 0.f, 0.f};
        mma_from_lds(smem, smem + 16384, acc, wm, wn, fr, fq, sw);
        mma_from_lds(smem + 32768, smem + 32768 + 16384, acc, wm, wn, fr, fq, sw);
        __syncthreads();
        float* sc = (float*)smem;
#pragma unroll
        for (int mt = 0; mt < 4; ++mt)
#pragma unroll
            for (int nt = 0; nt < 4; ++nt) {
                const int row = wm * 64 + mt * 16 + fr;
#pragma unroll
                for (int r = 0; r < 4; ++r) {
                    const int col = wn * 64 + nt * 16 + fq * 4 + r;
                    sc[row * 130 + wn * 65 + (col & 63)] = acc[mt][nt][r];
                }
            }
        __syncthreads();
        {
            const int row = tid >> 1, half = tid & 1;
            const float* rp = sc + row * 130 + half * 65;
            unsigned top[16];
#pragma unroll
            for (int g = 0; g < 4; ++g) {
                unsigned L[16];
#pragma unroll
                for (int j = 0; j < 16; ++j) { const int col = half * 64 + g * 16 + j; L[j] = (enc_key(rp[g * 16 + j]) & ~0x7Fu) | (unsigned)col; }
                sort16_desc(L);
                if (g == 0) {
#pragma unroll
                    for (int j = 0; j < 16; ++j) top[j] = L[j];
                } else topmerge16(top, L);
            }
            unsigned Bp[16];
#pragma unroll
            for (int j = 0; j < 16; ++j) Bp[j] = (unsigned)__shfl_xor((int)top[j], 1);
            topmerge16(top, Bp);
            if (p == 0) {
#pragma unroll
                for (int j = 0; j < 16; ++j) T0[j] = top[j];
            } else {
#pragma unroll
                for (int j = 0; j < 16; ++j) T1[j] = top[j];
            }
        }
        __syncthreads();
    }
    {
        const int row = tid >> 1;
        unsigned char* slot = (unsigned char*)smem + row * 32;
        if ((tid & 1) == 0) {
#pragma unroll
            for (int j = 0; j < 16; ++j) { slot[j] = (unsigned char)(T0[j] & 0x7Fu); slot[16 + j] = (unsigned char)(T1[j] & 0x7Fu); }
            float a[16], b[16];
#pragma unroll
            for (int j = 0; j < 16; ++j) { a[j] = dec_key(T0[j]); b[j] = dec_key(T1[j]); }
            unsigned LA[16], LB[16], LC[16];
#pragma unroll
            for (int j = 0; j < 16; ++j) LA[j] = cand_key(a[0], b[j], 0, j);
#pragma unroll
            for (int j = 0; j < 8; ++j) LB[j] = cand_key(a[1], b[j], 1, j);
#pragma unroll
            for (int j = 0; j < 8; ++j) LB[8 + j] = cand_key(a[15 - j], b[0], 15 - j, 0);
            LC[0] = cand_key(a[2], b[0], 2, 0); LC[1] = cand_key(a[2], b[1], 2, 1); LC[2] = cand_key(a[2], b[2], 2, 2); LC[3] = cand_key(a[2], b[3], 2, 3); LC[4] = cand_key(a[2], b[4], 2, 4);
            LC[5] = cand_key(a[3], b[0], 3, 0); LC[6] = cand_key(a[3], b[1], 3, 1); LC[7] = cand_key(a[3], b[2], 3, 2); LC[8] = cand_key(a[3], b[3], 3, 3);
            LC[9] = cand_key(a[4], b[0], 4, 0); LC[10] = cand_key(a[4], b[1], 4, 1); LC[11] = cand_key(a[4], b[2], 4, 2);
            LC[12] = cand_key(a[5], b[0], 5, 0); LC[13] = cand_key(a[5], b[1], 5, 1);
            LC[14] = cand_key(a[6], b[0], 6, 0); LC[15] = cand_key(a[6], b[1], 6, 1);
            const unsigned d0 = cand_key(a[7], b[0], 7, 0), d1 = cand_key(a[7], b[1], 7, 1);
            bitonic16_desc(LB);
            sort16_desc(LC);
            topmerge16(LA, LB);
            LC[15] = LC[15] > d0 ? LC[15] : d0; LC[14] = LC[14] > d1 ? LC[14] : d1;
            bitonic16_desc(LC);
            topmerge16(LA, LC);
            float e[16], den = 0.f; const float vmax = dec_key(LA[0]);
#pragma unroll
            for (int r = 0; r < 16; ++r) { e[r] = __expf(dec_key(LA[r]) - vmax); den += e[r]; }
            const float inv = 1.f / den;
            const int t = m0 + row;
            int* oi = P.sel_idx + (size_t)t * 128 + h * 16; float* og = P.sel_g + (size_t)t * 128 + h * 16;
#pragma unroll
            for (int r = 0; r < 16; ++r) {
                const int i = (LA[r] >> 4) & 15, j = LA[r] & 15;
                oi[r] = (int)slot[i] * 128 + (int)slot[16 + j];
                og[r] = e[r] * inv;
            }
        }
    }
    __syncthreads();
}
typedef float f32x16 __attribute__((ext_vector_type(16)));
struct AttnFrag { u32x4 k[4]; u32x2 v[2][2][2]; };
__device__ __forceinline__ void attn_load(const Params& P, int b, int kvh, int qb, int w, int blk, int r, int hh, AttnFrag& f) {
    const bf16_t* kp; const bf16_t* vp; size_t vstride;
    if (blk < 9) {
        int kpos0 = (qb - 1) * 128 + 32 * (w + blk);
        if (kpos0 < 0 || kpos0 >= SEQ) kpos0 = 0;
        kp = P.K + (size_t)(b * SEQ + kpos0 + r) * 128 + kvh * 64 + 8 * hh;
        vp = P.VT + (size_t)((b * 2 + kvh) * 64 + r) * SEQ + kpos0 + 4 * hh; vstride = SEQ;
    } else {
        const int c0 = 32 * (blk - 9);
        kp = P.Kc + (size_t)(b * CTXL + c0 + r) * 128 + kvh * 64 + 8 * hh;
        vp = P.VcT + (size_t)((b * 2 + kvh) * 64 + r) * CTXL + c0 + 4 * hh; vstride = CTXL;
    }
#pragma unroll
    for (int ks = 0; ks < 4; ++ks) f.k[ks] = *(const u32x4*)(kp + 16 * ks);
#pragma unroll
    for (int db = 0; db < 2; ++db)
#pragma unroll
        for (int s = 0; s < 2; ++s) {
            f.v[db][s][0] = *(const u32x2*)(vp + (size_t)(32 * db) * vstride + 16 * s);
            f.v[db][s][1] = *(const u32x2*)(vp + (size_t)(32 * db) * vstride + 16 * s + 8);
        }
}
__device__ __forceinline__ void attn_item(const Params& P, int item) {
    const int head = item & 7, qb = (item >> 3) & 15, b = item >> 7, kvh = head >> 2;
    const int lane = threadIdx.x & 63, w = threadIdx.x >> 6, r = lane & 31, hh = lane >> 5;
    const int tok = b * SEQ + qb * 128 + 32 * w + r;
    bf16x8 qf[4];
    { const bf16_t* qp = P.Q + (size_t)tok * 512 + head * 64 + 8 * hh;
#pragma unroll
      for (int ks = 0; ks < 4; ++ks) qf[ks] = *(const bf16x8*)(qp + 16 * ks); }
    f32x16 o0, o1;
#pragma unroll
    for (int i = 0; i < 16; ++i) { o0[i] = 0.f; o1[i] = 0.f; }
    float mrun = P.sink[head], lrun = (hh == 0) ? 1.f : 0.f;
    AttnFrag cur, nxt;
    attn_load(P, b, kvh, qb, w, 0, r, hh, cur);
    for (int blk = 0; blk < 17; ++blk) {
        if (blk + 1 < 17) attn_load(P, b, kvh, qb, w, blk + 1, r, hh, nxt);
        int lo = 0, hi = 31;
        if (blk < 9) {
            const int kpos0 = (qb - 1) * 128 + 32 * (w + blk);
            if (kpos0 < 0 || kpos0 >= SEQ) lo = 64;
            else if (blk == 0) lo = r;
            else if (blk == 8) hi = r;
        }
        f32x16 s;
#pragma unroll
        for (int i = 0; i < 16; ++i) s[i] = 0.f;
#pragma unroll
        for (int ks = 0; ks < 4; ++ks) s = __builtin_amdgcn_mfma_f32_32x32x16_bf16(*(const bf16x8*)&cur.k[ks], qf[ks], s, 0, 0, 0);
        float mb = -3.0e38f;
#pragma unroll
        for (int i = 0; i < 16; ++i) { const int kk = (i & 3) + 8 * (i >> 2) + 4 * hh; const bool ok = (kk >= lo) && (kk <= hi); s[i] = ok ? s[i] : -3.0e38f; mb = fmaxf(mb, s[i]); }
        mb = fmaxf(mb, __shfl_xor(mb, 32));
        const float mn = fmaxf(mrun, mb);
        const float alpha = __expf(mrun - mn);
        float ps = 0.f; float p[16];
#pragma unroll
        for (int i = 0; i < 16; ++i) { p[i] = __expf(s[i] - mn); ps += p[i]; }
        lrun = lrun * alpha + ps; mrun = mn;
#pragma unroll
        for (int i = 0; i < 16; ++i) { o0[i] *= alpha; o1[i] *= alpha; }
        u32x4 pb[2];
        pb[0].x = pk2(p[0], p[1]); pb[0].y = pk2(p[2], p[3]); pb[0].z = pk2(p[4], p[5]); pb[0].w = pk2(p[6], p[7]);
        pb[1].x = pk2(p[8], p[9]); pb[1].y = pk2(p[10], p[11]); pb[1].z = pk2(p[12], p[13]); pb[1].w = pk2(p[14], p[15]);
#pragma unroll
        for (int sI = 0; sI < 2; ++sI) {
            u32x4 va, vb;
            va.x = cur.v[0][sI][0].x; va.y = cur.v[0][sI][0].y; va.z = cur.v[0][sI][1].x; va.w = cur.v[0][sI][1].y;
            vb.x = cur.v[1][sI][0].x; vb.y = cur.v[1][sI][0].y; vb.z = cur.v[1][sI][1].x; vb.w = cur.v[1][sI][1].y;
            o0 = __builtin_amdgcn_mfma_f32_32x32x16_bf16(*(const bf16x8*)&va, *(const bf16x8*)&pb[sI], o0, 0, 0, 0);
            o1 = __builtin_amdgcn_mfma_f32_32x32x16_bf16(*(const bf16x8*)&vb, *(const bf16x8*)&pb[sI], o1, 0, 0, 0);
        }
        if (blk + 1 < 17) cur = nxt;
    }
    const float ltot = lrun + __shfl_xor(lrun, 32);
    const float inv = 1.f / ltot;
    bf16_t* op = P.AO + (size_t)tok * 512 + head * 64 + 4 * hh;
#pragma unroll
    for (int g = 0; g < 4; ++g) {
        float t0[4] = { o0[4 * g] * inv, o0[4 * g + 1] * inv, o0[4 * g + 2] * inv, o0[4 * g + 3] * inv };
        float t1[4] = { o1[4 * g] * inv, o1[4 * g + 1] * inv, o1[4 * g + 2] * inv, o1[4 * g + 3] * inv };
        st4bf(op + 8 * g, t0); st4bf(op + 32 + 8 * g, t1);
    }
}

__device__ __forceinline__ void conv_range(const Params& P, size_t gtid, size_t gsize) {
    for (size_t idx = gtid; idx < (size_t)NTOK * 64; idx += gsize) {
        const int m = (int)(idx >> 6), c0 = (int)(idx & 63) * 8, l = m % SEQ;
        float cu[3][8];
#pragma unroll
        for (int t = 0; t < 3; ++t) {
            const int ll = l + t - 1;
            if (ll < 0 || ll >= SEQ) {
#pragma unroll
                for (int j = 0; j < 8; ++j) cu[t][j] = 0.f;
            } else {
                const u32x4 g = *(const u32x4*)(P.GC + (size_t)(m + t - 1) * 512 + c0), u = *(const u32x4*)(P.U + (size_t)(m + t - 1) * 512 + c0);
                cu[t][0] = bf2f(g.x & 0xffff) * bf2f(u.x & 0xffff); cu[t][1] = bf2f(g.x >> 16) * bf2f(u.x >> 16);
                cu[t][2] = bf2f(g.y & 0xffff) * bf2f(u.y & 0xffff); cu[t][3] = bf2f(g.y >> 16) * bf2f(u.y >> 16);
                cu[t][4] = bf2f(g.z & 0xffff) * bf2f(u.z & 0xffff); cu[t][5] = bf2f(g.z >> 16) * bf2f(u.z >> 16);
                cu[t][6] = bf2f(g.w & 0xffff) * bf2f(u.w & 0xffff); cu[t][7] = bf2f(g.w >> 16) * bf2f(u.w >> 16);
            }
        }
        const u32x4 gbv = *(const u32x4*)(P.GB + (size_t)m * 512 + c0);
        const float gb[8] = { bf2f(gbv.x & 0xffff), bf2f(gbv.x >> 16), bf2f(gbv.y & 0xffff), bf2f(gbv.y >> 16), bf2f(gbv.z & 0xffff), bf2f(gbv.z >> 16), bf2f(gbv.w & 0xffff), bf2f(gbv.w >> 16) };
        float o[8];
#pragma unroll
        for (int j = 0; j < 8; ++j) o[j] = gb[j] * (P.conv_w[c0 + j] * cu[0][j] + P.conv_w[512 + c0 + j] * cu[1][j] + P.conv_w[1024 + c0 + j] * cu[2][j]);
        st8bf(P.CA + (size_t)m * 512 + c0, o);
    }
}

__device__ __forceinline__ void unpack8(const u32x4 v, float* f) {
    f[0] = bf2f(v.x & 0xffff); f[1] = bf2f(v.x >> 16); f[2] = bf2f(v.y & 0xffff); f[3] = bf2f(v.y >> 16);
    f[4] = bf2f(v.z & 0xffff); f[5] = bf2f(v.z >> 16); f[6] = bf2f(v.w & 0xffff); f[7] = bf2f(v.w >> 16);
}
__device__ __forceinline__ void peer_final_token(const Params& P, int t, int lane) {
    const int b = t / SEQ;
    float h[16];
    { const bf16_t* hp = P.H2 + (size_t)t * DM; unpack8(*(const u32x4*)(hp + lane * 8), h); unpack8(*(const u32x4*)(hp + 512 + lane * 8), h + 8); }
    float acc[16];
#pragma unroll
    for (int j = 0; j < 16; ++j) acc[j] = 0.f;
    for (int k = 0; k < 128; ++k) {
        const int e = P.sel_idx[(size_t)t * 128 + k];
        const float g = P.sel_g[(size_t)t * 128 + k];
        float u[16];
        { const bf16_t* up = P.Ub + (size_t)e * DM; unpack8(*(const u32x4*)(up + lane * 8), u); unpack8(*(const u32x4*)(up + 512 + lane * 8), u + 8); }
        float d = 0.f;
#pragma unroll
        for (int j = 0; j < 16; ++j) d += u[j] * h[j];
        d = wave_sum(d);
        const float act = 0.5f * d * (1.f + erff(d * 0.70710678118654752f));
        const float w = g * act;
        float v[16];
        { const bf16_t* vp = P.Vb + (size_t)e * DM; unpack8(*(const u32x4*)(vp + lane * 8), v); unpack8(*(const u32x4*)(vp + 512 + lane * 8), v + 8); }
#pragma unroll
        for (int j = 0; j < 16; ++j) acc[j] += w * v[j];
    }
    float x2[16]; float ss = 0.f;
    const float* x1 = P.out + (size_t)t * DM; const float* g2 = P.mod + (size_t)b * NMOD + 5 * DM;
#pragma unroll
    for (int half = 0; half < 2; ++half) {
        const int d0 = half * 512 + lane * 8;
        const f32x4 xa = *(const f32x4*)(x1 + d0), xb = *(const f32x4*)(x1 + d0 + 4), ga = *(const f32x4*)(g2 + d0), gb = *(const f32x4*)(g2 + d0 + 4);
        const float xv[8] = { xa.x, xa.y, xa.z, xa.w, xb.x, xb.y, xb.z, xb.w }, gv[8] = { ga.x, ga.y, ga.z, ga.w, gb.x, gb.y, gb.z, gb.w };
#pragma unroll
        for (int j = 0; j < 8; ++j) { const float v = xv[j] + gv[j] * acc[half * 8 + j]; x2[half * 8 + j] = v; ss += v * v; }
    }
    ss = wave_sum(ss);
    const float rstd = rsqrtf(ss * (1.f / DM) + 1e-6f);
    float* op = P.out + (size_t)t * DM;
#pragma unroll
    for (int half = 0; half < 2; ++half) {
        const int d0 = half * 512 + lane * 8;
        const f32x4 fa = *(const f32x4*)(P.fg + d0), fb = *(const f32x4*)(P.fg + d0 + 4);
        f32x4 oa, ob;
        oa.x = x2[half * 8 + 0] * rstd * fa.x; oa.y = x2[half * 8 + 1] * rstd * fa.y; oa.z = x2[half * 8 + 2] * rstd * fa.z; oa.w = x2[half * 8 + 3] * rstd * fa.w;
        ob.x = x2[half * 8 + 4] * rstd * fb.x; ob.y = x2[half * 8 + 5] * rstd * fb.y; ob.z = x2[half * 8 + 6] * rstd * fb.z; ob.w = x2[half * 8 + 7] * rstd * fb.w;
        *(f32x4*)(op + d0) = oa; *(f32x4*)(op + d0 + 4) = ob;
    }
}

constexpr int NPHASE = 9;
template <int PH> __device__ __forceinline__ void run_phase(const Params& P, char* smem) {
    const int bid = blockIdx.x, G = gridDim.x, tid = threadIdx.x;
    const size_t gtid = (size_t)bid * 256 + tid, gsize = (size_t)G * 256;
    if (PH == 0) {
        for (int it = bid; it < 192; it += G) modp_item(P, it, smem);
        float (*tile)[65] = (float (*)[65])smem;
        for (int it = bid; it < 1088; it += G) transpose_tile(P.w_in, DM, PROJW, P.WinT, it, tile);
        for (int it = bid; it < 128; it += G) transpose_tile(P.w_ao, 512, DM, P.WaoT, it, tile);
        for (int it = bid; it < 128; it += G) transpose_tile(P.w_co, 512, DM, P.WcoT, it, tile);
        for (int it = bid; it < 256; it += G) transpose_tile(P.w_mix, DM, DM, P.WmixT, it, tile);
        for (int it = bid; it < 512; it += G) transpose_tile(P.pw_q, DM, 2048, P.PwqT, it, tile);
        cvt_range(P.keys, P.KeysB, (size_t)16 * 128 * 128 / 8, gtid, gsize);
        cvt_range(P.pu, P.Ub, (size_t)NEXP * DM / 8, gtid, gsize);
        cvt_range(P.pv, P.Vb, (size_t)NEXP * DM / 8, gtid, gsize);
        rope_tab(P, (int)gtid, (int)gsize);
    } else if (PH == 1) {
        for (int i = (int)gtid; i < 17 * NMOD; i += (int)gsize) {
            float v = P.b_mod[i % NMOD];
#pragma unroll
            for (int kc = 0; kc < 8; ++kc) v += P.modp[(size_t)kc * 17 * NMOD + i];
            P.mod[i] = v;
        }
        for (int it = bid; it < 1152; it += G) norm1_item(P, it, smem);
    } else if (PH == 2) {
        for (int t = bid; t < 256 * 34 + 64; t += G) {
            if (t < 256 * 34) { int mt, nt; tile_coords(t, 256, 34, mt, nt); gemm_tile<MODE_INPROJ>(P, P.H, DM, P.WinT, DM, DM, mt * 128, nt * 128, nt * 128 >= 768, smem); }
            else { const int u = t - 256 * 34, mt = u >> 1, nt = u & 1; gemm_tile<MODE_CTXKV>(P, P.HC, DM, P.WinT + (size_t)512 * DM, DM, DM, mt * 128, nt * 128, nt == 0, smem); }
        }
    } else if (PH == 3) {
        for (int it = bid; it < NB * 16 * 8; it += G) attn_item(P, it);
        conv_range(P, gtid, gsize);
    } else if (PH == 4) {
        for (int t = bid; t < 256 * 8; t += G) {
            int mt, nt; tile_coords(t, 256, 8, mt, nt);
            gemm_tile<MODE_AO1>(P, P.AO, 512, P.WaoT, 512, 512, mt * 128, nt * 128, true, smem);
            gemm_tile<MODE_CO2>(P, P.CA, 512, P.WcoT, 512, 512, mt * 128, nt * 128, true, smem);
        }
    } else if (PH == 5) {
        for (int t = bid; t < 256 * 8; t += G) { int mt, nt; tile_coords(t, 256, 8, mt, nt); gemm_tile<MODE_MIX>(P, P.YG, DM, P.WmixT, DM, DM, mt * 128, nt * 128, true, smem); }
    } else if (PH == 6) {
        const int lane = tid & 63, wid = tid >> 6;
        for (int row = bid * 4 + wid; row < NTOK; row += G * 4) { const int b = row / SEQ;
            norm_row(P.out + (size_t)row * DM, P.n2, P.mod + (size_t)b * NMOD + 4 * DM, P.mod + (size_t)b * NMOD + 3 * DM, P.H2 + (size_t)row * DM, lane); }
    } else if (PH == 7) {
        for (int it = bid; it < 256 * 8; it += G) peer_retrieve_item(P, it >> 3, it & 7, smem);
    } else if (PH == 8) {
        const int lane = tid & 63, wid = tid >> 6;
        for (int t = bid * 4 + wid; t < NTOK; t += G * 4) peer_final_token(P, t, lane);
    }
}
constexpr int MEGA_LDS = RETR_LDS;
#ifndef MULTI_LAUNCH
__global__ void __launch_bounds__(256, 2) k_mega(Params P) {
    extern __shared__ __attribute__((aligned(16))) char smem[];
    cg::grid_group grid = cg::this_grid();
    run_phase<0>(P, smem); grid.sync();
    run_phase<1>(P, smem); grid.sync();
    run_phase<2>(P, smem); grid.sync();
    run_phase<3>(P, smem); grid.sync();
    run_phase<4>(P, smem); grid.sync();
    run_phase<5>(P, smem); grid.sync();
    run_phase<6>(P, smem); grid.sync();
    run_phase<7>(P, smem); grid.sync();
    run_phase<8>(P, smem);
}
#else
template <int PH> __global__ void __launch_bounds__(256, 2) k_phase(Params P) {
    extern __shared__ __attribute__((aligned(16))) char smem[];
    run_phase<PH>(P, smem);
}
#endif

static size_t carve(size_t& off, size_t bytes) { const size_t o = off; off += (bytes + 255) & ~(size_t)255; return o; }

extern "C" void kernel_launch(void* const* d_in, const int* in_sizes, int n_in, void* d_out, int out_size, void* d_ws, size_t ws_size, hipStream_t stream) {
    Params P{};
    P.x = (const float*)d_in[0]; P.c = (const float*)d_in[1]; P.ctx = (const float*)d_in[2]; P.c_ctx = (const float*)d_in[3];
    P.w_mod = (const float*)d_in[4]; P.b_mod = (const float*)d_in[5]; P.n1 = (const float*)d_in[6]; P.n2 = (const float*)d_in[7];
    P.w_in = (const float*)d_in[8]; P.sink = (const float*)d_in[9]; P.conv_w = (const float*)d_in[10]; P.w_ao = (const float*)d_in[11];
    P.w_co = (const float*)d_in[12]; P.w_mix = (const float*)d_in[13]; P.pw_q = (const float*)d_in[14]; P.keys = (const float*)d_in[15];
    P.pu = (const float*)d_in[16]; P.pv = (const float*)d_in[17]; P.fg = (const float*)d_in[18];
    P.out = (float*)d_out;
    char* ws = (char*)d_ws; size_t off = 0;
    P.modp = (float*)(ws + carve(off, (size_t)8 * 17 * NMOD * 4));
    P.mod = (float*)(ws + carve(off, (size_t)17 * NMOD * 4));
    P.rope = (float*)(ws + carve(off, 3072 * 4));
    P.WinT = (bf16_t*)(ws + carve(off, (size_t)PROJW * DM * 2));
    P.WaoT = (bf16_t*)(ws + carve(off, (size_t)DM * 512 * 2));
    P.WcoT = (bf16_t*)(ws + carve(off, (size_t)DM * 512 * 2));
    P.WmixT = (bf16_t*)(ws + carve(off, (size_t)DM * DM * 2));
    P.PwqT = (bf16_t*)(ws + carve(off, (size_t)2048 * DM * 2));
    P.KeysB = (bf16_t*)(ws + carve(off, (size_t)16 * 128 * 128 * 2));
    P.Ub = (bf16_t*)(ws + carve(off, (size_t)NEXP * DM * 2));
    P.Vb = (bf16_t*)(ws + carve(off, (size_t)NEXP * DM * 2));
    P.HC = (bf16_t*)(ws + carve(off, (size_t)NCTX * DM * 2));
    const size_t regA = carve(off, (size_t)NTOK * DM * 2);
    P.H = (bf16_t*)(ws + regA); P.YG = (bf16_t*)(ws + regA); P.H2 = (bf16_t*)(ws + regA);
    const size_t regB = off;
    P.Q = (bf16_t*)(ws + carve(off, (size_t)NTOK * 512 * 2));
    P.K = (bf16_t*)(ws + carve(off, (size_t)NTOK * 128 * 2));
    P.VT = (bf16_t*)(ws + carve(off, (size_t)NTOK * 128 * 2));
    P.Kc = (bf16_t*)(ws + carve(off, (size_t)NCTX * 128 * 2));
    P.VcT = (bf16_t*)(ws + carve(off, (size_t)NCTX * 128 * 2));
    const size_t regC = off;
    P.GB = (bf16_t*)(ws + carve(off, (size_t)NTOK * 512 * 2));
    P.GC = (bf16_t*)(ws + carve(off, (size_t)NTOK * 512 * 2));
    P.U = (bf16_t*)(ws + carve(off, (size_t)NTOK * 512 * 2));
    P.M1 = (bf16_t*)(ws + regC);
    P.GA = (bf16_t*)(ws + carve(off, (size_t)NTOK * DM * 2));
    P.GV = (bf16_t*)(ws + carve(off, (size_t)NTOK * DM * 2));
    P.AO = (bf16_t*)(ws + carve(off, (size_t)NTOK * 512 * 2));
    P.CA = (bf16_t*)(ws + carve(off, (size_t)NTOK * 512 * 2));
    const size_t need = off;
    { size_t o2 = regB;
      P.sel_idx = (int*)(ws + carve(o2, (size_t)NTOK * 128 * 4));
      P.sel_g = (float*)(ws + carve(o2, (size_t)NTOK * 128 * 4));
      if (o2 > regC) { fprintf(stderr, "kernel_launch: late buffers overflow\n"); return; } }
    if (need > ws_size) { fprintf(stderr, "kernel_launch: workspace too small: need %zu have %zu\n", need, ws_size); return; }

#ifdef MULTI_LAUNCH
    static bool attr_done = false;
    if (!attr_done) {
#define SETA(PH) hipFuncSetAttribute((const void*)k_phase<PH>, hipFuncAttributeMaxDynamicSharedMemorySize, MEGA_LDS)
        SETA(0); SETA(1); SETA(2); SETA(3); SETA(4); SETA(5); SETA(6); SETA(7); SETA(8);
        attr_done = true;
    }
#define LP(PH) k_phase<PH><<<512, 256, MEGA_LDS, stream>>>(P)
    LP(0); LP(1); LP(2); LP(3); LP(4); LP(5); LP(6); LP(7); LP(8);
#else
    static int grid_blocks = 0;
    if (!grid_blocks) {
        int dev = 0, cus = 0, per_cu = 0;
        hipGetDevice(&dev);
        hipDeviceGetAttribute(&cus, hipDeviceAttributeMultiprocessorCount, dev);
        hipFuncSetAttribute((const void*)k_mega, hipFuncAttributeMaxDynamicSharedMemorySize, MEGA_LDS);
        hipOccupancyMaxActiveBlocksPerMultiprocessor(&per_cu, (const void*)k_mega, 256, MEGA_LDS);
        if (per_cu > 2) per_cu = 2;
        if (per_cu < 1) { fprintf(stderr, "kernel_launch: occupancy query returned %d\n", per_cu); per_cu = 1; }
        grid_blocks = cus * per_cu;
    }
    void* args[] = { &P };
    hipError_t e = hipLaunchCooperativeKernel((const void*)k_mega, dim3(grid_blocks), dim3(256), args, MEGA_LDS, stream);
    if (e != hipSuccess) fprintf(stderr, "cooperative launch failed: %s (grid %d)\n", hipGetErrorString(e), grid_blocks);
#endif
}
```

```cpp
#include <hip/hip_runtime.h>
#include <cstdio>
#include <cstdint>

typedef unsigned short bf16_t;
typedef short bf16x8 __attribute__((ext_vector_type(8)));
typedef float f32x4 __attribute__((ext_vector_type(4)));
typedef unsigned u32x4 __attribute__((ext_vector_type(4)));
typedef unsigned u32x2 __attribute__((ext_vector_type(2)));

constexpr int DM = 1024, NB = 16, SEQ = 2048, NTOK = NB * SEQ, CTXL = 256, NCTX = NB * CTXL;
constexpr int PROJW = 4352;
constexpr int NMOD = 6 * DM;
constexpr int NEXP = 16384;

__device__ __forceinline__ float bf2f(bf16_t x) { return __uint_as_float(((unsigned)x) << 16); }
__device__ __forceinline__ bf16_t f2bf(float f) {
    unsigned u = __float_as_uint(f);
    u += 0x7fffu + ((u >> 16) & 1u);
    return (bf16_t)(u >> 16);
}
__device__ __forceinline__ unsigned pk2(float lo, float hi) { return (unsigned)f2bf(lo) | ((unsigned)f2bf(hi) << 16); }
__device__ __forceinline__ float sigmoidf_(float x) { return 1.f / (1.f + __expf(-x)); }
__device__ __forceinline__ float wave_sum(float v) {
#pragma unroll
    for (int o = 1; o < 64; o <<= 1) v += __shfl_xor(v, o);
    return v;
}

struct Params {
    const float *x, *c, *ctx, *c_ctx, *w_mod, *b_mod, *n1, *n2, *w_in, *sink, *conv_w, *w_ao, *w_co, *w_mix, *pw_q, *keys, *pu, *pv, *fg;
    float* out;
    float *modp, *mod, *rope;
    bf16_t *WinT, *WaoT, *WcoT, *WmixT, *PwqT, *KeysB, *Ub, *Vb;
    bf16_t *H, *HC, *Q, *K, *VT, *Kc, *VcT, *GB, *GC, *U, *GA, *GV, *AO, *CA, *M1, *YG, *H2, *QH;
    float* TKv; int* TKi;
    int* sel_idx; float* sel_g;
    float* X1;
    unsigned* bar;
};

__device__ __forceinline__ void modp_item(const Params& P, int item, char* smem) {
    float (*s)[128] = (float (*)[128])smem;
    const int kc = item / 24, nc = item % 24;
    __syncthreads();
    for (int i = threadIdx.x; i < 17 * 128; i += 256) {
        const int r = i / 128, k = i % 128;
        const float v = (r < 16) ? P.c[r * DM + kc * 128 + k] : P.c_ctx[kc * 128 + k];
        s[r][k] = v / (1.f + __expf(-v));
    }
    __syncthreads();
    const int n = nc * 256 + threadIdx.x;
    float acc[17];
#pragma unroll
    for (int r = 0; r < 17; ++r) acc[r] = 0.f;
    for (int k = 0; k < 128; ++k) {
        const float w = P.w_mod[(size_t)(kc * 128 + k) * NMOD + n];
#pragma unroll
        for (int r = 0; r < 17; ++r) acc[r] += s[r][k] * w;
    }
#pragma unroll
    for (int r = 0; r < 17; ++r) P.modp[((size_t)kc * 17 + r) * NMOD + n] = acc[r];
}
__device__ __forceinline__ void cvt_range(const float* src, bf16_t* dst, size_t n8, size_t gtid, size_t gsize) {
    for (size_t i = gtid; i < n8; i += gsize) {
        const f32x4 a = *(const f32x4*)(src + i * 8), b = *(const f32x4*)(src + i * 8 + 4);
        u32x4 o; o.x = pk2(a.x, a.y); o.y = pk2(a.z, a.w); o.z = pk2(b.x, b.y); o.w = pk2(b.z, b.w);
        *(u32x4*)(dst + i * 8) = o;
    }
}
__device__ __forceinline__ void rope_tab(const Params& P, int gtid, int gsize) {
    for (int i = gtid; i < 1536; i += gsize) {
        int pos, f; bool isc;
        if (i < 512) { pos = i / 16; f = i % 16; isc = false; } else { pos = (i - 512) / 16; f = (i - 512) % 16; isc = true; }
        const double inv = pow(10000.0, -(double)f / 16.0);
        const double ang = (double)pos * inv;
        const float cv = (float)cos(ang), sv = (float)sin(ang);
        if (!isc) { P.rope[pos * 16 + f] = cv; P.rope[512 + pos * 16 + f] = sv; }
        else { P.rope[1024 + pos * 16 + f] = cv; P.rope[2048 + pos * 16 + f] = sv; }
    }
}
__device__ __forceinline__ void transpose_tile(const float* W, int K, int N, bf16_t* Wt, int item, float (*tile)[65]) {
    const int ntn = N / 64, kt = item / ntn, nt = item % ntn, k0 = kt * 64, n0 = nt * 64;
    const int tx = threadIdx.x & 63, ty = threadIdx.x >> 6;
    __syncthreads();
#pragma unroll
    for (int i = 0; i < 16; ++i) { const int k = i * 4 + ty; tile[k][tx] = W[(size_t)(k0 + k) * N + n0 + tx]; }
    __syncthreads();
#pragma unroll
    for (int i = 0; i < 16; ++i) { const int n = i * 4 + ty; Wt[(size_t)(n0 + n) * K + k0 + tx] = f2bf(tile[tx][n]); }
}

__device__ __forceinline__ void norm_row(const float* xr, const float* g, const float* scale, const float* shift, bf16_t* dst, int lane) {
    f32x4 v[4]; float s = 0.f;
#pragma unroll
    for (int j = 0; j < 4; ++j) { v[j] = *(const f32x4*)(xr + j * 256 + lane * 4); s += v[j].x * v[j].x + v[j].y * v[j].y + v[j].z * v[j].z + v[j].w * v[j].w; }
    s = wave_sum(s);
    const float rstd = rsqrtf(s * (1.f / DM) + 1e-6f);
#pragma unroll
    for (int j = 0; j < 4; ++j) {
        const int d = j * 256 + lane * 4;
        const f32x4 gg = *(const f32x4*)(g + d), sc = *(const f32x4*)(scale + d), sh = *(const f32x4*)(shift + d);
        const float y0 = v[j].x * rstd * gg.x * (1.f + sc.x) + sh.x;
        const float y1 = v[j].y * rstd * gg.y * (1.f + sc.y) + sh.y;
        const float y2 = v[j].z * rstd * gg.z * (1.f + sc.z) + sh.z;
        const float y3 = v[j].w * rstd * gg.w * (1.f + sc.w) + sh.w;
        u32x2 o; o.x = pk2(y0, y1); o.y = pk2(y2, y3);
        *(u32x2*)(dst + d) = o;
    }
}

__device__ __forceinline__ void norm1_item(const Params& P, int item, char* smem) {
    float* sc = (float*)smem; float* sh = sc + DM;
    const bool isctx = item >= 1024;
    const int row0 = isctx ? (item - 1024) * 32 : item * 32;
    const int r = isctx ? 16 : row0 / SEQ;
    __syncthreads();
    for (int d = threadIdx.x; d < DM; d += 256) {
        float a = P.b_mod[DM + d], b = P.b_mod[d];
#pragma unroll
        for (int kc = 0; kc < 8; ++kc) { a += P.modp[((size_t)kc * 17 + r) * NMOD + DM + d]; b += P.modp[((size_t)kc * 17 + r) * NMOD + d]; }
        sc[d] = a; sh[d] = b;
    }
    __syncthreads();
    const int lane = threadIdx.x & 63, wid = threadIdx.x >> 6;
    for (int i = wid; i < 32; i += 4) {
        const int row = row0 + i;
        if (!isctx) norm_row(P.x + (size_t)row * DM, P.n1, sc, sh, P.H + (size_t)row * DM, lane);
        else norm_row(P.ctx + (size_t)row * DM, P.n1, sc, sh, P.HC + (size_t)row * DM, lane);
    }
}
enum { MODE_INPROJ = 0, MODE_CTXKV = 1, MODE_AO1 = 2, MODE_CO2 = 3, MODE_MIX = 4, MODE_QH = 5 };

__device__ __forceinline__ void st8bf(bf16_t* p, const float* v) {
    u32x4 o; o.x = pk2(v[0], v[1]); o.y = pk2(v[2], v[3]); o.z = pk2(v[4], v[5]); o.w = pk2(v[6], v[7]);
    *(u32x4*)p = o;
}
__device__ __forceinline__ void st4bf(bf16_t* p, const float* v) {
    u32x2 o; o.x = pk2(v[0], v[1]); o.y = pk2(v[2], v[3]);
    *(u32x2*)p = o;
}
template <int MODE> __device__ __forceinline__ void epi8(const Params& P, int m, int n, const float* v) {
    if (MODE == MODE_INPROJ) {
        if (n < 1280) st8bf(P.GB + (size_t)m * 512 + (n - 768), v);
        else if (n < 1792) st8bf(P.GC + (size_t)m * 512 + (n - 1280), v);
        else if (n < 2304) st8bf(P.U + (size_t)m * 512 + (n - 1792), v);
        else {
            float s[8];
#pragma unroll
            for (int j = 0; j < 8; ++j) s[j] = sigmoidf_(v[j]);
            if (n < 3328) st8bf(P.GA + (size_t)m * DM + (n - 2304), s);
            else st8bf(P.GV + (size_t)m * DM + (n - 3328), s);
        }
    } else if (MODE == MODE_CTXKV) {
        st8bf(P.Kc + (size_t)m * 128 + n, v);
    } else if (MODE == MODE_AO1) {
        const u32x4 g = *(const u32x4*)(P.GA + (size_t)m * DM + n);
        float o[8];
        o[0] = v[0] * bf2f(g.x & 0xffff); o[1] = v[1] * bf2f(g.x >> 16); o[2] = v[2] * bf2f(g.y & 0xffff); o[3] = v[3] * bf2f(g.y >> 16);
        o[4] = v[4] * bf2f(g.z & 0xffff); o[5] = v[5] * bf2f(g.z >> 16); o[6] = v[6] * bf2f(g.w & 0xffff); o[7] = v[7] * bf2f(g.w >> 16);
        st8bf(P.M1 + (size_t)m * DM + n, o);
    } else if (MODE == MODE_CO2) {
        const u32x4 g = *(const u32x4*)(P.GV + (size_t)m * DM + n);
        const u32x4 a = *(const u32x4*)(P.M1 + (size_t)m * DM + n);
        float o[8];
        o[0] = bf2f(a.x & 0xffff) + v[0] * bf2f(g.x & 0xffff); o[1] = bf2f(a.x >> 16) + v[1] * bf2f(g.x >> 16);
        o[2] = bf2f(a.y & 0xffff) + v[2] * bf2f(g.y & 0xffff); o[3] = bf2f(a.y >> 16) + v[3] * bf2f(g.y >> 16);
        o[4] = bf2f(a.z & 0xffff) + v[4] * bf2f(g.z & 0xffff); o[5] = bf2f(a.z >> 16) + v[5] * bf2f(g.z >> 16);
        o[6] = bf2f(a.w & 0xffff) + v[6] * bf2f(g.w & 0xffff); o[7] = bf2f(a.w >> 16) + v[7] * bf2f(g.w >> 16);
        st8bf(P.YG + (size_t)m * DM + n, o);
    } else if (MODE == MODE_MIX) {
        const int b = m / SEQ;
        const float* g1 = P.mod + (size_t)b * NMOD + 2 * DM + n;
        const float* xr = P.x + (size_t)m * DM + n;
        float* o = P.X1 + (size_t)m * DM + n;
        const f32x4 x0 = *(const f32x4*)xr, x1 = *(const f32x4*)(xr + 4), g0 = *(const f32x4*)g1, g1v = *(const f32x4*)(g1 + 4);
        f32x4 o0, o1;
        o0.x = x0.x + g0.x * v[0]; o0.y = x0.y + g0.y * v[1]; o0.z = x0.z + g0.z * v[2]; o0.w = x0.w + g0.w * v[3];
        o1.x = x1.x + g1v.x * v[4]; o1.y = x1.y + g1v.y * v[5]; o1.z = x1.z + g1v.z * v[6]; o1.w = x1.w + g1v.w * v[7];
        *(f32x4*)o = o0; *(f32x4*)(o + 4) = o1;
    } else if (MODE == MODE_QH) {
        st8bf(P.QH + (size_t)m * 2048 + n, v);
    }
}
__device__ __forceinline__ void epi_rope(const Params& P, int m, int n, const float* lo, const float* hi) {
    const int d0 = n & 63;
    const int l = m % SEQ;
    const float *ct, *st;
    if (d0 < 16) { const int row = l >> 6; ct = P.rope + row * 16 + d0; st = P.rope + 512 + row * 16 + d0; }
    else { const int col = l & 63; ct = P.rope + 1024 + col * 16 + (d0 - 32); st = P.rope + 2048 + col * 16 + (d0 - 32); }
    float a[4], b[4];
    const float sc = (n < 512) ? 0.125f : 1.f;
#pragma unroll
    for (int j = 0; j < 4; ++j) { const float cc = ct[j], ss = st[j]; a[j] = (lo[j] * cc - hi[j] * ss) * sc; b[j] = (lo[j] * ss + hi[j] * cc) * sc; }
    if (n < 512) { st4bf(P.Q + (size_t)m * 512 + n, a); st4bf(P.Q + (size_t)m * 512 + n + 16, b); }
    else { st4bf(P.K + (size_t)m * 128 + (n - 512), a); st4bf(P.K + (size_t)m * 128 + (n - 512) + 16, b); }
}
__device__ __forceinline__ void epi_v4(const Params& P, int m, int dcol, const float* v, bool ctx) {
    const int kvh = dcol >> 6, dd = dcol & 63;
    if (!ctx) { const int b = m / SEQ, l = m % SEQ;
#pragma unroll
        for (int j = 0; j < 4; ++j) P.VT[((size_t)(b * 2 + kvh) * 64 + dd + j) * SEQ + l] = f2bf(v[j]);
    } else { const int b = m / CTXL, cpos = m % CTXL;
#pragma unroll
        for (int j = 0; j < 4; ++j) P.VcT[((size_t)(b * 2 + kvh) * 64 + dd + j) * CTXL + cpos] = f2bf(v[j]);
    }
}

constexpr int GEMM_LDS = 65536;
constexpr int RETR_LDS = 128 * 130 * 4;
__device__ __forceinline__ int lds_off(int row, int chunk) { return row * 128 + ((chunk ^ ((row >> 1) & 7)) << 4); }

__device__ __forceinline__ void mma_from_lds(const char* As, const char* Bs, f32x4 (&acc)[4][4], int wm, int wn, int fr, int fq, int sw) {
#pragma unroll
    for (int ks = 0; ks < 2; ++ks) {
        bf16x8 af[4], bfr[4];
        const int coff = ((ks * 4 + fq) ^ sw) << 4;
#pragma unroll
        for (int mt = 0; mt < 4; ++mt) af[mt] = *(const bf16x8*)(As + (wm * 64 + mt * 16 + fr) * 128 + coff);
#pragma unroll
        for (int nt = 0; nt < 4; ++nt) bfr[nt] = *(const bf16x8*)(Bs + (wn * 64 + nt * 16 + fr) * 128 + coff);
#pragma unroll
        for (int mt = 0; mt < 4; ++mt)
#pragma unroll
            for (int nt = 0; nt < 4; ++nt) acc[mt][nt] = __builtin_amdgcn_mfma_f32_16x16x32_bf16(bfr[nt], af[mt], acc[mt][nt], 0, 0, 0);
    }
}
__device__ __forceinline__ void gemm_mainloop(const bf16_t* __restrict__ A, int lda, const bf16_t* __restrict__ Bt, int ldb, int K, int m0, int n0, bool perm, char* smem, f32x4 (&acc)[4][4]) {
    const int tid = threadIdx.x, lane = tid & 63, wid = tid >> 6;
    const int wm = wid >> 1, wn = wid & 1, fr = lane & 15, fq = lane >> 4;
    const int srow = tid >> 3, schunk = tid & 7;
    const bf16_t* ag[4]; const bf16_t* bg[4]; int soff[4];
#pragma unroll
    for (int p = 0; p < 4; ++p) {
        const int row = p * 32 + srow;
        ag[p] = A + (size_t)(m0 + row) * lda + schunk * 8;
        int brow = row;
        if (perm) { const int g = row >> 5, rr = row & 31, nn = rr >> 4, i = rr & 15; brow = 32 * g + 8 * (i >> 2) + 4 * nn + (i & 3); }
        bg[p] = Bt + (size_t)(n0 + brow) * ldb + schunk * 8;
        soff[p] = lds_off(row, schunk);
    }
#pragma unroll
    for (int i = 0; i < 4; ++i)
#pragma unroll
        for (int j = 0; j < 4; ++j) acc[i][j] = (f32x4){0.f, 0.f, 0.f, 0.f};
    u32x4 ra[4], rb[4];
#pragma unroll
    for (int p = 0; p < 4; ++p) { ra[p] = *(const u32x4*)(ag[p]); rb[p] = *(const u32x4*)(bg[p]); }
#pragma unroll
    for (int p = 0; p < 4; ++p) { *(u32x4*)(smem + soff[p]) = ra[p]; *(u32x4*)(smem + 16384 + soff[p]) = rb[p]; }
    __syncthreads();
    const int nk = K / 64;
    const int sw = (fr >> 1) & 7;
    for (int kt = 0; kt < nk; ++kt) {
        const int cur = kt & 1;
        if (kt + 1 < nk) {
            const int k0 = (kt + 1) * 64;
#pragma unroll
            for (int p = 0; p < 4; ++p) { ra[p] = *(const u32x4*)(ag[p] + k0); rb[p] = *(const u32x4*)(bg[p] + k0); }
        }
        mma_from_lds(smem + cur * 32768, smem + cur * 32768 + 16384, acc, wm, wn, fr, fq, sw);
        if (kt + 1 < nk) {
            char* dst = smem + (cur ^ 1) * 32768;
#pragma unroll
            for (int p = 0; p < 4; ++p) { *(u32x4*)(dst + soff[p]) = ra[p]; *(u32x4*)(dst + 16384 + soff[p]) = rb[p]; }
        }
        __syncthreads();
    }
}
template <int MODE>
__device__ __forceinline__ void gemm_tile(const Params& P, const bf16_t* __restrict__ A, int lda, const bf16_t* __restrict__ Bt, int ldb, int K, int m0, int n0, bool perm, char* smem) {
    const int lane = threadIdx.x & 63, wid = threadIdx.x >> 6;
    const int wm = wid >> 1, wn = wid & 1, fr = lane & 15, fq = lane >> 4;
    f32x4 acc[4][4];
    gemm_mainloop(A, lda, Bt, ldb, K, m0, n0, perm, smem, acc);
#pragma unroll
    for (int mt = 0; mt < 4; ++mt) {
        const int m = m0 + wm * 64 + mt * 16 + fr;
        if (perm) {
#pragma unroll
            for (int p = 0; p < 2; ++p) {
                float v[8] = { acc[mt][2 * p][0], acc[mt][2 * p][1], acc[mt][2 * p][2], acc[mt][2 * p][3], acc[mt][2 * p + 1][0], acc[mt][2 * p + 1][1], acc[mt][2 * p + 1][2], acc[mt][2 * p + 1][3] };
                epi8<MODE>(P, m, n0 + wn * 64 + 32 * p + 8 * fq, v);
            }
        } else if (MODE == MODE_INPROJ && n0 < 640) {
#pragma unroll
            for (int p = 0; p < 2; ++p) {
                float lo[4] = { acc[mt][2 * p][0], acc[mt][2 * p][1], acc[mt][2 * p][2], acc[mt][2 * p][3] };
                float hi[4] = { acc[mt][2 * p + 1][0], acc[mt][2 * p + 1][1], acc[mt][2 * p + 1][2], acc[mt][2 * p + 1][3] };
                epi_rope(P, m, n0 + wn * 64 + 32 * p + 4 * fq, lo, hi);
            }
        } else if (MODE == MODE_INPROJ || MODE == MODE_CTXKV) {
            const int dbase = (MODE == MODE_INPROJ) ? (n0 - 640) : (n0 - 128);
#pragma unroll
            for (int nt = 0; nt < 4; ++nt) {
                float v[4] = { acc[mt][nt][0], acc[mt][nt][1], acc[mt][nt][2], acc[mt][nt][3] };
                epi_v4(P, m, dbase + wn * 64 + 16 * nt + 4 * fq, v, MODE == MODE_CTXKV);
            }
        }
    }
}
__device__ __forceinline__ void tile_coords(int t, int ntm, int ntn, int& mt, int& nt) {
    const int per = 8 * ntn, g = t / per, r = t % per;
    mt = g * 8 + (r & 7); nt = r >> 3;
}
#define CEU(a, b) { const unsigned _t = (a) > (b) ? (a) : (b); (b) = (a) > (b) ? (b) : (a); (a) = _t; }
__device__ __forceinline__ void sort16_desc(unsigned (&v)[16]) {
    CEU(v[0], v[1]); CEU(v[2], v[3]); CEU(v[0], v[2]); CEU(v[1], v[3]); CEU(v[1], v[2]); CEU(v[4], v[5]);
    CEU(v[6], v[7]); CEU(v[4], v[6]); CEU(v[5], v[7]); CEU(v[5], v[6]); CEU(v[0], v[4]); CEU(v[2], v[6]);
    CEU(v[2], v[4]); CEU(v[1], v[5]); CEU(v[3], v[7]); CEU(v[3], v[5]); CEU(v[1], v[2]); CEU(v[3], v[4]);
    CEU(v[5], v[6]); CEU(v[8], v[9]); CEU(v[10], v[11]); CEU(v[8], v[10]); CEU(v[9], v[11]); CEU(v[9], v[10]);
    CEU(v[12], v[13]); CEU(v[14], v[15]); CEU(v[12], v[14]); CEU(v[13], v[15]); CEU(v[13], v[14]); CEU(v[8], v[12]);
    CEU(v[10], v[14]); CEU(v[10], v[12]); CEU(v[9], v[13]); CEU(v[11], v[15]); CEU(v[11], v[13]); CEU(v[9], v[10]);
    CEU(v[11], v[12]); CEU(v[13], v[14]); CEU(v[0], v[8]); CEU(v[4], v[12]); CEU(v[4], v[8]); CEU(v[2], v[10]);
    CEU(v[6], v[14]); CEU(v[6], v[10]); CEU(v[2], v[4]); CEU(v[6], v[8]); CEU(v[10], v[12]); CEU(v[1], v[9]);
    CEU(v[5], v[13]); CEU(v[5], v[9]); CEU(v[3], v[11]); CEU(v[7], v[15]); CEU(v[7], v[11]); CEU(v[3], v[5]);
    CEU(v[7], v[9]); CEU(v[11], v[13]); CEU(v[1], v[2]); CEU(v[3], v[4]); CEU(v[5], v[6]); CEU(v[7], v[8]);
    CEU(v[9], v[10]); CEU(v[11], v[12]); CEU(v[13], v[14]);
}
__device__ __forceinline__ void bitonic16_desc(unsigned (&v)[16]) {
    CEU(v[0], v[8]); CEU(v[1], v[9]); CEU(v[2], v[10]); CEU(v[3], v[11]); CEU(v[4], v[12]); CEU(v[5], v[13]);
    CEU(v[6], v[14]); CEU(v[7], v[15]); CEU(v[0], v[4]); CEU(v[1], v[5]); CEU(v[2], v[6]); CEU(v[3], v[7]);
    CEU(v[8], v[12]); CEU(v[9], v[13]); CEU(v[10], v[14]); CEU(v[11], v[15]); CEU(v[0], v[2]); CEU(v[1], v[3]);
    CEU(v[4], v[6]); CEU(v[5], v[7]); CEU(v[8], v[10]); CEU(v[9], v[11]); CEU(v[12], v[14]); CEU(v[13], v[15]);
    CEU(v[0], v[1]); CEU(v[2], v[3]); CEU(v[4], v[5]); CEU(v[6], v[7]); CEU(v[8], v[9]); CEU(v[10], v[11]);
    CEU(v[12], v[13]); CEU(v[14], v[15]);
}

__device__ __forceinline__ unsigned enc_key(float f) { const unsigned b = __float_as_uint(f); return b ^ ((unsigned)((int)b >> 31) | 0x80000000u); }
__device__ __forceinline__ float dec_key(unsigned k) { const unsigned b = (k & 0x80000000u) ? (k & 0x7fffffffu) : ~k; return __uint_as_float(b); }
__device__ __forceinline__ void topmerge16(unsigned (&top)[16], const unsigned (&L)[16]) {
#pragma unroll
    for (int i = 0; i < 16; ++i) top[i] = top[i] > L[15 - i] ? top[i] : L[15 - i];
    bitonic16_desc(top);
}
__device__ __forceinline__ unsigned cand_key(float a, float b, int i, int j) { return (enc_key(a + b) & ~0xFFu) | (unsigned)(i << 4) | (unsigned)j; }

__device__ __forceinline__ void peer_retrieve_item(const Params& P, int mtile, int h, char* smem) {
    const int tid = threadIdx.x, lane = tid & 63, wid = tid >> 6;
    const int wm = wid >> 1, wn = wid & 1, fr = lane & 15, fq = lane >> 4;
    const int sw = (fr >> 1) & 7;
    const int m0 = mtile * 128;
    unsigned T0[16], T1[16];
#pragma unroll 1
    for (int p = 0; p < 2; ++p) {
        const int hp = h * 2 + p;
        f32x4 acc[4][4];
        gemm_mainloop(P.H2, DM, P.PwqT, DM, DM, m0, hp * 128, false, smem, acc);
#pragma unroll
        for (int mt = 0; mt < 4; ++mt)
#pragma unroll
            for (int nt = 0; nt < 4; ++nt) {
                const int row = wm * 64 + mt * 16 + fr;
                u32x2 o; o.x = pk2(acc[mt][nt][0], acc[mt][nt][1]); o.y = pk2(acc[mt][nt][2], acc[mt][nt][3]);
                *(u32x2*)(smem + wn * 32768 + lds_off(row, 2 * nt + (fq >> 1)) + (fq & 1) * 8) = o;
            }
        {
            const int srow = tid >> 3, schunk = tid & 7;
            const bf16_t* kb = P.KeysB + (size_t)hp * 128 * 128;
#pragma unroll
            for (int hf = 0; hf < 2; ++hf)
#pragma unroll
                for (int q = 0; q < 4; ++q) {
                    const int row = q * 32 + srow;
                    const u32x4 v = *(const u32x4*)(kb + (size_t)row * 128 + hf * 64 + schunk * 8);
                    *(u32x4*)(smem + hf * 32768 + 16384 + lds_off(row, schunk)) = v;
                }
        }
        __syncthreads();
#pragma unroll
        for (int i = 0; i < 4; ++i)
#pragma unroll
            for (int j = 0; j < 4; ++j) acc[i][j] = (f32x4){0.f, 0.f, 0.f, 0.f};
        mma_from_lds(smem, smem + 16384, acc, wm, wn, fr, fq, sw);
        mma_from_lds(smem + 32768, smem + 32768 + 16384, acc, wm, wn, fr, fq, sw);
        __syncthreads();
        float* sc = (float*)smem;
#pragma unroll
        for (int mt = 0; mt < 4; ++mt)
#pragma unroll
            for (int nt = 0; nt < 4; ++nt) {
                const int row = wm * 64 + mt * 16 + fr;
#pragma unroll
                for (int r = 0; r < 4; ++r) {
                    const int col = wn * 64 + nt * 16 + fq * 4 + r;
                    sc[row * 130 + wn * 65 + (col & 63)] = acc[mt][nt][r];
                }
            }
        __syncthreads();
        {
            const int row = tid >> 1, half = tid & 1;
            const float* rp = sc + row * 130 + half * 65;
            unsigned top[16];
#pragma unroll
            for (int g = 0; g < 4; ++g) {
                unsigned L[16];
#pragma unroll
                for (int j = 0; j < 16; ++j) { const int col = half * 64 + g * 16 + j; L[j] = (enc_key(rp[g * 16 + j]) & ~0x7Fu) | (unsigned)col; }
                sort16_desc(L);
                if (g == 0) {
#pragma unroll
                    for (int j = 0; j < 16; ++j) top[j] = L[j];
                } else topmerge16(top, L);
            }
            unsigned Bp[16];
#pragma unroll
            for (int j = 0; j < 16; ++j) Bp[j] = (unsigned)__shfl_xor((int)top[j], 1);
            topmerge16(top, Bp);
            if (p == 0) {
#pragma unroll
                for (int j = 0; j < 16; ++j) T0[j] = top[j];
            } else {
#pragma unroll
                for (int j = 0; j < 16; ++j) T1[j] = top[j];
            }
        }
        __syncthreads();
    }
    {
        const int row = tid >> 1;
        unsigned char* slot = (unsigned char*)smem + row * 32;
        if ((tid & 1) == 0) {
#pragma unroll
            for (int j = 0; j < 16; ++j) { slot[j] = (unsigned char)(T0[j] & 0x7Fu); slot[16 + j] = (unsigned char)(T1[j] & 0x7Fu); }
            float a[16], b[16];
#pragma unroll
            for (int j = 0; j < 16; ++j) { a[j] = dec_key(T0[j]); b[j] = dec_key(T1[j]); }
            unsigned LA[16], LB[16], LC[16];
#pragma unroll
            for (int j = 0; j < 16; ++j) LA[j] = cand_key(a[0], b[j], 0, j);
#pragma unroll
            for (int j = 0; j < 8; ++j) LB[j] = cand_key(a[1], b[j], 1, j);
#pragma unroll
            for (int j = 0; j < 8; ++j) LB[8 + j] = cand_key(a[15 - j], b[0], 15 - j, 0);
            LC[0] = cand_key(a[2], b[0], 2, 0); LC[1] = cand_key(a[2], b[1], 2, 1); LC[2] = cand_key(a[2], b[2], 2, 2); LC[3] = cand_key(a[2], b[3], 2, 3); LC[4] = cand_key(a[2], b[4], 2, 4);
            LC[5] = cand_key(a[3], b[0], 3, 0); LC[6] = cand_key(a[3], b[1], 3, 1); LC[7] = cand_key(a[3], b[2], 3, 2); LC[8] = cand_key(a[3], b[3], 3, 3);
            LC[9] = cand_key(a[4], b[0], 4, 0); LC[10] = cand_key(a[4], b[1], 4, 1); LC[11] = cand_key(a[4], b[2], 4, 2);
            LC[12] = cand_key(a[5], b[0], 5, 0); LC[13] = cand_key(a[5], b[1], 5, 1);
            LC[14] = cand_key(a[6], b[0], 6, 0); LC[15] = cand_key(a[6], b[1], 6, 1);
            const unsigned d0 = cand_key(a[7], b[0], 7, 0), d1 = cand_key(a[7], b[1], 7, 1);
            bitonic16_desc(LB);
            sort16_desc(LC);
            topmerge16(LA, LB);
            LC[15] = LC[15] > d0 ? LC[15] : d0; LC[14] = LC[14] > d1 ? LC[14] : d1;
            bitonic16_desc(LC);
            topmerge16(LA, LC);
            float e[16], den = 0.f; const float vmax = dec_key(LA[0]);
#pragma unroll
            for (int r = 0; r < 16; ++r) { e[r] = __expf(dec_key(LA[r]) - vmax); den += e[r]; }
            const float inv = 1.f / den;
            const int t = m0 + row;
            int* oi = P.sel_idx + (size_t)t * 128 + h * 16; float* og = P.sel_g + (size_t)t * 128 + h * 16;
#pragma unroll
            for (int r = 0; r < 16; ++r) {
                const int i = (LA[r] >> 4) & 15, j = LA[r] & 15;
                oi[r] = (int)slot[i] * 128 + (int)slot[16 + j];
                og[r] = e[r] * inv;
            }
        }
    }
    __syncthreads();
}
typedef float f32x16 __attribute__((ext_vector_type(16)));
struct AttnFrag { u32x4 k[4]; u32x2 v[2][2][2]; };
__device__ __forceinline__ void attn_load(const Params& P, int b, int kvh, int qb, int w, int blk, int r, int hh, AttnFrag& f) {
    const bf16_t* kp; const bf16_t* vp; size_t vstride;
    if (blk < 9) {
        int kpos0 = (qb - 1) * 128 + 32 * (w + blk);
        if (kpos0 < 0 || kpos0 >= SEQ) kpos0 = 0;
        kp = P.K + (size_t)(b * SEQ + kpos0 + r) * 128 + kvh * 64 + 8 * hh;
        vp = P.VT + (size_t)((b * 2 + kvh) * 64 + r) * SEQ + kpos0 + 4 * hh; vstride = SEQ;
    } else {
        const int c0 = 32 * (blk - 9);
        kp = P.Kc + (size_t)(b * CTXL + c0 + r) * 128 + kvh * 64 + 8 * hh;
        vp = P.VcT + (size_t)((b * 2 + kvh) * 64 + r) * CTXL + c0 + 4 * hh; vstride = CTXL;
    }
#pragma unroll
    for (int ks = 0; ks < 4; ++ks) f.k[ks] = *(const u32x4*)(kp + 16 * ks);
#pragma unroll
    for (int db = 0; db < 2; ++db)
#pragma unroll
        for (int s = 0; s < 2; ++s) {
            f.v[db][s][0] = *(const u32x2*)(vp + (size_t)(32 * db) * vstride + 16 * s);
            f.v[db][s][1] = *(const u32x2*)(vp + (size_t)(32 * db) * vstride + 16 * s + 8);
        }
}
__device__ __forceinline__ void attn_item(const Params& P, int item) {
    const int head = item & 7, qb = (item >> 3) & 15, b = item >> 7, kvh = head >> 2;
    const int lane = threadIdx.x & 63, w = threadIdx.x >> 6, r = lane & 31, hh = lane >> 5;
    const int tok = b * SEQ + qb * 128 + 32 * w + r;
    bf16x8 qf[4];
    { const bf16_t* qp = P.Q + (size_t)tok * 512 + head * 64 + 8 * hh;
#pragma unroll
      for (int ks = 0; ks < 4; ++ks) qf[ks] = *(const bf16x8*)(qp + 16 * ks); }
    f32x16 o0, o1;
#pragma unroll
    for (int i = 0; i < 16; ++i) { o0[i] = 0.f; o1[i] = 0.f; }
    float mrun = P.sink[head], lrun = (hh == 0) ? 1.f : 0.f;
    AttnFrag cur, nxt;
    attn_load(P, b, kvh, qb, w, 0, r, hh, cur);
    for (int blk = 0; blk < 17; ++blk) {
        if (blk + 1 < 17) attn_load(P, b, kvh, qb, w, blk + 1, r, hh, nxt);
        int lo = 0, hi = 31;
        if (blk < 9) {
            const int kpos0 = (qb - 1) * 128 + 32 * (w + blk);
            if (kpos0 < 0 || kpos0 >= SEQ) lo = 64;
            else if (blk == 0) lo = r;
            else if (blk == 8) hi = r;
        }
        f32x16 s;
#pragma unroll
        for (int i = 0; i < 16; ++i) s[i] = 0.f;
#pragma unroll
        for (int ks = 0; ks < 4; ++ks) s = __builtin_amdgcn_mfma_f32_32x32x16_bf16(*(const bf16x8*)&cur.k[ks], qf[ks], s, 0, 0, 0);
        float mb = -3.0e38f;
#pragma unroll
        for (int i = 0; i < 16; ++i) { const int kk = (i & 3) + 8 * (i >> 2) + 4 * hh; const bool ok = (kk >= lo) && (kk <= hi); s[i] = ok ? s[i] : -3.0e38f; mb = fmaxf(mb, s[i]); }
        mb = fmaxf(mb, __shfl_xor(mb, 32));
        const float mn = fmaxf(mrun, mb);
        const float alpha = __expf(mrun - mn);
        float ps = 0.f; float p[16];
#pragma unroll
        for (int i = 0; i < 16; ++i) { p[i] = __expf(s[i] - mn); ps += p[i]; }
        lrun = lrun * alpha + ps; mrun = mn;
#pragma unroll
        for (int i = 0; i < 16; ++i) { o0[i] *= alpha; o1[i] *= alpha; }
        u32x4 pb[2];
        pb[0].x = pk2(p[0], p[1]); pb[0].y = pk2(p[2], p[3]); pb[0].z = pk2(p[4], p[5]); pb[0].w = pk2(p[6], p[7]);
        pb[1].x = pk2(p[8], p[9]); pb[1].y = pk2(p[10], p[11]); pb[1].z = pk2(p[12], p[13]); pb[1].w = pk2(p[14], p[15]);
#pragma unroll
        for (int sI = 0; sI < 2; ++sI) {
            u32x4 va, vb;
            va.x = cur.v[0][sI][0].x; va.y = cur.v[0][sI][0].y; va.z = cur.v[0][sI][1].x; va.w = cur.v[0][sI][1].y;
            vb.x = cur.v[1][sI][0].x; vb.y = cur.v[1][sI][0].y; vb.z = cur.v[1][sI][1].x; vb.w = cur.v[1][sI][1].y;
            o0 = __builtin_amdgcn_mfma_f32_32x32x16_bf16(*(const bf16x8*)&va, *(const bf16x8*)&pb[sI], o0, 0, 0, 0);
            o1 = __builtin_amdgcn_mfma_f32_32x32x16_bf16(*(const bf16x8*)&vb, *(const bf16x8*)&pb[sI], o1, 0, 0, 0);
        }
        if (blk + 1 < 17) cur = nxt;
    }
    const float ltot = lrun + __shfl_xor(lrun, 32);
    const float inv = 1.f / ltot;
    bf16_t* op = P.AO + (size_t)tok * 512 + head * 64 + 4 * hh;
#pragma unroll
    for (int g = 0; g < 4; ++g) {
        float t0[4] = { o0[4 * g] * inv, o0[4 * g + 1] * inv, o0[4 * g + 2] * inv, o0[4 * g + 3] * inv };
        float t1[4] = { o1[4 * g] * inv, o1[4 * g + 1] * inv, o1[4 * g + 2] * inv, o1[4 * g + 3] * inv };
        st4bf(op + 8 * g, t0); st4bf(op + 32 + 8 * g, t1);
    }
}

__device__ __forceinline__ void conv_range(const Params& P, size_t gtid, size_t gsize) {
    for (size_t idx = gtid; idx < (size_t)NTOK * 64; idx += gsize) {
        const int m = (int)(idx >> 6), c0 = (int)(idx & 63) * 8, l = m % SEQ;
        float cu[3][8];
#pragma unroll
        for (int t = 0; t < 3; ++t) {
            const int ll = l + t - 1;
            if (ll < 0 || ll >= SEQ) {
#pragma unroll
                for (int j = 0; j < 8; ++j) cu[t][j] = 0.f;
            } else {
                const u32x4 g = *(const u32x4*)(P.GC + (size_t)(m + t - 1) * 512 + c0), u = *(const u32x4*)(P.U + (size_t)(m + t - 1) * 512 + c0);
                cu[t][0] = bf2f(g.x & 0xffff) * bf2f(u.x & 0xffff); cu[t][1] = bf2f(g.x >> 16) * bf2f(u.x >> 16);
                cu[t][2] = bf2f(g.y & 0xffff) * bf2f(u.y & 0xffff); cu[t][3] = bf2f(g.y >> 16) * bf2f(u.y >> 16);
                cu[t][4] = bf2f(g.z & 0xffff) * bf2f(u.z & 0xffff); cu[t][5] = bf2f(g.z >> 16) * bf2f(u.z >> 16);
                cu[t][6] = bf2f(g.w & 0xffff) * bf2f(u.w & 0xffff); cu[t][7] = bf2f(g.w >> 16) * bf2f(u.w >> 16);
            }
        }
        const u32x4 gbv = *(const u32x4*)(P.GB + (size_t)m * 512 + c0);
        const float gb[8] = { bf2f(gbv.x & 0xffff), bf2f(gbv.x >> 16), bf2f(gbv.y & 0xffff), bf2f(gbv.y >> 16), bf2f(gbv.z & 0xffff), bf2f(gbv.z >> 16), bf2f(gbv.w & 0xffff), bf2f(gbv.w >> 16) };
        float o[8];
#pragma unroll
        for (int j = 0; j < 8; ++j) o[j] = gb[j] * (P.conv_w[c0 + j] * cu[0][j] + P.conv_w[512 + c0 + j] * cu[1][j] + P.conv_w[1024 + c0 + j] * cu[2][j]);
        st8bf(P.CA + (size_t)m * 512 + c0, o);
    }
}

__device__ __forceinline__ void unpack8(const u32x4 v, float* f) {
    f[0] = bf2f(v.x & 0xffff); f[1] = bf2f(v.x >> 16); f[2] = bf2f(v.y & 0xffff); f[3] = bf2f(v.y >> 16);
    f[4] = bf2f(v.z & 0xffff); f[5] = bf2f(v.z >> 16); f[6] = bf2f(v.w & 0xffff); f[7] = bf2f(v.w >> 16);
}
typedef __bf16 bf2_t __attribute__((ext_vector_type(2)));
__device__ __forceinline__ float dot2bf(unsigned a, unsigned b, float c) { return __builtin_amdgcn_fdot2_f32_bf16(__builtin_bit_cast(bf2_t, a), __builtin_bit_cast(bf2_t, b), c, false); }
__device__ __forceinline__ float gelu_erf(float d) { return 0.5f * d * (1.f + erff(d * 0.70710678118654752f)); }
__device__ __forceinline__ float reduce64(float (&part)[64], int lane) {
#pragma unroll
    for (int i = 0; i < 32; ++i) { auto r = __builtin_amdgcn_permlane32_swap(__float_as_uint(part[i]), __float_as_uint(part[32 + i]), false, false); part[i] = __uint_as_float(r[0]) + __uint_as_float(r[1]); }
#pragma unroll
    for (int i = 0; i < 16; ++i) { auto r = __builtin_amdgcn_permlane16_swap(__float_as_uint(part[i]), __float_as_uint(part[16 + i]), false, false); part[i] = __uint_as_float(r[0]) + __uint_as_float(r[1]); }
#define RSTAGE(N) { const bool up = (lane & N) != 0; _Pragma("unroll") for (int i = 0; i < N; ++i) { const float keep = up ? part[N + i] : part[i], send = up ? part[i] : part[N + i]; part[i] = keep + __shfl_xor(send, N); } }
    RSTAGE(8) RSTAGE(4) RSTAGE(2) RSTAGE(1)
#undef RSTAGE
    return part[0];
}
__device__ __forceinline__ void peer_final_token(const Params& P, int t, int lane) {
    const int b = t / SEQ;
    const u32x4 h0 = *(const u32x4*)(P.H2 + (size_t)t * DM + lane * 8), h1 = *(const u32x4*)(P.H2 + (size_t)t * DM + 512 + lane * 8);
    float acc[16];
#pragma unroll
    for (int j = 0; j < 16; ++j) acc[j] = 0.f;
#pragma unroll 1
    for (int half = 0; half < 2; ++half) {
        const int myidx = P.sel_idx[(size_t)t * 128 + half * 64 + lane];
        const float myg = P.sel_g[(size_t)t * 128 + half * 64 + lane];
        float part[64];
#pragma unroll
        for (int k = 0; k < 64; ++k) {
            const int e = __builtin_amdgcn_readlane(myidx, k);
            const bf16_t* up = P.Ub + (size_t)e * DM + lane * 8;
            const u32x4 a = *(const u32x4*)up, c = *(const u32x4*)(up + 512);
            float d = dot2bf(a.x, h0.x, 0.f); d = dot2bf(a.y, h0.y, d); d = dot2bf(a.z, h0.z, d); d = dot2bf(a.w, h0.w, d);
            d = dot2bf(c.x, h1.x, d); d = dot2bf(c.y, h1.y, d); d = dot2bf(c.z, h1.z, d); d = dot2bf(c.w, h1.w, d);
            part[k] = d;
        }
        const float a = reduce64(part, lane);
        const float w = myg * gelu_erf(a);
#pragma unroll
        for (int k = 0; k < 64; ++k) {
            const int e = __builtin_amdgcn_readlane(myidx, k);
            const float wk = __uint_as_float(__builtin_amdgcn_readlane(__float_as_uint(w), k));
            const bf16_t* vp = P.Vb + (size_t)e * DM + lane * 8;
            const u32x4 x = *(const u32x4*)vp, y = *(const u32x4*)(vp + 512);
            acc[0] += wk * __uint_as_float(x.x << 16); acc[1] += wk * __uint_as_float(x.x & 0xffff0000u);
            acc[2] += wk * __uint_as_float(x.y << 16); acc[3] += wk * __uint_as_float(x.y & 0xffff0000u);
            acc[4] += wk * __uint_as_float(x.z << 16); acc[5] += wk * __uint_as_float(x.z & 0xffff0000u);
            acc[6] += wk * __uint_as_float(x.w << 16); acc[7] += wk * __uint_as_float(x.w & 0xffff0000u);
            acc[8] += wk * __uint_as_float(y.x << 16); acc[9] += wk * __uint_as_float(y.x & 0xffff0000u);
            acc[10] += wk * __uint_as_float(y.y << 16); acc[11] += wk * __uint_as_float(y.y & 0xffff0000u);
            acc[12] += wk * __uint_as_float(y.z << 16); acc[13] += wk * __uint_as_float(y.z & 0xffff0000u);
            acc[14] += wk * __uint_as_float(y.w << 16); acc[15] += wk * __uint_as_float(y.w & 0xffff0000u);
        }
    }
    float x2[16]; float ss = 0.f;
    const float* x1 = P.X1 + (size_t)t * DM; const float* g2 = P.mod + (size_t)b * NMOD + 5 * DM;
#pragma unroll
    for (int half = 0; half < 2; ++half) {
        const int d0 = half * 512 + lane * 8;
        const f32x4 xa = *(const f32x4*)(x1 + d0), xb = *(const f32x4*)(x1 + d0 + 4), ga = *(const f32x4*)(g2 + d0), gb = *(const f32x4*)(g2 + d0 + 4);
        const float xv[8] = { xa.x, xa.y, xa.z, xa.w, xb.x, xb.y, xb.z, xb.w }, gv[8] = { ga.x, ga.y, ga.z, ga.w, gb.x, gb.y, gb.z, gb.w };
#pragma unroll
        for (int j = 0; j < 8; ++j) { const float v = xv[j] + gv[j] * acc[half * 8 + j]; x2[half * 8 + j] = v; ss += v * v; }
    }
    ss = wave_sum(ss);
    const float rstd = rsqrtf(ss * (1.f / DM) + 1e-6f);
    float* op = P.out + (size_t)t * DM;
#pragma unroll
    for (int half = 0; half < 2; ++half) {
        const int d0 = half * 512 + lane * 8;
        const f32x4 fa = *(const f32x4*)(P.fg + d0), fb = *(const f32x4*)(P.fg + d0 + 4);
        f32x4 oa, ob;
        oa.x = x2[half * 8 + 0] * rstd * fa.x; oa.y = x2[half * 8 + 1] * rstd * fa.y; oa.z = x2[half * 8 + 2] * rstd * fa.z; oa.w = x2[half * 8 + 3] * rstd * fa.w;
        ob.x = x2[half * 8 + 4] * rstd * fb.x; ob.y = x2[half * 8 + 5] * rstd * fb.y; ob.z = x2[half * 8 + 6] * rstd * fb.z; ob.w = x2[half * 8 + 7] * rstd * fb.w;
        *(f32x4*)(op + d0) = oa; *(f32x4*)(op + d0 + 4) = ob;
    }
}

#define XB_TMO      128
#define XB_XCNT(j)  (256  + 64 * (j))
#define XB_XSUB(j)  (1280 + 64 * (j))
#define XB_XGEN(j)  (2304 + 64 * (j))
#define XB_TOP      3328
#define XB_TOPGEN   3392
#define XCD_BAR_WORDS 3456
#define XB_SPIN_CAP (1u << 22)
#define LAS __attribute__((address_space(3)))
__device__ __forceinline__ unsigned xb_ld(unsigned* p)              { return __hip_atomic_load(p, __ATOMIC_RELAXED, __HIP_MEMORY_SCOPE_AGENT); }
__device__ __forceinline__ unsigned xb_add(unsigned* p, unsigned v) { return __hip_atomic_fetch_add(p, v, __ATOMIC_RELAXED, __HIP_MEMORY_SCOPE_AGENT); }
__device__ __forceinline__ unsigned xb_xcc_id() { return (unsigned)__builtin_amdgcn_s_getreg((3 << 11) | 20) & 0xFu; }
#define XB_SPIN(cond, bar) do { unsigned _sp = 0; while (cond) { __builtin_amdgcn_s_sleep(1); \
    if ((++_sp & 255u) == 0u) { if (xb_ld(&(bar)[XB_TMO])) break; if (_sp > XB_SPIN_CAP) { atomicAdd(&(bar)[XB_TMO], 1u); break; } } } } while (0)
struct XcdBarrier { unsigned* bar; unsigned x; volatile LAS unsigned* st; };
__device__ __forceinline__ XcdBarrier xcd_barrier_post(unsigned* bar, volatile LAS unsigned* st) {
    XcdBarrier b; b.bar = bar; b.x = xb_xcc_id(); b.st = st;
    if (threadIdx.x == 0) (void)xb_add(&bar[XB_XCNT(b.x)], 1u);
    return b;
}
__device__ __forceinline__ void xcd_barrier_complete(unsigned* bar, unsigned x, unsigned& nloc, unsigned& nx) {
    const unsigned G = gridDim.x * gridDim.y * gridDim.z;
    unsigned sum, cnt, mine, sp = 0u;
    for (;;) {
        sum = 0u; cnt = 0u; mine = 0u;
#pragma unroll
        for (unsigned j = 0; j < 16; ++j) { const unsigned c = xb_ld(&bar[XB_XCNT(j)]); sum += c; cnt += (c > 0u) ? 1u : 0u; mine = (j == x) ? c : mine; }
        if (sum == G) break;
        __builtin_amdgcn_s_sleep(1);
        if ((++sp & 255u) == 0u) { if (xb_ld(&bar[XB_TMO])) break; if (sp > XB_SPIN_CAP) { atomicAdd(&bar[XB_TMO], 1u); break; } }
    }
    nloc = mine > 0u ? mine : 1u; nx = cnt > 0u ? cnt : 1u;
}
__device__ __forceinline__ void xcd_barrier(const XcdBarrier& b) {
    asm volatile("s_waitcnt vmcnt(0)" ::: "memory");
    __syncthreads();
    if (threadIdx.x == 0) {
        unsigned* bar = b.bar;
        __builtin_amdgcn_s_waitcnt(0);
        unsigned nloc = b.st[0], nx = b.st[1];
        if (nloc == 0u) { xcd_barrier_complete(bar, b.x, nloc, nx); b.st[0] = nloc; b.st[1] = nx; }
        const unsigned old = xb_add(&bar[XB_XSUB(b.x)], 1u);
        const unsigned gen = old / nloc;
        if (old + 1u == (gen + 1u) * nloc) {
            __builtin_amdgcn_fence(__ATOMIC_RELEASE, "agent");
            asm volatile("s_waitcnt vmcnt(0)" ::: "memory");
            const unsigned og = xb_add(&bar[XB_TOP], 1u);
            const unsigned tg = og / nx;
            if (og + 1u == (tg + 1u) * nx) xb_add(&bar[XB_TOPGEN], 1u);
            else XB_SPIN(xb_ld(&bar[XB_TOPGEN]) == tg, bar);
            __builtin_amdgcn_fence(__ATOMIC_ACQUIRE, "agent");
            xb_add(&bar[XB_XGEN(b.x)], 1u);
            asm volatile("s_waitcnt vmcnt(0)" ::: "memory");
        } else {
            XB_SPIN(xb_ld(&bar[XB_XGEN(b.x)]) == gen, bar);
            __builtin_amdgcn_fence(__ATOMIC_ACQUIRE, "agent");
            asm volatile("s_waitcnt vmcnt(0)" ::: "memory");
        }
    }
    __syncthreads();
}

constexpr int NPHASE = 9;
template <int PH> __device__ __forceinline__ void run_phase(const Params& P, char* smem) {
    const int bid = blockIdx.x, G = gridDim.x, tid = threadIdx.x;
    const size_t gtid = (size_t)bid * 256 + tid, gsize = (size_t)G * 256;
    if (PH == 0) {
        for (int it = bid; it < 192; it += G) modp_item(P, it, smem);
        float (*tile)[65] = (float (*)[65])smem;
        for (int it = bid; it < 1088; it += G) transpose_tile(P.w_in, DM, PROJW, P.WinT, it, tile);
        for (int it = bid; it < 128; it += G) transpose_tile(P.w_ao, 512, DM, P.WaoT, it, tile);
        for (int it = bid; it < 128; it += G) transpose_tile(P.w_co, 512, DM, P.WcoT, it, tile);
        for (int it = bid; it < 256; it += G) transpose_tile(P.w_mix, DM, DM, P.WmixT, it, tile);
        for (int it = bid; it < 512; it += G) transpose_tile(P.pw_q, DM, 2048, P.PwqT, it, tile);
        cvt_range(P.keys, P.KeysB, (size_t)16 * 128 * 128 / 8, gtid, gsize);
        cvt_range(P.pu, P.Ub, (size_t)NEXP * DM / 8, gtid, gsize);
        cvt_range(P.pv, P.Vb, (size_t)NEXP * DM / 8, gtid, gsize);
        rope_tab(P, (int)gtid, (int)gsize);
    } else if (PH == 1) {
        for (int i = (int)gtid; i < 17 * NMOD; i += (int)gsize) {
            float v = P.b_mod[i % NMOD];
#pragma unroll
            for (int kc = 0; kc < 8; ++kc) v += P.modp[(size_t)kc * 17 * NMOD + i];
            P.mod[i] = v;
        }
        for (int it = bid; it < 1152; it += G) norm1_item(P, it, smem);
    } else if (PH == 2) {
        for (int t = bid; t < 256 * 34 + 64; t += G) {
            if (t < 256 * 34) { int mt, nt; tile_coords(t, 256, 34, mt, nt); gemm_tile<MODE_INPROJ>(P, P.H, DM, P.WinT, DM, DM, mt * 128, nt * 128, nt * 128 >= 768, smem); }
            else { const int u = t - 256 * 34, mt = u >> 1, nt = u & 1; gemm_tile<MODE_CTXKV>(P, P.HC, DM, P.WinT + (size_t)512 * DM, DM, DM, mt * 128, nt * 128, nt == 0, smem); }
        }
    } else if (PH == 3) {
        for (int it = bid; it < NB * 16 * 8; it += G) attn_item(P, it);
        conv_range(P, gtid, gsize);
    } else if (PH == 4) {
        for (int t = bid; t < 256 * 8; t += G) {
            int mt, nt; tile_coords(t, 256, 8, mt, nt);
            gemm_tile<MODE_AO1>(P, P.AO, 512, P.WaoT, 512, 512, mt * 128, nt * 128, true, smem);
            gemm_tile<MODE_CO2>(P, P.CA, 512, P.WcoT, 512, 512, mt * 128, nt * 128, true, smem);
        }
    } else if (PH == 5) {
        for (int t = bid; t < 256 * 8; t += G) { int mt, nt; tile_coords(t, 256, 8, mt, nt); gemm_tile<MODE_MIX>(P, P.YG, DM, P.WmixT, DM, DM, mt * 128, nt * 128, true, smem); }
    } else if (PH == 6) {
        const int lane = tid & 63, wid = tid >> 6;
        for (int row = bid * 4 + wid; row < NTOK; row += G * 4) { const int b = row / SEQ;
            norm_row(P.X1 + (size_t)row * DM, P.n2, P.mod + (size_t)b * NMOD + 4 * DM, P.mod + (size_t)b * NMOD + 3 * DM, P.H2 + (size_t)row * DM, lane); }
    } else if (PH == 7) {
        for (int it = bid; it < 256 * 8; it += G) peer_retrieve_item(P, it >> 3, it & 7, smem);
    } else if (PH == 8) {
        const int lane = tid & 63, wid = tid >> 6;
        for (int t = bid * 4 + wid; t < NTOK; t += G * 4) peer_final_token(P, t, lane);
    }
}
constexpr int MEGA_LDS = RETR_LDS;
#ifndef MULTI_LAUNCH
__global__ void __launch_bounds__(256, 2) k_mega(Params P) {
    extern __shared__ __attribute__((aligned(16))) char smem[];
    volatile LAS unsigned* st = (volatile LAS unsigned*)(smem + MEGA_LDS);
    if (threadIdx.x < 4) st[threadIdx.x] = 0u;
    __syncthreads();
    const XcdBarrier bar = xcd_barrier_post(P.bar, st);
    run_phase<0>(P, smem); xcd_barrier(bar);
    run_phase<1>(P, smem); xcd_barrier(bar);
    run_phase<2>(P, smem); xcd_barrier(bar);
    run_phase<3>(P, smem); xcd_barrier(bar);
    run_phase<4>(P, smem); xcd_barrier(bar);
    run_phase<5>(P, smem); xcd_barrier(bar);
    run_phase<6>(P, smem); xcd_barrier(bar);
    run_phase<7>(P, smem); xcd_barrier(bar);
    run_phase<8>(P, smem);
}
#else
template <int PH> __global__ void __launch_bounds__(256, 2) k_phase(Params P) {
    extern __shared__ __attribute__((aligned(16))) char smem[];
    run_phase<PH>(P, smem);
}
#endif

static size_t carve(size_t& off, size_t bytes) { const size_t o = off; off += (bytes + 255) & ~(size_t)255; return o; }

extern "C" void kernel_launch(void* const* d_in, const int* in_sizes, int n_in, void* d_out, int out_size, void* d_ws, size_t ws_size, hipStream_t stream) {
    Params P{};
    P.x = (const float*)d_in[0]; P.c = (const float*)d_in[1]; P.ctx = (const float*)d_in[2]; P.c_ctx = (const float*)d_in[3];
    P.w_mod = (const float*)d_in[4]; P.b_mod = (const float*)d_in[5]; P.n1 = (const float*)d_in[6]; P.n2 = (const float*)d_in[7];
    P.w_in = (const float*)d_in[8]; P.sink = (const float*)d_in[9]; P.conv_w = (const float*)d_in[10]; P.w_ao = (const float*)d_in[11];
    P.w_co = (const float*)d_in[12]; P.w_mix = (const float*)d_in[13]; P.pw_q = (const float*)d_in[14]; P.keys = (const float*)d_in[15];
    P.pu = (const float*)d_in[16]; P.pv = (const float*)d_in[17]; P.fg = (const float*)d_in[18];
    P.out = (float*)d_out;
    char* ws = (char*)d_ws; size_t off = 0;
    P.modp = (float*)(ws + carve(off, (size_t)8 * 17 * NMOD * 4));
    P.mod = (float*)(ws + carve(off, (size_t)17 * NMOD * 4));
    P.rope = (float*)(ws + carve(off, 3072 * 4));
    P.WinT = (bf16_t*)(ws + carve(off, (size_t)PROJW * DM * 2));
    P.WaoT = (bf16_t*)(ws + carve(off, (size_t)DM * 512 * 2));
    P.WcoT = (bf16_t*)(ws + carve(off, (size_t)DM * 512 * 2));
    P.WmixT = (bf16_t*)(ws + carve(off, (size_t)DM * DM * 2));
    P.PwqT = (bf16_t*)(ws + carve(off, (size_t)2048 * DM * 2));
    P.KeysB = (bf16_t*)(ws + carve(off, (size_t)16 * 128 * 128 * 2));
    P.Ub = (bf16_t*)(ws + carve(off, (size_t)NEXP * DM * 2));
    P.Vb = (bf16_t*)(ws + carve(off, (size_t)NEXP * DM * 2));
    P.HC = (bf16_t*)(ws + carve(off, (size_t)NCTX * DM * 2));
    const size_t regA = carve(off, (size_t)NTOK * DM * 2);
    P.H = (bf16_t*)(ws + regA); P.YG = (bf16_t*)(ws + regA); P.H2 = (bf16_t*)(ws + regA);
    const size_t regB = off;
    P.Q = (bf16_t*)(ws + carve(off, (size_t)NTOK * 512 * 2));
    P.K = (bf16_t*)(ws + carve(off, (size_t)NTOK * 128 * 2));
    P.VT = (bf16_t*)(ws + carve(off, (size_t)NTOK * 128 * 2));
    P.Kc = (bf16_t*)(ws + carve(off, (size_t)NCTX * 128 * 2));
    P.VcT = (bf16_t*)(ws + carve(off, (size_t)NCTX * 128 * 2));
    const size_t regC = off;
    P.GB = (bf16_t*)(ws + carve(off, (size_t)NTOK * 512 * 2));
    P.GC = (bf16_t*)(ws + carve(off, (size_t)NTOK * 512 * 2));
    P.U = (bf16_t*)(ws + carve(off, (size_t)NTOK * 512 * 2));
    P.M1 = (bf16_t*)(ws + regC);
    const size_t regD = off;
    P.GA = (bf16_t*)(ws + carve(off, (size_t)NTOK * DM * 2));
    P.GV = (bf16_t*)(ws + carve(off, (size_t)NTOK * DM * 2));
    P.AO = (bf16_t*)(ws + carve(off, (size_t)NTOK * 512 * 2));
    P.CA = (bf16_t*)(ws + carve(off, (size_t)NTOK * 512 * 2));
    P.X1 = (float*)(ws + regD);
    P.bar = (unsigned*)(ws + carve(off, (size_t)XCD_BAR_WORDS * 4));
    const size_t need = off;
    { size_t o2 = regB;
      P.sel_idx = (int*)(ws + carve(o2, (size_t)NTOK * 128 * 4));
      P.sel_g = (float*)(ws + carve(o2, (size_t)NTOK * 128 * 4));
      if (o2 > regC) { fprintf(stderr, "kernel_launch: late buffers overflow\n"); return; } }
    if (need > ws_size) { fprintf(stderr, "kernel_launch: workspace too small: need %zu have %zu\n", need, ws_size); return; }

#ifdef MULTI_LAUNCH
    static bool attr_done = false;
    if (!attr_done) {
#define SETA(PH) hipFuncSetAttribute((const void*)k_phase<PH>, hipFuncAttributeMaxDynamicSharedMemorySize, MEGA_LDS)
        SETA(0); SETA(1); SETA(2); SETA(3); SETA(4); SETA(5); SETA(6); SETA(7); SETA(8);
        attr_done = true;
    }
#define LP(PH) k_phase<PH><<<512, 256, MEGA_LDS, stream>>>(P)
    LP(0); LP(1); LP(2); LP(3); LP(4); LP(5); LP(6); LP(7); LP(8);
#else
    static int grid_blocks = 0;
    if (!grid_blocks) {
        int dev = 0, cus = 0, per_cu = 0;
        (void)hipGetDevice(&dev);
        (void)hipDeviceGetAttribute(&cus, hipDeviceAttributeMultiprocessorCount, dev);
        (void)hipFuncSetAttribute((const void*)k_mega, hipFuncAttributeMaxDynamicSharedMemorySize, MEGA_LDS + 16);
        (void)hipOccupancyMaxActiveBlocksPerMultiprocessor(&per_cu, (const void*)k_mega, 256, MEGA_LDS + 16);
        if (per_cu > 2) per_cu = 2;
        if (per_cu < 1) { fprintf(stderr, "kernel_launch: occupancy query returned %d\n", per_cu); per_cu = 1; }
        grid_blocks = cus * per_cu;
    }
    (void)hipMemsetAsync(P.bar, 0, (size_t)XCD_BAR_WORDS * 4, stream);
    void* args[] = { &P };
    hipError_t e = hipLaunchCooperativeKernel((const void*)k_mega, dim3(grid_blocks), dim3(256), args, MEGA_LDS + 16, stream);
    if (e != hipSuccess) fprintf(stderr, "cooperative launch failed: %s (grid %d)\n", hipGetErrorString(e), grid_blocks);
#endif
}
```

```cpp
#include <hip/hip_runtime.h>
#include <cstdio>
#include <cstdint>

typedef unsigned short bf16_t;
typedef short bf16x8 __attribute__((ext_vector_type(8)));
typedef float f32x4 __attribute__((ext_vector_type(4)));
typedef unsigned u32x4 __attribute__((ext_vector_type(4)));
typedef unsigned u32x2 __attribute__((ext_vector_type(2)));

constexpr int DM = 1024, NB = 16, SEQ = 2048, NTOK = NB * SEQ, CTXL = 256, NCTX = NB * CTXL;
constexpr int PROJW = 4352;
constexpr int NMOD = 6 * DM;
constexpr int NEXP = 16384;

__device__ __forceinline__ float bf2f(bf16_t x) { return __uint_as_float(((unsigned)x) << 16); }
__device__ __forceinline__ bf16_t f2bf(float f) {
    unsigned u = __float_as_uint(f);
    u += 0x7fffu + ((u >> 16) & 1u);
    return (bf16_t)(u >> 16);
}
__device__ __forceinline__ unsigned pk2(float lo, float hi) { return (unsigned)f2bf(lo) | ((unsigned)f2bf(hi) << 16); }
__device__ __forceinline__ float sigmoidf_(float x) { return 1.f / (1.f + __expf(-x)); }
__device__ __forceinline__ float wave_sum(float v) {
#pragma unroll
    for (int o = 1; o < 64; o <<= 1) v += __shfl_xor(v, o);
    return v;
}

__device__ __forceinline__ float wave_max(float v) {
#pragma unroll
    for (int o = 1; o < 64; o <<= 1) v = fmaxf(v, __shfl_xor(v, o));
    return v;
}
__device__ __forceinline__ unsigned q8(float x, float inv, int bias) {
    int q = (int)rintf(x * inv); q = q > 127 ? 127 : (q < -127 ? -127 : q);
    return (unsigned)((q + bias) & 0xff);
}
__device__ __forceinline__ void quant_row(const float* src, unsigned char* dst, float* scale_out, int lane, int bias) {
    f32x4 v[4]; float amax = 0.f;
#pragma unroll
    for (int j = 0; j < 4; ++j) { v[j] = *(const f32x4*)(src + 16 * lane + 4 * j); amax = fmaxf(amax, fmaxf(fmaxf(fabsf(v[j].x), fabsf(v[j].y)), fmaxf(fabsf(v[j].z), fabsf(v[j].w)))); }
    amax = wave_max(amax);
    const float sc = amax > 0.f ? amax * (1.f / 127.f) : 1.f, inv = 1.f / sc;
    u32x4 w;
    w.x = q8(v[0].x, inv, bias) | (q8(v[0].y, inv, bias) << 8) | (q8(v[0].z, inv, bias) << 16) | (q8(v[0].w, inv, bias) << 24);
    w.y = q8(v[1].x, inv, bias) | (q8(v[1].y, inv, bias) << 8) | (q8(v[1].z, inv, bias) << 16) | (q8(v[1].w, inv, bias) << 24);
    w.z = q8(v[2].x, inv, bias) | (q8(v[2].y, inv, bias) << 8) | (q8(v[2].z, inv, bias) << 16) | (q8(v[2].w, inv, bias) << 24);
    w.w = q8(v[3].x, inv, bias) | (q8(v[3].y, inv, bias) << 8) | (q8(v[3].z, inv, bias) << 16) | (q8(v[3].w, inv, bias) << 24);
    *(u32x4*)(dst + 16 * lane) = w;
    if (lane == 0) *scale_out = sc;
}

struct Params {
    const float *x, *c, *ctx, *c_ctx, *w_mod, *b_mod, *n1, *n2, *w_in, *sink, *conv_w, *w_ao, *w_co, *w_mix, *pw_q, *keys, *pu, *pv, *fg;
    float* out;
    float *modp, *mod, *rope;
    bf16_t *WinT, *WaoT, *WcoT, *WmixT, *PwqT, *KeysB;
    bf16_t *H, *HC, *Q, *K, *VT, *Kc, *VcT, *GB, *GC, *U, *GA, *GV, *AO, *CA, *M1, *YG, *H2, *QH;
    float* TKv; int* TKi;
    int* sel_idx; float* sel_g;
    float* X1;
    unsigned* bar;
    signed char *Uq, *H2q; unsigned char* Vq; float *su, *sv, *sh2;
};

__device__ __forceinline__ void modp_item(const Params& P, int item, char* smem) {
    float (*s)[128] = (float (*)[128])smem;
    const int kc = item / 24, nc = item % 24;
    __syncthreads();
    for (int i = threadIdx.x; i < 17 * 128; i += 256) {
        const int r = i / 128, k = i % 128;
        const float v = (r < 16) ? P.c[r * DM + kc * 128 + k] : P.c_ctx[kc * 128 + k];
        s[r][k] = v / (1.f + __expf(-v));
    }
    __syncthreads();
    const int n = nc * 256 + threadIdx.x;
    float acc[17];
#pragma unroll
    for (int r = 0; r < 17; ++r) acc[r] = 0.f;
    for (int k = 0; k < 128; ++k) {
        const float w = P.w_mod[(size_t)(kc * 128 + k) * NMOD + n];
#pragma unroll
        for (int r = 0; r < 17; ++r) acc[r] += s[r][k] * w;
    }
#pragma unroll
    for (int r = 0; r < 17; ++r) P.modp[((size_t)kc * 17 + r) * NMOD + n] = acc[r];
}
__device__ __forceinline__ void cvt_range(const float* src, bf16_t* dst, size_t n8, size_t gtid, size_t gsize) {
    for (size_t i = gtid; i < n8; i += gsize) {
        const f32x4 a = *(const f32x4*)(src + i * 8), b = *(const f32x4*)(src + i * 8 + 4);
        u32x4 o; o.x = pk2(a.x, a.y); o.y = pk2(a.z, a.w); o.z = pk2(b.x, b.y); o.w = pk2(b.z, b.w);
        *(u32x4*)(dst + i * 8) = o;
    }
}
__device__ __forceinline__ void rope_tab(const Params& P, int gtid, int gsize) {
    for (int i = gtid; i < 1536; i += gsize) {
        int pos, f; bool isc;
        if (i < 512) { pos = i / 16; f = i % 16; isc = false; } else { pos = (i - 512) / 16; f = (i - 512) % 16; isc = true; }
        const double inv = pow(10000.0, -(double)f / 16.0);
        const double ang = (double)pos * inv;
        const float cv = (float)cos(ang), sv = (float)sin(ang);
        if (!isc) { P.rope[pos * 16 + f] = cv; P.rope[512 + pos * 16 + f] = sv; }
        else { P.rope[1024 + pos * 16 + f] = cv; P.rope[2048 + pos * 16 + f] = sv; }
    }
}
__device__ __forceinline__ void transpose_tile(const float* W, int K, int N, bf16_t* Wt, int item, float (*tile)[65]) {
    const int ntn = N / 64, kt = item / ntn, nt = item % ntn, k0 = kt * 64, n0 = nt * 64;
    const int tx = threadIdx.x & 63, ty = threadIdx.x >> 6;
    __syncthreads();
#pragma unroll
    for (int i = 0; i < 16; ++i) { const int k = i * 4 + ty; tile[k][tx] = W[(size_t)(k0 + k) * N + n0 + tx]; }
    __syncthreads();
#pragma unroll
    for (int i = 0; i < 16; ++i) { const int n = i * 4 + ty; Wt[(size_t)(n0 + n) * K + k0 + tx] = f2bf(tile[tx][n]); }
}

__device__ __forceinline__ void norm_row(const float* xr, const float* g, const float* scale, const float* shift, bf16_t* dst, int lane) {
    f32x4 v[4]; float s = 0.f;
#pragma unroll
    for (int j = 0; j < 4; ++j) { v[j] = *(const f32x4*)(xr + j * 256 + lane * 4); s += v[j].x * v[j].x + v[j].y * v[j].y + v[j].z * v[j].z + v[j].w * v[j].w; }
    s = wave_sum(s);
    const float rstd = rsqrtf(s * (1.f / DM) + 1e-6f);
#pragma unroll
    for (int j = 0; j < 4; ++j) {
        const int d = j * 256 + lane * 4;
        const f32x4 gg = *(const f32x4*)(g + d), sc = *(const f32x4*)(scale + d), sh = *(const f32x4*)(shift + d);
        const float y0 = v[j].x * rstd * gg.x * (1.f + sc.x) + sh.x;
        const float y1 = v[j].y * rstd * gg.y * (1.f + sc.y) + sh.y;
        const float y2 = v[j].z * rstd * gg.z * (1.f + sc.z) + sh.z;
        const float y3 = v[j].w * rstd * gg.w * (1.f + sc.w) + sh.w;
        u32x2 o; o.x = pk2(y0, y1); o.y = pk2(y2, y3);
        *(u32x2*)(dst + d) = o;
    }
}

__device__ __forceinline__ void norm_row_q(const float* xr, const float* g, const float* scale, const float* shift, bf16_t* dst, signed char* dq, float* sq, int lane) {
    f32x4 v[4]; float s = 0.f;
#pragma unroll
    for (int j = 0; j < 4; ++j) { v[j] = *(const f32x4*)(xr + j * 256 + lane * 4); s += v[j].x * v[j].x + v[j].y * v[j].y + v[j].z * v[j].z + v[j].w * v[j].w; }
    s = wave_sum(s);
    const float rstd = rsqrtf(s * (1.f / DM) + 1e-6f);
    float amax = 0.f;
#pragma unroll
    for (int j = 0; j < 4; ++j) {
        const int d = j * 256 + lane * 4;
        const f32x4 gg = *(const f32x4*)(g + d), sc = *(const f32x4*)(scale + d), sh = *(const f32x4*)(shift + d);
        v[j].x = v[j].x * rstd * gg.x * (1.f + sc.x) + sh.x;
        v[j].y = v[j].y * rstd * gg.y * (1.f + sc.y) + sh.y;
        v[j].z = v[j].z * rstd * gg.z * (1.f + sc.z) + sh.z;
        v[j].w = v[j].w * rstd * gg.w * (1.f + sc.w) + sh.w;
        u32x2 o; o.x = pk2(v[j].x, v[j].y); o.y = pk2(v[j].z, v[j].w);
        *(u32x2*)(dst + d) = o;
        amax = fmaxf(amax, fmaxf(fmaxf(fabsf(v[j].x), fabsf(v[j].y)), fmaxf(fabsf(v[j].z), fabsf(v[j].w))));
    }
    amax = wave_max(amax);
    const float qs = amax > 0.f ? amax * (1.f / 127.f) : 1.f, inv = 1.f / qs;
#pragma unroll
    for (int j = 0; j < 4; ++j) {
        const unsigned w = q8(v[j].x, inv, 0) | (q8(v[j].y, inv, 0) << 8) | (q8(v[j].z, inv, 0) << 16) | (q8(v[j].w, inv, 0) << 24);
        *(unsigned*)(dq + j * 256 + lane * 4) = w;
    }
    if (lane == 0) *sq = qs;
}

__device__ __forceinline__ void norm1_item(const Params& P, int item, char* smem) {
    float* sc = (float*)smem; float* sh = sc + DM;
    const bool isctx = item >= 1024;
    const int row0 = isctx ? (item - 1024) * 32 : item * 32;
    const int r = isctx ? 16 : row0 / SEQ;
    __syncthreads();
    for (int d = threadIdx.x; d < DM; d += 256) {
        float a = P.b_mod[DM + d], b = P.b_mod[d];
#pragma unroll
        for (int kc = 0; kc < 8; ++kc) { a += P.modp[((size_t)kc * 17 + r) * NMOD + DM + d]; b += P.modp[((size_t)kc * 17 + r) * NMOD + d]; }
        sc[d] = a; sh[d] = b;
    }
    __syncthreads();
    const int lane = threadIdx.x & 63, wid = threadIdx.x >> 6;
    for (int i = wid; i < 32; i += 4) {
        const int row = row0 + i;
        if (!isctx) norm_row(P.x + (size_t)row * DM, P.n1, sc, sh, P.H + (size_t)row * DM, lane);
        else norm_row(P.ctx + (size_t)row * DM, P.n1, sc, sh, P.HC + (size_t)row * DM, lane);
    }
}
enum { MODE_INPROJ = 0, MODE_CTXKV = 1, MODE_AO1 = 2, MODE_CO2 = 3, MODE_MIX = 4, MODE_QH = 5 };

__device__ __forceinline__ void st8bf(bf16_t* p, const float* v) {
    u32x4 o; o.x = pk2(v[0], v[1]); o.y = pk2(v[2], v[3]); o.z = pk2(v[4], v[5]); o.w = pk2(v[6], v[7]);
    *(u32x4*)p = o;
}
__device__ __forceinline__ void st4bf(bf16_t* p, const float* v) {
    u32x2 o; o.x = pk2(v[0], v[1]); o.y = pk2(v[2], v[3]);
    *(u32x2*)p = o;
}
template <int MODE> __device__ __forceinline__ void epi8(const Params& P, int m, int n, const float* v) {
    if (MODE == MODE_INPROJ) {
        if (n < 1280) st8bf(P.GB + (size_t)m * 512 + (n - 768), v);
        else if (n < 1792) st8bf(P.GC + (size_t)m * 512 + (n - 1280), v);
        else if (n < 2304) st8bf(P.U + (size_t)m * 512 + (n - 1792), v);
        else {
            float s[8];
#pragma unroll
            for (int j = 0; j < 8; ++j) s[j] = sigmoidf_(v[j]);
            if (n < 3328) st8bf(P.GA + (size_t)m * DM + (n - 2304), s);
            else st8bf(P.GV + (size_t)m * DM + (n - 3328), s);
        }
    } else if (MODE == MODE_CTXKV) {
        st8bf(P.Kc + (size_t)m * 128 + n, v);
    } else if (MODE == MODE_AO1) {
        const u32x4 g = *(const u32x4*)(P.GA + (size_t)m * DM + n);
        float o[8];
        o[0] = v[0] * bf2f(g.x & 0xffff); o[1] = v[1] * bf2f(g.x >> 16); o[2] = v[2] * bf2f(g.y & 0xffff); o[3] = v[3] * bf2f(g.y >> 16);
        o[4] = v[4] * bf2f(g.z & 0xffff); o[5] = v[5] * bf2f(g.z >> 16); o[6] = v[6] * bf2f(g.w & 0xffff); o[7] = v[7] * bf2f(g.w >> 16);
        st8bf(P.M1 + (size_t)m * DM + n, o);
    } else if (MODE == MODE_CO2) {
        const u32x4 g = *(const u32x4*)(P.GV + (size_t)m * DM + n);
        const u32x4 a = *(const u32x4*)(P.M1 + (size_t)m * DM + n);
        float o[8];
        o[0] = bf2f(a.x & 0xffff) + v[0] * bf2f(g.x & 0xffff); o[1] = bf2f(a.x >> 16) + v[1] * bf2f(g.x >> 16);
        o[2] = bf2f(a.y & 0xffff) + v[2] * bf2f(g.y & 0xffff); o[3] = bf2f(a.y >> 16) + v[3] * bf2f(g.y >> 16);
        o[4] = bf2f(a.z & 0xffff) + v[4] * bf2f(g.z & 0xffff); o[5] = bf2f(a.z >> 16) + v[5] * bf2f(g.z >> 16);
        o[6] = bf2f(a.w & 0xffff) + v[6] * bf2f(g.w & 0xffff); o[7] = bf2f(a.w >> 16) + v[7] * bf2f(g.w >> 16);
        st8bf(P.YG + (size_t)m * DM + n, o);
    } else if (MODE == MODE_MIX) {
        const int b = m / SEQ;
        const float* g1 = P.mod + (size_t)b * NMOD + 2 * DM + n;
        const float* xr = P.x + (size_t)m * DM + n;
        float* o = P.X1 + (size_t)m * DM + n;
        const f32x4 x0 = *(const f32x4*)xr, x1 = *(const f32x4*)(xr + 4), g0 = *(const f32x4*)g1, g1v = *(const f32x4*)(g1 + 4);
        f32x4 o0, o1;
        o0.x = x0.x + g0.x * v[0]; o0.y = x0.y + g0.y * v[1]; o0.z = x0.z + g0.z * v[2]; o0.w = x0.w + g0.w * v[3];
        o1.x = x1.x + g1v.x * v[4]; o1.y = x1.y + g1v.y * v[5]; o1.z = x1.z + g1v.z * v[6]; o1.w = x1.w + g1v.w * v[7];
        *(f32x4*)o = o0; *(f32x4*)(o + 4) = o1;
    } else if (MODE == MODE_QH) {
        st8bf(P.QH + (size_t)m * 2048 + n, v);
    }
}
__device__ __forceinline__ void epi_rope(const Params& P, int m, int n, const float* lo, const float* hi) {
    const int d0 = n & 63;
    const int l = m % SEQ;
    const float *ct, *st;
    if (d0 < 16) { const int row = l >> 6; ct = P.rope + row * 16 + d0; st = P.rope + 512 + row * 16 + d0; }
    else { const int col = l & 63; ct = P.rope + 1024 + col * 16 + (d0 - 32); st = P.rope + 2048 + col * 16 + (d0 - 32); }
    float a[4], b[4];
    const float sc = (n < 512) ? 0.125f : 1.f;
#pragma unroll
    for (int j = 0; j < 4; ++j) { const float cc = ct[j], ss = st[j]; a[j] = (lo[j] * cc - hi[j] * ss) * sc; b[j] = (lo[j] * ss + hi[j] * cc) * sc; }
    if (n < 512) { st4bf(P.Q + (size_t)m * 512 + n, a); st4bf(P.Q + (size_t)m * 512 + n + 16, b); }
    else { st4bf(P.K + (size_t)m * 128 + (n - 512), a); st4bf(P.K + (size_t)m * 128 + (n - 512) + 16, b); }
}
__device__ __forceinline__ void epi_v4(const Params& P, int m, int dcol, const float* v, bool ctx) {
    const int kvh = dcol >> 6, dd = dcol & 63;
    if (!ctx) { const int b = m / SEQ, l = m % SEQ;
#pragma unroll
        for (int j = 0; j < 4; ++j) P.VT[((size_t)(b * 2 + kvh) * 64 + dd + j) * SEQ + l] = f2bf(v[j]);
    } else { const int b = m / CTXL, cpos = m % CTXL;
#pragma unroll
        for (int j = 0; j < 4; ++j) P.VcT[((size_t)(b * 2 + kvh) * 64 + dd + j) * CTXL + cpos] = f2bf(v[j]);
    }
}

constexpr int GEMM_LDS = 65536;
constexpr int RETR_LDS = 128 * 130 * 4;
__device__ __forceinline__ int lds_off(int row, int chunk) { return row * 128 + ((chunk ^ ((row >> 1) & 7)) << 4); }

__device__ __forceinline__ void mma_from_lds(const char* As, const char* Bs, f32x4 (&acc)[4][4], int wm, int wn, int fr, int fq, int sw) {
#pragma unroll
    for (int ks = 0; ks < 2; ++ks) {
        bf16x8 af[4], bfr[4];
        const int coff = ((ks * 4 + fq) ^ sw) << 4;
#pragma unroll
        for (int mt = 0; mt < 4; ++mt) af[mt] = *(const bf16x8*)(As + (wm * 64 + mt * 16 + fr) * 128 + coff);
#pragma unroll
        for (int nt = 0; nt < 4; ++nt) bfr[nt] = *(const bf16x8*)(Bs + (wn * 64 + nt * 16 + fr) * 128 + coff);
#pragma unroll
        for (int mt = 0; mt < 4; ++mt)
#pragma unroll
            for (int nt = 0; nt < 4; ++nt) acc[mt][nt] = __builtin_amdgcn_mfma_f32_16x16x32_bf16(bfr[nt], af[mt], acc[mt][nt], 0, 0, 0);
    }
}
__device__ __forceinline__ void gemm_mainloop(const bf16_t* __restrict__ A, int lda, const bf16_t* __restrict__ Bt, int ldb, int K, int m0, int n0, bool perm, char* smem, f32x4 (&acc)[4][4]) {
    const int tid = threadIdx.x, lane = tid & 63, wid = tid >> 6;
    const int wm = wid >> 1, wn = wid & 1, fr = lane & 15, fq = lane >> 4;
    const int srow = tid >> 3, schunk = tid & 7;
    const bf16_t* ag[4]; const bf16_t* bg[4]; int soff[4];
#pragma unroll
    for (int p = 0; p < 4; ++p) {
        const int row = p * 32 + srow;
        ag[p] = A + (size_t)(m0 + row) * lda + schunk * 8;
        int brow = row;
        if (perm) { const int g = row >> 5, rr = row & 31, nn = rr >> 4, i = rr & 15; brow = 32 * g + 8 * (i >> 2) + 4 * nn + (i & 3); }
        bg[p] = Bt + (size_t)(n0 + brow) * ldb + schunk * 8;
        soff[p] = lds_off(row, schunk);
    }
#pragma unroll
    for (int i = 0; i < 4; ++i)
#pragma unroll
        for (int j = 0; j < 4; ++j) acc[i][j] = (f32x4){0.f, 0.f, 0.f, 0.f};
    u32x4 ra[4], rb[4];
#pragma unroll
    for (int p = 0; p < 4; ++p) { ra[p] = *(const u32x4*)(ag[p]); rb[p] = *(const u32x4*)(bg[p]); }
#pragma unroll
    for (int p = 0; p < 4; ++p) { *(u32x4*)(smem + soff[p]) = ra[p]; *(u32x4*)(smem + 16384 + soff[p]) = rb[p]; }
    __syncthreads();
    const int nk = K / 64;
    const int sw = (fr >> 1) & 7;
    for (int kt = 0; kt < nk; ++kt) {
        const int cur = kt & 1;
        if (kt + 1 < nk) {
            const int k0 = (kt + 1) * 64;
#pragma unroll
            for (int p = 0; p < 4; ++p) { ra[p] = *(const u32x4*)(ag[p] + k0); rb[p] = *(const u32x4*)(bg[p] + k0); }
        }
        mma_from_lds(smem + cur * 32768, smem + cur * 32768 + 16384, acc, wm, wn, fr, fq, sw);
        if (kt + 1 < nk) {
            char* dst = smem + (cur ^ 1) * 32768;
#pragma unroll
            for (int p = 0; p < 4; ++p) { *(u32x4*)(dst + soff[p]) = ra[p]; *(u32x4*)(dst + 16384 + soff[p]) = rb[p]; }
        }
        __syncthreads();
    }
}
template <int MODE>
__device__ __forceinline__ void gemm_tile(const Params& P, const bf16_t* __restrict__ A, int lda, const bf16_t* __restrict__ Bt, int ldb, int K, int m0, int n0, bool perm, char* smem) {
    const int lane = threadIdx.x & 63, wid = threadIdx.x >> 6;
    const int wm = wid >> 1, wn = wid & 1, fr = lane & 15, fq = lane >> 4;
    f32x4 acc[4][4];
    gemm_mainloop(A, lda, Bt, ldb, K, m0, n0, perm, smem, acc);
#pragma unroll
    for (int mt = 0; mt < 4; ++mt) {
        const int m = m0 + wm * 64 + mt * 16 + fr;
        if (perm) {
#pragma unroll
            for (int p = 0; p < 2; ++p) {
                float v[8] = { acc[mt][2 * p][0], acc[mt][2 * p][1], acc[mt][2 * p][2], acc[mt][2 * p][3], acc[mt][2 * p + 1][0], acc[mt][2 * p + 1][1], acc[mt][2 * p + 1][2], acc[mt][2 * p + 1][3] };
                epi8<MODE>(P, m, n0 + wn * 64 + 32 * p + 8 * fq, v);
            }
        } else if (MODE == MODE_INPROJ && n0 < 640) {
#pragma unroll
            for (int p = 0; p < 2; ++p) {
                float lo[4] = { acc[mt][2 * p][0], acc[mt][2 * p][1], acc[mt][2 * p][2], acc[mt][2 * p][3] };
                float hi[4] = { acc[mt][2 * p + 1][0], acc[mt][2 * p + 1][1], acc[mt][2 * p + 1][2], acc[mt][2 * p + 1][3] };
                epi_rope(P, m, n0 + wn * 64 + 32 * p + 4 * fq, lo, hi);
            }
        } else if (MODE == MODE_INPROJ || MODE == MODE_CTXKV) {
            const int dbase = (MODE == MODE_INPROJ) ? (n0 - 640) : (n0 - 128);
#pragma unroll
            for (int nt = 0; nt < 4; ++nt) {
                float v[4] = { acc[mt][nt][0], acc[mt][nt][1], acc[mt][nt][2], acc[mt][nt][3] };
                epi_v4(P, m, dbase + wn * 64 + 16 * nt + 4 * fq, v, MODE == MODE_CTXKV);
            }
        }
    }
}
__device__ __forceinline__ void tile_coords(int t, int ntm, int ntn, int& mt, int& nt) {
    const int per = 8 * ntn, g = t / per, r = t % per;
    mt = g * 8 + (r & 7); nt = r >> 3;
}
#define CEU(a, b) { const unsigned _t = (a) > (b) ? (a) : (b); (b) = (a) > (b) ? (b) : (a); (a) = _t; }
__device__ __forceinline__ void sort16_desc(unsigned (&v)[16]) {
    CEU(v[0], v[1]); CEU(v[2], v[3]); CEU(v[0], v[2]); CEU(v[1], v[3]); CEU(v[1], v[2]); CEU(v[4], v[5]);
    CEU(v[6], v[7]); CEU(v[4], v[6]); CEU(v[5], v[7]); CEU(v[5], v[6]); CEU(v[0], v[4]); CEU(v[2], v[6]);
    CEU(v[2], v[4]); CEU(v[1], v[5]); CEU(v[3], v[7]); CEU(v[3], v[5]); CEU(v[1], v[2]); CEU(v[3], v[4]);
    CEU(v[5], v[6]); CEU(v[8], v[9]); CEU(v[10], v[11]); CEU(v[8], v[10]); CEU(v[9], v[11]); CEU(v[9], v[10]);
    CEU(v[12], v[13]); CEU(v[14], v[15]); CEU(v[12], v[14]); CEU(v[13], v[15]); CEU(v[13], v[14]); CEU(v[8], v[12]);
    CEU(v[10], v[14]); CEU(v[10], v[12]); CEU(v[9], v[13]); CEU(v[11], v[15]); CEU(v[11], v[13]); CEU(v[9], v[10]);
    CEU(v[11], v[12]); CEU(v[13], v[14]); CEU(v[0], v[8]); CEU(v[4], v[12]); CEU(v[4], v[8]); CEU(v[2], v[10]);
    CEU(v[6], v[14]); CEU(v[6], v[10]); CEU(v[2], v[4]); CEU(v[6], v[8]); CEU(v[10], v[12]); CEU(v[1], v[9]);
    CEU(v[5], v[13]); CEU(v[5], v[9]); CEU(v[3], v[11]); CEU(v[7], v[15]); CEU(v[7], v[11]); CEU(v[3], v[5]);
    CEU(v[7], v[9]); CEU(v[11], v[13]); CEU(v[1], v[2]); CEU(v[3], v[4]); CEU(v[5], v[6]); CEU(v[7], v[8]);
    CEU(v[9], v[10]); CEU(v[11], v[12]); CEU(v[13], v[14]);
}
__device__ __forceinline__ void bitonic16_desc(unsigned (&v)[16]) {
    CEU(v[0], v[8]); CEU(v[1], v[9]); CEU(v[2], v[10]); CEU(v[3], v[11]); CEU(v[4], v[12]); CEU(v[5], v[13]);
    CEU(v[6], v[14]); CEU(v[7], v[15]); CEU(v[0], v[4]); CEU(v[1], v[5]); CEU(v[2], v[6]); CEU(v[3], v[7]);
    CEU(v[8], v[12]); CEU(v[9], v[13]); CEU(v[10], v[14]); CEU(v[11], v[15]); CEU(v[0], v[2]); CEU(v[1], v[3]);
    CEU(v[4], v[6]); CEU(v[5], v[7]); CEU(v[8], v[10]); CEU(v[9], v[11]); CEU(v[12], v[14]); CEU(v[13], v[15]);
    CEU(v[0], v[1]); CEU(v[2], v[3]); CEU(v[4], v[5]); CEU(v[6], v[7]); CEU(v[8], v[9]); CEU(v[10], v[11]);
    CEU(v[12], v[13]); CEU(v[14], v[15]);
}

__device__ __forceinline__ unsigned enc_key(float f) { const unsigned b = __float_as_uint(f); return b ^ ((unsigned)((int)b >> 31) | 0x80000000u); }
__device__ __forceinline__ float dec_key(unsigned k) { const unsigned b = (k & 0x80000000u) ? (k & 0x7fffffffu) : ~k; return __uint_as_float(b); }
__device__ __forceinline__ void topmerge16(unsigned (&top)[16], const unsigned (&L)[16]) {
#pragma unroll
    for (int i = 0; i < 16; ++i) top[i] = top[i] > L[15 - i] ? top[i] : L[15 - i];
    bitonic16_desc(top);
}
__device__ __forceinline__ unsigned cand_key(float a, float b, int i, int j) { return (enc_key(a + b) & ~0xFFu) | (unsigned)(i << 4) | (unsigned)j; }

__device__ __forceinline__ void peer_retrieve_item(const Params& P, int mtile, int h, char* smem) {
    const int tid = threadIdx.x, lane = tid & 63, wid = tid >> 6;
    const int wm = wid >> 1, wn = wid & 1, fr = lane & 15, fq = lane >> 4;
    const int sw = (fr >> 1) & 7;
    const int m0 = mtile * 128;
    unsigned T0[16], T1[16];
#pragma unroll 1
    for (int p = 0; p < 2; ++p) {
        const int hp = h * 2 + p;
        f32x4 acc[4][4];
        gemm_mainloop(P.H2, DM, P.PwqT, DM, DM, m0, hp * 128, false, smem, acc);
#pragma unroll
        for (int mt = 0; mt < 4; ++mt)
#pragma unroll
            for (int nt = 0; nt < 4; ++nt) {
                const int row = wm * 64 + mt * 16 + fr;
                u32x2 o; o.x = pk2(acc[mt][nt][0], acc[mt][nt][1]); o.y = pk2(acc[mt][nt][2], acc[mt][nt][3]);
                *(u32x2*)(smem + wn * 32768 + lds_off(row, 2 * nt + (fq >> 1)) + (fq & 1) * 8) = o;
            }
        {
            const int srow = tid >> 3, schunk = tid & 7;
            const bf16_t* kb = P.KeysB + (size_t)hp * 128 * 128;
#pragma unroll
            for (int hf = 0; hf < 2; ++hf)
#pragma unroll
                for (int q = 0; q < 4; ++q) {
                    const int row = q * 32 + srow;
                    const u32x4 v = *(const u32x4*)(kb + (size_t)row * 128 + hf * 64 + schunk * 8);
                    *(u32x4*)(smem + hf * 32768 + 16384 + lds_off(row, schunk)) = v;
                }
        }
        __syncthreads();
#pragma unroll
        for (int i = 0; i < 4; ++i)
#pragma unroll
            for (int j = 0; j < 4; ++j) acc[i][j] = (f32x4){0.f, 0.f, 0.f, 0.f};
        mma_from_lds(smem, smem + 16384, acc, wm, wn, fr, fq, sw);
        mma_from_lds(smem + 32768, smem + 32768 + 16384, acc, wm, wn, fr, fq, sw);
        __syncthreads();
        float* sc = (float*)smem;
#pragma unroll
        for (int mt = 0; mt < 4; ++mt)
#pragma unroll
            for (int nt = 0; nt < 4; ++nt) {
                const int row = wm * 64 + mt * 16 + fr;
#pragma unroll
                for (int r = 0; r < 4; ++r) {
                    const int col = wn * 64 + nt * 16 + fq * 4 + r;
                    sc[row * 130 + wn * 65 + (col & 63)] = acc[mt][nt][r];
                }
            }
        __syncthreads();
        {
            const int row = tid >> 1, half = tid & 1;
            const float* rp = sc + row * 130 + half * 65;
            unsigned top[16];
#pragma unroll 1
            for (int g = 0; g < 4; ++g) {
                unsigned L[16];
#pragma unroll
                for (int j = 0; j < 16; ++j) { const int col = half * 64 + g * 16 + j; L[j] = (enc_key(rp[g * 16 + j]) & ~0x7Fu) | (unsigned)col; }
                sort16_desc(L);
                if (g == 0) {
#pragma unroll
                    for (int j = 0; j < 16; ++j) top[j] = L[j];
                } else topmerge16(top, L);
            }
            unsigned Bp[16];
#pragma unroll
            for (int j = 0; j < 16; ++j) Bp[j] = (unsigned)__shfl_xor((int)top[j], 1);
            topmerge16(top, Bp);
            if (p == 0) {
#pragma unroll
                for (int j = 0; j < 16; ++j) T0[j] = top[j];
            } else {
#pragma unroll
                for (int j = 0; j < 16; ++j) T1[j] = top[j];
            }
        }
        __syncthreads();
    }
    {
        const int row = tid >> 1;
        unsigned char* slot = (unsigned char*)smem + row * 32;
        if ((tid & 1) == 0) {
#pragma unroll
            for (int j = 0; j < 16; ++j) { slot[j] = (unsigned char)(T0[j] & 0x7Fu); slot[16 + j] = (unsigned char)(T1[j] & 0x7Fu); }
            float a[16], b[16];
#pragma unroll
            for (int j = 0; j < 16; ++j) { a[j] = dec_key(T0[j]); b[j] = dec_key(T1[j]); }
            unsigned LA[16], LB[16], LC[16];
#pragma unroll
            for (int j = 0; j < 16; ++j) LA[j] = cand_key(a[0], b[j], 0, j);
#pragma unroll
            for (int j = 0; j < 8; ++j) LB[j] = cand_key(a[1], b[j], 1, j);
#pragma unroll
            for (int j = 0; j < 8; ++j) LB[8 + j] = cand_key(a[15 - j], b[0], 15 - j, 0);
            LC[0] = cand_key(a[2], b[0], 2, 0); LC[1] = cand_key(a[2], b[1], 2, 1); LC[2] = cand_key(a[2], b[2], 2, 2); LC[3] = cand_key(a[2], b[3], 2, 3); LC[4] = cand_key(a[2], b[4], 2, 4);
            LC[5] = cand_key(a[3], b[0], 3, 0); LC[6] = cand_key(a[3], b[1], 3, 1); LC[7] = cand_key(a[3], b[2], 3, 2); LC[8] = cand_key(a[3], b[3], 3, 3);
            LC[9] = cand_key(a[4], b[0], 4, 0); LC[10] = cand_key(a[4], b[1], 4, 1); LC[11] = cand_key(a[4], b[2], 4, 2);
            LC[12] = cand_key(a[5], b[0], 5, 0); LC[13] = cand_key(a[5], b[1], 5, 1);
            LC[14] = cand_key(a[6], b[0], 6, 0); LC[15] = cand_key(a[6], b[1], 6, 1);
            const unsigned d0 = cand_key(a[7], b[0], 7, 0), d1 = cand_key(a[7], b[1], 7, 1);
            bitonic16_desc(LB);
            sort16_desc(LC);
            topmerge16(LA, LB);
            LC[15] = LC[15] > d0 ? LC[15] : d0; LC[14] = LC[14] > d1 ? LC[14] : d1;
            bitonic16_desc(LC);
            topmerge16(LA, LC);
            float e[16], den = 0.f; const float vmax = dec_key(LA[0]);
#pragma unroll
            for (int r = 0; r < 16; ++r) { e[r] = __expf(dec_key(LA[r]) - vmax); den += e[r]; }
            const float inv = 1.f / den;
            const int t = m0 + row;
            int* oi = P.sel_idx + (size_t)t * 128 + h * 16; float* og = P.sel_g + (size_t)t * 128 + h * 16;
#pragma unroll
            for (int r = 0; r < 16; ++r) {
                const int i = (LA[r] >> 4) & 15, j = LA[r] & 15;
                oi[r] = (int)slot[i] * 128 + (int)slot[16 + j];
                og[r] = e[r] * inv;
            }
        }
    }
    __syncthreads();
}
typedef float f32x16 __attribute__((ext_vector_type(16)));
struct AttnFrag { u32x4 k[4]; u32x2 v[2][2][2]; };
__device__ __forceinline__ void attn_load(const Params& P, int b, int kvh, int qb, int w, int blk, int r, int hh, AttnFrag& f) {
    const bf16_t* kp; const bf16_t* vp; size_t vstride;
    if (blk < 9) {
        int kpos0 = (qb - 1) * 128 + 32 * (w + blk);
        if (kpos0 < 0 || kpos0 >= SEQ) kpos0 = 0;
        kp = P.K + (size_t)(b * SEQ + kpos0 + r) * 128 + kvh * 64 + 8 * hh;
        vp = P.VT + (size_t)((b * 2 + kvh) * 64 + r) * SEQ + kpos0 + 4 * hh; vstride = SEQ;
    } else {
        const int c0 = 32 * (blk - 9);
        kp = P.Kc + (size_t)(b * CTXL + c0 + r) * 128 + kvh * 64 + 8 * hh;
        vp = P.VcT + (size_t)((b * 2 + kvh) * 64 + r) * CTXL + c0 + 4 * hh; vstride = CTXL;
    }
#pragma unroll
    for (int ks = 0; ks < 4; ++ks) f.k[ks] = *(const u32x4*)(kp + 16 * ks);
#pragma unroll
    for (int db = 0; db < 2; ++db)
#pragma unroll
        for (int s = 0; s < 2; ++s) {
            f.v[db][s][0] = *(const u32x2*)(vp + (size_t)(32 * db) * vstride + 16 * s);
            f.v[db][s][1] = *(const u32x2*)(vp + (size_t)(32 * db) * vstride + 16 * s + 8);
        }
}
__device__ __forceinline__ void attn_item(const Params& P, int item) {
    const int head = item & 7, qb = (item >> 3) & 15, b = item >> 7, kvh = head >> 2;
    const int lane = threadIdx.x & 63, w = threadIdx.x >> 6, r = lane & 31, hh = lane >> 5;
    const int tok = b * SEQ + qb * 128 + 32 * w + r;
    bf16x8 qf[4];
    { const bf16_t* qp = P.Q + (size_t)tok * 512 + head * 64 + 8 * hh;
#pragma unroll
      for (int ks = 0; ks < 4; ++ks) qf[ks] = *(const bf16x8*)(qp + 16 * ks); }
    f32x16 o0, o1;
#pragma unroll
    for (int i = 0; i < 16; ++i) { o0[i] = 0.f; o1[i] = 0.f; }
    float mrun = P.sink[head], lrun = (hh == 0) ? 1.f : 0.f;
    AttnFrag cur, nxt;
    attn_load(P, b, kvh, qb, w, 0, r, hh, cur);
    for (int blk = 0; blk < 17; ++blk) {
        if (blk + 1 < 17) attn_load(P, b, kvh, qb, w, blk + 1, r, hh, nxt);
        int lo = 0, hi = 31;
        if (blk < 9) {
            const int kpos0 = (qb - 1) * 128 + 32 * (w + blk);
            if (kpos0 < 0 || kpos0 >= SEQ) lo = 64;
            else if (blk == 0) lo = r;
            else if (blk == 8) hi = r;
        }
        f32x16 s;
#pragma unroll
        for (int i = 0; i < 16; ++i) s[i] = 0.f;
#pragma unroll
        for (int ks = 0; ks < 4; ++ks) s = __builtin_amdgcn_mfma_f32_32x32x16_bf16(*(const bf16x8*)&cur.k[ks], qf[ks], s, 0, 0, 0);
        float mb = -3.0e38f;
#pragma unroll
        for (int i = 0; i < 16; ++i) { const int kk = (i & 3) + 8 * (i >> 2) + 4 * hh; const bool ok = (kk >= lo) && (kk <= hi); s[i] = ok ? s[i] : -3.0e38f; mb = fmaxf(mb, s[i]); }
        mb = fmaxf(mb, __shfl_xor(mb, 32));
        const float mn = fmaxf(mrun, mb);
        const float alpha = __expf(mrun - mn);
        float ps = 0.f; float p[16];
#pragma unroll
        for (int i = 0; i < 16; ++i) { p[i] = __expf(s[i] - mn); ps += p[i]; }
        lrun = lrun * alpha + ps; mrun = mn;
#pragma unroll
        for (int i = 0; i < 16; ++i) { o0[i] *= alpha; o1[i] *= alpha; }
        u32x4 pb[2];
        pb[0].x = pk2(p[0], p[1]); pb[0].y = pk2(p[2], p[3]); pb[0].z = pk2(p[4], p[5]); pb[0].w = pk2(p[6], p[7]);
        pb[1].x = pk2(p[8], p[9]); pb[1].y = pk2(p[10], p[11]); pb[1].z = pk2(p[12], p[13]); pb[1].w = pk2(p[14], p[15]);
#pragma unroll
        for (int sI = 0; sI < 2; ++sI) {
            u32x4 va, vb;
            va.x = cur.v[0][sI][0].x; va.y = cur.v[0][sI][0].y; va.z = cur.v[0][sI][1].x; va.w = cur.v[0][sI][1].y;
            vb.x = cur.v[1][sI][0].x; vb.y = cur.v[1][sI][0].y; vb.z = cur.v[1][sI][1].x; vb.w = cur.v[1][sI][1].y;
            o0 = __builtin_amdgcn_mfma_f32_32x32x16_bf16(*(const bf16x8*)&va, *(const bf16x8*)&pb[sI], o0, 0, 0, 0);
            o1 = __builtin_amdgcn_mfma_f32_32x32x16_bf16(*(const bf16x8*)&vb, *(const bf16x8*)&pb[sI], o1, 0, 0, 0);
        }
        if (blk + 1 < 17) cur = nxt;
    }
    const float ltot = lrun + __shfl_xor(lrun, 32);
    const float inv = 1.f / ltot;
    bf16_t* op = P.AO + (size_t)tok * 512 + head * 64 + 4 * hh;
#pragma unroll
    for (int g = 0; g < 4; ++g) {
        float t0[4] = { o0[4 * g] * inv, o0[4 * g + 1] * inv, o0[4 * g + 2] * inv, o0[4 * g + 3] * inv };
        float t1[4] = { o1[4 * g] * inv, o1[4 * g + 1] * inv, o1[4 * g + 2] * inv, o1[4 * g + 3] * inv };
        st4bf(op + 8 * g, t0); st4bf(op + 32 + 8 * g, t1);
    }
}

__device__ __forceinline__ void conv_range(const Params& P, size_t gtid, size_t gsize) {
    for (size_t idx = gtid; idx < (size_t)NTOK * 64; idx += gsize) {
        const int m = (int)(idx >> 6), c0 = (int)(idx & 63) * 8, l = m % SEQ;
        float cu[3][8];
#pragma unroll
        for (int t = 0; t < 3; ++t) {
            const int ll = l + t - 1;
            if (ll < 0 || ll >= SEQ) {
#pragma unroll
                for (int j = 0; j < 8; ++j) cu[t][j] = 0.f;
            } else {
                const u32x4 g = *(const u32x4*)(P.GC + (size_t)(m + t - 1) * 512 + c0), u = *(const u32x4*)(P.U + (size_t)(m + t - 1) * 512 + c0);
                cu[t][0] = bf2f(g.x & 0xffff) * bf2f(u.x & 0xffff); cu[t][1] = bf2f(g.x >> 16) * bf2f(u.x >> 16);
                cu[t][2] = bf2f(g.y & 0xffff) * bf2f(u.y & 0xffff); cu[t][3] = bf2f(g.y >> 16) * bf2f(u.y >> 16);
                cu[t][4] = bf2f(g.z & 0xffff) * bf2f(u.z & 0xffff); cu[t][5] = bf2f(g.z >> 16) * bf2f(u.z >> 16);
                cu[t][6] = bf2f(g.w & 0xffff) * bf2f(u.w & 0xffff); cu[t][7] = bf2f(g.w >> 16) * bf2f(u.w >> 16);
            }
        }
        const u32x4 gbv = *(const u32x4*)(P.GB + (size_t)m * 512 + c0);
        const float gb[8] = { bf2f(gbv.x & 0xffff), bf2f(gbv.x >> 16), bf2f(gbv.y & 0xffff), bf2f(gbv.y >> 16), bf2f(gbv.z & 0xffff), bf2f(gbv.z >> 16), bf2f(gbv.w & 0xffff), bf2f(gbv.w >> 16) };
        float o[8];
#pragma unroll
        for (int j = 0; j < 8; ++j) o[j] = gb[j] * (P.conv_w[c0 + j] * cu[0][j] + P.conv_w[512 + c0 + j] * cu[1][j] + P.conv_w[1024 + c0 + j] * cu[2][j]);
        st8bf(P.CA + (size_t)m * 512 + c0, o);
    }
}

__device__ __forceinline__ void unpack8(const u32x4 v, float* f) {
    f[0] = bf2f(v.x & 0xffff); f[1] = bf2f(v.x >> 16); f[2] = bf2f(v.y & 0xffff); f[3] = bf2f(v.y >> 16);
    f[4] = bf2f(v.z & 0xffff); f[5] = bf2f(v.z >> 16); f[6] = bf2f(v.w & 0xffff); f[7] = bf2f(v.w >> 16);
}
__device__ __forceinline__ float gelu_erf(float d) { return 0.5f * d * (1.f + erff(d * 0.70710678118654752f)); }
__device__ __forceinline__ int reduce64i(int (&part)[64], int lane) {
#pragma unroll
    for (int i = 0; i < 32; ++i) { auto r = __builtin_amdgcn_permlane32_swap((unsigned)part[i], (unsigned)part[32 + i], false, false); part[i] = (int)r[0] + (int)r[1]; }
#pragma unroll
    for (int i = 0; i < 16; ++i) { auto r = __builtin_amdgcn_permlane16_swap((unsigned)part[i], (unsigned)part[16 + i], false, false); part[i] = (int)r[0] + (int)r[1]; }
#define RSTAGE(N) { const bool up = (lane & N) != 0; _Pragma("unroll") for (int i = 0; i < N; ++i) { const int keep = up ? part[N + i] : part[i], send = up ? part[i] : part[N + i]; part[i] = keep + __shfl_xor(send, N); } }
    RSTAGE(8) RSTAGE(4) RSTAGE(2) RSTAGE(1)
#undef RSTAGE
    return part[0];
}
#define UB0(x) ((float)((x) & 0xffu))
#define UB1(x) ((float)(((x) >> 8) & 0xffu))
#define UB2(x) ((float)(((x) >> 16) & 0xffu))
#define UB3(x) ((float)((x) >> 24))
__device__ __forceinline__ void peer_final_token(const Params& P, int t, int lane) {
    const int b = t / SEQ;
    const u32x4 hq = *(const u32x4*)(P.H2q + (size_t)t * DM + 16 * lane);
    const float sh = P.sh2[t];
    float acc[16];
#pragma unroll
    for (int j = 0; j < 16; ++j) acc[j] = 0.f;
    float csum = 0.f;
#pragma unroll 1
    for (int half = 0; half < 2; ++half) {
        const int myidx = P.sel_idx[(size_t)t * 128 + half * 64 + lane];
        const float myg = P.sel_g[(size_t)t * 128 + half * 64 + lane];
        const float mysu = P.su[myidx], mysv = P.sv[myidx];
        int part[64];
#pragma unroll
        for (int k = 0; k < 64; ++k) {
            const int e = __builtin_amdgcn_readlane(myidx, k);
            const u32x4 a = *(const u32x4*)(P.Uq + (size_t)e * DM + 16 * lane);
            int d = __builtin_amdgcn_sdot4((int)a.x, (int)hq.x, 0, false);
            d = __builtin_amdgcn_sdot4((int)a.y, (int)hq.y, d, false);
            d = __builtin_amdgcn_sdot4((int)a.z, (int)hq.z, d, false);
            d = __builtin_amdgcn_sdot4((int)a.w, (int)hq.w, d, false);
            part[k] = d;
        }
        const int isum = reduce64i(part, lane);
        const float a = (float)isum * mysu * sh;
        const float c = myg * gelu_erf(a) * mysv;
        csum += c;
#pragma unroll
        for (int k = 0; k < 64; ++k) {
            const int e = __builtin_amdgcn_readlane(myidx, k);
            const float ck = __uint_as_float(__builtin_amdgcn_readlane(__float_as_uint(c), k));
            const u32x4 x = *(const u32x4*)(P.Vq + (size_t)e * DM + 16 * lane);
            acc[0] += ck * UB0(x.x); acc[1] += ck * UB1(x.x); acc[2] += ck * UB2(x.x); acc[3] += ck * UB3(x.x);
            acc[4] += ck * UB0(x.y); acc[5] += ck * UB1(x.y); acc[6] += ck * UB2(x.y); acc[7] += ck * UB3(x.y);
            acc[8] += ck * UB0(x.z); acc[9] += ck * UB1(x.z); acc[10] += ck * UB2(x.z); acc[11] += ck * UB3(x.z);
            acc[12] += ck * UB0(x.w); acc[13] += ck * UB1(x.w); acc[14] += ck * UB2(x.w); acc[15] += ck * UB3(x.w);
        }
    }
    const float cb = 128.f * wave_sum(csum);
    float x2[16]; float ss = 0.f;
    const float* x1 = P.X1 + (size_t)t * DM + 16 * lane; const float* g2 = P.mod + (size_t)b * NMOD + 5 * DM + 16 * lane;
#pragma unroll
    for (int q = 0; q < 4; ++q) {
        const f32x4 xa = *(const f32x4*)(x1 + 4 * q), ga = *(const f32x4*)(g2 + 4 * q);
        x2[4 * q + 0] = xa.x + ga.x * (acc[4 * q + 0] - cb); x2[4 * q + 1] = xa.y + ga.y * (acc[4 * q + 1] - cb);
        x2[4 * q + 2] = xa.z + ga.z * (acc[4 * q + 2] - cb); x2[4 * q + 3] = xa.w + ga.w * (acc[4 * q + 3] - cb);
        ss += x2[4 * q] * x2[4 * q] + x2[4 * q + 1] * x2[4 * q + 1] + x2[4 * q + 2] * x2[4 * q + 2] + x2[4 * q + 3] * x2[4 * q + 3];
    }
    ss = wave_sum(ss);
    const float rstd = rsqrtf(ss * (1.f / DM) + 1e-6f);
    float* op = P.out + (size_t)t * DM + 16 * lane; const float* fgp = P.fg + 16 * lane;
#pragma unroll
    for (int q = 0; q < 4; ++q) {
        const f32x4 fa = *(const f32x4*)(fgp + 4 * q);
        f32x4 o; o.x = x2[4 * q] * rstd * fa.x; o.y = x2[4 * q + 1] * rstd * fa.y; o.z = x2[4 * q + 2] * rstd * fa.z; o.w = x2[4 * q + 3] * rstd * fa.w;
        *(f32x4*)(op + 4 * q) = o;
    }
}

#define XB_TMO      128
#define XB_XCNT(j)  (256  + 64 * (j))
#define XB_XSUB(j)  (1280 + 64 * (j))
#define XB_XGEN(j)  (2304 + 64 * (j))
#define XB_TOP      3328
#define XB_TOPGEN   3392
#define XCD_BAR_WORDS 3456
#define XB_SPIN_CAP (1u << 22)
#define LAS __attribute__((address_space(3)))
__device__ __forceinline__ unsigned xb_ld(unsigned* p)              { return __hip_atomic_load(p, __ATOMIC_RELAXED, __HIP_MEMORY_SCOPE_AGENT); }
__device__ __forceinline__ unsigned xb_add(unsigned* p, unsigned v) { return __hip_atomic_fetch_add(p, v, __ATOMIC_RELAXED, __HIP_MEMORY_SCOPE_AGENT); }
__device__ __forceinline__ unsigned xb_xcc_id() { return (unsigned)__builtin_amdgcn_s_getreg((3 << 11) | 20) & 0xFu; }
#define XB_SPIN(cond, bar) do { unsigned _sp = 0; while (cond) { __builtin_amdgcn_s_sleep(1); \
    if ((++_sp & 255u) == 0u) { if (xb_ld(&(bar)[XB_TMO])) break; if (_sp > XB_SPIN_CAP) { atomicAdd(&(bar)[XB_TMO], 1u); break; } } } } while (0)
struct XcdBarrier { unsigned* bar; unsigned x; volatile LAS unsigned* st; };
__device__ __forceinline__ XcdBarrier xcd_barrier_post(unsigned* bar, volatile LAS unsigned* st) {
    XcdBarrier b; b.bar = bar; b.x = xb_xcc_id(); b.st = st;
    if (threadIdx.x == 0) (void)xb_add(&bar[XB_XCNT(b.x)], 1u);
    return b;
}
__device__ __forceinline__ void xcd_barrier_complete(unsigned* bar, unsigned x, unsigned& nloc, unsigned& nx) {
    const unsigned G = gridDim.x * gridDim.y * gridDim.z;
    unsigned sum, cnt, mine, sp = 0u;
    for (;;) {
        sum = 0u; cnt = 0u; mine = 0u;
#pragma unroll
        for (unsigned j = 0; j < 16; ++j) { const unsigned c = xb_ld(&bar[XB_XCNT(j)]); sum += c; cnt += (c > 0u) ? 1u : 0u; mine = (j == x) ? c : mine; }
        if (sum == G) break;
        __builtin_amdgcn_s_sleep(1);
        if ((++sp & 255u) == 0u) { if (xb_ld(&bar[XB_TMO])) break; if (sp > XB_SPIN_CAP) { atomicAdd(&bar[XB_TMO], 1u); break; } }
    }
    nloc = mine > 0u ? mine : 1u; nx = cnt > 0u ? cnt : 1u;
}
__device__ __forceinline__ void xcd_barrier(const XcdBarrier& b) {
    asm volatile("s_waitcnt vmcnt(0)" ::: "memory");
    __syncthreads();
    if (threadIdx.x == 0) {
        unsigned* bar = b.bar;
        __builtin_amdgcn_s_waitcnt(0);
        unsigned nloc = b.st[0], nx = b.st[1];
        if (nloc == 0u) { xcd_barrier_complete(bar, b.x, nloc, nx); b.st[0] = nloc; b.st[1] = nx; }
        const unsigned old = xb_add(&bar[XB_XSUB(b.x)], 1u);
        const unsigned gen = old / nloc;
        if (old + 1u == (gen + 1u) * nloc) {
            __builtin_amdgcn_fence(__ATOMIC_RELEASE, "agent");
            asm volatile("s_waitcnt vmcnt(0)" ::: "memory");
            const unsigned og = xb_add(&bar[XB_TOP], 1u);
            const unsigned tg = og / nx;
            if (og + 1u == (tg + 1u) * nx) xb_add(&bar[XB_TOPGEN], 1u);
            else XB_SPIN(xb_ld(&bar[XB_TOPGEN]) == tg, bar);
            __builtin_amdgcn_fence(__ATOMIC_ACQUIRE, "agent");
            xb_add(&bar[XB_XGEN(b.x)], 1u);
            asm volatile("s_waitcnt vmcnt(0)" ::: "memory");
        } else {
            XB_SPIN(xb_ld(&bar[XB_XGEN(b.x)]) == gen, bar);
            __builtin_amdgcn_fence(__ATOMIC_ACQUIRE, "agent");
            asm volatile("s_waitcnt vmcnt(0)" ::: "memory");
        }
    }
    __syncthreads();
}

constexpr int NPHASE = 9;
template <int PH> __device__ __forceinline__ void run_phase(const Params& P, char* smem) {
    const int bid = blockIdx.x, G = gridDim.x, tid = threadIdx.x;
    const size_t gtid = (size_t)bid * 256 + tid, gsize = (size_t)G * 256;
    if (PH == 0) {
        for (int it = bid; it < 192; it += G) modp_item(P, it, smem);
        float (*tile)[65] = (float (*)[65])smem;
        for (int it = bid; it < 1088; it += G) transpose_tile(P.w_in, DM, PROJW, P.WinT, it, tile);
        for (int it = bid; it < 128; it += G) transpose_tile(P.w_ao, 512, DM, P.WaoT, it, tile);
        for (int it = bid; it < 128; it += G) transpose_tile(P.w_co, 512, DM, P.WcoT, it, tile);
        for (int it = bid; it < 256; it += G) transpose_tile(P.w_mix, DM, DM, P.WmixT, it, tile);
        for (int it = bid; it < 512; it += G) transpose_tile(P.pw_q, DM, 2048, P.PwqT, it, tile);
        cvt_range(P.keys, P.KeysB, (size_t)16 * 128 * 128 / 8, gtid, gsize);
        { const int lane = tid & 63, wid = tid >> 6;
          for (int r = bid * 4 + wid; r < 2 * NEXP; r += G * 4) {
              if (r < NEXP) quant_row(P.pu + (size_t)r * DM, (unsigned char*)P.Uq + (size_t)r * DM, P.su + r, lane, 0);
              else { const int e = r - NEXP; quant_row(P.pv + (size_t)e * DM, P.Vq + (size_t)e * DM, P.sv + e, lane, 128); } } }
        rope_tab(P, (int)gtid, (int)gsize);
    } else if (PH == 1) {
        for (int i = (int)gtid; i < 17 * NMOD; i += (int)gsize) {
            float v = P.b_mod[i % NMOD];
#pragma unroll
            for (int kc = 0; kc < 8; ++kc) v += P.modp[(size_t)kc * 17 * NMOD + i];
            P.mod[i] = v;
        }
        for (int it = bid; it < 1152; it += G) norm1_item(P, it, smem);
    } else if (PH == 2) {
        for (int t = bid; t < 256 * 34 + 64; t += G) {
            if (t < 256 * 34) { int mt, nt; tile_coords(t, 256, 34, mt, nt); gemm_tile<MODE_INPROJ>(P, P.H, DM, P.WinT, DM, DM, mt * 128, nt * 128, nt * 128 >= 768, smem); }
            else { const int u = t - 256 * 34, mt = u >> 1, nt = u & 1; gemm_tile<MODE_CTXKV>(P, P.HC, DM, P.WinT + (size_t)512 * DM, DM, DM, mt * 128, nt * 128, nt == 0, smem); }
        }
    } else if (PH == 3) {
        for (int it = bid; it < NB * 16 * 8; it += G) attn_item(P, it);
        conv_range(P, gtid, gsize);
    } else if (PH == 4) {
        for (int t = bid; t < 256 * 8; t += G) {
            int mt, nt; tile_coords(t, 256, 8, mt, nt);
            gemm_tile<MODE_AO1>(P, P.AO, 512, P.WaoT, 512, 512, mt * 128, nt * 128, true, smem);
            gemm_tile<MODE_CO2>(P, P.CA, 512, P.WcoT, 512, 512, mt * 128, nt * 128, true, smem);
        }
    } else if (PH == 5) {
        for (int t = bid; t < 256 * 8; t += G) { int mt, nt; tile_coords(t, 256, 8, mt, nt); gemm_tile<MODE_MIX>(P, P.YG, DM, P.WmixT, DM, DM, mt * 128, nt * 128, true, smem); }
    } else if (PH == 6) {
        const int lane = tid & 63, wid = tid >> 6;
        for (int row = bid * 4 + wid; row < NTOK; row += G * 4) { const int b = row / SEQ;
            norm_row_q(P.X1 + (size_t)row * DM, P.n2, P.mod + (size_t)b * NMOD + 4 * DM, P.mod + (size_t)b * NMOD + 3 * DM, P.H2 + (size_t)row * DM, P.H2q + (size_t)row * DM, P.sh2 + row, lane); }
    } else if (PH == 7) {
        for (int it = bid; it < 256 * 8; it += G) peer_retrieve_item(P, it >> 3, it & 7, smem);
    } else if (PH == 8) {
        const int lane = tid & 63, wid = tid >> 6;
        for (int t = bid * 4 + wid; t < NTOK; t += G * 4) peer_final_token(P, t, lane);
    }
}
#ifndef REP0
#define REP0 1
#endif
#ifndef REP1
#define REP1 1
#endif
#ifndef REP2
#define REP2 1
#endif
#ifndef REP3
#define REP3 1
#endif
#ifndef REP4
#define REP4 1
#endif
#ifndef REP5
#define REP5 1
#endif
#ifndef REP6
#define REP6 1
#endif
#ifndef REP7
#define REP7 1
#endif
#ifndef REP8
#define REP8 1
#endif
constexpr int MEGA_LDS = RETR_LDS;
#ifndef MULTI_LAUNCH
__global__ void __launch_bounds__(256, 2) k_mega(Params P) {
    extern __shared__ __attribute__((aligned(16))) char smem[];
    volatile LAS unsigned* st = (volatile LAS unsigned*)(smem + MEGA_LDS);
    if (threadIdx.x < 4) st[threadIdx.x] = 0u;
    __syncthreads();
    const XcdBarrier bar = xcd_barrier_post(P.bar, st);
#define PHASE_SYNC(k) for (int rep = 0; rep < REP##k; ++rep) { run_phase<k>(P, smem); xcd_barrier(bar); }
    PHASE_SYNC(0) PHASE_SYNC(1) PHASE_SYNC(2) PHASE_SYNC(3) PHASE_SYNC(4) PHASE_SYNC(5) PHASE_SYNC(6) PHASE_SYNC(7)
    for (int rep = 0; rep < REP8 - 1; ++rep) { run_phase<8>(P, smem); xcd_barrier(bar); }
    run_phase<8>(P, smem);
}
#else
template <int PH> __global__ void __launch_bounds__(256, 2) k_phase(Params P) {
    extern __shared__ __attribute__((aligned(16))) char smem[];
    run_phase<PH>(P, smem);
}
#endif

static size_t carve(size_t& off, size_t bytes) { const size_t o = off; off += (bytes + 255) & ~(size_t)255; return o; }

extern "C" void kernel_launch(void* const* d_in, const int* in_sizes, int n_in, void* d_out, int out_size, void* d_ws, size_t ws_size, hipStream_t stream) {
    Params P{};
    P.x = (const float*)d_in[0]; P.c = (const float*)d_in[1]; P.ctx = (const float*)d_in[2]; P.c_ctx = (const float*)d_in[3];
    P.w_mod = (const float*)d_in[4]; P.b_mod = (const float*)d_in[5]; P.n1 = (const float*)d_in[6]; P.n2 = (const float*)d_in[7];
    P.w_in = (const float*)d_in[8]; P.sink = (const float*)d_in[9]; P.conv_w = (const float*)d_in[10]; P.w_ao = (const float*)d_in[11];
    P.w_co = (const float*)d_in[12]; P.w_mix = (const float*)d_in[13]; P.pw_q = (const float*)d_in[14]; P.keys = (const float*)d_in[15];
    P.pu = (const float*)d_in[16]; P.pv = (const float*)d_in[17]; P.fg = (const float*)d_in[18];
    P.out = (float*)d_out;
    char* ws = (char*)d_ws; size_t off = 0;
    P.modp = (float*)(ws + carve(off, (size_t)8 * 17 * NMOD * 4));
    P.mod = (float*)(ws + carve(off, (size_t)17 * NMOD * 4));
    P.rope = (float*)(ws + carve(off, 3072 * 4));
    P.WinT = (bf16_t*)(ws + carve(off, (size_t)PROJW * DM * 2));
    P.WaoT = (bf16_t*)(ws + carve(off, (size_t)DM * 512 * 2));
    P.WcoT = (bf16_t*)(ws + carve(off, (size_t)DM * 512 * 2));
    P.WmixT = (bf16_t*)(ws + carve(off, (size_t)DM * DM * 2));
    P.PwqT = (bf16_t*)(ws + carve(off, (size_t)2048 * DM * 2));
    P.KeysB = (bf16_t*)(ws + carve(off, (size_t)16 * 128 * 128 * 2));
    P.Uq = (signed char*)(ws + carve(off, (size_t)NEXP * DM));
    P.Vq = (unsigned char*)(ws + carve(off, (size_t)NEXP * DM));
    P.su = (float*)(ws + carve(off, (size_t)NEXP * 4));
    P.sv = (float*)(ws + carve(off, (size_t)NEXP * 4));
    P.sh2 = (float*)(ws + carve(off, (size_t)NTOK * 4));
    P.HC = (bf16_t*)(ws + carve(off, (size_t)NCTX * DM * 2));
    const size_t regA = carve(off, (size_t)NTOK * DM * 2);
    P.H = (bf16_t*)(ws + regA); P.YG = (bf16_t*)(ws + regA); P.H2 = (bf16_t*)(ws + regA);
    const size_t regB = off;
    P.Q = (bf16_t*)(ws + carve(off, (size_t)NTOK * 512 * 2));
    P.K = (bf16_t*)(ws + carve(off, (size_t)NTOK * 128 * 2));
    P.VT = (bf16_t*)(ws + carve(off, (size_t)NTOK * 128 * 2));
    P.Kc = (bf16_t*)(ws + carve(off, (size_t)NCTX * 128 * 2));
    P.VcT = (bf16_t*)(ws + carve(off, (size_t)NCTX * 128 * 2));
    const size_t regC = off;
    P.GB = (bf16_t*)(ws + carve(off, (size_t)NTOK * 512 * 2));
    P.GC = (bf16_t*)(ws + carve(off, (size_t)NTOK * 512 * 2));
    P.U = (bf16_t*)(ws + carve(off, (size_t)NTOK * 512 * 2));
    P.M1 = (bf16_t*)(ws + regC);
    const size_t regD = off;
    P.GA = (bf16_t*)(ws + carve(off, (size_t)NTOK * DM * 2));
    P.GV = (bf16_t*)(ws + carve(off, (size_t)NTOK * DM * 2));
    P.AO = (bf16_t*)(ws + carve(off, (size_t)NTOK * 512 * 2));
    P.H2q = (signed char*)P.AO;
    P.CA = (bf16_t*)(ws + carve(off, (size_t)NTOK * 512 * 2));
    P.X1 = (float*)(ws + regD);
    P.bar = (unsigned*)(ws + carve(off, (size_t)XCD_BAR_WORDS * 4));
    const size_t need = off;
    { size_t o2 = regB;
      P.sel_idx = (int*)(ws + carve(o2, (size_t)NTOK * 128 * 4));
      P.sel_g = (float*)(ws + carve(o2, (size_t)NTOK * 128 * 4));
      if (o2 > regC) { fprintf(stderr, "kernel_launch: late buffers overflow\n"); return; } }
    if (need > ws_size) { fprintf(stderr, "kernel_launch: workspace too small: need %zu have %zu\n", need, ws_size); return; }

#ifdef MULTI_LAUNCH
    static bool attr_done = false;
    if (!attr_done) {
#define SETA(PH) hipFuncSetAttribute((const void*)k_phase<PH>, hipFuncAttributeMaxDynamicSharedMemorySize, MEGA_LDS)
        SETA(0); SETA(1); SETA(2); SETA(3); SETA(4); SETA(5); SETA(6); SETA(7); SETA(8);
        attr_done = true;
    }
#define LP(PH) k_phase<PH><<<512, 256, MEGA_LDS, stream>>>(P)
    LP(0); LP(1); LP(2); LP(3); LP(4); LP(5); LP(6); LP(7); LP(8);
#else
    static int grid_blocks = 0;
    if (!grid_blocks) {
        int dev = 0, cus = 0, per_cu = 0;
        (void)hipGetDevice(&dev);
        (void)hipDeviceGetAttribute(&cus, hipDeviceAttributeMultiprocessorCount, dev);
        (void)hipFuncSetAttribute((const void*)k_mega, hipFuncAttributeMaxDynamicSharedMemorySize, MEGA_LDS + 16);
        (void)hipOccupancyMaxActiveBlocksPerMultiprocessor(&per_cu, (const void*)k_mega, 256, MEGA_LDS + 16);
        if (per_cu > 2) per_cu = 2;
        if (per_cu < 1) { fprintf(stderr, "kernel_launch: occupancy query returned %d\n", per_cu); per_cu = 1; }
        grid_blocks = cus * per_cu;
    }
    (void)hipMemsetAsync(P.bar, 0, (size_t)XCD_BAR_WORDS * 4, stream);
    void* args[] = { &P };
    hipError_t e = hipLaunchCooperativeKernel((const void*)k_mega, dim3(grid_blocks), dim3(256), args, MEGA_LDS + 16, stream);
    if (e != hipSuccess) fprintf(stderr, "cooperative launch failed: %s (grid %d)\n", hipGetErrorString(e), grid_blocks);
#endif
}
```

```cpp
#include <hip/hip_runtime.h>
#include <cstdio>
#include <cstdint>

typedef unsigned short bf16_t;
typedef short bf16x8 __attribute__((ext_vector_type(8)));
typedef float f32x4 __attribute__((ext_vector_type(4)));
typedef unsigned u32x4 __attribute__((ext_vector_type(4)));
typedef unsigned u32x2 __attribute__((ext_vector_type(2)));

constexpr int DM = 1024, NB = 16, SEQ = 2048, NTOK = NB * SEQ, CTXL = 256, NCTX = NB * CTXL;
constexpr int PROJW = 4352;
constexpr int NMOD = 6 * DM;
constexpr int NEXP = 16384;

__device__ __forceinline__ float bf2f(bf16_t x) { return __uint_as_float(((unsigned)x) << 16); }
__device__ __forceinline__ bf16_t f2bf(float f) {
    unsigned u = __float_as_uint(f);
    u += 0x7fffu + ((u >> 16) & 1u);
    return (bf16_t)(u >> 16);
}
__device__ __forceinline__ unsigned pk2(float lo, float hi) { return (unsigned)f2bf(lo) | ((unsigned)f2bf(hi) << 16); }
__device__ __forceinline__ float sigmoidf_(float x) { return 1.f / (1.f + __expf(-x)); }
__device__ __forceinline__ float wave_sum(float v) {
#pragma unroll
    for (int o = 1; o < 64; o <<= 1) v += __shfl_xor(v, o);
    return v;
}

__device__ __forceinline__ float wave_max(float v) {
#pragma unroll
    for (int o = 1; o < 64; o <<= 1) v = fmaxf(v, __shfl_xor(v, o));
    return v;
}
__device__ __forceinline__ unsigned q8(float x, float inv, int bias) {
    int q = (int)rintf(x * inv); q = q > 127 ? 127 : (q < -127 ? -127 : q);
    return (unsigned)((q + bias) & 0xff);
}
__device__ __forceinline__ void quant_row(const float* src, unsigned char* dst, float* scale_out, int lane, int bias) {
    f32x4 v[4]; float amax = 0.f;
#pragma unroll
    for (int j = 0; j < 4; ++j) { v[j] = *(const f32x4*)(src + 16 * lane + 4 * j); amax = fmaxf(amax, fmaxf(fmaxf(fabsf(v[j].x), fabsf(v[j].y)), fmaxf(fabsf(v[j].z), fabsf(v[j].w)))); }
    amax = wave_max(amax);
    const float sc = amax > 0.f ? amax * (1.f / 127.f) : 1.f, inv = 1.f / sc;
    u32x4 w;
    w.x = q8(v[0].x, inv, bias) | (q8(v[0].y, inv, bias) << 8) | (q8(v[0].z, inv, bias) << 16) | (q8(v[0].w, inv, bias) << 24);
    w.y = q8(v[1].x, inv, bias) | (q8(v[1].y, inv, bias) << 8) | (q8(v[1].z, inv, bias) << 16) | (q8(v[1].w, inv, bias) << 24);
    w.z = q8(v[2].x, inv, bias) | (q8(v[2].y, inv, bias) << 8) | (q8(v[2].z, inv, bias) << 16) | (q8(v[2].w, inv, bias) << 24);
    w.w = q8(v[3].x, inv, bias) | (q8(v[3].y, inv, bias) << 8) | (q8(v[3].z, inv, bias) << 16) | (q8(v[3].w, inv, bias) << 24);
    *(u32x4*)(dst + 16 * lane) = w;
    if (lane == 0) *scale_out = sc;
}

struct Params {
    const float *x, *c, *ctx, *c_ctx, *w_mod, *b_mod, *n1, *n2, *w_in, *sink, *conv_w, *w_ao, *w_co, *w_mix, *pw_q, *keys, *pu, *pv, *fg;
    float* out;
    float *modp, *mod, *rope;
    bf16_t *WinT, *WaoT, *WcoT, *WmixT, *PwqT, *KeysB;
    bf16_t *H, *HC, *Q, *K, *VT, *Kc, *VcT, *GB, *GC, *U, *GA, *GV, *AO, *CA, *M1, *YG, *H2, *QH;
    float* TKv; int* TKi;
    int* sel_idx; float* sel_g;
    float* X1;
    unsigned* bar;
    signed char *Uq, *H2q; unsigned char* Vq; float *su, *sv, *sh2;
};

__device__ __forceinline__ void modp_item(const Params& P, int item, char* smem) {
    float (*s)[128] = (float (*)[128])smem;
    const int kc = item / 24, nc = item % 24;
    __syncthreads();
    for (int i = threadIdx.x; i < 17 * 128; i += 256) {
        const int r = i / 128, k = i % 128;
        const float v = (r < 16) ? P.c[r * DM + kc * 128 + k] : P.c_ctx[kc * 128 + k];
        s[r][k] = v / (1.f + __expf(-v));
    }
    __syncthreads();
    const int n = nc * 256 + threadIdx.x;
    float acc[17];
#pragma unroll
    for (int r = 0; r < 17; ++r) acc[r] = 0.f;
    for (int k = 0; k < 128; ++k) {
        const float w = P.w_mod[(size_t)(kc * 128 + k) * NMOD + n];
#pragma unroll
        for (int r = 0; r < 17; ++r) acc[r] += s[r][k] * w;
    }
#pragma unroll
    for (int r = 0; r < 17; ++r) P.modp[((size_t)kc * 17 + r) * NMOD + n] = acc[r];
}
__device__ __forceinline__ void cvt_range(const float* src, bf16_t* dst, size_t n8, size_t gtid, size_t gsize) {
    for (size_t i = gtid; i < n8; i += gsize) {
        const f32x4 a = *(const f32x4*)(src + i * 8), b = *(const f32x4*)(src + i * 8 + 4);
        u32x4 o; o.x = pk2(a.x, a.y); o.y = pk2(a.z, a.w); o.z = pk2(b.x, b.y); o.w = pk2(b.z, b.w);
        *(u32x4*)(dst + i * 8) = o;
    }
}
__device__ __forceinline__ void rope_tab(const Params& P, int gtid, int gsize) {
    for (int i = gtid; i < 1536; i += gsize) {
        int pos, f; bool isc;
        if (i < 512) { pos = i / 16; f = i % 16; isc = false; } else { pos = (i - 512) / 16; f = (i - 512) % 16; isc = true; }
        const double inv = pow(10000.0, -(double)f / 16.0);
        const double ang = (double)pos * inv;
        const float cv = (float)cos(ang), sv = (float)sin(ang);
        if (!isc) { P.rope[pos * 16 + f] = cv; P.rope[512 + pos * 16 + f] = sv; }
        else { P.rope[1024 + pos * 16 + f] = cv; P.rope[2048 + pos * 16 + f] = sv; }
    }
}
__device__ __forceinline__ void transpose_tile(const float* W, int K, int N, bf16_t* Wt, int item, float (*tile)[65]) {
    const int ntn = N / 64, kt = item / ntn, nt = item % ntn, k0 = kt * 64, n0 = nt * 64;
    const int tx = threadIdx.x & 63, ty = threadIdx.x >> 6;
    __syncthreads();
#pragma unroll
    for (int i = 0; i < 16; ++i) { const int k = i * 4 + ty; tile[k][tx] = W[(size_t)(k0 + k) * N + n0 + tx]; }
    __syncthreads();
#pragma unroll
    for (int i = 0; i < 16; ++i) { const int n = i * 4 + ty; Wt[(size_t)(n0 + n) * K + k0 + tx] = f2bf(tile[tx][n]); }
}

__device__ __forceinline__ void norm_row(const float* xr, const float* g, const float* scale, const float* shift, bf16_t* dst, int lane) {
    f32x4 v[4]; float s = 0.f;
#pragma unroll
    for (int j = 0; j < 4; ++j) { v[j] = *(const f32x4*)(xr + j * 256 + lane * 4); s += v[j].x * v[j].x + v[j].y * v[j].y + v[j].z * v[j].z + v[j].w * v[j].w; }
    s = wave_sum(s);
    const float rstd = rsqrtf(s * (1.f / DM) + 1e-6f);
#pragma unroll
    for (int j = 0; j < 4; ++j) {
        const int d = j * 256 + lane * 4;
        const f32x4 gg = *(const f32x4*)(g + d), sc = *(const f32x4*)(scale + d), sh = *(const f32x4*)(shift + d);
        const float y0 = v[j].x * rstd * gg.x * (1.f + sc.x) + sh.x;
        const float y1 = v[j].y * rstd * gg.y * (1.f + sc.y) + sh.y;
        const float y2 = v[j].z * rstd * gg.z * (1.f + sc.z) + sh.z;
        const float y3 = v[j].w * rstd * gg.w * (1.f + sc.w) + sh.w;
        u32x2 o; o.x = pk2(y0, y1); o.y = pk2(y2, y3);
        *(u32x2*)(dst + d) = o;
    }
}

__device__ __forceinline__ void norm_row_q(const float* xr, const float* g, const float* scale, const float* shift, bf16_t* dst, signed char* dq, float* sq, int lane) {
    f32x4 v[4]; float s = 0.f;
#pragma unroll
    for (int j = 0; j < 4; ++j) { v[j] = *(const f32x4*)(xr + j * 256 + lane * 4); s += v[j].x * v[j].x + v[j].y * v[j].y + v[j].z * v[j].z + v[j].w * v[j].w; }
    s = wave_sum(s);
    const float rstd = rsqrtf(s * (1.f / DM) + 1e-6f);
    float amax = 0.f;
#pragma unroll
    for (int j = 0; j < 4; ++j) {
        const int d = j * 256 + lane * 4;
        const f32x4 gg = *(const f32x4*)(g + d), sc = *(const f32x4*)(scale + d), sh = *(const f32x4*)(shift + d);
        v[j].x = v[j].x * rstd * gg.x * (1.f + sc.x) + sh.x;
        v[j].y = v[j].y * rstd * gg.y * (1.f + sc.y) + sh.y;
        v[j].z = v[j].z * rstd * gg.z * (1.f + sc.z) + sh.z;
        v[j].w = v[j].w * rstd * gg.w * (1.f + sc.w) + sh.w;
        u32x2 o; o.x = pk2(v[j].x, v[j].y); o.y = pk2(v[j].z, v[j].w);
        *(u32x2*)(dst + d) = o;
        amax = fmaxf(amax, fmaxf(fmaxf(fabsf(v[j].x), fabsf(v[j].y)), fmaxf(fabsf(v[j].z), fabsf(v[j].w))));
    }
    amax = wave_max(amax);
    const float qs = amax > 0.f ? amax * (1.f / 127.f) : 1.f, inv = 1.f / qs;
#pragma unroll
    for (int j = 0; j < 4; ++j) {
        const unsigned w = q8(v[j].x, inv, 0) | (q8(v[j].y, inv, 0) << 8) | (q8(v[j].z, inv, 0) << 16) | (q8(v[j].w, inv, 0) << 24);
        *(unsigned*)(dq + j * 256 + lane * 4) = w;
    }
    if (lane == 0) *sq = qs;
}

__device__ __forceinline__ void norm1_item(const Params& P, int item, char* smem) {
    float* sc = (float*)smem; float* sh = sc + DM;
    const bool isctx = item >= 1024;
    const int row0 = isctx ? (item - 1024) * 32 : item * 32;
    const int r = isctx ? 16 : row0 / SEQ;
    __syncthreads();
    for (int d = threadIdx.x; d < DM; d += 256) {
        float a = P.b_mod[DM + d], b = P.b_mod[d];
#pragma unroll
        for (int kc = 0; kc < 8; ++kc) { a += P.modp[((size_t)kc * 17 + r) * NMOD + DM + d]; b += P.modp[((size_t)kc * 17 + r) * NMOD + d]; }
        sc[d] = a; sh[d] = b;
    }
    __syncthreads();
    const int lane = threadIdx.x & 63, wid = threadIdx.x >> 6;
    for (int i = wid; i < 32; i += 4) {
        const int row = row0 + i;
        if (!isctx) norm_row(P.x + (size_t)row * DM, P.n1, sc, sh, P.H + (size_t)row * DM, lane);
        else norm_row(P.ctx + (size_t)row * DM, P.n1, sc, sh, P.HC + (size_t)row * DM, lane);
    }
}
enum { MODE_INPROJ = 0, MODE_CTXKV = 1, MODE_AO1 = 2, MODE_CO2 = 3, MODE_MIX = 4, MODE_QH = 5 };

__device__ __forceinline__ void st8bf(bf16_t* p, const float* v) {
    u32x4 o; o.x = pk2(v[0], v[1]); o.y = pk2(v[2], v[3]); o.z = pk2(v[4], v[5]); o.w = pk2(v[6], v[7]);
    *(u32x4*)p = o;
}
__device__ __forceinline__ void st4bf(bf16_t* p, const float* v) {
    u32x2 o; o.x = pk2(v[0], v[1]); o.y = pk2(v[2], v[3]);
    *(u32x2*)p = o;
}
template <int MODE> __device__ __forceinline__ void epi8(const Params& P, int m, int n, const float* v, int aux) {
    if (MODE == MODE_INPROJ) {
        if (n < 1280) st8bf(P.GB + (size_t)m * 512 + (n - 768), v);
        else if (n < 1792) st8bf(P.GC + (size_t)m * 512 + (n - 1280), v);
        else if (n < 2304) st8bf(P.U + (size_t)m * 512 + (n - 1792), v);
        else {
            float s[8];
#pragma unroll
            for (int j = 0; j < 8; ++j) s[j] = sigmoidf_(v[j]);
            if (n < 3328) st8bf(P.GA + (size_t)m * DM + (n - 2304), s);
            else st8bf(P.GV + (size_t)m * DM + (n - 3328), s);
        }
    } else if (MODE == MODE_CTXKV) {
        { const int b = m / CTXL, c = m % CTXL, kvh = n >> 6, d0 = n & 63;
          st8bf(P.Kc + ((((size_t)((b * 2 + kvh) * 8 + (c >> 5)) * 4 + (d0 >> 4)) * 2 + ((d0 >> 3) & 1)) * 32 + (c & 31)) * 8, v); }
    } else if (MODE == MODE_AO1) {
        const u32x4 g = *(const u32x4*)((aux ? P.GV : P.GA) + (size_t)m * DM + n);
        u32x4 a = (u32x4){0u, 0u, 0u, 0u};
        if (aux) a = *(const u32x4*)(P.M1 + (size_t)m * DM + n);
        float o[8];
        o[0] = bf2f(a.x & 0xffff) + v[0] * bf2f(g.x & 0xffff); o[1] = bf2f(a.x >> 16) + v[1] * bf2f(g.x >> 16);
        o[2] = bf2f(a.y & 0xffff) + v[2] * bf2f(g.y & 0xffff); o[3] = bf2f(a.y >> 16) + v[3] * bf2f(g.y >> 16);
        o[4] = bf2f(a.z & 0xffff) + v[4] * bf2f(g.z & 0xffff); o[5] = bf2f(a.z >> 16) + v[5] * bf2f(g.z >> 16);
        o[6] = bf2f(a.w & 0xffff) + v[6] * bf2f(g.w & 0xffff); o[7] = bf2f(a.w >> 16) + v[7] * bf2f(g.w >> 16);
        st8bf((aux ? P.YG : P.M1) + (size_t)m * DM + n, o);
    } else if (MODE == MODE_MIX) {
        const int b = m / SEQ;
        const float* g1 = P.mod + (size_t)b * NMOD + 2 * DM + n;
        const float* xr = P.x + (size_t)m * DM + n;
        float* o = P.X1 + (size_t)m * DM + n;
        const f32x4 x0 = *(const f32x4*)xr, x1 = *(const f32x4*)(xr + 4), g0 = *(const f32x4*)g1, g1v = *(const f32x4*)(g1 + 4);
        f32x4 o0, o1;
        o0.x = x0.x + g0.x * v[0]; o0.y = x0.y + g0.y * v[1]; o0.z = x0.z + g0.z * v[2]; o0.w = x0.w + g0.w * v[3];
        o1.x = x1.x + g1v.x * v[4]; o1.y = x1.y + g1v.y * v[5]; o1.z = x1.z + g1v.z * v[6]; o1.w = x1.w + g1v.w * v[7];
        *(f32x4*)o = o0; *(f32x4*)(o + 4) = o1;
    } else if (MODE == MODE_QH) {
        st8bf(P.QH + (size_t)m * 2048 + n, v);
    }
}
__device__ __forceinline__ void epi_rope(const Params& P, int m, int n, const float* lo, const float* hi) {
    const int d0 = n & 63;
    const int l = m % SEQ;
    const float *ct, *st;
    if (d0 < 16) { const int row = l >> 6; ct = P.rope + row * 16 + d0; st = P.rope + 512 + row * 16 + d0; }
    else { const int col = l & 63; ct = P.rope + 1024 + col * 16 + (d0 - 32); st = P.rope + 2048 + col * 16 + (d0 - 32); }
    float a[4], b[4];
    const float sc = (n < 512) ? 0.125f : 1.f;
#pragma unroll
    for (int j = 0; j < 4; ++j) { const float cc = ct[j], ss = st[j]; a[j] = (lo[j] * cc - hi[j] * ss) * sc; b[j] = (lo[j] * ss + hi[j] * cc) * sc; }
    if (n < 512) { st4bf(P.Q + (size_t)m * 512 + n, a); st4bf(P.Q + (size_t)m * 512 + n + 16, b); }
    else { const int bb = m / SEQ, kvh = (n - 512) >> 6;
        bf16_t* kp = P.K + ((((size_t)((bb * 2 + kvh) * 64 + (l >> 5)) * 4 + (d0 >> 4)) * 2 + ((d0 >> 3) & 1)) * 32 + (l & 31)) * 8 + (d0 & 7);
        st4bf(kp, a); st4bf(kp + 512, b); }
}
__device__ __forceinline__ void epi_v4(const Params& P, int m, int dcol, const float* v, bool ctx) {
    const int kvh = dcol >> 6, dd = dcol & 63;
    if (!ctx) { const int b = m / SEQ, l = m % SEQ;
#pragma unroll
        for (int j = 0; j < 4; ++j) {
            const int kk = l & 31;
            P.VT[(((((size_t)((b * 2 + kvh) * 64 + (l >> 5)) * 2 + (dd >> 5)) * 2 + (kk >> 4)) * 2 + ((kk >> 2) & 1)) * 32 + ((dd & 31) + j)) * 8 + 4 * ((kk >> 3) & 1) + (kk & 3)] = f2bf(v[j]); }
    } else { const int b = m / CTXL, cpos = m % CTXL;
#pragma unroll
        for (int j = 0; j < 4; ++j) {
            const int kk = cpos & 31;
            P.VcT[(((((size_t)((b * 2 + kvh) * 8 + (cpos >> 5)) * 2 + (dd >> 5)) * 2 + (kk >> 4)) * 2 + ((kk >> 2) & 1)) * 32 + ((dd & 31) + j)) * 8 + 4 * ((kk >> 3) & 1) + (kk & 3)] = f2bf(v[j]); }
    }
}

constexpr int GEMM_LDS = 65536;
constexpr int RETR_LDS = 128 * 130 * 4;
__device__ __forceinline__ int lds_off(int row, int chunk) { return row * 128 + ((chunk ^ ((row >> 1) & 7)) << 4); }

__device__ __forceinline__ void mma_from_lds(const char* As, const char* Bs, f32x4 (&acc)[4][4], int wm, int wn, int fr, int fq, int sw) {
#pragma unroll
    for (int ks = 0; ks < 2; ++ks) {
        bf16x8 af[4], bfr[4];
        const int coff = ((ks * 4 + fq) ^ sw) << 4;
#pragma unroll
        for (int mt = 0; mt < 4; ++mt) af[mt] = *(const bf16x8*)(As + (wm * 64 + mt * 16 + fr) * 128 + coff);
#pragma unroll
        for (int nt = 0; nt < 4; ++nt) bfr[nt] = *(const bf16x8*)(Bs + (wn * 64 + nt * 16 + fr) * 128 + coff);
#pragma unroll
        for (int mt = 0; mt < 4; ++mt)
#pragma unroll
            for (int nt = 0; nt < 4; ++nt) acc[mt][nt] = __builtin_amdgcn_mfma_f32_16x16x32_bf16(bfr[nt], af[mt], acc[mt][nt], 0, 0, 0);
    }
}
__device__ __forceinline__ void gemm_mainloop(const bf16_t* __restrict__ A, int lda, const bf16_t* __restrict__ Bt, int ldb, int K, int m0, int n0, bool perm, char* smem, f32x4 (&acc)[4][4]) {
    const int tid = threadIdx.x, lane = tid & 63, wid = tid >> 6;
    const int wm = wid >> 1, wn = wid & 1, fr = lane & 15, fq = lane >> 4;
    const bf16_t* ag[4]; const bf16_t* bg[4];
#pragma unroll
    for (int i = 0; i < 4; ++i) {
        const int row = (wid + 4 * i) * 8 + (lane >> 3);
        const int c = (lane & 7) ^ ((row >> 1) & 7);
        ag[i] = A + (size_t)(m0 + row) * lda + c * 8;
        int brow = row;
        if (perm) { const int g = row >> 5, rr = row & 31, nn = rr >> 4, j = rr & 15; brow = 32 * g + 8 * (j >> 2) + 4 * nn + (j & 3); }
        bg[i] = Bt + (size_t)(n0 + brow) * ldb + c * 8;
    }
#pragma unroll
    for (int i = 0; i < 4; ++i)
#pragma unroll
        for (int j = 0; j < 4; ++j) acc[i][j] = (f32x4){0.f, 0.f, 0.f, 0.f};
#define GSTAGE(buf, k0) { _Pragma("unroll") for (int i = 0; i < 4; ++i) { \
        __builtin_amdgcn_global_load_lds((const unsigned*)(ag[i] + (k0)), (unsigned*)(smem + (buf) * 32768 + (wid + 4 * i) * 1024), 16, 0, 0); \
        __builtin_amdgcn_global_load_lds((const unsigned*)(bg[i] + (k0)), (unsigned*)(smem + (buf) * 32768 + 16384 + (wid + 4 * i) * 1024), 16, 0, 0); } }
    GSTAGE(0, 0)
    asm volatile("s_waitcnt vmcnt(0)" ::: "memory");
    __syncthreads();
    const int nk = K / 64;
    const int sw = (fr >> 1) & 7;
    for (int kt = 0; kt < nk; ++kt) {
        const int cur = kt & 1;
        if (kt + 1 < nk) GSTAGE(cur ^ 1, (kt + 1) * 64)
        mma_from_lds(smem + cur * 32768, smem + cur * 32768 + 16384, acc, wm, wn, fr, fq, sw);
        asm volatile("s_waitcnt vmcnt(0)" ::: "memory");
        __syncthreads();
    }
#undef GSTAGE
}

template <int MT, int NST>
__device__ __forceinline__ void gemm_ring(const bf16_t* __restrict__ A, int lda, const bf16_t* __restrict__ Bt, int ldb, int K, int m0, int n0, bool perm, char* smem, f32x4 (&acc)[MT][4]) {
    constexpr int SA = 2048 * MT, SB = SA + 8192, GA = MT / 2, GL = GA + 2;
    const int tid = threadIdx.x, lane = tid & 63, wid = __builtin_amdgcn_readfirstlane(tid >> 6);
    const int wm = wid >> 1, wn = wid & 1, fr = lane & 15, fq = lane >> 4;
    const int c8 = ((lane & 3) ^ (3 * ((lane >> 4) & 1))) * 8;
    unsigned aoff[GA], boff[2];
#pragma unroll
    for (int i = 0; i < GA; ++i) aoff[i] = (unsigned)(((wid + 4 * i) * 16 + (lane >> 2)) * lda + c8) * 2u;
#pragma unroll
    for (int i = 0; i < 2; ++i) {
        const int row = (wid + 4 * i) * 16 + (lane >> 2);
        int brow = row;
        if (perm) { const int g = row >> 5, rr = row & 31, nn = rr >> 4, j = rr & 15; brow = 32 * g + 8 * (j >> 2) + 4 * nn + (j & 3); }
        boff[i] = (unsigned)(brow * ldb + c8) * 2u;
    }
    const char* Abase = (const char*)(A + (size_t)m0 * lda);
    const char* Bbase = (const char*)(Bt + (size_t)n0 * ldb);
#pragma unroll
    for (int i = 0; i < MT; ++i)
#pragma unroll
        for (int j = 0; j < 4; ++j) acc[i][j] = (f32x4){0.f, 0.f, 0.f, 0.f};
#define RSTAGE_(buf, k0) { char* sb_ = smem + (buf) * SB; const char* ab_ = Abase + (size_t)(k0) * 2; const char* bb_ = Bbase + (size_t)(k0) * 2; \
        _Pragma("unroll") for (int i = 0; i < GA; ++i) __builtin_amdgcn_global_load_lds((const unsigned*)(ab_ + aoff[i]), (unsigned*)(sb_ + (wid + 4 * i) * 1024), 16, 0, 0); \
        _Pragma("unroll") for (int i = 0; i < 2; ++i) __builtin_amdgcn_global_load_lds((const unsigned*)(bb_ + boff[i]), (unsigned*)(sb_ + SA + (wid + 4 * i) * 1024), 16, 0, 0); }
    const int nk = K / 32;
    asm volatile("s_waitcnt vmcnt(0)" ::: "memory");
#pragma unroll
    for (int s = 0; s < NST - 1; ++s) RSTAGE_(s, s * 32)
    const int coff = (fq ^ (3 * ((fr >> 2) & 1))) << 4;
    int cur = 0, nxt = NST - 1;
    for (int kt = 0; kt < nk; ++kt) {
        const int rem = nk - 1 - kt;
        if (rem >= NST - 2) asm volatile("s_waitcnt vmcnt(%0)" :: "n"(GL * (NST - 2)) : "memory");
        else if (NST == 4 && rem == 1) asm volatile("s_waitcnt vmcnt(%0)" :: "n"(GL) : "memory");
        else asm volatile("s_waitcnt vmcnt(0)" ::: "memory");
        __builtin_amdgcn_s_barrier();
        if (kt + NST - 1 < nk) RSTAGE_(nxt, (kt + NST - 1) * 32)
        const char* As = smem + cur * SB;
        const char* Bs = As + SA;
        bf16x8 af[MT], bfr[4];
#pragma unroll
        for (int mt = 0; mt < MT; ++mt) af[mt] = *(const bf16x8*)(As + (wm * 16 * MT + mt * 16 + fr) * 64 + coff);
#pragma unroll
        for (int nt = 0; nt < 4; ++nt) bfr[nt] = *(const bf16x8*)(Bs + (wn * 64 + nt * 16 + fr) * 64 + coff);
#pragma unroll
        for (int mt = 0; mt < MT; ++mt)
#pragma unroll
            for (int nt = 0; nt < 4; ++nt) acc[mt][nt] = __builtin_amdgcn_mfma_f32_16x16x32_bf16(bfr[nt], af[mt], acc[mt][nt], 0, 0, 0);
        cur = (cur + 1 == NST) ? 0 : cur + 1;
        nxt = (nxt + 1 == NST) ? 0 : nxt + 1;
    }
#undef RSTAGE_
    __syncthreads();
}

template <int MODE, int MT>
__device__ __forceinline__ void gemm_tile(const Params& P, const bf16_t* __restrict__ A, int lda, const bf16_t* __restrict__ Bt, int ldb, int K, int m0, int n0, bool perm, char* smem, int aux = 0) {
    const int lane = threadIdx.x & 63, wid = threadIdx.x >> 6;
    const int wm = wid >> 1, wn = wid & 1, fr = lane & 15, fq = lane >> 4;
    f32x4 acc[MT][4];
    gemm_ring<MT, (MT == 8 ? 3 : 4)>(A, lda, Bt, ldb, K, m0, n0, perm, smem, acc);
#pragma unroll
    for (int mt = 0; mt < MT; ++mt) {
        const int m = m0 + wm * 16 * MT + mt * 16 + fr;
        if (perm) {
#pragma unroll
            for (int p = 0; p < 2; ++p) {
                float v[8] = { acc[mt][2 * p][0], acc[mt][2 * p][1], acc[mt][2 * p][2], acc[mt][2 * p][3], acc[mt][2 * p + 1][0], acc[mt][2 * p + 1][1], acc[mt][2 * p + 1][2], acc[mt][2 * p + 1][3] };
                epi8<MODE>(P, m, n0 + wn * 64 + 32 * p + 8 * fq, v, aux);
            }
        } else if (MODE == MODE_INPROJ && n0 < 640) {
#pragma unroll
            for (int p = 0; p < 2; ++p) {
                float lo[4] = { acc[mt][2 * p][0], acc[mt][2 * p][1], acc[mt][2 * p][2], acc[mt][2 * p][3] };
                float hi[4] = { acc[mt][2 * p + 1][0], acc[mt][2 * p + 1][1], acc[mt][2 * p + 1][2], acc[mt][2 * p + 1][3] };
                epi_rope(P, m, n0 + wn * 64 + 32 * p + 4 * fq, lo, hi);
            }
        } else if (MODE == MODE_INPROJ || MODE == MODE_CTXKV) {
            const int dbase = (MODE == MODE_INPROJ) ? (n0 - 640) : (n0 - 128);
#pragma unroll
            for (int nt = 0; nt < 4; ++nt) {
                float v[4] = { acc[mt][nt][0], acc[mt][nt][1], acc[mt][nt][2], acc[mt][nt][3] };
                epi_v4(P, m, dbase + wn * 64 + 16 * nt + 4 * fq, v, MODE == MODE_CTXKV);
            }
        }
        asm volatile("" ::: "memory");
    }
}
__device__ __forceinline__ void tile_coords(int t, int ntm, int ntn, int& mt, int& nt) {
    const int per = 8 * ntn, g = t / per, r = t % per;
    mt = g * 8 + (r & 7); nt = r >> 3;
}
#define CEU(a, b) { const unsigned _t = (a) > (b) ? (a) : (b); (b) = (a) > (b) ? (b) : (a); (a) = _t; }
__device__ __forceinline__ void sort16_desc(unsigned (&v)[16]) {
    CEU(v[0], v[1]); CEU(v[2], v[3]); CEU(v[0], v[2]); CEU(v[1], v[3]); CEU(v[1], v[2]); CEU(v[4], v[5]);
    CEU(v[6], v[7]); CEU(v[4], v[6]); CEU(v[5], v[7]); CEU(v[5], v[6]); CEU(v[0], v[4]); CEU(v[2], v[6]);
    CEU(v[2], v[4]); CEU(v[1], v[5]); CEU(v[3], v[7]); CEU(v[3], v[5]); CEU(v[1], v[2]); CEU(v[3], v[4]);
    CEU(v[5], v[6]); CEU(v[8], v[9]); CEU(v[10], v[11]); CEU(v[8], v[10]); CEU(v[9], v[11]); CEU(v[9], v[10]);
    CEU(v[12], v[13]); CEU(v[14], v[15]); CEU(v[12], v[14]); CEU(v[13], v[15]); CEU(v[13], v[14]); CEU(v[8], v[12]);
    CEU(v[10], v[14]); CEU(v[10], v[12]); CEU(v[9], v[13]); CEU(v[11], v[15]); CEU(v[11], v[13]); CEU(v[9], v[10]);
    CEU(v[11], v[12]); CEU(v[13], v[14]); CEU(v[0], v[8]); CEU(v[4], v[12]); CEU(v[4], v[8]); CEU(v[2], v[10]);
    CEU(v[6], v[14]); CEU(v[6], v[10]); CEU(v[2], v[4]); CEU(v[6], v[8]); CEU(v[10], v[12]); CEU(v[1], v[9]);
    CEU(v[5], v[13]); CEU(v[5], v[9]); CEU(v[3], v[11]); CEU(v[7], v[15]); CEU(v[7], v[11]); CEU(v[3], v[5]);
    CEU(v[7], v[9]); CEU(v[11], v[13]); CEU(v[1], v[2]); CEU(v[3], v[4]); CEU(v[5], v[6]); CEU(v[7], v[8]);
    CEU(v[9], v[10]); CEU(v[11], v[12]); CEU(v[13], v[14]);
}
__device__ __forceinline__ void bitonic16_desc(unsigned (&v)[16]) {
    CEU(v[0], v[8]); CEU(v[1], v[9]); CEU(v[2], v[10]); CEU(v[3], v[11]); CEU(v[4], v[12]); CEU(v[5], v[13]);
    CEU(v[6], v[14]); CEU(v[7], v[15]); CEU(v[0], v[4]); CEU(v[1], v[5]); CEU(v[2], v[6]); CEU(v[3], v[7]);
    CEU(v[8], v[12]); CEU(v[9], v[13]); CEU(v[10], v[14]); CEU(v[11], v[15]); CEU(v[0], v[2]); CEU(v[1], v[3]);
    CEU(v[4], v[6]); CEU(v[5], v[7]); CEU(v[8], v[10]); CEU(v[9], v[11]); CEU(v[12], v[14]); CEU(v[13], v[15]);
    CEU(v[0], v[1]); CEU(v[2], v[3]); CEU(v[4], v[5]); CEU(v[6], v[7]); CEU(v[8], v[9]); CEU(v[10], v[11]);
    CEU(v[12], v[13]); CEU(v[14], v[15]);
}

__device__ __forceinline__ unsigned enc_key(float f) { const unsigned b = __float_as_uint(f); return b ^ ((unsigned)((int)b >> 31) | 0x80000000u); }
__device__ __forceinline__ float dec_key(unsigned k) { const unsigned b = (k & 0x80000000u) ? (k & 0x7fffffffu) : ~k; return __uint_as_float(b); }
__device__ __forceinline__ void topmerge16(unsigned (&top)[16], const unsigned (&L)[16]) {
#pragma unroll
    for (int i = 0; i < 16; ++i) top[i] = top[i] > L[15 - i] ? top[i] : L[15 - i];
    bitonic16_desc(top);
}
__device__ __forceinline__ unsigned cand_key(float a, float b, int i, int j) { return (enc_key(a + b) & ~0xFFu) | (unsigned)(i << 4) | (unsigned)j; }

__device__ __forceinline__ void peer_retrieve_item(const Params& P, int mtile, int h, char* smem) {
    const int tid = threadIdx.x, lane = tid & 63, wid = tid >> 6;
    const int wm = wid >> 1, wn = wid & 1, fr = lane & 15, fq = lane >> 4;
    const int sw = (fr >> 1) & 7;
    const int m0 = mtile * 128;
    unsigned T0[16], T1[16];
#pragma unroll 1
    for (int p = 0; p < 2; ++p) {
        const int hp = h * 2 + p;
        f32x4 acc[4][4];
        gemm_ring<4, 4>(P.H2, DM, P.PwqT, DM, DM, m0, hp * 128, false, smem, acc);
#pragma unroll
        for (int mt = 0; mt < 4; ++mt)
#pragma unroll
            for (int nt = 0; nt < 4; ++nt) {
                const int row = wm * 64 + mt * 16 + fr;
                u32x2 o; o.x = pk2(acc[mt][nt][0], acc[mt][nt][1]); o.y = pk2(acc[mt][nt][2], acc[mt][nt][3]);
                *(u32x2*)(smem + wn * 32768 + lds_off(row, 2 * nt + (fq >> 1)) + (fq & 1) * 8) = o;
            }
        {
            const int srow = tid >> 3, schunk = tid & 7;
            const bf16_t* kb = P.KeysB + (size_t)hp * 128 * 128;
#pragma unroll
            for (int hf = 0; hf < 2; ++hf)
#pragma unroll
                for (int q = 0; q < 4; ++q) {
                    const int row = q * 32 + srow;
                    const u32x4 v = *(const u32x4*)(kb + (size_t)row * 128 + hf * 64 + schunk * 8);
                    *(u32x4*)(smem + hf * 32768 + 16384 + lds_off(row, schunk)) = v;
                }
        }
        __syncthreads();
#pragma unroll
        for (int i = 0; i < 4; ++i)
#pragma unroll
            for (int j = 0; j < 4; ++j) acc[i][j] = (f32x4){0.f, 0.f, 0.f, 0.f};
        mma_from_lds(smem, smem + 16384, acc, wm, wn, fr, fq, sw);
        mma_from_lds(smem + 32768, smem + 32768 + 16384, acc, wm, wn, fr, fq, sw);
        __syncthreads();
        float* sc = (float*)smem;
#pragma unroll
        for (int mt = 0; mt < 4; ++mt)
#pragma unroll
            for (int nt = 0; nt < 4; ++nt) {
                const int row = wm * 64 + mt * 16 + fr;
#pragma unroll
                for (int r = 0; r < 4; ++r) {
                    const int col = wn * 64 + nt * 16 + fq * 4 + r;
                    sc[row * 130 + wn * 65 + (col & 63)] = acc[mt][nt][r];
                }
            }
        __syncthreads();
        {
            const int row = tid >> 1, half = tid & 1;
            const float* rp = sc + row * 130 + half * 65;
            unsigned top[16];
#pragma unroll 1
            for (int g = 0; g < 4; ++g) {
                unsigned L[16];
#pragma unroll
                for (int j = 0; j < 16; ++j) { const int col = half * 64 + g * 16 + j; L[j] = (enc_key(rp[g * 16 + j]) & ~0x7Fu) | (unsigned)col; }
                sort16_desc(L);
                if (g == 0) {
#pragma unroll
                    for (int j = 0; j < 16; ++j) top[j] = L[j];
                } else topmerge16(top, L);
            }
            unsigned Bp[16];
#pragma unroll
            for (int j = 0; j < 16; ++j) Bp[j] = (unsigned)__shfl_xor((int)top[j], 1);
            topmerge16(top, Bp);
            if (p == 0) {
#pragma unroll
                for (int j = 0; j < 16; ++j) T0[j] = top[j];
            } else {
#pragma unroll
                for (int j = 0; j < 16; ++j) T1[j] = top[j];
            }
        }
        __syncthreads();
    }
    {
        const int row = tid >> 1;
        unsigned char* slot = (unsigned char*)smem + row * 32;
        if ((tid & 1) == 0) {
#pragma unroll
            for (int j = 0; j < 16; ++j) { slot[j] = (unsigned char)(T0[j] & 0x7Fu); slot[16 + j] = (unsigned char)(T1[j] & 0x7Fu); }
            float a[16], b[16];
#pragma unroll
            for (int j = 0; j < 16; ++j) { a[j] = dec_key(T0[j]); b[j] = dec_key(T1[j]); }
            unsigned LA[16], LB[16], LC[16];
#pragma unroll
            for (int j = 0; j < 16; ++j) LA[j] = cand_key(a[0], b[j], 0, j);
#pragma unroll
            for (int j = 0; j < 8; ++j) LB[j] = cand_key(a[1], b[j], 1, j);
#pragma unroll
            for (int j = 0; j < 8; ++j) LB[8 + j] = cand_key(a[15 - j], b[0], 15 - j, 0);
            LC[0] = cand_key(a[2], b[0], 2, 0); LC[1] = cand_key(a[2], b[1], 2, 1); LC[2] = cand_key(a[2], b[2], 2, 2); LC[3] = cand_key(a[2], b[3], 2, 3); LC[4] = cand_key(a[2], b[4], 2, 4);
            LC[5] = cand_key(a[3], b[0], 3, 0); LC[6] = cand_key(a[3], b[1], 3, 1); LC[7] = cand_key(a[3], b[2], 3, 2); LC[8] = cand_key(a[3], b[3], 3, 3);
            LC[9] = cand_key(a[4], b[0], 4, 0); LC[10] = cand_key(a[4], b[1], 4, 1); LC[11] = cand_key(a[4], b[2], 4, 2);
            LC[12] = cand_key(a[5], b[0], 5, 0); LC[13] = cand_key(a[5], b[1], 5, 1);
            LC[14] = cand_key(a[6], b[0], 6, 0); LC[15] = cand_key(a[6], b[1], 6, 1);
            const unsigned d0 = cand_key(a[7], b[0], 7, 0), d1 = cand_key(a[7], b[1], 7, 1);
            bitonic16_desc(LB);
            sort16_desc(LC);
            topmerge16(LA, LB);
            LC[15] = LC[15] > d0 ? LC[15] : d0; LC[14] = LC[14] > d1 ? LC[14] : d1;
            bitonic16_desc(LC);
            topmerge16(LA, LC);
            float e[16], den = 0.f; const float vmax = dec_key(LA[0]);
#pragma unroll
            for (int r = 0; r < 16; ++r) { e[r] = __expf(dec_key(LA[r]) - vmax); den += e[r]; }
            const float inv = 1.f / den;
            const int t = m0 + row;
            int* oi = P.sel_idx + (size_t)t * 128 + h * 16; float* og = P.sel_g + (size_t)t * 128 + h * 16;
#pragma unroll
            for (int r = 0; r < 16; ++r) {
                const int i = (LA[r] >> 4) & 15, j = LA[r] & 15;
                oi[r] = (int)slot[i] * 128 + (int)slot[16 + j];
                og[r] = e[r] * inv;
            }
        }
    }
    __syncthreads();
}
typedef float f32x16 __attribute__((ext_vector_type(16)));
struct AttnFrag { u32x4 k[4]; u32x4 v[2][2]; };
__device__ __forceinline__ void attn_load(const Params& P, int b, int kvh, int qb, int w, int blk, int r, int hh, AttnFrag& f) {
    const bf16_t* kp; const bf16_t* vp;
    if (blk < 9) {
        int kpos0 = (qb - 1) * 128 + 32 * (w + blk);
        if (kpos0 < 0 || kpos0 >= SEQ) kpos0 = 0;
        const size_t blkoff = (size_t)((b * 2 + kvh) * 64 + (kpos0 >> 5)) * 2048 + (hh * 32 + r) * 8;
        kp = P.K + blkoff; vp = P.VT + blkoff;
    } else {
        const size_t blkoff = (size_t)((b * 2 + kvh) * 8 + (blk - 9)) * 2048 + (hh * 32 + r) * 8;
        kp = P.Kc + blkoff; vp = P.VcT + blkoff;
    }
#pragma unroll
    for (int ks = 0; ks < 4; ++ks) f.k[ks] = *(const u32x4*)(kp + 512 * ks);
#pragma unroll
    for (int db = 0; db < 2; ++db)
#pragma unroll
        for (int s = 0; s < 2; ++s) f.v[db][s] = *(const u32x4*)(vp + 512 * (db * 2 + s));
}
__device__ __forceinline__ void attn_item(const Params& P, int item) {
    const int head = item & 7, qb = (item >> 3) & 15, b = item >> 7, kvh = head >> 2;
    const int lane = threadIdx.x & 63, w = threadIdx.x >> 6, r = lane & 31, hh = lane >> 5;
    const int tok = b * SEQ + qb * 128 + 32 * w + r;
    bf16x8 qf[4];
    { const bf16_t* qp = P.Q + (size_t)tok * 512 + head * 64 + 8 * hh;
#pragma unroll
      for (int ks = 0; ks < 4; ++ks) qf[ks] = *(const bf16x8*)(qp + 16 * ks); }
    f32x16 o0, o1;
#pragma unroll
    for (int i = 0; i < 16; ++i) { o0[i] = 0.f; o1[i] = 0.f; }
    float mrun = P.sink[head], lrun = (hh == 0) ? 1.f : 0.f;
    AttnFrag cur, nxt;
    attn_load(P, b, kvh, qb, w, 0, r, hh, cur);
    for (int blk = 0; blk < 17; ++blk) {
        if (blk + 1 < 17) attn_load(P, b, kvh, qb, w, blk + 1, r, hh, nxt);
        int lo = 0, hi = 31;
        if (blk < 9) {
            const int kpos0 = (qb - 1) * 128 + 32 * (w + blk);
            if (kpos0 < 0 || kpos0 >= SEQ) lo = 64;
            else if (blk == 0) lo = r;
            else if (blk == 8) hi = r;
        }
        f32x16 s;
#pragma unroll
        for (int i = 0; i < 16; ++i) s[i] = 0.f;
#pragma unroll
        for (int ks = 0; ks < 4; ++ks) s = __builtin_amdgcn_mfma_f32_32x32x16_bf16(*(const bf16x8*)&cur.k[ks], qf[ks], s, 0, 0, 0);
        float mb = -3.0e38f;
#pragma unroll
        for (int i = 0; i < 16; ++i) { const int kk = (i & 3) + 8 * (i >> 2) + 4 * hh; const bool ok = (kk >= lo) && (kk <= hi); s[i] = ok ? s[i] : -3.0e38f; mb = fmaxf(mb, s[i]); }
        mb = fmaxf(mb, __shfl_xor(mb, 32));
        const float mn = fmaxf(mrun, mb);
        const float alpha = __expf(mrun - mn);
        float ps = 0.f; float p[16];
#pragma unroll
        for (int i = 0; i < 16; ++i) { p[i] = __expf(s[i] - mn); ps += p[i]; }
        lrun = lrun * alpha + ps; mrun = mn;
#pragma unroll
        for (int i = 0; i < 16; ++i) { o0[i] *= alpha; o1[i] *= alpha; }
        u32x4 pb[2];
        pb[0].x = pk2(p[0], p[1]); pb[0].y = pk2(p[2], p[3]); pb[0].z = pk2(p[4], p[5]); pb[0].w = pk2(p[6], p[7]);
        pb[1].x = pk2(p[8], p[9]); pb[1].y = pk2(p[10], p[11]); pb[1].z = pk2(p[12], p[13]); pb[1].w = pk2(p[14], p[15]);
#pragma unroll
        for (int sI = 0; sI < 2; ++sI) {
            const u32x4 va = cur.v[0][sI], vb = cur.v[1][sI];
            o0 = __builtin_amdgcn_mfma_f32_32x32x16_bf16(*(const bf16x8*)&va, *(const bf16x8*)&pb[sI], o0, 0, 0, 0);
            o1 = __builtin_amdgcn_mfma_f32_32x32x16_bf16(*(const bf16x8*)&vb, *(const bf16x8*)&pb[sI], o1, 0, 0, 0);
        }
        if (blk + 1 < 17) cur = nxt;
    }
    const float ltot = lrun + __shfl_xor(lrun, 32);
    const float inv = 1.f / ltot;
    bf16_t* op = P.AO + (size_t)tok * 512 + head * 64 + 4 * hh;
#pragma unroll
    for (int g = 0; g < 4; ++g) {
        float t0[4] = { o0[4 * g] * inv, o0[4 * g + 1] * inv, o0[4 * g + 2] * inv, o0[4 * g + 3] * inv };
        float t1[4] = { o1[4 * g] * inv, o1[4 * g + 1] * inv, o1[4 * g + 2] * inv, o1[4 * g + 3] * inv };
        st4bf(op + 8 * g, t0); st4bf(op + 32 + 8 * g, t1);
    }
}

__device__ __forceinline__ void conv_range(const Params& P, size_t gtid, size_t gsize) {
    for (size_t idx = gtid; idx < (size_t)NTOK * 64; idx += gsize) {
        const int m = (int)(idx >> 6), c0 = (int)(idx & 63) * 8, l = m % SEQ;
        float cu[3][8];
#pragma unroll
        for (int t = 0; t < 3; ++t) {
            const int ll = l + t - 1;
            if (ll < 0 || ll >= SEQ) {
#pragma unroll
                for (int j = 0; j < 8; ++j) cu[t][j] = 0.f;
            } else {
                const u32x4 g = *(const u32x4*)(P.GC + (size_t)(m + t - 1) * 512 + c0), u = *(const u32x4*)(P.U + (size_t)(m + t - 1) * 512 + c0);
                cu[t][0] = bf2f(g.x & 0xffff) * bf2f(u.x & 0xffff); cu[t][1] = bf2f(g.x >> 16) * bf2f(u.x >> 16);
                cu[t][2] = bf2f(g.y & 0xffff) * bf2f(u.y & 0xffff); cu[t][3] = bf2f(g.y >> 16) * bf2f(u.y >> 16);
                cu[t][4] = bf2f(g.z & 0xffff) * bf2f(u.z & 0xffff); cu[t][5] = bf2f(g.z >> 16) * bf2f(u.z >> 16);
                cu[t][6] = bf2f(g.w & 0xffff) * bf2f(u.w & 0xffff); cu[t][7] = bf2f(g.w >> 16) * bf2f(u.w >> 16);
            }
        }
        const u32x4 gbv = *(const u32x4*)(P.GB + (size_t)m * 512 + c0);
        const float gb[8] = { bf2f(gbv.x & 0xffff), bf2f(gbv.x >> 16), bf2f(gbv.y & 0xffff), bf2f(gbv.y >> 16), bf2f(gbv.z & 0xffff), bf2f(gbv.z >> 16), bf2f(gbv.w & 0xffff), bf2f(gbv.w >> 16) };
        float o[8];
#pragma unroll
        for (int j = 0; j < 8; ++j) o[j] = gb[j] * (P.conv_w[c0 + j] * cu[0][j] + P.conv_w[512 + c0 + j] * cu[1][j] + P.conv_w[1024 + c0 + j] * cu[2][j]);
        st8bf(P.CA + (size_t)m * 512 + c0, o);
    }
}

__device__ __forceinline__ void unpack8(const u32x4 v, float* f) {
    f[0] = bf2f(v.x & 0xffff); f[1] = bf2f(v.x >> 16); f[2] = bf2f(v.y & 0xffff); f[3] = bf2f(v.y >> 16);
    f[4] = bf2f(v.z & 0xffff); f[5] = bf2f(v.z >> 16); f[6] = bf2f(v.w & 0xffff); f[7] = bf2f(v.w >> 16);
}
__device__ __forceinline__ float gelu_erf(float d) { return 0.5f * d * (1.f + erff(d * 0.70710678118654752f)); }
__device__ __forceinline__ int reduce64i(int (&part)[64], int lane) {
#pragma unroll
    for (int i = 0; i < 32; ++i) { auto r = __builtin_amdgcn_permlane32_swap((unsigned)part[i], (unsigned)part[32 + i], false, false); part[i] = (int)r[0] + (int)r[1]; }
#pragma unroll
    for (int i = 0; i < 16; ++i) { auto r = __builtin_amdgcn_permlane16_swap((unsigned)part[i], (unsigned)part[16 + i], false, false); part[i] = (int)r[0] + (int)r[1]; }
#define RSTAGE(N) { const bool up = (lane & N) != 0; _Pragma("unroll") for (int i = 0; i < N; ++i) { const int keep = up ? part[N + i] : part[i], send = up ? part[i] : part[N + i]; part[i] = keep + __shfl_xor(send, N); } }
    RSTAGE(8) RSTAGE(4) RSTAGE(2) RSTAGE(1)
#undef RSTAGE
    return part[0];
}
#define UB0(x) ((float)((x) & 0xffu))
#define UB1(x) ((float)(((x) >> 8) & 0xffu))
#define UB2(x) ((float)(((x) >> 16) & 0xffu))
#define UB3(x) ((float)((x) >> 24))
__device__ __forceinline__ void peer_final_token(const Params& P, int t, int lane) {
    const int b = t / SEQ;
    const u32x4 hq = *(const u32x4*)(P.H2q + (size_t)t * DM + 16 * lane);
    const float sh = P.sh2[t];
    float acc[16];
#pragma unroll
    for (int j = 0; j < 16; ++j) acc[j] = 0.f;
    float csum = 0.f;
#pragma unroll 1
    for (int half = 0; half < 2; ++half) {
        const int myidx = P.sel_idx[(size_t)t * 128 + half * 64 + lane];
        const float myg = P.sel_g[(size_t)t * 128 + half * 64 + lane];
        const float mysu = P.su[myidx], mysv = P.sv[myidx];
        int part[64];
#pragma unroll
        for (int k = 0; k < 64; ++k) {
            const int e = __builtin_amdgcn_readlane(myidx, k);
            const u32x4 a = *(const u32x4*)(P.Uq + (size_t)e * DM + 16 * lane);
            int d = __builtin_amdgcn_sdot4((int)a.x, (int)hq.x, 0, false);
            d = __builtin_amdgcn_sdot4((int)a.y, (int)hq.y, d, false);
            d = __builtin_amdgcn_sdot4((int)a.z, (int)hq.z, d, false);
            d = __builtin_amdgcn_sdot4((int)a.w, (int)hq.w, d, false);
            part[k] = d;
        }
        const int isum = reduce64i(part, lane);
        const float a = (float)isum * mysu * sh;
        const float c = myg * gelu_erf(a) * mysv;
        csum += c;
#pragma unroll
        for (int k = 0; k < 64; ++k) {
            const int e = __builtin_amdgcn_readlane(myidx, k);
            const float ck = __uint_as_float(__builtin_amdgcn_readlane(__float_as_uint(c), k));
            const u32x4 x = *(const u32x4*)(P.Vq + (size_t)e * DM + 16 * lane);
            acc[0] += ck * UB0(x.x); acc[1] += ck * UB1(x.x); acc[2] += ck * UB2(x.x); acc[3] += ck * UB3(x.x);
            acc[4] += ck * UB0(x.y); acc[5] += ck * UB1(x.y); acc[6] += ck * UB2(x.y); acc[7] += ck * UB3(x.y);
            acc[8] += ck * UB0(x.z); acc[9] += ck * UB1(x.z); acc[10] += ck * UB2(x.z); acc[11] += ck * UB3(x.z);
            acc[12] += ck * UB0(x.w); acc[13] += ck * UB1(x.w); acc[14] += ck * UB2(x.w); acc[15] += ck * UB3(x.w);
        }
    }
    const float cb = 128.f * wave_sum(csum);
    float x2[16]; float ss = 0.f;
    const float* x1 = P.X1 + (size_t)t * DM + 16 * lane; const float* g2 = P.mod + (size_t)b * NMOD + 5 * DM + 16 * lane;
#pragma unroll
    for (int q = 0; q < 4; ++q) {
        const f32x4 xa = *(const f32x4*)(x1 + 4 * q), ga = *(const f32x4*)(g2 + 4 * q);
        x2[4 * q + 0] = xa.x + ga.x * (acc[4 * q + 0] - cb); x2[4 * q + 1] = xa.y + ga.y * (acc[4 * q + 1] - cb);
        x2[4 * q + 2] = xa.z + ga.z * (acc[4 * q + 2] - cb); x2[4 * q + 3] = xa.w + ga.w * (acc[4 * q + 3] - cb);
        ss += x2[4 * q] * x2[4 * q] + x2[4 * q + 1] * x2[4 * q + 1] + x2[4 * q + 2] * x2[4 * q + 2] + x2[4 * q + 3] * x2[4 * q + 3];
    }
    ss = wave_sum(ss);
    const float rstd = rsqrtf(ss * (1.f / DM) + 1e-6f);
    float* op = P.out + (size_t)t * DM + 16 * lane; const float* fgp = P.fg + 16 * lane;
#pragma unroll
    for (int q = 0; q < 4; ++q) {
        const f32x4 fa = *(const f32x4*)(fgp + 4 * q);
        f32x4 o; o.x = x2[4 * q] * rstd * fa.x; o.y = x2[4 * q + 1] * rstd * fa.y; o.z = x2[4 * q + 2] * rstd * fa.z; o.w = x2[4 * q + 3] * rstd * fa.w;
        *(f32x4*)(op + 4 * q) = o;
    }
}

#define XB_TMO      128
#define XB_XCNT(j)  (256  + 64 * (j))
#define XB_XSUB(j)  (1280 + 64 * (j))
#define XB_XGEN(j)  (2304 + 64 * (j))
#define XB_TOP      3328
#define XB_TOPGEN   3392
#define XCD_BAR_WORDS 3456
#define XB_SPIN_CAP (1u << 22)
#define LAS __attribute__((address_space(3)))
__device__ __forceinline__ unsigned xb_ld(unsigned* p)              { return __hip_atomic_load(p, __ATOMIC_RELAXED, __HIP_MEMORY_SCOPE_AGENT); }
__device__ __forceinline__ unsigned xb_add(unsigned* p, unsigned v) { return __hip_atomic_fetch_add(p, v, __ATOMIC_RELAXED, __HIP_MEMORY_SCOPE_AGENT); }
__device__ __forceinline__ unsigned xb_xcc_id() { return (unsigned)__builtin_amdgcn_s_getreg((3 << 11) | 20) & 0xFu; }
#define XB_SPIN(cond, bar) do { unsigned _sp = 0; while (cond) { __builtin_amdgcn_s_sleep(1); \
    if ((++_sp & 255u) == 0u) { if (xb_ld(&(bar)[XB_TMO])) break; if (_sp > XB_SPIN_CAP) { atomicAdd(&(bar)[XB_TMO], 1u); break; } } } } while (0)
struct XcdBarrier { unsigned* bar; unsigned x; volatile LAS unsigned* st; };
__device__ __forceinline__ XcdBarrier xcd_barrier_post(unsigned* bar, volatile LAS unsigned* st) {
    XcdBarrier b; b.bar = bar; b.x = xb_xcc_id(); b.st = st;
    if (threadIdx.x == 0) (void)xb_add(&bar[XB_XCNT(b.x)], 1u);
    return b;
}
__device__ __forceinline__ void xcd_barrier_complete(unsigned* bar, unsigned x, unsigned& nloc, unsigned& nx) {
    const unsigned G = gridDim.x * gridDim.y * gridDim.z;
    unsigned sum, cnt, mine, sp = 0u;
    for (;;) {
        sum = 0u; cnt = 0u; mine = 0u;
#pragma unroll
        for (unsigned j = 0; j < 16; ++j) { const unsigned c = xb_ld(&bar[XB_XCNT(j)]); sum += c; cnt += (c > 0u) ? 1u : 0u; mine = (j == x) ? c : mine; }
        if (sum == G) break;
        __builtin_amdgcn_s_sleep(1);
        if ((++sp & 255u) == 0u) { if (xb_ld(&bar[XB_TMO])) break; if (sp > XB_SPIN_CAP) { atomicAdd(&bar[XB_TMO], 1u); break; } }
    }
    nloc = mine > 0u ? mine : 1u; nx = cnt > 0u ? cnt : 1u;
}
__device__ __forceinline__ void xcd_barrier(const XcdBarrier& b) {
    asm volatile("s_waitcnt vmcnt(0)" ::: "memory");
    __syncthreads();
    if (threadIdx.x == 0) {
        unsigned* bar = b.bar;
        __builtin_amdgcn_s_waitcnt(0);
        unsigned nloc = b.st[0], nx = b.st[1];
        if (nloc == 0u) { xcd_barrier_complete(bar, b.x, nloc, nx); b.st[0] = nloc; b.st[1] = nx; }
        const unsigned old = xb_add(&bar[XB_XSUB(b.x)], 1u);
        const unsigned gen = old / nloc;
        if (old + 1u == (gen + 1u) * nloc) {
            __builtin_amdgcn_fence(__ATOMIC_RELEASE, "agent");
            asm volatile("s_waitcnt vmcnt(0)" ::: "memory");
            const unsigned og = xb_add(&bar[XB_TOP], 1u);
            const unsigned tg = og / nx;
            if (og + 1u == (tg + 1u) * nx) xb_add(&bar[XB_TOPGEN], 1u);
            else XB_SPIN(xb_ld(&bar[XB_TOPGEN]) == tg, bar);
            __builtin_amdgcn_fence(__ATOMIC_ACQUIRE, "agent");
            xb_add(&bar[XB_XGEN(b.x)], 1u);
            asm volatile("s_waitcnt vmcnt(0)" ::: "memory");
        } else {
            XB_SPIN(xb_ld(&bar[XB_XGEN(b.x)]) == gen, bar);
            __builtin_amdgcn_fence(__ATOMIC_ACQUIRE, "agent");
            asm volatile("s_waitcnt vmcnt(0)" ::: "memory");
        }
    }
    __syncthreads();
}

constexpr int NPHASE = 9;
template <int PH> __device__ __forceinline__ void run_phase(const Params& P, char* smem) {
    int tid_ = threadIdx.x; asm volatile("" : "+v"(tid_));
    const int bid = blockIdx.x, G = gridDim.x, tid = tid_;
    const size_t gtid = (size_t)bid * 256 + tid, gsize = (size_t)G * 256;
    if (PH == 0) {
        for (int it = bid; it < 192; it += G) modp_item(P, it, smem);
        float (*tile)[65] = (float (*)[65])smem;
        for (int it = bid; it < 1088; it += G) transpose_tile(P.w_in, DM, PROJW, P.WinT, it, tile);
        for (int it = bid; it < 128; it += G) transpose_tile(P.w_ao, 512, DM, P.WaoT, it, tile);
        for (int it = bid; it < 128; it += G) transpose_tile(P.w_co, 512, DM, P.WcoT, it, tile);
        for (int it = bid; it < 256; it += G) transpose_tile(P.w_mix, DM, DM, P.WmixT, it, tile);
        for (int it = bid; it < 512; it += G) transpose_tile(P.pw_q, DM, 2048, P.PwqT, it, tile);
        cvt_range(P.keys, P.KeysB, (size_t)16 * 128 * 128 / 8, gtid, gsize);
        { const int lane = tid & 63, wid = tid >> 6;
          for (int r = bid * 4 + wid; r < 2 * NEXP; r += G * 4) {
              if (r < NEXP) quant_row(P.pu + (size_t)r * DM, (unsigned char*)P.Uq + (size_t)r * DM, P.su + r, lane, 0);
              else { const int e = r - NEXP; quant_row(P.pv + (size_t)e * DM, P.Vq + (size_t)e * DM, P.sv + e, lane, 128); } } }
        rope_tab(P, (int)gtid, (int)gsize);
    } else if (PH == 1) {
        for (int i = (int)gtid; i < 17 * NMOD; i += (int)gsize) {
            float v = P.b_mod[i % NMOD];
#pragma unroll
            for (int kc = 0; kc < 8; ++kc) v += P.modp[(size_t)kc * 17 * NMOD + i];
            P.mod[i] = v;
        }
        for (int it = bid; it < 1152; it += G) norm1_item(P, it, smem);
    } else if (PH == 2) {
        for (int t = bid; t < 128 * 34 + 32; t += G) {
            if (t < 128 * 34) { int mt, nt; tile_coords(t, 128, 34, mt, nt); gemm_tile<MODE_INPROJ, 8>(P, P.H, DM, P.WinT, DM, DM, mt * 256, nt * 128, nt * 128 >= 768, smem); }
            else { const int u = t - 128 * 34, mt = u >> 1, nt = u & 1; gemm_tile<MODE_CTXKV, 8>(P, P.HC, DM, P.WinT + (size_t)512 * DM, DM, DM, mt * 256, nt * 128, nt == 0, smem); }
        }
    } else if (PH == 3) {
        for (int it = bid; it < NB * 16 * 8; it += G) attn_item(P, it);
        conv_range(P, gtid, gsize);
    } else if (PH == 4) {
        for (int t = bid; t < 128 * 8; t += G) {
            int mt, nt; tile_coords(t, 128, 8, mt, nt);
#pragma unroll 1
            for (int s = 0; s < 2; ++s) gemm_tile<MODE_AO1, 8>(P, s ? P.CA : P.AO, 512, s ? P.WcoT : P.WaoT, 512, 512, mt * 256, nt * 128, true, smem, s);
        }
    } else if (PH == 5) {
        for (int t = bid; t < 128 * 8; t += G) { int mt, nt; tile_coords(t, 128, 8, mt, nt); gemm_tile<MODE_MIX, 8>(P, P.YG, DM, P.WmixT, DM, DM, mt * 256, nt * 128, true, smem); }
    } else if (PH == 6) {
        const int lane = tid & 63, wid = tid >> 6;
        for (int row = bid * 4 + wid; row < NTOK; row += G * 4) { const int b = row / SEQ;
            norm_row_q(P.X1 + (size_t)row * DM, P.n2, P.mod + (size_t)b * NMOD + 4 * DM, P.mod + (size_t)b * NMOD + 3 * DM, P.H2 + (size_t)row * DM, P.H2q + (size_t)row * DM, P.sh2 + row, lane); }
    } else if (PH == 7) {
        for (int it = bid; it < 256 * 8; it += G) peer_retrieve_item(P, it >> 3, it & 7, smem);
    } else if (PH == 8) {
        const int lane = tid & 63, wid = tid >> 6;
        for (int t = bid * 4 + wid; t < NTOK; t += G * 4) peer_final_token(P, t, lane);
    }
}
#ifndef REP0
#define REP0 1
#endif
#ifndef REP1
#define REP1 1
#endif
#ifndef REP2
#define REP2 1
#endif
#ifndef REP3
#define REP3 1
#endif
#ifndef REP4
#define REP4 1
#endif
#ifndef REP5
#define REP5 1
#endif
#ifndef REP6
#define REP6 1
#endif
#ifndef REP7
#define REP7 1
#endif
#ifndef REP8
#define REP8 1
#endif
constexpr int MEGA_LDS = 3 * (2048 * 8 + 8192);
#ifndef MULTI_LAUNCH
__global__ void __launch_bounds__(256, 2) k_mega(Params P) {
    extern __shared__ __attribute__((aligned(16))) char smem[];
    volatile LAS unsigned* st = (volatile LAS unsigned*)(smem + MEGA_LDS);
    if (threadIdx.x < 4) st[threadIdx.x] = 0u;
    __syncthreads();
    const XcdBarrier bar = xcd_barrier_post(P.bar, st);
#define PHASE_SYNC(k) for (int rep = 0; rep < REP##k; ++rep) { run_phase<k>(P, smem); xcd_barrier(bar); }
    PHASE_SYNC(0) PHASE_SYNC(1) PHASE_SYNC(2) PHASE_SYNC(3) PHASE_SYNC(4) PHASE_SYNC(5) PHASE_SYNC(6) PHASE_SYNC(7)
    for (int rep = 0; rep < REP8 - 1; ++rep) { run_phase<8>(P, smem); xcd_barrier(bar); }
    run_phase<8>(P, smem);
}
#else
template <int PH> __global__ void __launch_bounds__(256, 2) k_phase(Params P) {
    extern __shared__ __attribute__((aligned(16))) char smem[];
    run_phase<PH>(P, smem);
}
#endif

static size_t carve(size_t& off, size_t bytes) { const size_t o = off; off += (bytes + 255) & ~(size_t)255; return o; }

extern "C" void kernel_launch(void* const* d_in, const int* in_sizes, int n_in, void* d_out, int out_size, void* d_ws, size_t ws_size, hipStream_t stream) {
    Params P{};
    P.x = (const float*)d_in[0]; P.c = (const float*)d_in[1]; P.ctx = (const float*)d_in[2]; P.c_ctx = (const float*)d_in[3];
    P.w_mod = (const float*)d_in[4]; P.b_mod = (const float*)d_in[5]; P.n1 = (const float*)d_in[6]; P.n2 = (const float*)d_in[7];
    P.w_in = (const float*)d_in[8]; P.sink = (const float*)d_in[9]; P.conv_w = (const float*)d_in[10]; P.w_ao = (const float*)d_in[11];
    P.w_co = (const float*)d_in[12]; P.w_mix = (const float*)d_in[13]; P.pw_q = (const float*)d_in[14]; P.keys = (const float*)d_in[15];
    P.pu = (const float*)d_in[16]; P.pv = (const float*)d_in[17]; P.fg = (const float*)d_in[18];
    P.out = (float*)d_out;
    char* ws = (char*)d_ws; size_t off = 0;
    P.modp = (float*)(ws + carve(off, (size_t)8 * 17 * NMOD * 4));
    P.mod = (float*)(ws + carve(off, (size_t)17 * NMOD * 4));
    P.rope = (float*)(ws + carve(off, 3072 * 4));
    P.WinT = (bf16_t*)(ws + carve(off, (size_t)PROJW * DM * 2));
    P.WaoT = (bf16_t*)(ws + carve(off, (size_t)DM * 512 * 2));
    P.WcoT = (bf16_t*)(ws + carve(off, (size_t)DM * 512 * 2));
    P.WmixT = (bf16_t*)(ws + carve(off, (size_t)DM * DM * 2));
    P.PwqT = (bf16_t*)(ws + carve(off, (size_t)2048 * DM * 2));
    P.KeysB = (bf16_t*)(ws + carve(off, (size_t)16 * 128 * 128 * 2));
    P.Uq = (signed char*)(ws + carve(off, (size_t)NEXP * DM));
    P.Vq = (unsigned char*)(ws + carve(off, (size_t)NEXP * DM));
    P.su = (float*)(ws + carve(off, (size_t)NEXP * 4));
    P.sv = (float*)(ws + carve(off, (size_t)NEXP * 4));
    P.sh2 = (float*)(ws + carve(off, (size_t)NTOK * 4));
    P.HC = (bf16_t*)(ws + carve(off, (size_t)NCTX * DM * 2));
    const size_t regA = carve(off, (size_t)NTOK * DM * 2);
    P.H = (bf16_t*)(ws + regA); P.YG = (bf16_t*)(ws + regA); P.H2 = (bf16_t*)(ws + regA);
    const size_t regB = off;
    P.Q = (bf16_t*)(ws + carve(off, (size_t)NTOK * 512 * 2));
    P.K = (bf16_t*)(ws + carve(off, (size_t)NTOK * 128 * 2));
    P.VT = (bf16_t*)(ws + carve(off, (size_t)NTOK * 128 * 2));
    P.Kc = (bf16_t*)(ws + carve(off, (size_t)NCTX * 128 * 2));
    P.VcT = (bf16_t*)(ws + carve(off, (size_t)NCTX * 128 * 2));
    const size_t regC = off;
    P.GB = (bf16_t*)(ws + carve(off, (size_t)NTOK * 512 * 2));
    P.GC = (bf16_t*)(ws + carve(off, (size_t)NTOK * 512 * 2));
    P.U = (bf16_t*)(ws + carve(off, (size_t)NTOK * 512 * 2));
    P.M1 = (bf16_t*)(ws + regC);
    const size_t regD = off;
    P.GA = (bf16_t*)(ws + carve(off, (size_t)NTOK * DM * 2));
    P.GV = (bf16_t*)(ws + carve(off, (size_t)NTOK * DM * 2));
    P.AO = (bf16_t*)(ws + carve(off, (size_t)NTOK * 512 * 2));
    P.H2q = (signed char*)P.AO;
    P.CA = (bf16_t*)(ws + carve(off, (size_t)NTOK * 512 * 2));
    P.X1 = (float*)(ws + regD);
    P.bar = (unsigned*)(ws + carve(off, (size_t)XCD_BAR_WORDS * 4));
    const size_t need = off;
    { size_t o2 = regB;
      P.sel_idx = (int*)(ws + carve(o2, (size_t)NTOK * 128 * 4));
      P.sel_g = (float*)(ws + carve(o2, (size_t)NTOK * 128 * 4));
      if (o2 > regC) { fprintf(stderr, "kernel_launch: late buffers overflow\n"); return; } }
    if (need > ws_size) { fprintf(stderr, "kernel_launch: workspace too small: need %zu have %zu\n", need, ws_size); return; }

#ifdef MULTI_LAUNCH
    static bool attr_done = false;
    if (!attr_done) {
#define SETA(PH) hipFuncSetAttribute((const void*)k_phase<PH>, hipFuncAttributeMaxDynamicSharedMemorySize, MEGA_LDS)
        SETA(0); SETA(1); SETA(2); SETA(3); SETA(4); SETA(5); SETA(6); SETA(7); SETA(8);
        attr_done = true;
    }
#define LP(PH) k_phase<PH><<<512, 256, MEGA_LDS, stream>>>(P)
    LP(0); LP(1); LP(2); LP(3); LP(4); LP(5); LP(6); LP(7); LP(8);
#else
    static int grid_blocks = 0;
    if (!grid_blocks) {
        int dev = 0, cus = 0, per_cu = 0;
        (void)hipGetDevice(&dev);
        (void)hipDeviceGetAttribute(&cus, hipDeviceAttributeMultiprocessorCount, dev);
        (void)hipFuncSetAttribute((const void*)k_mega, hipFuncAttributeMaxDynamicSharedMemorySize, MEGA_LDS + 16);
        (void)hipOccupancyMaxActiveBlocksPerMultiprocessor(&per_cu, (const void*)k_mega, 256, MEGA_LDS + 16);
        if (per_cu > 2) per_cu = 2;
        if (per_cu < 1) { fprintf(stderr, "kernel_launch: occupancy query returned %d\n", per_cu); per_cu = 1; }
        grid_blocks = cus * per_cu;
    }
    (void)hipMemsetAsync(P.bar, 0, (size_t)XCD_BAR_WORDS * 4, stream);
    void* args[] = { &P };
    hipError_t e = hipLaunchCooperativeKernel((const void*)k_mega, dim3(grid_blocks), dim3(256), args, MEGA_LDS + 16, stream);
    if (e != hipSuccess) fprintf(stderr, "cooperative launch failed: %s (grid %d)\n", hipGetErrorString(e), grid_blocks);
#endif
}
```

```cpp
#include <hip/hip_runtime.h>
#include <cstdio>
#include <cstdint>

typedef unsigned short bf16_t;
typedef short bf16x8 __attribute__((ext_vector_type(8)));
typedef float f32x4 __attribute__((ext_vector_type(4)));
typedef unsigned u32x4 __attribute__((ext_vector_type(4)));
typedef unsigned u32x2 __attribute__((ext_vector_type(2)));

constexpr int DM = 1024, NB = 16, SEQ = 2048, NTOK = NB * SEQ, CTXL = 256, NCTX = NB * CTXL;
constexpr int PROJW = 4352;
constexpr int NMOD = 6 * DM;
constexpr int NEXP = 16384;

__device__ __forceinline__ float bf2f(bf16_t x) { return __uint_as_float(((unsigned)x) << 16); }
__device__ __forceinline__ bf16_t f2bf(float f) {
    unsigned u = __float_as_uint(f);
    u += 0x7fffu + ((u >> 16) & 1u);
    return (bf16_t)(u >> 16);
}
__device__ __forceinline__ unsigned pk2(float lo, float hi) { return (unsigned)f2bf(lo) | ((unsigned)f2bf(hi) << 16); }
__device__ __forceinline__ float sigmoidf_(float x) { return 1.f / (1.f + __expf(-x)); }
__device__ __forceinline__ float wave_sum(float v) {
#pragma unroll
    for (int o = 1; o < 64; o <<= 1) v += __shfl_xor(v, o);
    return v;
}

__device__ __forceinline__ float wave_max(float v) {
#pragma unroll
    for (int o = 1; o < 64; o <<= 1) v = fmaxf(v, __shfl_xor(v, o));
    return v;
}
__device__ __forceinline__ unsigned q8(float x, float inv, int bias) {
    int q = (int)rintf(x * inv); q = q > 127 ? 127 : (q < -127 ? -127 : q);
    return (unsigned)((q + bias) & 0xff);
}
__device__ __forceinline__ void load_row16(const float* src, int lane, f32x4 (&v)[4]) {
#pragma unroll
    for (int j = 0; j < 4; ++j) v[j] = *(const f32x4*)(src + 16 * lane + 4 * j);
}
__device__ __forceinline__ void quant_row(f32x4 (&v)[4], unsigned char* dst, float* scale_out, int lane, int bias) {
    float amax = 0.f;
#pragma unroll
    for (int j = 0; j < 4; ++j) amax = fmaxf(amax, fmaxf(fmaxf(fabsf(v[j].x), fabsf(v[j].y)), fmaxf(fabsf(v[j].z), fabsf(v[j].w))));
    amax = wave_max(amax);
    const float sc = amax > 0.f ? amax * (1.f / 127.f) : 1.f, inv = 1.f / sc;
    u32x4 w;
    w.x = q8(v[0].x, inv, bias) | (q8(v[0].y, inv, bias) << 8) | (q8(v[0].z, inv, bias) << 16) | (q8(v[0].w, inv, bias) << 24);
    w.y = q8(v[1].x, inv, bias) | (q8(v[1].y, inv, bias) << 8) | (q8(v[1].z, inv, bias) << 16) | (q8(v[1].w, inv, bias) << 24);
    w.z = q8(v[2].x, inv, bias) | (q8(v[2].y, inv, bias) << 8) | (q8(v[2].z, inv, bias) << 16) | (q8(v[2].w, inv, bias) << 24);
    w.w = q8(v[3].x, inv, bias) | (q8(v[3].y, inv, bias) << 8) | (q8(v[3].z, inv, bias) << 16) | (q8(v[3].w, inv, bias) << 24);
    *(u32x4*)(dst + 16 * lane) = w;
    if (lane == 0) *scale_out = sc;
}

struct Params {
    const float *x, *c, *ctx, *c_ctx, *w_mod, *b_mod, *n1, *n2, *w_in, *sink, *conv_w, *w_ao, *w_co, *w_mix, *pw_q, *keys, *pu, *pv, *fg;
    float* out;
    float *modp, *mod, *rope;
    bf16_t *WinT, *WaoT, *WcoT, *WmixT, *PwqT, *KeysB;
    bf16_t *H, *HC, *Q, *K, *VT, *Kc, *VcT, *GB, *GC, *U, *GA, *GV, *AO, *CA, *M1, *YG, *H2, *QH;
    float* TKv; int* TKi;
    int* sel_idx; float* sel_g;
    float* X1;
    unsigned* bar;
    signed char *Uq, *H2q; unsigned char* Vq; float *su, *sv, *sh2;
};

__device__ __forceinline__ void modp_item(const Params& P, int item, char* smem) {
    float (*s)[128] = (float (*)[128])smem;
    const int kc = item / 24, nc = item % 24;
    __syncthreads();
    for (int i = threadIdx.x; i < 17 * 128; i += 256) {
        const int r = i / 128, k = i % 128;
        const float v = (r < 16) ? P.c[r * DM + kc * 128 + k] : P.c_ctx[kc * 128 + k];
        s[r][k] = v / (1.f + __expf(-v));
    }
    __syncthreads();
    const int n = nc * 256 + threadIdx.x;
    float acc[17];
#pragma unroll
    for (int r = 0; r < 17; ++r) acc[r] = 0.f;
    for (int k = 0; k < 128; ++k) {
        const float w = P.w_mod[(size_t)(kc * 128 + k) * NMOD + n];
#pragma unroll
        for (int r = 0; r < 17; ++r) acc[r] += s[r][k] * w;
    }
#pragma unroll
    for (int r = 0; r < 17; ++r) P.modp[((size_t)kc * 17 + r) * NMOD + n] = acc[r];
}
__device__ __forceinline__ void cvt_range(const float* src, bf16_t* dst, size_t n8, size_t gtid, size_t gsize) {
    for (size_t i = gtid; i < n8; i += gsize) {
        const f32x4 a = *(const f32x4*)(src + i * 8), b = *(const f32x4*)(src + i * 8 + 4);
        u32x4 o; o.x = pk2(a.x, a.y); o.y = pk2(a.z, a.w); o.z = pk2(b.x, b.y); o.w = pk2(b.z, b.w);
        *(u32x4*)(dst + i * 8) = o;
    }
}
__device__ __forceinline__ void rope_tab(const Params& P, int gtid, int gsize) {
    for (int i = gtid; i < 1536; i += gsize) {
        int pos, f; bool isc;
        if (i < 512) { pos = i / 16; f = i % 16; isc = false; } else { pos = (i - 512) / 16; f = (i - 512) % 16; isc = true; }
        const double inv = pow(10000.0, -(double)f / 16.0);
        const double ang = (double)pos * inv;
        const float cv = (float)cos(ang), sv = (float)sin(ang);
        if (!isc) { P.rope[pos * 16 + f] = cv; P.rope[512 + pos * 16 + f] = sv; }
        else { P.rope[1024 + pos * 16 + f] = cv; P.rope[2048 + pos * 16 + f] = sv; }
    }
}
__device__ __forceinline__ void transpose_tile(const float* W, int K, int N, bf16_t* Wt, int item, float (*tile)[65]) {
    const int ntn = N / 64, kt = item / ntn, nt = item % ntn, k0 = kt * 64, n0 = nt * 64;
    const int tx = threadIdx.x & 63, ty = threadIdx.x >> 6;
    __syncthreads();
#pragma unroll
    for (int i = 0; i < 16; ++i) { const int k = i * 4 + ty; tile[k][tx] = W[(size_t)(k0 + k) * N + n0 + tx]; }
    __syncthreads();
#pragma unroll
    for (int i = 0; i < 16; ++i) { const int n = i * 4 + ty; Wt[(size_t)(n0 + n) * K + k0 + tx] = f2bf(tile[tx][n]); }
}

__device__ __forceinline__ void load_row4(const float* xr, int lane, f32x4 (&v)[4]) {
#pragma unroll
    for (int j = 0; j < 4; ++j) v[j] = *(const f32x4*)(xr + j * 256 + lane * 4);
}
__device__ __forceinline__ void norm_row(f32x4 (&v)[4], const float* g, const float* scale, const float* shift, bf16_t* dst, int lane) {
    float s = 0.f;
#pragma unroll
    for (int j = 0; j < 4; ++j) s += v[j].x * v[j].x + v[j].y * v[j].y + v[j].z * v[j].z + v[j].w * v[j].w;
    s = wave_sum(s);
    const float rstd = rsqrtf(s * (1.f / DM) + 1e-6f);
#pragma unroll
    for (int j = 0; j < 4; ++j) {
        const int d = j * 256 + lane * 4;
        const f32x4 gg = *(const f32x4*)(g + d), sc = *(const f32x4*)(scale + d), sh = *(const f32x4*)(shift + d);
        const float y0 = v[j].x * rstd * gg.x * (1.f + sc.x) + sh.x;
        const float y1 = v[j].y * rstd * gg.y * (1.f + sc.y) + sh.y;
        const float y2 = v[j].z * rstd * gg.z * (1.f + sc.z) + sh.z;
        const float y3 = v[j].w * rstd * gg.w * (1.f + sc.w) + sh.w;
        u32x2 o; o.x = pk2(y0, y1); o.y = pk2(y2, y3);
        *(u32x2*)(dst + d) = o;
    }
}

__device__ __forceinline__ void norm_row_q(f32x4 (&v)[4], const float* g, const float* scale, const float* shift, bf16_t* dst, signed char* dq, float* sq, int lane) {
    float s = 0.f;
#pragma unroll
    for (int j = 0; j < 4; ++j) s += v[j].x * v[j].x + v[j].y * v[j].y + v[j].z * v[j].z + v[j].w * v[j].w;
    s = wave_sum(s);
    const float rstd = rsqrtf(s * (1.f / DM) + 1e-6f);
    float amax = 0.f;
#pragma unroll
    for (int j = 0; j < 4; ++j) {
        const int d = j * 256 + lane * 4;
        const f32x4 gg = *(const f32x4*)(g + d), sc = *(const f32x4*)(scale + d), sh = *(const f32x4*)(shift + d);
        v[j].x = v[j].x * rstd * gg.x * (1.f + sc.x) + sh.x;
        v[j].y = v[j].y * rstd * gg.y * (1.f + sc.y) + sh.y;
        v[j].z = v[j].z * rstd * gg.z * (1.f + sc.z) + sh.z;
        v[j].w = v[j].w * rstd * gg.w * (1.f + sc.w) + sh.w;
        u32x2 o; o.x = pk2(v[j].x, v[j].y); o.y = pk2(v[j].z, v[j].w);
        *(u32x2*)(dst + d) = o;
        amax = fmaxf(amax, fmaxf(fmaxf(fabsf(v[j].x), fabsf(v[j].y)), fmaxf(fabsf(v[j].z), fabsf(v[j].w))));
    }
    amax = wave_max(amax);
    const float qs = amax > 0.f ? amax * (1.f / 127.f) : 1.f, inv = 1.f / qs;
#pragma unroll
    for (int j = 0; j < 4; ++j) {
        const unsigned w = q8(v[j].x, inv, 0) | (q8(v[j].y, inv, 0) << 8) | (q8(v[j].z, inv, 0) << 16) | (q8(v[j].w, inv, 0) << 24);
        *(unsigned*)(dq + j * 256 + lane * 4) = w;
    }
    if (lane == 0) *sq = qs;
}

__device__ __forceinline__ void norm1_item(const Params& P, int item, char* smem) {
    float* sc = (float*)smem; float* sh = sc + DM;
    const bool isctx = item >= 1024;
    const int row0 = isctx ? (item - 1024) * 32 : item * 32;
    const int r = isctx ? 16 : row0 / SEQ;
    __syncthreads();
    for (int d = threadIdx.x; d < DM; d += 256) {
        float a = P.b_mod[DM + d], b = P.b_mod[d];
#pragma unroll
        for (int kc = 0; kc < 8; ++kc) { a += P.modp[((size_t)kc * 17 + r) * NMOD + DM + d]; b += P.modp[((size_t)kc * 17 + r) * NMOD + d]; }
        sc[d] = a; sh[d] = b;
    }
    __syncthreads();
    const int lane = threadIdx.x & 63, wid = threadIdx.x >> 6;
    const float* srcb = isctx ? P.ctx : P.x; bf16_t* dstb = isctx ? P.HC : P.H;
    for (int i = wid; i < 32; i += 8) {
        const int ra = row0 + i, rb = row0 + i + 4;
        f32x4 va[4], vb[4];
        load_row4(srcb + (size_t)ra * DM, lane, va); load_row4(srcb + (size_t)rb * DM, lane, vb);
        norm_row(va, P.n1, sc, sh, dstb + (size_t)ra * DM, lane);
        norm_row(vb, P.n1, sc, sh, dstb + (size_t)rb * DM, lane);
    }
}
enum { MODE_INPROJ = 0, MODE_CTXKV = 1, MODE_AO1 = 2, MODE_CO2 = 3, MODE_MIX = 4, MODE_QH = 5 };

__device__ __forceinline__ void st8bf(bf16_t* p, const float* v) {
    u32x4 o; o.x = pk2(v[0], v[1]); o.y = pk2(v[2], v[3]); o.z = pk2(v[4], v[5]); o.w = pk2(v[6], v[7]);
    *(u32x4*)p = o;
}
__device__ __forceinline__ void st4bf(bf16_t* p, const float* v) {
    u32x2 o; o.x = pk2(v[0], v[1]); o.y = pk2(v[2], v[3]);
    *(u32x2*)p = o;
}
template <int MODE> __device__ __forceinline__ void epi8(const Params& P, int m, int n, const float* v, int aux) {
    if (MODE == MODE_INPROJ) {
        if (n < 1280) st8bf(P.GB + (size_t)m * 512 + (n - 768), v);
        else if (n < 1792) st8bf(P.GC + (size_t)m * 512 + (n - 1280), v);
        else if (n < 2304) st8bf(P.U + (size_t)m * 512 + (n - 1792), v);
        else {
            float s[8];
#pragma unroll
            for (int j = 0; j < 8; ++j) s[j] = sigmoidf_(v[j]);
            if (n < 3328) st8bf(P.GA + (size_t)m * DM + (n - 2304), s);
            else st8bf(P.GV + (size_t)m * DM + (n - 3328), s);
        }
    } else if (MODE == MODE_CTXKV) {
        { const int b = m / CTXL, c = m % CTXL, kvh = n >> 6, d0 = n & 63;
          st8bf(P.Kc + ((((size_t)((b * 2 + kvh) * 8 + (c >> 5)) * 4 + (d0 >> 4)) * 2 + ((d0 >> 3) & 1)) * 32 + (c & 31)) * 8, v); }
    } else if (MODE == MODE_AO1) {
        const u32x4 g = *(const u32x4*)((aux ? P.GV : P.GA) + (size_t)m * DM + n);
        u32x4 a = (u32x4){0u, 0u, 0u, 0u};
        if (aux) a = *(const u32x4*)(P.M1 + (size_t)m * DM + n);
        float o[8];
        o[0] = bf2f(a.x & 0xffff) + v[0] * bf2f(g.x & 0xffff); o[1] = bf2f(a.x >> 16) + v[1] * bf2f(g.x >> 16);
        o[2] = bf2f(a.y & 0xffff) + v[2] * bf2f(g.y & 0xffff); o[3] = bf2f(a.y >> 16) + v[3] * bf2f(g.y >> 16);
        o[4] = bf2f(a.z & 0xffff) + v[4] * bf2f(g.z & 0xffff); o[5] = bf2f(a.z >> 16) + v[5] * bf2f(g.z >> 16);
        o[6] = bf2f(a.w & 0xffff) + v[6] * bf2f(g.w & 0xffff); o[7] = bf2f(a.w >> 16) + v[7] * bf2f(g.w >> 16);
        st8bf((aux ? P.YG : P.M1) + (size_t)m * DM + n, o);
    } else if (MODE == MODE_MIX) {
        const int b = m / SEQ;
        const float* g1 = P.mod + (size_t)b * NMOD + 2 * DM + n;
        const float* xr = P.x + (size_t)m * DM + n;
        float* o = P.X1 + (size_t)m * DM + n;
        const f32x4 x0 = *(const f32x4*)xr, x1 = *(const f32x4*)(xr + 4), g0 = *(const f32x4*)g1, g1v = *(const f32x4*)(g1 + 4);
        f32x4 o0, o1;
        o0.x = x0.x + g0.x * v[0]; o0.y = x0.y + g0.y * v[1]; o0.z = x0.z + g0.z * v[2]; o0.w = x0.w + g0.w * v[3];
        o1.x = x1.x + g1v.x * v[4]; o1.y = x1.y + g1v.y * v[5]; o1.z = x1.z + g1v.z * v[6]; o1.w = x1.w + g1v.w * v[7];
        *(f32x4*)o = o0; *(f32x4*)(o + 4) = o1;
    } else if (MODE == MODE_QH) {
        st8bf(P.QH + (size_t)m * 2048 + n, v);
    }
}
__device__ __forceinline__ void epi_rope(const Params& P, int m, int n, const float* lo, const float* hi) {
    const int d0 = n & 63;
    const int l = m % SEQ;
    const float *ct, *st;
    if (d0 < 16) { const int row = l >> 6; ct = P.rope + row * 16 + d0; st = P.rope + 512 + row * 16 + d0; }
    else { const int col = l & 63; ct = P.rope + 1024 + col * 16 + (d0 - 32); st = P.rope + 2048 + col * 16 + (d0 - 32); }
    float a[4], b[4];
    const float sc = (n < 512) ? 0.125f : 1.f;
#pragma unroll
    for (int j = 0; j < 4; ++j) { const float cc = ct[j], ss = st[j]; a[j] = (lo[j] * cc - hi[j] * ss) * sc; b[j] = (lo[j] * ss + hi[j] * cc) * sc; }
    if (n < 512) { st4bf(P.Q + (size_t)m * 512 + n, a); st4bf(P.Q + (size_t)m * 512 + n + 16, b); }
    else { const int bb = m / SEQ, kvh = (n - 512) >> 6;
        bf16_t* kp = P.K + ((((size_t)((bb * 2 + kvh) * 64 + (l >> 5)) * 4 + (d0 >> 4)) * 2 + ((d0 >> 3) & 1)) * 32 + (l & 31)) * 8 + (d0 & 7);
        st4bf(kp, a); st4bf(kp + 512, b); }
}
__device__ __forceinline__ void epi_v4(const Params& P, int m, int dcol, const float* v, bool ctx) {
    const int kvh = dcol >> 6, dd = dcol & 63;
    if (!ctx) { const int b = m / SEQ, l = m % SEQ;
#pragma unroll
        for (int j = 0; j < 4; ++j) {
            const int kk = l & 31;
            P.VT[(((((size_t)((b * 2 + kvh) * 64 + (l >> 5)) * 2 + (dd >> 5)) * 2 + (kk >> 4)) * 2 + ((kk >> 2) & 1)) * 32 + ((dd & 31) + j)) * 8 + 4 * ((kk >> 3) & 1) + (kk & 3)] = f2bf(v[j]); }
    } else { const int b = m / CTXL, cpos = m % CTXL;
#pragma unroll
        for (int j = 0; j < 4; ++j) {
            const int kk = cpos & 31;
            P.VcT[(((((size_t)((b * 2 + kvh) * 8 + (cpos >> 5)) * 2 + (dd >> 5)) * 2 + (kk >> 4)) * 2 + ((kk >> 2) & 1)) * 32 + ((dd & 31) + j)) * 8 + 4 * ((kk >> 3) & 1) + (kk & 3)] = f2bf(v[j]); }
    }
}

constexpr int GEMM_LDS = 65536;
constexpr int RETR_LDS = 128 * 130 * 4;
__device__ __forceinline__ int lds_off(int row, int chunk) { return row * 128 + ((chunk ^ ((row >> 1) & 7)) << 4); }

__device__ __forceinline__ void mma_from_lds(const char* As, const char* Bs, f32x4 (&acc)[4][4], int wm, int wn, int fr, int fq, int sw) {
#pragma unroll
    for (int ks = 0; ks < 2; ++ks) {
        bf16x8 af[4], bfr[4];
        const int coff = ((ks * 4 + fq) ^ sw) << 4;
#pragma unroll
        for (int mt = 0; mt < 4; ++mt) af[mt] = *(const bf16x8*)(As + (wm * 64 + mt * 16 + fr) * 128 + coff);
#pragma unroll
        for (int nt = 0; nt < 4; ++nt) bfr[nt] = *(const bf16x8*)(Bs + (wn * 64 + nt * 16 + fr) * 128 + coff);
#pragma unroll
        for (int mt = 0; mt < 4; ++mt)
#pragma unroll
            for (int nt = 0; nt < 4; ++nt) acc[mt][nt] = __builtin_amdgcn_mfma_f32_16x16x32_bf16(bfr[nt], af[mt], acc[mt][nt], 0, 0, 0);
    }
}
__device__ __forceinline__ void gemm_mainloop(const bf16_t* __restrict__ A, int lda, const bf16_t* __restrict__ Bt, int ldb, int K, int m0, int n0, bool perm, char* smem, f32x4 (&acc)[4][4]) {
    const int tid = threadIdx.x, lane = tid & 63, wid = tid >> 6;
    const int wm = wid >> 1, wn = wid & 1, fr = lane & 15, fq = lane >> 4;
    const bf16_t* ag[4]; const bf16_t* bg[4];
#pragma unroll
    for (int i = 0; i < 4; ++i) {
        const int row = (wid + 4 * i) * 8 + (lane >> 3);
        const int c = (lane & 7) ^ ((row >> 1) & 7);
        ag[i] = A + (size_t)(m0 + row) * lda + c * 8;
        int brow = row;
        if (perm) { const int g = row >> 5, rr = row & 31, nn = rr >> 4, j = rr & 15; brow = 32 * g + 8 * (j >> 2) + 4 * nn + (j & 3); }
        bg[i] = Bt + (size_t)(n0 + brow) * ldb + c * 8;
    }
#pragma unroll
    for (int i = 0; i < 4; ++i)
#pragma unroll
        for (int j = 0; j < 4; ++j) acc[i][j] = (f32x4){0.f, 0.f, 0.f, 0.f};
#define GSTAGE(buf, k0) { _Pragma("unroll") for (int i = 0; i < 4; ++i) { \
        __builtin_amdgcn_global_load_lds((const unsigned*)(ag[i] + (k0)), (unsigned*)(smem + (buf) * 32768 + (wid + 4 * i) * 1024), 16, 0, 0); \
        __builtin_amdgcn_global_load_lds((const unsigned*)(bg[i] + (k0)), (unsigned*)(smem + (buf) * 32768 + 16384 + (wid + 4 * i) * 1024), 16, 0, 0); } }
    GSTAGE(0, 0)
    asm volatile("s_waitcnt vmcnt(0)" ::: "memory");
    __syncthreads();
    const int nk = K / 64;
    const int sw = (fr >> 1) & 7;
    for (int kt = 0; kt < nk; ++kt) {
        const int cur = kt & 1;
        if (kt + 1 < nk) GSTAGE(cur ^ 1, (kt + 1) * 64)
        mma_from_lds(smem + cur * 32768, smem + cur * 32768 + 16384, acc, wm, wn, fr, fq, sw);
        asm volatile("s_waitcnt vmcnt(0)" ::: "memory");
        __syncthreads();
    }
#undef GSTAGE
}

template <int MT, int NST>
__device__ __forceinline__ void gemm_ring(const bf16_t* __restrict__ A, int lda, const bf16_t* __restrict__ Bt, int ldb, int K, int m0, int n0, bool perm, char* smem, f32x4 (&acc)[MT][4]) {
    constexpr int SA = 2048 * MT, SB = SA + 8192, GA = MT / 2, GL = GA + 2;
    const int tid = threadIdx.x, lane = tid & 63, wid = __builtin_amdgcn_readfirstlane(tid >> 6);
    const int wm = wid >> 1, wn = wid & 1, fr = lane & 15, fq = lane >> 4;
    const int c8 = ((lane & 3) ^ (3 * ((lane >> 4) & 1))) * 8;
    unsigned aoff[GA], boff[2];
#pragma unroll
    for (int i = 0; i < GA; ++i) aoff[i] = (unsigned)(((wid + 4 * i) * 16 + (lane >> 2)) * lda + c8) * 2u;
#pragma unroll
    for (int i = 0; i < 2; ++i) {
        const int row = (wid + 4 * i) * 16 + (lane >> 2);
        int brow = row;
        if (perm) { const int g = row >> 5, rr = row & 31, nn = rr >> 4, j = rr & 15; brow = 32 * g + 8 * (j >> 2) + 4 * nn + (j & 3); }
        boff[i] = (unsigned)(brow * ldb + c8) * 2u;
    }
    const char* Abase = (const char*)(A + (size_t)m0 * lda);
    const char* Bbase = (const char*)(Bt + (size_t)n0 * ldb);
#pragma unroll
    for (int i = 0; i < MT; ++i)
#pragma unroll
        for (int j = 0; j < 4; ++j) acc[i][j] = (f32x4){0.f, 0.f, 0.f, 0.f};
#define RSTAGE_(buf, k0) { char* sb_ = smem + (buf) * SB; const char* ab_ = Abase + (size_t)(k0) * 2; const char* bb_ = Bbase + (size_t)(k0) * 2; \
        _Pragma("unroll") for (int i = 0; i < GA; ++i) __builtin_amdgcn_global_load_lds((const unsigned*)(ab_ + aoff[i]), (unsigned*)(sb_ + (wid + 4 * i) * 1024), 16, 0, 0); \
        _Pragma("unroll") for (int i = 0; i < 2; ++i) __builtin_amdgcn_global_load_lds((const unsigned*)(bb_ + boff[i]), (unsigned*)(sb_ + SA + (wid + 4 * i) * 1024), 16, 0, 0); }
    const int nk = K / 32;
    asm volatile("s_waitcnt vmcnt(0)" ::: "memory");
#pragma unroll
    for (int s = 0; s < NST - 1; ++s) RSTAGE_(s, s * 32)
    const int coff = (fq ^ (3 * ((fr >> 2) & 1))) << 4;
    int cur = 0, nxt = NST - 1;
#pragma unroll 1
    for (int kt = 0; kt < nk; ++kt) {
        const int rem = nk - 1 - kt;
        if (rem >= NST - 2) asm volatile("s_waitcnt vmcnt(%0)" :: "n"(GL * (NST - 2)) : "memory");
        else if (NST == 4 && rem == 1) asm volatile("s_waitcnt vmcnt(%0)" :: "n"(GL) : "memory");
        else asm volatile("s_waitcnt vmcnt(0)" ::: "memory");
        __builtin_amdgcn_s_barrier();
        const char* As = smem + cur * SB;
        const char* Bs = As + SA;
        bf16x8 af[MT], bfr[4];
#pragma unroll
        for (int mt = 0; mt < MT; ++mt) af[mt] = *(const bf16x8*)(As + (wm * 16 * MT + mt * 16 + fr) * 64 + coff);
#pragma unroll
        for (int nt = 0; nt < 4; ++nt) bfr[nt] = *(const bf16x8*)(Bs + (wn * 64 + nt * 16 + fr) * 64 + coff);
        const bool more = (kt + NST - 1 < nk);
        char* sb_ = smem + nxt * SB; const char* ab_ = Abase + (size_t)((kt + NST - 1) * 32) * 2; const char* bb_ = Bbase + (size_t)((kt + NST - 1) * 32) * 2;
        __builtin_amdgcn_s_setprio(1);
#pragma unroll
        for (int mt = 0; mt < MT; ++mt) {
#pragma unroll
            for (int nt = 0; nt < 4; ++nt) acc[mt][nt] = __builtin_amdgcn_mfma_f32_16x16x32_bf16(bfr[nt], af[mt], acc[mt][nt], 0, 0, 0);
            if (more) {
                if (mt < GA) __builtin_amdgcn_global_load_lds((const unsigned*)(ab_ + aoff[mt]), (unsigned*)(sb_ + (wid + 4 * mt) * 1024), 16, 0, 0);
                else if (mt < GA + 2) __builtin_amdgcn_global_load_lds((const unsigned*)(bb_ + boff[mt - GA]), (unsigned*)(sb_ + SA + (wid + 4 * (mt - GA)) * 1024), 16, 0, 0);
            }
        }
        __builtin_amdgcn_s_setprio(0);
        cur = (cur + 1 == NST) ? 0 : cur + 1;
        nxt = (nxt + 1 == NST) ? 0 : nxt + 1;
    }
#undef RSTAGE_
    __syncthreads();
}

template <int MODE, int MT>
__device__ __forceinline__ void gemm_tile(const Params& P, const bf16_t* __restrict__ A, int lda, const bf16_t* __restrict__ Bt, int ldb, int K, int m0, int n0, bool perm, char* smem, int aux = 0) {
    const int lane = threadIdx.x & 63, wid = threadIdx.x >> 6;
    const int wm = wid >> 1, wn = wid & 1, fr = lane & 15, fq = lane >> 4;
    f32x4 acc[MT][4];
    gemm_ring<MT, (MT == 8 ? 3 : 4)>(A, lda, Bt, ldb, K, m0, n0, perm, smem, acc);
#pragma unroll
    for (int mt = 0; mt < MT; ++mt) {
        const int m = m0 + wm * 16 * MT + mt * 16 + fr;
        if (perm) {
#pragma unroll
            for (int p = 0; p < 2; ++p) {
                float v[8] = { acc[mt][2 * p][0], acc[mt][2 * p][1], acc[mt][2 * p][2], acc[mt][2 * p][3], acc[mt][2 * p + 1][0], acc[mt][2 * p + 1][1], acc[mt][2 * p + 1][2], acc[mt][2 * p + 1][3] };
                epi8<MODE>(P, m, n0 + wn * 64 + 32 * p + 8 * fq, v, aux);
            }
        } else if (MODE == MODE_INPROJ && n0 < 640) {
#pragma unroll
            for (int p = 0; p < 2; ++p) {
                float lo[4] = { acc[mt][2 * p][0], acc[mt][2 * p][1], acc[mt][2 * p][2], acc[mt][2 * p][3] };
                float hi[4] = { acc[mt][2 * p + 1][0], acc[mt][2 * p + 1][1], acc[mt][2 * p + 1][2], acc[mt][2 * p + 1][3] };
                epi_rope(P, m, n0 + wn * 64 + 32 * p + 4 * fq, lo, hi);
            }
        } else if (MODE == MODE_INPROJ || MODE == MODE_CTXKV) {
            const int dbase = (MODE == MODE_INPROJ) ? (n0 - 640) : (n0 - 128);
#pragma unroll
            for (int nt = 0; nt < 4; ++nt) {
                float v[4] = { acc[mt][nt][0], acc[mt][nt][1], acc[mt][nt][2], acc[mt][nt][3] };
                epi_v4(P, m, dbase + wn * 64 + 16 * nt + 4 * fq, v, MODE == MODE_CTXKV);
            }
        }
        asm volatile("" ::: "memory"); __builtin_amdgcn_sched_barrier(0);
    }
}
__device__ __forceinline__ void tile_coords(int t, int ntm, int ntn, int& mt, int& nt) {
    const int per = 8 * ntn, g = t / per, r = t % per;
    mt = g * 8 + (r & 7); nt = r >> 3;
}
#define CEU(a, b) { const unsigned _t = (a) > (b) ? (a) : (b); (b) = (a) > (b) ? (b) : (a); (a) = _t; }
__device__ __forceinline__ void sort16_desc(unsigned (&v)[16]) {
    CEU(v[0], v[1]); CEU(v[2], v[3]); CEU(v[0], v[2]); CEU(v[1], v[3]); CEU(v[1], v[2]); CEU(v[4], v[5]);
    CEU(v[6], v[7]); CEU(v[4], v[6]); CEU(v[5], v[7]); CEU(v[5], v[6]); CEU(v[0], v[4]); CEU(v[2], v[6]);
    CEU(v[2], v[4]); CEU(v[1], v[5]); CEU(v[3], v[7]); CEU(v[3], v[5]); CEU(v[1], v[2]); CEU(v[3], v[4]);
    CEU(v[5], v[6]); CEU(v[8], v[9]); CEU(v[10], v[11]); CEU(v[8], v[10]); CEU(v[9], v[11]); CEU(v[9], v[10]);
    CEU(v[12], v[13]); CEU(v[14], v[15]); CEU(v[12], v[14]); CEU(v[13], v[15]); CEU(v[13], v[14]); CEU(v[8], v[12]);
    CEU(v[10], v[14]); CEU(v[10], v[12]); CEU(v[9], v[13]); CEU(v[11], v[15]); CEU(v[11], v[13]); CEU(v[9], v[10]);
    CEU(v[11], v[12]); CEU(v[13], v[14]); CEU(v[0], v[8]); CEU(v[4], v[12]); CEU(v[4], v[8]); CEU(v[2], v[10]);
    CEU(v[6], v[14]); CEU(v[6], v[10]); CEU(v[2], v[4]); CEU(v[6], v[8]); CEU(v[10], v[12]); CEU(v[1], v[9]);
    CEU(v[5], v[13]); CEU(v[5], v[9]); CEU(v[3], v[11]); CEU(v[7], v[15]); CEU(v[7], v[11]); CEU(v[3], v[5]);
    CEU(v[7], v[9]); CEU(v[11], v[13]); CEU(v[1], v[2]); CEU(v[3], v[4]); CEU(v[5], v[6]); CEU(v[7], v[8]);
    CEU(v[9], v[10]); CEU(v[11], v[12]); CEU(v[13], v[14]);
}
__device__ __forceinline__ void bitonic16_desc(unsigned (&v)[16]) {
    CEU(v[0], v[8]); CEU(v[1], v[9]); CEU(v[2], v[10]); CEU(v[3], v[11]); CEU(v[4], v[12]); CEU(v[5], v[13]);
    CEU(v[6], v[14]); CEU(v[7], v[15]); CEU(v[0], v[4]); CEU(v[1], v[5]); CEU(v[2], v[6]); CEU(v[3], v[7]);
    CEU(v[8], v[12]); CEU(v[9], v[13]); CEU(v[10], v[14]); CEU(v[11], v[15]); CEU(v[0], v[2]); CEU(v[1], v[3]);
    CEU(v[4], v[6]); CEU(v[5], v[7]); CEU(v[8], v[10]); CEU(v[9], v[11]); CEU(v[12], v[14]); CEU(v[13], v[15]);
    CEU(v[0], v[1]); CEU(v[2], v[3]); CEU(v[4], v[5]); CEU(v[6], v[7]); CEU(v[8], v[9]); CEU(v[10], v[11]);
    CEU(v[12], v[13]); CEU(v[14], v[15]);
}

__device__ __forceinline__ unsigned enc_key(float f) { const unsigned b = __float_as_uint(f); return b ^ ((unsigned)((int)b >> 31) | 0x80000000u); }
__device__ __forceinline__ float dec_key(unsigned k) { const unsigned b = (k & 0x80000000u) ? (k & 0x7fffffffu) : ~k; return __uint_as_float(b); }
__device__ __forceinline__ void topmerge16(unsigned (&top)[16], const unsigned (&L)[16]) {
#pragma unroll
    for (int i = 0; i < 16; ++i) top[i] = top[i] > L[15 - i] ? top[i] : L[15 - i];
    bitonic16_desc(top);
}
__device__ __forceinline__ unsigned cand_key(float a, float b, int i, int j) { return (enc_key(a + b) & ~0xFFu) | (unsigned)(i << 4) | (unsigned)j; }

__device__ __forceinline__ void peer_retrieve_item(const Params& P, int mtile, int h, char* smem) {
    const int tid = threadIdx.x, lane = tid & 63, wid = tid >> 6;
    const int wm = wid >> 1, wn = wid & 1, fr = lane & 15, fq = lane >> 4;
    const int sw = (fr >> 1) & 7;
    const int m0 = mtile * 128;
    unsigned T0[16], T1[16];
#pragma unroll 1
    for (int p = 0; p < 2; ++p) {
        const int hp = h * 2 + p;
        f32x4 acc[4][4];
        gemm_ring<4, 4>(P.H2, DM, P.PwqT, DM, DM, m0, hp * 128, false, smem, acc);
#pragma unroll
        for (int mt = 0; mt < 4; ++mt)
#pragma unroll
            for (int nt = 0; nt < 4; ++nt) {
                const int row = wm * 64 + mt * 16 + fr;
                u32x2 o; o.x = pk2(acc[mt][nt][0], acc[mt][nt][1]); o.y = pk2(acc[mt][nt][2], acc[mt][nt][3]);
                *(u32x2*)(smem + wn * 32768 + lds_off(row, 2 * nt + (fq >> 1)) + (fq & 1) * 8) = o;
            }
        {
            const int srow = tid >> 3, schunk = tid & 7;
            const bf16_t* kb = P.KeysB + (size_t)hp * 128 * 128;
#pragma unroll
            for (int hf = 0; hf < 2; ++hf)
#pragma unroll
                for (int q = 0; q < 4; ++q) {
                    const int row = q * 32 + srow;
                    const u32x4 v = *(const u32x4*)(kb + (size_t)row * 128 + hf * 64 + schunk * 8);
                    *(u32x4*)(smem + hf * 32768 + 16384 + lds_off(row, schunk)) = v;
                }
        }
        __syncthreads();
#pragma unroll
        for (int i = 0; i < 4; ++i)
#pragma unroll
            for (int j = 0; j < 4; ++j) acc[i][j] = (f32x4){0.f, 0.f, 0.f, 0.f};
        mma_from_lds(smem, smem + 16384, acc, wm, wn, fr, fq, sw);
        mma_from_lds(smem + 32768, smem + 32768 + 16384, acc, wm, wn, fr, fq, sw);
        __syncthreads();
        float* sc = (float*)smem;
#pragma unroll
        for (int mt = 0; mt < 4; ++mt)
#pragma unroll
            for (int nt = 0; nt < 4; ++nt) {
                const int row = wm * 64 + mt * 16 + fr;
#pragma unroll
                for (int r = 0; r < 4; ++r) {
                    const int col = wn * 64 + nt * 16 + fq * 4 + r;
                    sc[row * 130 + wn * 65 + (col & 63)] = acc[mt][nt][r];
                }
            }
        __syncthreads();
        {
            const int row = tid >> 1, half = tid & 1;
            const float* rp = sc + row * 130 + half * 65;
            unsigned top[16];
#pragma unroll 1
            for (int g = 0; g < 4; ++g) {
                unsigned L[16];
#pragma unroll
                for (int j = 0; j < 16; ++j) { const int col = half * 64 + g * 16 + j; L[j] = (enc_key(rp[g * 16 + j]) & ~0x7Fu) | (unsigned)col; }
                sort16_desc(L);
                if (g == 0) {
#pragma unroll
                    for (int j = 0; j < 16; ++j) top[j] = L[j];
                } else topmerge16(top, L);
            }
            unsigned Bp[16];
#pragma unroll
            for (int j = 0; j < 16; ++j) Bp[j] = (unsigned)__shfl_xor((int)top[j], 1);
            topmerge16(top, Bp);
            if (p == 0) {
#pragma unroll
                for (int j = 0; j < 16; ++j) T0[j] = top[j];
            } else {
#pragma unroll
                for (int j = 0; j < 16; ++j) T1[j] = top[j];
            }
        }
        __syncthreads();
    }
    {
        const int row = tid >> 1;
        unsigned char* slot = (unsigned char*)smem + row * 32;
        if ((tid & 1) == 0) {
#pragma unroll
            for (int j = 0; j < 16; ++j) { slot[j] = (unsigned char)(T0[j] & 0x7Fu); slot[16 + j] = (unsigned char)(T1[j] & 0x7Fu); }
            float a[16], b[16];
#pragma unroll
            for (int j = 0; j < 16; ++j) { a[j] = dec_key(T0[j]); b[j] = dec_key(T1[j]); }
            unsigned LA[16], LB[16], LC[16];
#pragma unroll
            for (int j = 0; j < 16; ++j) LA[j] = cand_key(a[0], b[j], 0, j);
#pragma unroll
            for (int j = 0; j < 8; ++j) LB[j] = cand_key(a[1], b[j], 1, j);
#pragma unroll
            for (int j = 0; j < 8; ++j) LB[8 + j] = cand_key(a[15 - j], b[0], 15 - j, 0);
            LC[0] = cand_key(a[2], b[0], 2, 0); LC[1] = cand_key(a[2], b[1], 2, 1); LC[2] = cand_key(a[2], b[2], 2, 2); LC[3] = cand_key(a[2], b[3], 2, 3); LC[4] = cand_key(a[2], b[4], 2, 4);
            LC[5] = cand_key(a[3], b[0], 3, 0); LC[6] = cand_key(a[3], b[1], 3, 1); LC[7] = cand_key(a[3], b[2], 3, 2); LC[8] = cand_key(a[3], b[3], 3, 3);
            LC[9] = cand_key(a[4], b[0], 4, 0); LC[10] = cand_key(a[4], b[1], 4, 1); LC[11] = cand_key(a[4], b[2], 4, 2);
            LC[12] = cand_key(a[5], b[0], 5, 0); LC[13] = cand_key(a[5], b[1], 5, 1);
            LC[14] = cand_key(a[6], b[0], 6, 0); LC[15] = cand_key(a[6], b[1], 6, 1);
            const unsigned d0 = cand_key(a[7], b[0], 7, 0), d1 = cand_key(a[7], b[1], 7, 1);
            bitonic16_desc(LB);
            sort16_desc(LC);
            topmerge16(LA, LB);
            LC[15] = LC[15] > d0 ? LC[15] : d0; LC[14] = LC[14] > d1 ? LC[14] : d1;
            bitonic16_desc(LC);
            topmerge16(LA, LC);
            float e[16], den = 0.f; const float vmax = dec_key(LA[0]);
#pragma unroll
            for (int r = 0; r < 16; ++r) { e[r] = __expf(dec_key(LA[r]) - vmax); den += e[r]; }
            const float inv = 1.f / den;
            const int t = m0 + row;
            int* oi = P.sel_idx + (size_t)t * 128 + h * 16; float* og = P.sel_g + (size_t)t * 128 + h * 16;
#pragma unroll
            for (int r = 0; r < 16; ++r) {
                const int i = (LA[r] >> 4) & 15, j = LA[r] & 15;
                oi[r] = (int)slot[i] * 128 + (int)slot[16 + j];
                og[r] = e[r] * inv;
            }
        }
    }
    __syncthreads();
}
typedef float f32x16 __attribute__((ext_vector_type(16)));
struct AttnFrag { u32x4 k[4]; u32x4 v[2][2]; };
__device__ __forceinline__ void attn_load(const Params& P, int b, int kvh, int qb, int w, int blk, int r, int hh, AttnFrag& f) {
    const bf16_t* kp; const bf16_t* vp;
    if (blk < 9) {
        int kpos0 = (qb - 1) * 128 + 32 * (w + blk);
        if (kpos0 < 0 || kpos0 >= SEQ) kpos0 = 0;
        const size_t blkoff = (size_t)((b * 2 + kvh) * 64 + (kpos0 >> 5)) * 2048 + (hh * 32 + r) * 8;
        kp = P.K + blkoff; vp = P.VT + blkoff;
    } else {
        const size_t blkoff = (size_t)((b * 2 + kvh) * 8 + (blk - 9)) * 2048 + (hh * 32 + r) * 8;
        kp = P.Kc + blkoff; vp = P.VcT + blkoff;
    }
#pragma unroll
    for (int ks = 0; ks < 4; ++ks) f.k[ks] = *(const u32x4*)(kp + 512 * ks);
#pragma unroll
    for (int db = 0; db < 2; ++db)
#pragma unroll
        for (int s = 0; s < 2; ++s) f.v[db][s] = *(const u32x4*)(vp + 512 * (db * 2 + s));
}
__device__ __forceinline__ void attn_item(const Params& P, int item) {
    const int head = item & 7, qb = (item >> 3) & 15, b = item >> 7, kvh = head >> 2;
    const int lane = threadIdx.x & 63, w = threadIdx.x >> 6, r = lane & 31, hh = lane >> 5;
    const int tok = b * SEQ + qb * 128 + 32 * w + r;
    bf16x8 qf[4];
    { const bf16_t* qp = P.Q + (size_t)tok * 512 + head * 64 + 8 * hh;
#pragma unroll
      for (int ks = 0; ks < 4; ++ks) qf[ks] = *(const bf16x8*)(qp + 16 * ks); }
    f32x16 o0, o1;
#pragma unroll
    for (int i = 0; i < 16; ++i) { o0[i] = 0.f; o1[i] = 0.f; }
    float mrun = P.sink[head], lrun = (hh == 0) ? 1.f : 0.f;
    AttnFrag cur, nxt;
    attn_load(P, b, kvh, qb, w, 0, r, hh, cur);
    for (int blk = 0; blk < 17; ++blk) {
        if (blk + 1 < 17) attn_load(P, b, kvh, qb, w, blk + 1, r, hh, nxt);
        int lo = 0, hi = 31;
        if (blk < 9) {
            const int kpos0 = (qb - 1) * 128 + 32 * (w + blk);
            if (kpos0 < 0 || kpos0 >= SEQ) lo = 64;
            else if (blk == 0) lo = r;
            else if (blk == 8) hi = r;
        }
        f32x16 s;
#pragma unroll
        for (int i = 0; i < 16; ++i) s[i] = 0.f;
#pragma unroll
        for (int ks = 0; ks < 4; ++ks) s = __builtin_amdgcn_mfma_f32_32x32x16_bf16(*(const bf16x8*)&cur.k[ks], qf[ks], s, 0, 0, 0);
        float mb = -3.0e38f;
#pragma unroll
        for (int i = 0; i < 16; ++i) { const int kk = (i & 3) + 8 * (i >> 2) + 4 * hh; const bool ok = (kk >= lo) && (kk <= hi); s[i] = ok ? s[i] : -3.0e38f; mb = fmaxf(mb, s[i]); }
        mb = fmaxf(mb, __shfl_xor(mb, 32));
        const float mn = fmaxf(mrun, mb);
        const float alpha = __expf(mrun - mn);
        float ps = 0.f; float p[16];
#pragma unroll
        for (int i = 0; i < 16; ++i) { p[i] = __expf(s[i] - mn); ps += p[i]; }
        lrun = lrun * alpha + ps; mrun = mn;
#pragma unroll
        for (int i = 0; i < 16; ++i) { o0[i] *= alpha; o1[i] *= alpha; }
        u32x4 pb[2];
        pb[0].x = pk2(p[0], p[1]); pb[0].y = pk2(p[2], p[3]); pb[0].z = pk2(p[4], p[5]); pb[0].w = pk2(p[6], p[7]);
        pb[1].x = pk2(p[8], p[9]); pb[1].y = pk2(p[10], p[11]); pb[1].z = pk2(p[12], p[13]); pb[1].w = pk2(p[14], p[15]);
#pragma unroll
        for (int sI = 0; sI < 2; ++sI) {
            const u32x4 va = cur.v[0][sI], vb = cur.v[1][sI];
            o0 = __builtin_amdgcn_mfma_f32_32x32x16_bf16(*(const bf16x8*)&va, *(const bf16x8*)&pb[sI], o0, 0, 0, 0);
            o1 = __builtin_amdgcn_mfma_f32_32x32x16_bf16(*(const bf16x8*)&vb, *(const bf16x8*)&pb[sI], o1, 0, 0, 0);
        }
        if (blk + 1 < 17) cur = nxt;
    }
    const float ltot = lrun + __shfl_xor(lrun, 32);
    const float inv = 1.f / ltot;
    bf16_t* op = P.AO + (size_t)tok * 512 + head * 64 + 4 * hh;
#pragma unroll
    for (int g = 0; g < 4; ++g) {
        float t0[4] = { o0[4 * g] * inv, o0[4 * g + 1] * inv, o0[4 * g + 2] * inv, o0[4 * g + 3] * inv };
        float t1[4] = { o1[4 * g] * inv, o1[4 * g + 1] * inv, o1[4 * g + 2] * inv, o1[4 * g + 3] * inv };
        st4bf(op + 8 * g, t0); st4bf(op + 32 + 8 * g, t1);
    }
}

__device__ __forceinline__ void conv_range(const Params& P, size_t gtid, size_t gsize) {
    for (size_t idx = gtid; idx < (size_t)NTOK * 64; idx += gsize) {
        const int m = (int)(idx >> 6), c0 = (int)(idx & 63) * 8, l = m % SEQ;
        float cu[3][8];
#pragma unroll
        for (int t = 0; t < 3; ++t) {
            const int ll = l + t - 1;
            if (ll < 0 || ll >= SEQ) {
#pragma unroll
                for (int j = 0; j < 8; ++j) cu[t][j] = 0.f;
            } else {
                const u32x4 g = *(const u32x4*)(P.GC + (size_t)(m + t - 1) * 512 + c0), u = *(const u32x4*)(P.U + (size_t)(m + t - 1) * 512 + c0);
                cu[t][0] = bf2f(g.x & 0xffff) * bf2f(u.x & 0xffff); cu[t][1] = bf2f(g.x >> 16) * bf2f(u.x >> 16);
                cu[t][2] = bf2f(g.y & 0xffff) * bf2f(u.y & 0xffff); cu[t][3] = bf2f(g.y >> 16) * bf2f(u.y >> 16);
                cu[t][4] = bf2f(g.z & 0xffff) * bf2f(u.z & 0xffff); cu[t][5] = bf2f(g.z >> 16) * bf2f(u.z >> 16);
                cu[t][6] = bf2f(g.w & 0xffff) * bf2f(u.w & 0xffff); cu[t][7] = bf2f(g.w >> 16) * bf2f(u.w >> 16);
            }
        }
        const u32x4 gbv = *(const u32x4*)(P.GB + (size_t)m * 512 + c0);
        const float gb[8] = { bf2f(gbv.x & 0xffff), bf2f(gbv.x >> 16), bf2f(gbv.y & 0xffff), bf2f(gbv.y >> 16), bf2f(gbv.z & 0xffff), bf2f(gbv.z >> 16), bf2f(gbv.w & 0xffff), bf2f(gbv.w >> 16) };
        float o[8];
#pragma unroll
        for (int j = 0; j < 8; ++j) o[j] = gb[j] * (P.conv_w[c0 + j] * cu[0][j] + P.conv_w[512 + c0 + j] * cu[1][j] + P.conv_w[1024 + c0 + j] * cu[2][j]);
        st8bf(P.CA + (size_t)m * 512 + c0, o);
    }
}

__device__ __forceinline__ void unpack8(const u32x4 v, float* f) {
    f[0] = bf2f(v.x & 0xffff); f[1] = bf2f(v.x >> 16); f[2] = bf2f(v.y & 0xffff); f[3] = bf2f(v.y >> 16);
    f[4] = bf2f(v.z & 0xffff); f[5] = bf2f(v.z >> 16); f[6] = bf2f(v.w & 0xffff); f[7] = bf2f(v.w >> 16);
}
__device__ __forceinline__ float gelu_erf(float d) { return 0.5f * d * (1.f + erff(d * 0.70710678118654752f)); }
__device__ __forceinline__ int reduce64i(int (&part)[64], int lane) {
#pragma unroll
    for (int i = 0; i < 32; ++i) { auto r = __builtin_amdgcn_permlane32_swap((unsigned)part[i], (unsigned)part[32 + i], false, false); part[i] = (int)r[0] + (int)r[1]; }
#pragma unroll
    for (int i = 0; i < 16; ++i) { auto r = __builtin_amdgcn_permlane16_swap((unsigned)part[i], (unsigned)part[16 + i], false, false); part[i] = (int)r[0] + (int)r[1]; }
#define RSTAGE(N) { const bool up = (lane & N) != 0; _Pragma("unroll") for (int i = 0; i < N; ++i) { const int keep = up ? part[N + i] : part[i], send = up ? part[i] : part[N + i]; part[i] = keep + __shfl_xor(send, N); } }
    RSTAGE(8) RSTAGE(4) RSTAGE(2) RSTAGE(1)
#undef RSTAGE
    return part[0];
}
#define UB0(x) ((float)((x) & 0xffu))
#define UB1(x) ((float)(((x) >> 8) & 0xffu))
#define UB2(x) ((float)(((x) >> 16) & 0xffu))
#define UB3(x) ((float)((x) >> 24))
__device__ __forceinline__ void peer_final_token(const Params& P, int t, int lane) {
    const int b = t / SEQ;
    const u32x4 hq = *(const u32x4*)(P.H2q + (size_t)t * DM + 16 * lane);
    const float sh = P.sh2[t];
    float acc[16];
#pragma unroll
    for (int j = 0; j < 16; ++j) acc[j] = 0.f;
    float csum = 0.f;
#pragma unroll 1
    for (int half = 0; half < 2; ++half) {
        const int myidx = P.sel_idx[(size_t)t * 128 + half * 64 + lane];
        const float myg = P.sel_g[(size_t)t * 128 + half * 64 + lane];
        const float mysu = P.su[myidx], mysv = P.sv[myidx];
        int part[64];
#pragma unroll
        for (int k = 0; k < 64; ++k) {
            const int e = __builtin_amdgcn_readlane(myidx, k);
            const u32x4 a = *(const u32x4*)(P.Uq + (size_t)e * DM + 16 * lane);
            int d = __builtin_amdgcn_sdot4((int)a.x, (int)hq.x, 0, false);
            d = __builtin_amdgcn_sdot4((int)a.y, (int)hq.y, d, false);
            d = __builtin_amdgcn_sdot4((int)a.z, (int)hq.z, d, false);
            d = __builtin_amdgcn_sdot4((int)a.w, (int)hq.w, d, false);
            part[k] = d;
        }
        const int isum = reduce64i(part, lane);
        const float a = (float)isum * mysu * sh;
        const float c = myg * gelu_erf(a) * mysv;
        csum += c;
#pragma unroll
        for (int k = 0; k < 64; ++k) {
            const int e = __builtin_amdgcn_readlane(myidx, k);
            const float ck = __uint_as_float(__builtin_amdgcn_readlane(__float_as_uint(c), k));
            const u32x4 x = *(const u32x4*)(P.Vq + (size_t)e * DM + 16 * lane);
            acc[0] += ck * UB0(x.x); acc[1] += ck * UB1(x.x); acc[2] += ck * UB2(x.x); acc[3] += ck * UB3(x.x);
            acc[4] += ck * UB0(x.y); acc[5] += ck * UB1(x.y); acc[6] += ck * UB2(x.y); acc[7] += ck * UB3(x.y);
            acc[8] += ck * UB0(x.z); acc[9] += ck * UB1(x.z); acc[10] += ck * UB2(x.z); acc[11] += ck * UB3(x.z);
            acc[12] += ck * UB0(x.w); acc[13] += ck * UB1(x.w); acc[14] += ck * UB2(x.w); acc[15] += ck * UB3(x.w);
        }
    }
    const float cb = 128.f * wave_sum(csum);
    float x2[16]; float ss = 0.f;
    const float* x1 = P.X1 + (size_t)t * DM + 16 * lane; const float* g2 = P.mod + (size_t)b * NMOD + 5 * DM + 16 * lane;
#pragma unroll
    for (int q = 0; q < 4; ++q) {
        const f32x4 xa = *(const f32x4*)(x1 + 4 * q), ga = *(const f32x4*)(g2 + 4 * q);
        x2[4 * q + 0] = xa.x + ga.x * (acc[4 * q + 0] - cb); x2[4 * q + 1] = xa.y + ga.y * (acc[4 * q + 1] - cb);
        x2[4 * q + 2] = xa.z + ga.z * (acc[4 * q + 2] - cb); x2[4 * q + 3] = xa.w + ga.w * (acc[4 * q + 3] - cb);
        ss += x2[4 * q] * x2[4 * q] + x2[4 * q + 1] * x2[4 * q + 1] + x2[4 * q + 2] * x2[4 * q + 2] + x2[4 * q + 3] * x2[4 * q + 3];
    }
    ss = wave_sum(ss);
    const float rstd = rsqrtf(ss * (1.f / DM) + 1e-6f);
    float* op = P.out + (size_t)t * DM + 16 * lane; const float* fgp = P.fg + 16 * lane;
#pragma unroll
    for (int q = 0; q < 4; ++q) {
        const f32x4 fa = *(const f32x4*)(fgp + 4 * q);
        f32x4 o; o.x = x2[4 * q] * rstd * fa.x; o.y = x2[4 * q + 1] * rstd * fa.y; o.z = x2[4 * q + 2] * rstd * fa.z; o.w = x2[4 * q + 3] * rstd * fa.w;
        *(f32x4*)(op + 4 * q) = o;
    }
}

#define XB_TMO      128
#define XB_XCNT(j)  (256  + 64 * (j))
#define XB_XSUB(j)  (1280 + 64 * (j))
#define XB_XGEN(j)  (2304 + 64 * (j))
#define XB_TOP      3328
#define XB_TOPGEN   3392
#define XCD_BAR_WORDS 3456
#define XB_SPIN_CAP (1u << 22)
#define LAS __attribute__((address_space(3)))
__device__ __forceinline__ unsigned xb_ld(unsigned* p)              { return __hip_atomic_load(p, __ATOMIC_RELAXED, __HIP_MEMORY_SCOPE_AGENT); }
__device__ __forceinline__ unsigned xb_add(unsigned* p, unsigned v) { return __hip_atomic_fetch_add(p, v, __ATOMIC_RELAXED, __HIP_MEMORY_SCOPE_AGENT); }
__device__ __forceinline__ unsigned xb_xcc_id() { return (unsigned)__builtin_amdgcn_s_getreg((3 << 11) | 20) & 0xFu; }
#define XB_SPIN(cond, bar) do { unsigned _sp = 0; while (cond) { __builtin_amdgcn_s_sleep(1); \
    if ((++_sp & 255u) == 0u) { if (xb_ld(&(bar)[XB_TMO])) break; if (_sp > XB_SPIN_CAP) { atomicAdd(&(bar)[XB_TMO], 1u); break; } } } } while (0)
struct XcdBarrier { unsigned* bar; unsigned x; volatile LAS unsigned* st; };
__device__ __forceinline__ XcdBarrier xcd_barrier_post(unsigned* bar, volatile LAS unsigned* st) {
    XcdBarrier b; b.bar = bar; b.x = xb_xcc_id(); b.st = st;
    if (threadIdx.x == 0) (void)xb_add(&bar[XB_XCNT(b.x)], 1u);
    return b;
}
__device__ __forceinline__ void xcd_barrier_complete(unsigned* bar, unsigned x, unsigned& nloc, unsigned& nx) {
    const unsigned G = gridDim.x * gridDim.y * gridDim.z;
    unsigned sum, cnt, mine, sp = 0u;
    for (;;) {
        sum = 0u; cnt = 0u; mine = 0u;
#pragma unroll
        for (unsigned j = 0; j < 16; ++j) { const unsigned c = xb_ld(&bar[XB_XCNT(j)]); sum += c; cnt += (c > 0u) ? 1u : 0u; mine = (j == x) ? c : mine; }
        if (sum == G) break;
        __builtin_amdgcn_s_sleep(1);
        if ((++sp & 255u) == 0u) { if (xb_ld(&bar[XB_TMO])) break; if (sp > XB_SPIN_CAP) { atomicAdd(&bar[XB_TMO], 1u); break; } }
    }
    nloc = mine > 0u ? mine : 1u; nx = cnt > 0u ? cnt : 1u;
}
__device__ __forceinline__ void xcd_barrier(const XcdBarrier& b) {
    asm volatile("s_waitcnt vmcnt(0)" ::: "memory");
    __syncthreads();
    if (threadIdx.x == 0) {
        unsigned* bar = b.bar;
        __builtin_amdgcn_s_waitcnt(0);
        unsigned nloc = b.st[0], nx = b.st[1];
        if (nloc == 0u) { xcd_barrier_complete(bar, b.x, nloc, nx); b.st[0] = nloc; b.st[1] = nx; }
        const unsigned old = xb_add(&bar[XB_XSUB(b.x)], 1u);
        const unsigned gen = old / nloc;
        if (old + 1u == (gen + 1u) * nloc) {
            __builtin_amdgcn_fence(__ATOMIC_RELEASE, "agent");
            asm volatile("s_waitcnt vmcnt(0)" ::: "memory");
            const unsigned og = xb_add(&bar[XB_TOP], 1u);
            const unsigned tg = og / nx;
            if (og + 1u == (tg + 1u) * nx) xb_add(&bar[XB_TOPGEN], 1u);
            else XB_SPIN(xb_ld(&bar[XB_TOPGEN]) == tg, bar);
            __builtin_amdgcn_fence(__ATOMIC_ACQUIRE, "agent");
            xb_add(&bar[XB_XGEN(b.x)], 1u);
            asm volatile("s_waitcnt vmcnt(0)" ::: "memory");
        } else {
            XB_SPIN(xb_ld(&bar[XB_XGEN(b.x)]) == gen, bar);
            __builtin_amdgcn_fence(__ATOMIC_ACQUIRE, "agent");
            asm volatile("s_waitcnt vmcnt(0)" ::: "memory");
        }
    }
    __syncthreads();
}

constexpr int NPHASE = 9;
template <int PH> __device__ __forceinline__ void run_phase(const Params& P, char* smem) {
    int tid_ = threadIdx.x; asm volatile("" : "+v"(tid_));
    const int bid = blockIdx.x, G = gridDim.x, tid = tid_;
    const size_t gtid = (size_t)bid * 256 + tid, gsize = (size_t)G * 256;
    if (PH == 0) {
        for (int it = bid; it < 192; it += G) modp_item(P, it, smem);
        float (*tile)[65] = (float (*)[65])smem;
        for (int it = bid; it < 1088; it += G) transpose_tile(P.w_in, DM, PROJW, P.WinT, it, tile);
        for (int it = bid; it < 128; it += G) transpose_tile(P.w_ao, 512, DM, P.WaoT, it, tile);
        for (int it = bid; it < 128; it += G) transpose_tile(P.w_co, 512, DM, P.WcoT, it, tile);
        for (int it = bid; it < 256; it += G) transpose_tile(P.w_mix, DM, DM, P.WmixT, it, tile);
        for (int it = bid; it < 512; it += G) transpose_tile(P.pw_q, DM, 2048, P.PwqT, it, tile);
        cvt_range(P.keys, P.KeysB, (size_t)16 * 128 * 128 / 8, gtid, gsize);
        { const int lane = tid & 63, wid = tid >> 6;
          for (int r = bid * 4 + wid; r < NEXP; r += G * 4) {
              f32x4 va[4], vb[4];
              load_row16(P.pu + (size_t)r * DM, lane, va); load_row16(P.pv + (size_t)r * DM, lane, vb);
              quant_row(va, (unsigned char*)P.Uq + (size_t)r * DM, P.su + r, lane, 0);
              quant_row(vb, P.Vq + (size_t)r * DM, P.sv + r, lane, 128); } }
        rope_tab(P, (int)gtid, (int)gsize);
    } else if (PH == 1) {
        for (int i = (int)gtid; i < 17 * NMOD; i += (int)gsize) {
            float v = P.b_mod[i % NMOD];
#pragma unroll
            for (int kc = 0; kc < 8; ++kc) v += P.modp[(size_t)kc * 17 * NMOD + i];
            P.mod[i] = v;
        }
        for (int it = bid; it < 1152; it += G) norm1_item(P, it, smem);
    } else if (PH == 2) {
        for (int t = bid; t < 128 * 34 + 32; t += G) {
            if (t < 128 * 34) { int mt, nt; tile_coords(t, 128, 34, mt, nt); gemm_tile<MODE_INPROJ, 8>(P, P.H, DM, P.WinT, DM, DM, mt * 256, nt * 128, nt * 128 >= 768, smem); }
            else { const int u = t - 128 * 34, mt = u >> 1, nt = u & 1; gemm_tile<MODE_CTXKV, 8>(P, P.HC, DM, P.WinT + (size_t)512 * DM, DM, DM, mt * 256, nt * 128, nt == 0, smem); }
        }
    } else if (PH == 3) {
        for (int it = bid; it < NB * 16 * 8; it += G) attn_item(P, it);
        conv_range(P, gtid, gsize);
    } else if (PH == 4) {
        for (int t = bid; t < 128 * 8; t += G) { int mt, nt; tile_coords(t, 128, 8, mt, nt); gemm_tile<MODE_AO1, 8>(P, P.AO, 512, P.WaoT, 512, 512, mt * 256, nt * 128, true, smem, 0); }
        for (int t = bid; t < 128 * 8; t += G) { int mt, nt; tile_coords(t, 128, 8, mt, nt); gemm_tile<MODE_AO1, 8>(P, P.CA, 512, P.WcoT, 512, 512, mt * 256, nt * 128, true, smem, 1); }
    } else if (PH == 5) {
        for (int t = bid; t < 128 * 8; t += G) { int mt, nt; tile_coords(t, 128, 8, mt, nt); gemm_tile<MODE_MIX, 8>(P, P.YG, DM, P.WmixT, DM, DM, mt * 256, nt * 128, true, smem); }
    } else if (PH == 6) {
        const int lane = tid & 63, wid = tid >> 6;
        for (int row = bid * 4 + wid; row < NTOK; row += G * 8) {
            const int rb = row + G * 4;
            f32x4 va[4], vb[4];
            load_row4(P.X1 + (size_t)row * DM, lane, va);
            if (rb < NTOK) load_row4(P.X1 + (size_t)rb * DM, lane, vb);
            { const int b = row / SEQ; norm_row_q(va, P.n2, P.mod + (size_t)b * NMOD + 4 * DM, P.mod + (size_t)b * NMOD + 3 * DM, P.H2 + (size_t)row * DM, P.H2q + (size_t)row * DM, P.sh2 + row, lane); }
            if (rb < NTOK) { const int b = rb / SEQ; norm_row_q(vb, P.n2, P.mod + (size_t)b * NMOD + 4 * DM, P.mod + (size_t)b * NMOD + 3 * DM, P.H2 + (size_t)rb * DM, P.H2q + (size_t)rb * DM, P.sh2 + rb, lane); }
        }
    } else if (PH == 7) {
        for (int it = bid; it < 256 * 8; it += G) peer_retrieve_item(P, it >> 3, it & 7, smem);
    } else if (PH == 8) {
        const int lane = tid & 63, wid = tid >> 6;
        for (int t = bid * 4 + wid; t < NTOK; t += G * 4) peer_final_token(P, t, lane);
    }
}
#ifndef REP0
#define REP0 1
#endif
#ifndef REP1
#define REP1 1
#endif
#ifndef REP2
#define REP2 1
#endif
#ifndef REP3
#define REP3 1
#endif
#ifndef REP4
#define REP4 1
#endif
#ifndef REP5
#define REP5 1
#endif
#ifndef REP6
#define REP6 1
#endif
#ifndef REP7
#define REP7 1
#endif
#ifndef REP8
#define REP8 1
#endif
constexpr int MEGA_LDS = 3 * (2048 * 8 + 8192);
#ifndef MULTI_LAUNCH
__global__ void __launch_bounds__(256, 2) k_mega(Params P) {
    extern __shared__ __attribute__((aligned(16))) char smem[];
    volatile LAS unsigned* st = (volatile LAS unsigned*)(smem + MEGA_LDS);
    if (threadIdx.x < 4) st[threadIdx.x] = 0u;
    __syncthreads();
    const XcdBarrier bar = xcd_barrier_post(P.bar, st);
#define PHASE_SYNC(k) for (int rep = 0; rep < REP##k; ++rep) { run_phase<k>(P, smem); xcd_barrier(bar); }
    PHASE_SYNC(0) PHASE_SYNC(1) PHASE_SYNC(2) PHASE_SYNC(3) PHASE_SYNC(4) PHASE_SYNC(5) PHASE_SYNC(6) PHASE_SYNC(7)
    for (int rep = 0; rep < REP8 - 1; ++rep) { run_phase<8>(P, smem); xcd_barrier(bar); }
    run_phase<8>(P, smem);
}
#else
template <int PH> __global__ void __launch_bounds__(256, 2) k_phase(Params P) {
    extern __shared__ __attribute__((aligned(16))) char smem[];
    run_phase<PH>(P, smem);
}
#endif

static size_t carve(size_t& off, size_t bytes) { const size_t o = off; off += (bytes + 255) & ~(size_t)255; return o; }

extern "C" void kernel_launch(void* const* d_in, const int* in_sizes, int n_in, void* d_out, int out_size, void* d_ws, size_t ws_size, hipStream_t stream) {
    Params P{};
    P.x = (const float*)d_in[0]; P.c = (const float*)d_in[1]; P.ctx = (const float*)d_in[2]; P.c_ctx = (const float*)d_in[3];
    P.w_mod = (const float*)d_in[4]; P.b_mod = (const float*)d_in[5]; P.n1 = (const float*)d_in[6]; P.n2 = (const float*)d_in[7];
    P.w_in = (const float*)d_in[8]; P.sink = (const float*)d_in[9]; P.conv_w = (const float*)d_in[10]; P.w_ao = (const float*)d_in[11];
    P.w_co = (const float*)d_in[12]; P.w_mix = (const float*)d_in[13]; P.pw_q = (const float*)d_in[14]; P.keys = (const float*)d_in[15];
    P.pu = (const float*)d_in[16]; P.pv = (const float*)d_in[17]; P.fg = (const float*)d_in[18];
    P.out = (float*)d_out;
    char* ws = (char*)d_ws; size_t off = 0;
    P.modp = (float*)(ws + carve(off, (size_t)8 * 17 * NMOD * 4));
    P.mod = (float*)(ws + carve(off, (size_t)17 * NMOD * 4));
    P.rope = (float*)(ws + carve(off, 3072 * 4));
    P.WinT = (bf16_t*)(ws + carve(off, (size_t)PROJW * DM * 2));
    P.WaoT = (bf16_t*)(ws + carve(off, (size_t)DM * 512 * 2));
    P.WcoT = (bf16_t*)(ws + carve(off, (size_t)DM * 512 * 2));
    P.WmixT = (bf16_t*)(ws + carve(off, (size_t)DM * DM * 2));
    P.PwqT = (bf16_t*)(ws + carve(off, (size_t)2048 * DM * 2));
    P.KeysB = (bf16_t*)(ws + carve(off, (size_t)16 * 128 * 128 * 2));
    P.Uq = (signed char*)(ws + carve(off, (size_t)NEXP * DM));
    P.Vq = (unsigned char*)(ws + carve(off, (size_t)NEXP * DM));
    P.su = (float*)(ws + carve(off, (size_t)NEXP * 4));
    P.sv = (float*)(ws + carve(off, (size_t)NEXP * 4));
    P.sh2 = (float*)(ws + carve(off, (size_t)NTOK * 4));
    P.HC = (bf16_t*)(ws + carve(off, (size_t)NCTX * DM * 2));
    const size_t regA = carve(off, (size_t)NTOK * DM * 2);
    P.H = (bf16_t*)(ws + regA); P.YG = (bf16_t*)(ws + regA); P.H2 = (bf16_t*)(ws + regA);
    const size_t regB = off;
    P.Q = (bf16_t*)(ws + carve(off, (size_t)NTOK * 512 * 2));
    P.K = (bf16_t*)(ws + carve(off, (size_t)NTOK * 128 * 2));
    P.VT = (bf16_t*)(ws + carve(off, (size_t)NTOK * 128 * 2));
    P.Kc = (bf16_t*)(ws + carve(off, (size_t)NCTX * 128 * 2));
    P.VcT = (bf16_t*)(ws + carve(off, (size_t)NCTX * 128 * 2));
    const size_t regC = off;
    P.GB = (bf16_t*)(ws + carve(off, (size_t)NTOK * 512 * 2));
    P.GC = (bf16_t*)(ws + carve(off, (size_t)NTOK * 512 * 2));
    P.U = (bf16_t*)(ws + carve(off, (size_t)NTOK * 512 * 2));
    P.M1 = (bf16_t*)(ws + regC);
    const size_t regD = off;
    P.GA = (bf16_t*)(ws + carve(off, (size_t)NTOK * DM * 2));
    P.GV = (bf16_t*)(ws + carve(off, (size_t)NTOK * DM * 2));
    P.AO = (bf16_t*)(ws + carve(off, (size_t)NTOK * 512 * 2));
    P.H2q = (signed char*)P.AO;
    P.CA = (bf16_t*)(ws + carve(off, (size_t)NTOK * 512 * 2));
    P.X1 = (float*)(ws + regD);
    P.bar = (unsigned*)(ws + carve(off, (size_t)XCD_BAR_WORDS * 4));
    const size_t need = off;
    { size_t o2 = regB;
      P.sel_idx = (int*)(ws + carve(o2, (size_t)NTOK * 128 * 4));
      P.sel_g = (float*)(ws + carve(o2, (size_t)NTOK * 128 * 4));
      if (o2 > regC) { fprintf(stderr, "kernel_launch: late buffers overflow\n"); return; } }
    if (need > ws_size) { fprintf(stderr, "kernel_launch: workspace too small: need %zu have %zu\n", need, ws_size); return; }

#ifdef MULTI_LAUNCH
    static bool attr_done = false;
    if (!attr_done) {
#define SETA(PH) hipFuncSetAttribute((const void*)k_phase<PH>, hipFuncAttributeMaxDynamicSharedMemorySize, MEGA_LDS)
        SETA(0); SETA(1); SETA(2); SETA(3); SETA(4); SETA(5); SETA(6); SETA(7); SETA(8);
        attr_done = true;
    }
#define LP(PH) k_phase<PH><<<512, 256, MEGA_LDS, stream>>>(P)
    LP(0); LP(1); LP(2); LP(3); LP(4); LP(5); LP(6); LP(7); LP(8);
#else
    static int grid_blocks = 0;
    if (!grid_blocks) {
        int dev = 0, cus = 0, per_cu = 0;
        (void)hipGetDevice(&dev);
        (void)hipDeviceGetAttribute(&cus, hipDeviceAttributeMultiprocessorCount, dev);
        (void)hipFuncSetAttribute((const void*)k_mega, hipFuncAttributeMaxDynamicSharedMemorySize, MEGA_LDS + 16);
        (void)hipOccupancyMaxActiveBlocksPerMultiprocessor(&per_cu, (const void*)k_mega, 256, MEGA_LDS + 16);
        if (per_cu > 2) per_cu = 2;
        if (per_cu < 1) { fprintf(stderr, "kernel_launch: occupancy query returned %d\n", per_cu); per_cu = 1; }
        grid_blocks = cus * per_cu;
    }
    (void)hipMemsetAsync(P.bar, 0, (size_t)XCD_BAR_WORDS * 4, stream);
    void* args[] = { &P };
    hipError_t e = hipLaunchCooperativeKernel((const void*)k_mega, dim3(grid_blocks), dim3(256), args, MEGA_LDS + 16, stream);
    if (e != hipSuccess) fprintf(stderr, "cooperative launch failed: %s (grid %d)\n", hipGetErrorString(e), grid_blocks);
#endif
}
```

```cpp
#include <hip/hip_runtime.h>
#include <cstdio>
#include <cstdint>

typedef unsigned short bf16_t;
typedef short bf16x8 __attribute__((ext_vector_type(8)));
typedef float f32x4 __attribute__((ext_vector_type(4)));
typedef unsigned u32x4 __attribute__((ext_vector_type(4)));
typedef unsigned u32x2 __attribute__((ext_vector_type(2)));

constexpr int DM = 1024, NB = 16, SEQ = 2048, NTOK = NB * SEQ, CTXL = 256, NCTX = NB * CTXL;
constexpr int PROJW = 4352;
constexpr int NMOD = 6 * DM;
constexpr int NEXP = 16384;

__device__ __forceinline__ float bf2f(bf16_t x) { return __uint_as_float(((unsigned)x) << 16); }
__device__ __forceinline__ bf16_t f2bf(float f) {
    unsigned u = __float_as_uint(f);
    u += 0x7fffu + ((u >> 16) & 1u);
    return (bf16_t)(u >> 16);
}
__device__ __forceinline__ unsigned pk2(float lo, float hi) { return (unsigned)f2bf(lo) | ((unsigned)f2bf(hi) << 16); }
__device__ __forceinline__ float sigmoidf_(float x) { return 1.f / (1.f + __expf(-x)); }
__device__ __forceinline__ float wave_sum(float v) {
#pragma unroll
    for (int o = 1; o < 64; o <<= 1) v += __shfl_xor(v, o);
    return v;
}

__device__ __forceinline__ float wave_max(float v) {
#pragma unroll
    for (int o = 1; o < 64; o <<= 1) v = fmaxf(v, __shfl_xor(v, o));
    return v;
}
__device__ __forceinline__ unsigned q8(float x, float inv, int bias) {
    int q = (int)rintf(x * inv); q = q > 127 ? 127 : (q < -127 ? -127 : q);
    return (unsigned)((q + bias) & 0xff);
}
__device__ __forceinline__ void load_row16(const float* src, int lane, f32x4 (&v)[4]) {
#pragma unroll
    for (int j = 0; j < 4; ++j) v[j] = *(const f32x4*)(src + 16 * lane + 4 * j);
}
__device__ __forceinline__ void quant_row(f32x4 (&v)[4], unsigned char* dst, float* scale_out, int lane, int bias) {
    float amax = 0.f;
#pragma unroll
    for (int j = 0; j < 4; ++j) amax = fmaxf(amax, fmaxf(fmaxf(fabsf(v[j].x), fabsf(v[j].y)), fmaxf(fabsf(v[j].z), fabsf(v[j].w))));
    amax = wave_max(amax);
    const float sc = amax > 0.f ? amax * (1.f / 127.f) : 1.f, inv = 1.f / sc;
    u32x4 w;
    w.x = q8(v[0].x, inv, bias) | (q8(v[0].y, inv, bias) << 8) | (q8(v[0].z, inv, bias) << 16) | (q8(v[0].w, inv, bias) << 24);
    w.y = q8(v[1].x, inv, bias) | (q8(v[1].y, inv, bias) << 8) | (q8(v[1].z, inv, bias) << 16) | (q8(v[1].w, inv, bias) << 24);
    w.z = q8(v[2].x, inv, bias) | (q8(v[2].y, inv, bias) << 8) | (q8(v[2].z, inv, bias) << 16) | (q8(v[2].w, inv, bias) << 24);
    w.w = q8(v[3].x, inv, bias) | (q8(v[3].y, inv, bias) << 8) | (q8(v[3].z, inv, bias) << 16) | (q8(v[3].w, inv, bias) << 24);
    *(u32x4*)(dst + 16 * lane) = w;
    if (lane == 0) *scale_out = sc;
}

struct Params {
    const float *x, *c, *ctx, *c_ctx, *w_mod, *b_mod, *n1, *n2, *w_in, *sink, *conv_w, *w_ao, *w_co, *w_mix, *pw_q, *keys, *pu, *pv, *fg;
    float* out;
    float *modp, *mod, *rope;
    bf16_t *WinT, *WaoT, *WcoT, *WmixT, *PwqT, *KeysB;
    bf16_t *H, *HC, *Q, *K, *VT, *Kc, *VcT, *GB, *GC, *U, *GA, *GV, *AO, *CA, *M1, *YG, *H2, *QH;
    float* TKv; int* TKi;
    int* sel_idx; float* sel_g;
    bf16_t* X1;
    unsigned* bar;
    signed char *Uq, *H2q; unsigned char* Vq; float *su, *sv, *sh2;
};

__device__ __forceinline__ void modp_item(const Params& P, int item, char* smem) {
    float (*s)[128] = (float (*)[128])smem;
    const int kc = item / 24, nc = item % 24;
    __syncthreads();
    for (int i = threadIdx.x; i < 17 * 128; i += 256) {
        const int r = i / 128, k = i % 128;
        const float v = (r < 16) ? P.c[r * DM + kc * 128 + k] : P.c_ctx[kc * 128 + k];
        s[r][k] = v / (1.f + __expf(-v));
    }
    __syncthreads();
    const int n = nc * 256 + threadIdx.x;
    float acc[17];
#pragma unroll
    for (int r = 0; r < 17; ++r) acc[r] = 0.f;
    for (int k = 0; k < 128; ++k) {
        const float w = P.w_mod[(size_t)(kc * 128 + k) * NMOD + n];
#pragma unroll
        for (int r = 0; r < 17; ++r) acc[r] += s[r][k] * w;
    }
#pragma unroll
    for (int r = 0; r < 17; ++r) P.modp[((size_t)kc * 17 + r) * NMOD + n] = acc[r];
}
__device__ __forceinline__ void cvt_range(const float* src, bf16_t* dst, size_t n8, size_t gtid, size_t gsize) {
    for (size_t i = gtid; i < n8; i += gsize) {
        const f32x4 a = *(const f32x4*)(src + i * 8), b = *(const f32x4*)(src + i * 8 + 4);
        u32x4 o; o.x = pk2(a.x, a.y); o.y = pk2(a.z, a.w); o.z = pk2(b.x, b.y); o.w = pk2(b.z, b.w);
        *(u32x4*)(dst + i * 8) = o;
    }
}
__device__ __forceinline__ void rope_tab(const Params& P, int gtid, int gsize) {
    for (int i = gtid; i < 1536; i += gsize) {
        int pos, f; bool isc;
        if (i < 512) { pos = i / 16; f = i % 16; isc = false; } else { pos = (i - 512) / 16; f = (i - 512) % 16; isc = true; }
        const double inv = pow(10000.0, -(double)f / 16.0);
        const double ang = (double)pos * inv;
        const float cv = (float)cos(ang), sv = (float)sin(ang);
        if (!isc) { P.rope[pos * 16 + f] = cv; P.rope[512 + pos * 16 + f] = sv; }
        else { P.rope[1024 + pos * 16 + f] = cv; P.rope[2048 + pos * 16 + f] = sv; }
    }
}
__device__ __forceinline__ void transpose_tile(const float* W, int K, int N, bf16_t* Wt, int item, float (*tile)[65]) {
    const int ntn = N / 64, kt = item / ntn, nt = item % ntn, k0 = kt * 64, n0 = nt * 64;
    const int tx = threadIdx.x & 63, ty = threadIdx.x >> 6;
    __syncthreads();
#pragma unroll
    for (int i = 0; i < 16; ++i) { const int k = i * 4 + ty; tile[k][tx] = W[(size_t)(k0 + k) * N + n0 + tx]; }
    __syncthreads();
#pragma unroll
    for (int i = 0; i < 16; ++i) { const int n = i * 4 + ty; Wt[(size_t)(n0 + n) * K + k0 + tx] = f2bf(tile[tx][n]); }
}

__device__ __forceinline__ void load_row4_bf(const bf16_t* xr, int lane, f32x4 (&v)[4]) {
#pragma unroll
    for (int j = 0; j < 4; ++j) { const u32x2 w = *(const u32x2*)(xr + j * 256 + lane * 4);
        v[j].x = bf2f(w.x & 0xffff); v[j].y = bf2f(w.x >> 16); v[j].z = bf2f(w.y & 0xffff); v[j].w = bf2f(w.y >> 16); }
}
__device__ __forceinline__ void load_row4(const float* xr, int lane, f32x4 (&v)[4]) {
#pragma unroll
    for (int j = 0; j < 4; ++j) v[j] = *(const f32x4*)(xr + j * 256 + lane * 4);
}
__device__ __forceinline__ void norm_row(f32x4 (&v)[4], const float* g, const float* scale, const float* shift, bf16_t* dst, int lane) {
    float s = 0.f;
#pragma unroll
    for (int j = 0; j < 4; ++j) s += v[j].x * v[j].x + v[j].y * v[j].y + v[j].z * v[j].z + v[j].w * v[j].w;
    s = wave_sum(s);
    const float rstd = rsqrtf(s * (1.f / DM) + 1e-6f);
#pragma unroll
    for (int j = 0; j < 4; ++j) {
        const int d = j * 256 + lane * 4;
        const f32x4 gg = *(const f32x4*)(g + d), sc = *(const f32x4*)(scale + d), sh = *(const f32x4*)(shift + d);
        const float y0 = v[j].x * rstd * gg.x * (1.f + sc.x) + sh.x;
        const float y1 = v[j].y * rstd * gg.y * (1.f + sc.y) + sh.y;
        const float y2 = v[j].z * rstd * gg.z * (1.f + sc.z) + sh.z;
        const float y3 = v[j].w * rstd * gg.w * (1.f + sc.w) + sh.w;
        u32x2 o; o.x = pk2(y0, y1); o.y = pk2(y2, y3);
        *(u32x2*)(dst + d) = o;
    }
}

__device__ __forceinline__ void norm_row_q(f32x4 (&v)[4], const float* g, const float* scale, const float* shift, bf16_t* dst, signed char* dq, float* sq, int lane) {
    float s = 0.f;
#pragma unroll
    for (int j = 0; j < 4; ++j) s += v[j].x * v[j].x + v[j].y * v[j].y + v[j].z * v[j].z + v[j].w * v[j].w;
    s = wave_sum(s);
    const float rstd = rsqrtf(s * (1.f / DM) + 1e-6f);
    float amax = 0.f;
#pragma unroll
    for (int j = 0; j < 4; ++j) {
        const int d = j * 256 + lane * 4;
        const f32x4 gg = *(const f32x4*)(g + d), sc = *(const f32x4*)(scale + d), sh = *(const f32x4*)(shift + d);
        v[j].x = v[j].x * rstd * gg.x * (1.f + sc.x) + sh.x;
        v[j].y = v[j].y * rstd * gg.y * (1.f + sc.y) + sh.y;
        v[j].z = v[j].z * rstd * gg.z * (1.f + sc.z) + sh.z;
        v[j].w = v[j].w * rstd * gg.w * (1.f + sc.w) + sh.w;
        u32x2 o; o.x = pk2(v[j].x, v[j].y); o.y = pk2(v[j].z, v[j].w);
        *(u32x2*)(dst + d) = o;
        amax = fmaxf(amax, fmaxf(fmaxf(fabsf(v[j].x), fabsf(v[j].y)), fmaxf(fabsf(v[j].z), fabsf(v[j].w))));
    }
    amax = wave_max(amax);
    const float qs = amax > 0.f ? amax * (1.f / 127.f) : 1.f, inv = 1.f / qs;
#pragma unroll
    for (int j = 0; j < 4; ++j) {
        const unsigned w = q8(v[j].x, inv, 0) | (q8(v[j].y, inv, 0) << 8) | (q8(v[j].z, inv, 0) << 16) | (q8(v[j].w, inv, 0) << 24);
        *(unsigned*)(dq + j * 256 + lane * 4) = w;
    }
    if (lane == 0) *sq = qs;
}

__device__ __forceinline__ void norm1_rows(const Params& P, bool isctx, int row0, int nrows, char* smem) {
    float* sc = (float*)smem; float* sh = sc + DM;
    const int r = isctx ? 16 : row0 / SEQ;
    __syncthreads();
    for (int d = threadIdx.x; d < DM; d += 256) {
        float a = P.b_mod[DM + d], b = P.b_mod[d];
#pragma unroll
        for (int kc = 0; kc < 8; ++kc) { a += P.modp[((size_t)kc * 17 + r) * NMOD + DM + d]; b += P.modp[((size_t)kc * 17 + r) * NMOD + d]; }
        sc[d] = a; sh[d] = b;
    }
    __syncthreads();
    const int lane = threadIdx.x & 63, wid = threadIdx.x >> 6;
    const float* srcb = isctx ? P.ctx : P.x; bf16_t* dstb = isctx ? P.HC : P.H;
    for (int i = wid; i < nrows; i += 8) {
        const int ra = row0 + i, rb = row0 + i + 4; const bool hb = (i + 4) < nrows;
        f32x4 va[4], vb[4];
        load_row4(srcb + (size_t)ra * DM, lane, va); if (hb) load_row4(srcb + (size_t)rb * DM, lane, vb);
        norm_row(va, P.n1, sc, sh, dstb + (size_t)ra * DM, lane);
        if (hb) norm_row(vb, P.n1, sc, sh, dstb + (size_t)rb * DM, lane);
    }
}
enum { MODE_INPROJ = 0, MODE_CTXKV = 1, MODE_AO1 = 2, MODE_CO2 = 3, MODE_MIX = 4, MODE_QH = 5 };

__device__ __forceinline__ void st8bf(bf16_t* p, const float* v) {
    u32x4 o; o.x = pk2(v[0], v[1]); o.y = pk2(v[2], v[3]); o.z = pk2(v[4], v[5]); o.w = pk2(v[6], v[7]);
    *(u32x4*)p = o;
}
__device__ __forceinline__ void st4bf(bf16_t* p, const float* v) {
    u32x2 o; o.x = pk2(v[0], v[1]); o.y = pk2(v[2], v[3]);
    *(u32x2*)p = o;
}
template <int MODE> __device__ __forceinline__ void epi8(const Params& P, int m, int n, const float* v, int aux) {
    if (MODE == MODE_INPROJ) {
        if (n < 1280) st8bf(P.GB + (size_t)m * 512 + (n - 768), v);
        else if (n < 1792) st8bf(P.GC + (size_t)m * 512 + (n - 1280), v);
        else if (n < 2304) st8bf(P.U + (size_t)m * 512 + (n - 1792), v);
        else {
            float s[8];
#pragma unroll
            for (int j = 0; j < 8; ++j) s[j] = sigmoidf_(v[j]);
            if (n < 3328) st8bf(P.GA + (size_t)m * DM + (n - 2304), s);
            else st8bf(P.GV + (size_t)m * DM + (n - 3328), s);
        }
    } else if (MODE == MODE_CTXKV) {
        { const int b = m / CTXL, c = m % CTXL, kvh = n >> 6, d0 = n & 63;
          st8bf(P.Kc + ((((size_t)((b * 2 + kvh) * 8 + (c >> 5)) * 4 + (d0 >> 4)) * 2 + ((d0 >> 3) & 1)) * 32 + (c & 31)) * 8, v); }
    } else if (MODE == MODE_AO1) {
        const u32x4 g = *(const u32x4*)((aux ? P.GV : P.GA) + (size_t)m * DM + n);
        u32x4 a = (u32x4){0u, 0u, 0u, 0u};
        if (aux) a = *(const u32x4*)(P.M1 + (size_t)m * DM + n);
        float o[8];
        o[0] = bf2f(a.x & 0xffff) + v[0] * bf2f(g.x & 0xffff); o[1] = bf2f(a.x >> 16) + v[1] * bf2f(g.x >> 16);
        o[2] = bf2f(a.y & 0xffff) + v[2] * bf2f(g.y & 0xffff); o[3] = bf2f(a.y >> 16) + v[3] * bf2f(g.y >> 16);
        o[4] = bf2f(a.z & 0xffff) + v[4] * bf2f(g.z & 0xffff); o[5] = bf2f(a.z >> 16) + v[5] * bf2f(g.z >> 16);
        o[6] = bf2f(a.w & 0xffff) + v[6] * bf2f(g.w & 0xffff); o[7] = bf2f(a.w >> 16) + v[7] * bf2f(g.w >> 16);
        st8bf((aux ? P.YG : P.M1) + (size_t)m * DM + n, o);
    } else if (MODE == MODE_MIX) {
        const int b = m / SEQ;
        const float* g1 = P.mod + (size_t)b * NMOD + 2 * DM + n;
        const float* xr = P.x + (size_t)m * DM + n;
        const f32x4 x0 = *(const f32x4*)xr, x1 = *(const f32x4*)(xr + 4), g0 = *(const f32x4*)g1, g1v = *(const f32x4*)(g1 + 4);
        float o[8];
        o[0] = x0.x + g0.x * v[0]; o[1] = x0.y + g0.y * v[1]; o[2] = x0.z + g0.z * v[2]; o[3] = x0.w + g0.w * v[3];
        o[4] = x1.x + g1v.x * v[4]; o[5] = x1.y + g1v.y * v[5]; o[6] = x1.z + g1v.z * v[6]; o[7] = x1.w + g1v.w * v[7];
        st8bf(P.X1 + (size_t)m * DM + n, o);
    } else if (MODE == MODE_QH) {
        st8bf(P.QH + (size_t)m * 2048 + n, v);
    }
}
__device__ __forceinline__ void epi_rope(const Params& P, int m, int n, const float* lo, const float* hi) {
    const int d0 = n & 63;
    const int l = m % SEQ;
    const float *ct, *st;
    if (d0 < 16) { const int row = l >> 6; ct = P.rope + row * 16 + d0; st = P.rope + 512 + row * 16 + d0; }
    else { const int col = l & 63; ct = P.rope + 1024 + col * 16 + (d0 - 32); st = P.rope + 2048 + col * 16 + (d0 - 32); }
    float a[4], b[4];
    const float sc = (n < 512) ? 0.125f : 1.f;
#pragma unroll
    for (int j = 0; j < 4; ++j) { const float cc = ct[j], ss = st[j]; a[j] = (lo[j] * cc - hi[j] * ss) * sc; b[j] = (lo[j] * ss + hi[j] * cc) * sc; }
    if (n < 512) { st4bf(P.Q + (size_t)m * 512 + n, a); st4bf(P.Q + (size_t)m * 512 + n + 16, b); }
    else { const int bb = m / SEQ, kvh = (n - 512) >> 6;
        bf16_t* kp = P.K + ((((size_t)((bb * 2 + kvh) * 64 + (l >> 5)) * 4 + (d0 >> 4)) * 2 + ((d0 >> 3) & 1)) * 32 + (l & 31)) * 8 + (d0 & 7);
        st4bf(kp, a); st4bf(kp + 512, b); }
}
__device__ __forceinline__ void epi_v4(const Params& P, int m, int dcol, const float* v, bool ctx) {
    const int kvh = dcol >> 6, dd = dcol & 63;
    if (!ctx) { const int b = m / SEQ, l = m % SEQ;
#pragma unroll
        for (int j = 0; j < 4; ++j) {
            const int kk = l & 31;
            P.VT[(((((size_t)((b * 2 + kvh) * 64 + (l >> 5)) * 2 + (dd >> 5)) * 2 + (kk >> 4)) * 2 + ((kk >> 2) & 1)) * 32 + ((dd & 31) + j)) * 8 + 4 * ((kk >> 3) & 1) + (kk & 3)] = f2bf(v[j]); }
    } else { const int b = m / CTXL, cpos = m % CTXL;
#pragma unroll
        for (int j = 0; j < 4; ++j) {
            const int kk = cpos & 31;
            P.VcT[(((((size_t)((b * 2 + kvh) * 8 + (cpos >> 5)) * 2 + (dd >> 5)) * 2 + (kk >> 4)) * 2 + ((kk >> 2) & 1)) * 32 + ((dd & 31) + j)) * 8 + 4 * ((kk >> 3) & 1) + (kk & 3)] = f2bf(v[j]); }
    }
}

constexpr int GEMM_LDS = 65536;
constexpr int RETR_LDS = 128 * 130 * 4;
__device__ __forceinline__ int lds_off(int row, int chunk) { return row * 128 + ((chunk ^ ((row >> 1) & 7)) << 4); }

__device__ __forceinline__ void mma_from_lds(const char* As, const char* Bs, f32x4 (&acc)[4][4], int wm, int wn, int fr, int fq, int sw) {
#pragma unroll
    for (int ks = 0; ks < 2; ++ks) {
        bf16x8 af[4], bfr[4];
        const int coff = ((ks * 4 + fq) ^ sw) << 4;
#pragma unroll
        for (int mt = 0; mt < 4; ++mt) af[mt] = *(const bf16x8*)(As + (wm * 64 + mt * 16 + fr) * 128 + coff);
#pragma unroll
        for (int nt = 0; nt < 4; ++nt) bfr[nt] = *(const bf16x8*)(Bs + (wn * 64 + nt * 16 + fr) * 128 + coff);
#pragma unroll
        for (int mt = 0; mt < 4; ++mt)
#pragma unroll
            for (int nt = 0; nt < 4; ++nt) acc[mt][nt] = __builtin_amdgcn_mfma_f32_16x16x32_bf16(bfr[nt], af[mt], acc[mt][nt], 0, 0, 0);
    }
}
__device__ __forceinline__ void gemm_mainloop(const bf16_t* __restrict__ A, int lda, const bf16_t* __restrict__ Bt, int ldb, int K, int m0, int n0, bool perm, char* smem, f32x4 (&acc)[4][4]) {
    const int tid = threadIdx.x, lane = tid & 63, wid = tid >> 6;
    const int wm = wid >> 1, wn = wid & 1, fr = lane & 15, fq = lane >> 4;
    const bf16_t* ag[4]; const bf16_t* bg[4];
#pragma unroll
    for (int i = 0; i < 4; ++i) {
        const int row = (wid + 4 * i) * 8 + (lane >> 3);
        const int c = (lane & 7) ^ ((row >> 1) & 7);
        ag[i] = A + (size_t)(m0 + row) * lda + c * 8;
        int brow = row;
        if (perm) { const int g = row >> 5, rr = row & 31, nn = rr >> 4, j = rr & 15; brow = 32 * g + 8 * (j >> 2) + 4 * nn + (j & 3); }
        bg[i] = Bt + (size_t)(n0 + brow) * ldb + c * 8;
    }
#pragma unroll
    for (int i = 0; i < 4; ++i)
#pragma unroll
        for (int j = 0; j < 4; ++j) acc[i][j] = (f32x4){0.f, 0.f, 0.f, 0.f};
#define GSTAGE(buf, k0) { _Pragma("unroll") for (int i = 0; i < 4; ++i) { \
        __builtin_amdgcn_global_load_lds((const unsigned*)(ag[i] + (k0)), (unsigned*)(smem + (buf) * 32768 + (wid + 4 * i) * 1024), 16, 0, 0); \
        __builtin_amdgcn_global_load_lds((const unsigned*)(bg[i] + (k0)), (unsigned*)(smem + (buf) * 32768 + 16384 + (wid + 4 * i) * 1024), 16, 0, 0); } }
    GSTAGE(0, 0)
    asm volatile("s_waitcnt vmcnt(0)" ::: "memory");
    __syncthreads();
    const int nk = K / 64;
    const int sw = (fr >> 1) & 7;
    for (int kt = 0; kt < nk; ++kt) {
        const int cur = kt & 1;
        if (kt + 1 < nk) GSTAGE(cur ^ 1, (kt + 1) * 64)
        mma_from_lds(smem + cur * 32768, smem + cur * 32768 + 16384, acc, wm, wn, fr, fq, sw);
        asm volatile("s_waitcnt vmcnt(0)" ::: "memory");
        __syncthreads();
    }
#undef GSTAGE
}

template <int MT, int NST>
__device__ __forceinline__ void gemm_ring(const bf16_t* __restrict__ A, int lda, const bf16_t* __restrict__ Bt, int ldb, int K, int m0, int n0, bool perm, char* smem, f32x4 (&acc)[MT][4]) {
    constexpr int SA = 2048 * MT, SB = SA + 8192, GA = MT / 2, GL = GA + 2;
    const int tid = threadIdx.x, lane = tid & 63, wid = __builtin_amdgcn_readfirstlane(tid >> 6);
    const int wm = wid >> 1, wn = wid & 1, fr = lane & 15, fq = lane >> 4;
    const int c8 = ((lane & 3) ^ (3 * ((lane >> 4) & 1))) * 8;
    unsigned aoff[GA], boff[2];
#pragma unroll
    for (int i = 0; i < GA; ++i) aoff[i] = (unsigned)(((wid + 4 * i) * 16 + (lane >> 2)) * lda + c8) * 2u;
#pragma unroll
    for (int i = 0; i < 2; ++i) {
        const int row = (wid + 4 * i) * 16 + (lane >> 2);
        int brow = row;
        if (perm) { const int g = row >> 5, rr = row & 31, nn = rr >> 4, j = rr & 15; brow = 32 * g + 8 * (j >> 2) + 4 * nn + (j & 3); }
        boff[i] = (unsigned)(brow * ldb + c8) * 2u;
    }
    const char* Abase = (const char*)(A + (size_t)m0 * lda);
    const char* Bbase = (const char*)(Bt + (size_t)n0 * ldb);
#pragma unroll
    for (int i = 0; i < MT; ++i)
#pragma unroll
        for (int j = 0; j < 4; ++j) acc[i][j] = (f32x4){0.f, 0.f, 0.f, 0.f};
#define RSTAGE_(buf, k0) { char* sb_ = smem + (buf) * SB; const char* ab_ = Abase + (size_t)(k0) * 2; const char* bb_ = Bbase + (size_t)(k0) * 2; \
        _Pragma("unroll") for (int i = 0; i < GA; ++i) __builtin_amdgcn_global_load_lds((const unsigned*)(ab_ + aoff[i]), (unsigned*)(sb_ + (wid + 4 * i) * 1024), 16, 0, 0); \
        _Pragma("unroll") for (int i = 0; i < 2; ++i) __builtin_amdgcn_global_load_lds((const unsigned*)(bb_ + boff[i]), (unsigned*)(sb_ + SA + (wid + 4 * i) * 1024), 16, 0, 0); }
    const int nk = K / 32;
    asm volatile("s_waitcnt vmcnt(0)" ::: "memory");
#pragma unroll
    for (int s = 0; s < NST - 1; ++s) RSTAGE_(s, s * 32)
    const int coff = (fq ^ (3 * ((fr >> 2) & 1))) << 4;
    int cur = 0, nxt = NST - 1;
#pragma unroll 1
    for (int kt = 0; kt < nk; ++kt) {
        const int rem = nk - 1 - kt;
        if (rem >= NST - 2) asm volatile("s_waitcnt vmcnt(%0)" :: "n"(GL * (NST - 2)) : "memory");
        else if (NST == 4 && rem == 1) asm volatile("s_waitcnt vmcnt(%0)" :: "n"(GL) : "memory");
        else asm volatile("s_waitcnt vmcnt(0)" ::: "memory");
        __builtin_amdgcn_s_barrier();
        const char* As = smem + cur * SB;
        const char* Bs = As + SA;
        bf16x8 af[MT], bfr[4];
#pragma unroll
        for (int mt = 0; mt < MT; ++mt) af[mt] = *(const bf16x8*)(As + (wm * 16 * MT + mt * 16 + fr) * 64 + coff);
#pragma unroll
        for (int nt = 0; nt < 4; ++nt) bfr[nt] = *(const bf16x8*)(Bs + (wn * 64 + nt * 16 + fr) * 64 + coff);
        const bool more = (kt + NST - 1 < nk);
        char* sb_ = smem + nxt * SB; const char* ab_ = Abase + (size_t)((kt + NST - 1) * 32) * 2; const char* bb_ = Bbase + (size_t)((kt + NST - 1) * 32) * 2;
        __builtin_amdgcn_s_setprio(1);
#pragma unroll
        for (int mt = 0; mt < MT; ++mt) {
#pragma unroll
            for (int nt = 0; nt < 4; ++nt) acc[mt][nt] = __builtin_amdgcn_mfma_f32_16x16x32_bf16(bfr[nt], af[mt], acc[mt][nt], 0, 0, 0);
            if (more) {
                if (mt < GA) __builtin_amdgcn_global_load_lds((const unsigned*)(ab_ + aoff[mt]), (unsigned*)(sb_ + (wid + 4 * mt) * 1024), 16, 0, 0);
                else if (mt < GA + 2) __builtin_amdgcn_global_load_lds((const unsigned*)(bb_ + boff[mt - GA]), (unsigned*)(sb_ + SA + (wid + 4 * (mt - GA)) * 1024), 16, 0, 0);
            }
        }
        __builtin_amdgcn_s_setprio(0);
        cur = (cur + 1 == NST) ? 0 : cur + 1;
        nxt = (nxt + 1 == NST) ? 0 : nxt + 1;
    }
#undef RSTAGE_
    __syncthreads();
}

template <int MODE, int MT>
__device__ __forceinline__ void gemm_tile(const Params& P, const bf16_t* __restrict__ A, int lda, const bf16_t* __restrict__ Bt, int ldb, int K, int m0, int n0, bool perm, char* smem, int aux = 0) {
    const int lane = threadIdx.x & 63, wid = threadIdx.x >> 6;
    const int wm = wid >> 1, wn = wid & 1, fr = lane & 15, fq = lane >> 4;
    f32x4 acc[MT][4];
    gemm_ring<MT, (MT == 8 ? 3 : 4)>(A, lda, Bt, ldb, K, m0, n0, perm, smem, acc);
#pragma unroll
    for (int mt = 0; mt < MT; ++mt) {
        const int m = m0 + wm * 16 * MT + mt * 16 + fr;
        if (perm) {
#pragma unroll
            for (int p = 0; p < 2; ++p) {
                float v[8] = { acc[mt][2 * p][0], acc[mt][2 * p][1], acc[mt][2 * p][2], acc[mt][2 * p][3], acc[mt][2 * p + 1][0], acc[mt][2 * p + 1][1], acc[mt][2 * p + 1][2], acc[mt][2 * p + 1][3] };
                epi8<MODE>(P, m, n0 + wn * 64 + 32 * p + 8 * fq, v, aux);
            }
        } else if (MODE == MODE_INPROJ && n0 < 640) {
#pragma unroll
            for (int p = 0; p < 2; ++p) {
                float lo[4] = { acc[mt][2 * p][0], acc[mt][2 * p][1], acc[mt][2 * p][2], acc[mt][2 * p][3] };
                float hi[4] = { acc[mt][2 * p + 1][0], acc[mt][2 * p + 1][1], acc[mt][2 * p + 1][2], acc[mt][2 * p + 1][3] };
                epi_rope(P, m, n0 + wn * 64 + 32 * p + 4 * fq, lo, hi);
            }
        } else if (MODE == MODE_INPROJ || MODE == MODE_CTXKV) {
            const int dbase = (MODE == MODE_INPROJ) ? (n0 - 640) : (n0 - 128);
#pragma unroll
            for (int nt = 0; nt < 4; ++nt) {
                float v[4] = { acc[mt][nt][0], acc[mt][nt][1], acc[mt][nt][2], acc[mt][nt][3] };
                epi_v4(P, m, dbase + wn * 64 + 16 * nt + 4 * fq, v, MODE == MODE_CTXKV);
            }
        }
        asm volatile("" ::: "memory"); __builtin_amdgcn_sched_barrier(0);
    }
}
__device__ __forceinline__ void tile_coords(int t, int ntm, int ntn, int& mt, int& nt) {
    const int per = 8 * ntn, g = t / per, r = t % per;
    mt = g * 8 + (r & 7); nt = r >> 3;
}
#define CEU(a, b) { const unsigned _t = (a) > (b) ? (a) : (b); (b) = (a) > (b) ? (b) : (a); (a) = _t; }
__device__ __forceinline__ void sort16_desc(unsigned (&v)[16]) {
    CEU(v[0], v[1]); CEU(v[2], v[3]); CEU(v[0], v[2]); CEU(v[1], v[3]); CEU(v[1], v[2]); CEU(v[4], v[5]);
    CEU(v[6], v[7]); CEU(v[4], v[6]); CEU(v[5], v[7]); CEU(v[5], v[6]); CEU(v[0], v[4]); CEU(v[2], v[6]);
    CEU(v[2], v[4]); CEU(v[1], v[5]); CEU(v[3], v[7]); CEU(v[3], v[5]); CEU(v[1], v[2]); CEU(v[3], v[4]);
    CEU(v[5], v[6]); CEU(v[8], v[9]); CEU(v[10], v[11]); CEU(v[8], v[10]); CEU(v[9], v[11]); CEU(v[9], v[10]);
    CEU(v[12], v[13]); CEU(v[14], v[15]); CEU(v[12], v[14]); CEU(v[13], v[15]); CEU(v[13], v[14]); CEU(v[8], v[12]);
    CEU(v[10], v[14]); CEU(v[10], v[12]); CEU(v[9], v[13]); CEU(v[11], v[15]); CEU(v[11], v[13]); CEU(v[9], v[10]);
    CEU(v[11], v[12]); CEU(v[13], v[14]); CEU(v[0], v[8]); CEU(v[4], v[12]); CEU(v[4], v[8]); CEU(v[2], v[10]);
    CEU(v[6], v[14]); CEU(v[6], v[10]); CEU(v[2], v[4]); CEU(v[6], v[8]); CEU(v[10], v[12]); CEU(v[1], v[9]);
    CEU(v[5], v[13]); CEU(v[5], v[9]); CEU(v[3], v[11]); CEU(v[7], v[15]); CEU(v[7], v[11]); CEU(v[3], v[5]);
    CEU(v[7], v[9]); CEU(v[11], v[13]); CEU(v[1], v[2]); CEU(v[3], v[4]); CEU(v[5], v[6]); CEU(v[7], v[8]);
    CEU(v[9], v[10]); CEU(v[11], v[12]); CEU(v[13], v[14]);
}
__device__ __forceinline__ void bitonic16_desc(unsigned (&v)[16]) {
    CEU(v[0], v[8]); CEU(v[1], v[9]); CEU(v[2], v[10]); CEU(v[3], v[11]); CEU(v[4], v[12]); CEU(v[5], v[13]);
    CEU(v[6], v[14]); CEU(v[7], v[15]); CEU(v[0], v[4]); CEU(v[1], v[5]); CEU(v[2], v[6]); CEU(v[3], v[7]);
    CEU(v[8], v[12]); CEU(v[9], v[13]); CEU(v[10], v[14]); CEU(v[11], v[15]); CEU(v[0], v[2]); CEU(v[1], v[3]);
    CEU(v[4], v[6]); CEU(v[5], v[7]); CEU(v[8], v[10]); CEU(v[9], v[11]); CEU(v[12], v[14]); CEU(v[13], v[15]);
    CEU(v[0], v[1]); CEU(v[2], v[3]); CEU(v[4], v[5]); CEU(v[6], v[7]); CEU(v[8], v[9]); CEU(v[10], v[11]);
    CEU(v[12], v[13]); CEU(v[14], v[15]);
}

__device__ __forceinline__ unsigned enc_key(float f) { const unsigned b = __float_as_uint(f); return b ^ ((unsigned)((int)b >> 31) | 0x80000000u); }
__device__ __forceinline__ float dec_key(unsigned k) { const unsigned b = (k & 0x80000000u) ? (k & 0x7fffffffu) : ~k; return __uint_as_float(b); }
__device__ __forceinline__ void topmerge16(unsigned (&top)[16], const unsigned (&L)[16]) {
#pragma unroll
    for (int i = 0; i < 16; ++i) top[i] = top[i] > L[15 - i] ? top[i] : L[15 - i];
    bitonic16_desc(top);
}
__device__ __forceinline__ unsigned cand_key(float a, float b, int i, int j) { return (enc_key(a + b) & ~0xFFu) | (unsigned)(i << 4) | (unsigned)j; }

__device__ __forceinline__ void peer_retrieve_item(const Params& P, int mtile, int h, char* smem) {
    const int tid = threadIdx.x, lane = tid & 63, wid = tid >> 6;
    const int wm = wid >> 1, wn = wid & 1, fr = lane & 15, fq = lane >> 4;
    const int sw = (fr >> 1) & 7;
    const int m0 = mtile * 128;
    unsigned T0[16], T1[16];
#pragma unroll 1
    for (int p = 0; p < 2; ++p) {
        const int hp = h * 2 + p;
        f32x4 acc[4][4];
        gemm_ring<4, 4>(P.H2, DM, P.PwqT, DM, DM, m0, hp * 128, false, smem, acc);
#pragma unroll
        for (int mt = 0; mt < 4; ++mt)
#pragma unroll
            for (int nt = 0; nt < 4; ++nt) {
                const int row = wm * 64 + mt * 16 + fr;
                u32x2 o; o.x = pk2(acc[mt][nt][0], acc[mt][nt][1]); o.y = pk2(acc[mt][nt][2], acc[mt][nt][3]);
                *(u32x2*)(smem + wn * 32768 + lds_off(row, 2 * nt + (fq >> 1)) + (fq & 1) * 8) = o;
            }
        {
            const int srow = tid >> 3, schunk = tid & 7;
            const bf16_t* kb = P.KeysB + (size_t)hp * 128 * 128;
#pragma unroll
            for (int hf = 0; hf < 2; ++hf)
#pragma unroll
                for (int q = 0; q < 4; ++q) {
                    const int row = q * 32 + srow;
                    const u32x4 v = *(const u32x4*)(kb + (size_t)row * 128 + hf * 64 + schunk * 8);
                    *(u32x4*)(smem + hf * 32768 + 16384 + lds_off(row, schunk)) = v;
                }
        }
        __syncthreads();
#pragma unroll
        for (int i = 0; i < 4; ++i)
#pragma unroll
            for (int j = 0; j < 4; ++j) acc[i][j] = (f32x4){0.f, 0.f, 0.f, 0.f};
        mma_from_lds(smem, smem + 16384, acc, wm, wn, fr, fq, sw);
        mma_from_lds(smem + 32768, smem + 32768 + 16384, acc, wm, wn, fr, fq, sw);
        __syncthreads();
        float* sc = (float*)smem;
#pragma unroll
        for (int mt = 0; mt < 4; ++mt)
#pragma unroll
            for (int nt = 0; nt < 4; ++nt) {
                const int row = wm * 64 + mt * 16 + fr;
#pragma unroll
                for (int r = 0; r < 4; ++r) {
                    const int col = wn * 64 + nt * 16 + fq * 4 + r;
                    sc[row * 130 + wn * 65 + (col & 63)] = acc[mt][nt][r];
                }
            }
        __syncthreads();
        {
            const int row = tid >> 1, half = tid & 1;
            const float* rp = sc + row * 130 + half * 65;
            unsigned top[16];
#pragma unroll 1
            for (int g = 0; g < 4; ++g) {
                unsigned L[16];
#pragma unroll
                for (int j = 0; j < 16; ++j) { const int col = half * 64 + g * 16 + j; L[j] = (enc_key(rp[g * 16 + j]) & ~0x7Fu) | (unsigned)col; }
                sort16_desc(L);
                if (g == 0) {
#pragma unroll
                    for (int j = 0; j < 16; ++j) top[j] = L[j];
                } else topmerge16(top, L);
            }
            unsigned Bp[16];
#pragma unroll
            for (int j = 0; j < 16; ++j) Bp[j] = (unsigned)__shfl_xor((int)top[j], 1);
            topmerge16(top, Bp);
            if (p == 0) {
#pragma unroll
                for (int j = 0; j < 16; ++j) T0[j] = top[j];
            } else {
#pragma unroll
                for (int j = 0; j < 16; ++j) T1[j] = top[j];
            }
        }
        __syncthreads();
    }
    {
        const int row = tid >> 1;
        unsigned char* slot = (unsigned char*)smem + row * 32;
        if ((tid & 1) == 0) {
#pragma unroll
            for (int j = 0; j < 16; ++j) { slot[j] = (unsigned char)(T0[j] & 0x7Fu); slot[16 + j] = (unsigned char)(T1[j] & 0x7Fu); }
            float a[16], b[16];
#pragma unroll
            for (int j = 0; j < 16; ++j) { a[j] = dec_key(T0[j]); b[j] = dec_key(T1[j]); }
            unsigned LA[16], LB[16], LC[16];
#pragma unroll
            for (int j = 0; j < 16; ++j) LA[j] = cand_key(a[0], b[j], 0, j);
#pragma unroll
            for (int j = 0; j < 8; ++j) LB[j] = cand_key(a[1], b[j], 1, j);
#pragma unroll
            for (int j = 0; j < 8; ++j) LB[8 + j] = cand_key(a[15 - j], b[0], 15 - j, 0);
            LC[0] = cand_key(a[2], b[0], 2, 0); LC[1] = cand_key(a[2], b[1], 2, 1); LC[2] = cand_key(a[2], b[2], 2, 2); LC[3] = cand_key(a[2], b[3], 2, 3); LC[4] = cand_key(a[2], b[4], 2, 4);
            LC[5] = cand_key(a[3], b[0], 3, 0); LC[6] = cand_key(a[3], b[1], 3, 1); LC[7] = cand_key(a[3], b[2], 3, 2); LC[8] = cand_key(a[3], b[3], 3, 3);
            LC[9] = cand_key(a[4], b[0], 4, 0); LC[10] = cand_key(a[4], b[1], 4, 1); LC[11] = cand_key(a[4], b[2], 4, 2);
            LC[12] = cand_key(a[5], b[0], 5, 0); LC[13] = cand_key(a[5], b[1], 5, 1);
            LC[14] = cand_key(a[6], b[0], 6, 0); LC[15] = cand_key(a[6], b[1], 6, 1);
            const unsigned d0 = cand_key(a[7], b[0], 7, 0), d1 = cand_key(a[7], b[1], 7, 1);
            bitonic16_desc(LB);
            sort16_desc(LC);
            topmerge16(LA, LB);
            LC[15] = LC[15] > d0 ? LC[15] : d0; LC[14] = LC[14] > d1 ? LC[14] : d1;
            bitonic16_desc(LC);
            topmerge16(LA, LC);
            float e[16], den = 0.f; const float vmax = dec_key(LA[0]);
#pragma unroll
            for (int r = 0; r < 16; ++r) { e[r] = __expf(dec_key(LA[r]) - vmax); den += e[r]; }
            const float inv = 1.f / den;
            const int t = m0 + row;
            int* oi = P.sel_idx + (size_t)t * 128 + h * 16; float* og = P.sel_g + (size_t)t * 128 + h * 16;
#pragma unroll
            for (int r = 0; r < 16; ++r) {
                const int i = (LA[r] >> 4) & 15, j = LA[r] & 15;
                oi[r] = (int)slot[i] * 128 + (int)slot[16 + j];
                og[r] = e[r] * inv;
            }
        }
    }
    __syncthreads();
}
typedef float f32x16 __attribute__((ext_vector_type(16)));
struct AttnFrag { u32x4 k[4]; u32x4 v[2][2]; };
__device__ __forceinline__ void attn_load(const Params& P, int b, int kvh, int qb, int w, int blk, int r, int hh, AttnFrag& f) {
    const bf16_t* kp; const bf16_t* vp;
    if (blk < 9) {
        int kpos0 = (qb - 1) * 128 + 32 * (w + blk);
        if (kpos0 < 0 || kpos0 >= SEQ) kpos0 = 0;
        const size_t blkoff = (size_t)((b * 2 + kvh) * 64 + (kpos0 >> 5)) * 2048 + (hh * 32 + r) * 8;
        kp = P.K + blkoff; vp = P.VT + blkoff;
    } else {
        const size_t blkoff = (size_t)((b * 2 + kvh) * 8 + (blk - 9)) * 2048 + (hh * 32 + r) * 8;
        kp = P.Kc + blkoff; vp = P.VcT + blkoff;
    }
#pragma unroll
    for (int ks = 0; ks < 4; ++ks) f.k[ks] = *(const u32x4*)(kp + 512 * ks);
#pragma unroll
    for (int db = 0; db < 2; ++db)
#pragma unroll
        for (int s = 0; s < 2; ++s) f.v[db][s] = *(const u32x4*)(vp + 512 * (db * 2 + s));
}
__device__ __forceinline__ void attn_item(const Params& P, int item) {
    const int head = item & 7, qb = (item >> 3) & 15, b = item >> 7, kvh = head >> 2;
    const int lane = threadIdx.x & 63, w = threadIdx.x >> 6, r = lane & 31, hh = lane >> 5;
    const int tok = b * SEQ + qb * 128 + 32 * w + r;
    bf16x8 qf[4];
    { const bf16_t* qp = P.Q + (size_t)tok * 512 + head * 64 + 8 * hh;
#pragma unroll
      for (int ks = 0; ks < 4; ++ks) qf[ks] = *(const bf16x8*)(qp + 16 * ks); }
    f32x16 o0, o1;
#pragma unroll
    for (int i = 0; i < 16; ++i) { o0[i] = 0.f; o1[i] = 0.f; }
    float mrun = P.sink[head], lrun = (hh == 0) ? 1.f : 0.f;
    AttnFrag cur, nxt;
    attn_load(P, b, kvh, qb, w, 0, r, hh, cur);
    for (int blk = 0; blk < 17; ++blk) {
        if (blk + 1 < 17) attn_load(P, b, kvh, qb, w, blk + 1, r, hh, nxt);
        int lo = 0, hi = 31;
        if (blk < 9) {
            const int kpos0 = (qb - 1) * 128 + 32 * (w + blk);
            if (kpos0 < 0 || kpos0 >= SEQ) lo = 64;
            else if (blk == 0) lo = r;
            else if (blk == 8) hi = r;
        }
        f32x16 s;
#pragma unroll
        for (int i = 0; i < 16; ++i) s[i] = 0.f;
#pragma unroll
        for (int ks = 0; ks < 4; ++ks) s = __builtin_amdgcn_mfma_f32_32x32x16_bf16(*(const bf16x8*)&cur.k[ks], qf[ks], s, 0, 0, 0);
        float mb = -3.0e38f;
#pragma unroll
        for (int i = 0; i < 16; ++i) { const int kk = (i & 3) + 8 * (i >> 2) + 4 * hh; const bool ok = (kk >= lo) && (kk <= hi); s[i] = ok ? s[i] : -3.0e38f; mb = fmaxf(mb, s[i]); }
        mb = fmaxf(mb, __shfl_xor(mb, 32));
        const float mn = fmaxf(mrun, mb);
        const float alpha = __expf(mrun - mn);
        float ps = 0.f; float p[16];
#pragma unroll
        for (int i = 0; i < 16; ++i) { p[i] = __expf(s[i] - mn); ps += p[i]; }
        lrun = lrun * alpha + ps; mrun = mn;
#pragma unroll
        for (int i = 0; i < 16; ++i) { o0[i] *= alpha; o1[i] *= alpha; }
        u32x4 pb[2];
        pb[0].x = pk2(p[0], p[1]); pb[0].y = pk2(p[2], p[3]); pb[0].z = pk2(p[4], p[5]); pb[0].w = pk2(p[6], p[7]);
        pb[1].x = pk2(p[8], p[9]); pb[1].y = pk2(p[10], p[11]); pb[1].z = pk2(p[12], p[13]); pb[1].w = pk2(p[14], p[15]);
#pragma unroll
        for (int sI = 0; sI < 2; ++sI) {
            const u32x4 va = cur.v[0][sI], vb = cur.v[1][sI];
            o0 = __builtin_amdgcn_mfma_f32_32x32x16_bf16(*(const bf16x8*)&va, *(const bf16x8*)&pb[sI], o0, 0, 0, 0);
            o1 = __builtin_amdgcn_mfma_f32_32x32x16_bf16(*(const bf16x8*)&vb, *(const bf16x8*)&pb[sI], o1, 0, 0, 0);
        }
        if (blk + 1 < 17) cur = nxt;
    }
    const float ltot = lrun + __shfl_xor(lrun, 32);
    const float inv = 1.f / ltot;
    bf16_t* op = P.AO + (size_t)tok * 512 + head * 64 + 4 * hh;
#pragma unroll
    for (int g = 0; g < 4; ++g) {
        float t0[4] = { o0[4 * g] * inv, o0[4 * g + 1] * inv, o0[4 * g + 2] * inv, o0[4 * g + 3] * inv };
        float t1[4] = { o1[4 * g] * inv, o1[4 * g + 1] * inv, o1[4 * g + 2] * inv, o1[4 * g + 3] * inv };
        st4bf(op + 8 * g, t0); st4bf(op + 32 + 8 * g, t1);
    }
}

__device__ __forceinline__ void conv_range(const Params& P, size_t gtid, size_t gsize) {
    for (size_t idx = gtid; idx < (size_t)NTOK * 64; idx += gsize) {
        const int m = (int)(idx >> 6), c0 = (int)(idx & 63) * 8, l = m % SEQ;
        float cu[3][8];
#pragma unroll
        for (int t = 0; t < 3; ++t) {
            const int ll = l + t - 1;
            if (ll < 0 || ll >= SEQ) {
#pragma unroll
                for (int j = 0; j < 8; ++j) cu[t][j] = 0.f;
            } else {
                const u32x4 g = *(const u32x4*)(P.GC + (size_t)(m + t - 1) * 512 + c0), u = *(const u32x4*)(P.U + (size_t)(m + t - 1) * 512 + c0);
                cu[t][0] = bf2f(g.x & 0xffff) * bf2f(u.x & 0xffff); cu[t][1] = bf2f(g.x >> 16) * bf2f(u.x >> 16);
                cu[t][2] = bf2f(g.y & 0xffff) * bf2f(u.y & 0xffff); cu[t][3] = bf2f(g.y >> 16) * bf2f(u.y >> 16);
                cu[t][4] = bf2f(g.z & 0xffff) * bf2f(u.z & 0xffff); cu[t][5] = bf2f(g.z >> 16) * bf2f(u.z >> 16);
                cu[t][6] = bf2f(g.w & 0xffff) * bf2f(u.w & 0xffff); cu[t][7] = bf2f(g.w >> 16) * bf2f(u.w >> 16);
            }
        }
        const u32x4 gbv = *(const u32x4*)(P.GB + (size_t)m * 512 + c0);
        const float gb[8] = { bf2f(gbv.x & 0xffff), bf2f(gbv.x >> 16), bf2f(gbv.y & 0xffff), bf2f(gbv.y >> 16), bf2f(gbv.z & 0xffff), bf2f(gbv.z >> 16), bf2f(gbv.w & 0xffff), bf2f(gbv.w >> 16) };
        float o[8];
#pragma unroll
        for (int j = 0; j < 8; ++j) o[j] = gb[j] * (P.conv_w[c0 + j] * cu[0][j] + P.conv_w[512 + c0 + j] * cu[1][j] + P.conv_w[1024 + c0 + j] * cu[2][j]);
        st8bf(P.CA + (size_t)m * 512 + c0, o);
    }
}

__device__ __forceinline__ void unpack8(const u32x4 v, float* f) {
    f[0] = bf2f(v.x & 0xffff); f[1] = bf2f(v.x >> 16); f[2] = bf2f(v.y & 0xffff); f[3] = bf2f(v.y >> 16);
    f[4] = bf2f(v.z & 0xffff); f[5] = bf2f(v.z >> 16); f[6] = bf2f(v.w & 0xffff); f[7] = bf2f(v.w >> 16);
}
__device__ __forceinline__ float gelu_erf(float d) { return 0.5f * d * (1.f + erff(d * 0.70710678118654752f)); }
__device__ __forceinline__ int reduce64i(int (&part)[64], int lane) {
#pragma unroll
    for (int i = 0; i < 32; ++i) { auto r = __builtin_amdgcn_permlane32_swap((unsigned)part[i], (unsigned)part[32 + i], false, false); part[i] = (int)r[0] + (int)r[1]; }
#pragma unroll
    for (int i = 0; i < 16; ++i) { auto r = __builtin_amdgcn_permlane16_swap((unsigned)part[i], (unsigned)part[16 + i], false, false); part[i] = (int)r[0] + (int)r[1]; }
#define RSTAGE(N) { const bool up = (lane & N) != 0; _Pragma("unroll") for (int i = 0; i < N; ++i) { const int keep = up ? part[N + i] : part[i], send = up ? part[i] : part[N + i]; part[i] = keep + __shfl_xor(send, N); } }
    RSTAGE(8) RSTAGE(4) RSTAGE(2) RSTAGE(1)
#undef RSTAGE
    return part[0];
}
#define UB0(x) ((float)((x) & 0xffu))
#define UB1(x) ((float)(((x) >> 8) & 0xffu))
#define UB2(x) ((float)(((x) >> 16) & 0xffu))
#define UB3(x) ((float)((x) >> 24))
__device__ __forceinline__ void peer_final_token(const Params& P, int t, int lane) {
    const int b = t / SEQ;
    const u32x4 hq = *(const u32x4*)(P.H2q + (size_t)t * DM + 16 * lane);
    const float sh = P.sh2[t];
    float acc[16];
#pragma unroll
    for (int j = 0; j < 16; ++j) acc[j] = 0.f;
    float csum = 0.f;
#pragma unroll 1
    for (int half = 0; half < 2; ++half) {
        const int myidx = P.sel_idx[(size_t)t * 128 + half * 64 + lane];
        const float myg = P.sel_g[(size_t)t * 128 + half * 64 + lane];
        const float mysu = P.su[myidx], mysv = P.sv[myidx];
        int part[64];
#pragma unroll
        for (int k = 0; k < 64; ++k) {
            const int e = __builtin_amdgcn_readlane(myidx, k);
            const u32x4 a = *(const u32x4*)(P.Uq + (size_t)e * DM + 16 * lane);
            int d = __builtin_amdgcn_sdot4((int)a.x, (int)hq.x, 0, false);
            d = __builtin_amdgcn_sdot4((int)a.y, (int)hq.y, d, false);
            d = __builtin_amdgcn_sdot4((int)a.z, (int)hq.z, d, false);
            d = __builtin_amdgcn_sdot4((int)a.w, (int)hq.w, d, false);
            part[k] = d;
        }
        const int isum = reduce64i(part, lane);
        const float a = (float)isum * mysu * sh;
        const float c = myg * gelu_erf(a) * mysv;
        csum += c;
#pragma unroll
        for (int k = 0; k < 64; ++k) {
            const int e = __builtin_amdgcn_readlane(myidx, k);
            const float ck = __uint_as_float(__builtin_amdgcn_readlane(__float_as_uint(c), k));
            const u32x4 x = *(const u32x4*)(P.Vq + (size_t)e * DM + 16 * lane);
            acc[0] += ck * UB0(x.x); acc[1] += ck * UB1(x.x); acc[2] += ck * UB2(x.x); acc[3] += ck * UB3(x.x);
            acc[4] += ck * UB0(x.y); acc[5] += ck * UB1(x.y); acc[6] += ck * UB2(x.y); acc[7] += ck * UB3(x.y);
            acc[8] += ck * UB0(x.z); acc[9] += ck * UB1(x.z); acc[10] += ck * UB2(x.z); acc[11] += ck * UB3(x.z);
            acc[12] += ck * UB0(x.w); acc[13] += ck * UB1(x.w); acc[14] += ck * UB2(x.w); acc[15] += ck * UB3(x.w);
        }
    }
    const float cb = 128.f * wave_sum(csum);
    float x2[16]; float ss = 0.f;
    const bf16_t* x1 = P.X1 + (size_t)t * DM + 16 * lane; const float* g2 = P.mod + (size_t)b * NMOD + 5 * DM + 16 * lane;
#pragma unroll
    for (int q = 0; q < 4; ++q) {
        const u32x2 xw = *(const u32x2*)(x1 + 4 * q);
        const f32x4 xa = (f32x4){ bf2f(xw.x & 0xffff), bf2f(xw.x >> 16), bf2f(xw.y & 0xffff), bf2f(xw.y >> 16) }, ga = *(const f32x4*)(g2 + 4 * q);
        x2[4 * q + 0] = xa.x + ga.x * (acc[4 * q + 0] - cb); x2[4 * q + 1] = xa.y + ga.y * (acc[4 * q + 1] - cb);
        x2[4 * q + 2] = xa.z + ga.z * (acc[4 * q + 2] - cb); x2[4 * q + 3] = xa.w + ga.w * (acc[4 * q + 3] - cb);
        ss += x2[4 * q] * x2[4 * q] + x2[4 * q + 1] * x2[4 * q + 1] + x2[4 * q + 2] * x2[4 * q + 2] + x2[4 * q + 3] * x2[4 * q + 3];
    }
    ss = wave_sum(ss);
    const float rstd = rsqrtf(ss * (1.f / DM) + 1e-6f);
    float* op = P.out + (size_t)t * DM + 16 * lane; const float* fgp = P.fg + 16 * lane;
#pragma unroll
    for (int q = 0; q < 4; ++q) {
        const f32x4 fa = *(const f32x4*)(fgp + 4 * q);
        f32x4 o; o.x = x2[4 * q] * rstd * fa.x; o.y = x2[4 * q + 1] * rstd * fa.y; o.z = x2[4 * q + 2] * rstd * fa.z; o.w = x2[4 * q + 3] * rstd * fa.w;
        *(f32x4*)(op + 4 * q) = o;
    }
}

#define XB_TMO      128
#define XB_XCNT(j)  (256  + 64 * (j))
#define XB_XSUB(j)  (1280 + 64 * (j))
#define XB_XGEN(j)  (2304 + 64 * (j))
#define XB_TOP      3328
#define XB_TOPGEN   3392
#define XCD_BAR_WORDS 3456
#define XB_SPIN_CAP (1u << 22)
#define LAS __attribute__((address_space(3)))
__device__ __forceinline__ unsigned xb_ld(unsigned* p)              { return __hip_atomic_load(p, __ATOMIC_RELAXED, __HIP_MEMORY_SCOPE_AGENT); }
__device__ __forceinline__ unsigned xb_add(unsigned* p, unsigned v) { return __hip_atomic_fetch_add(p, v, __ATOMIC_RELAXED, __HIP_MEMORY_SCOPE_AGENT); }
__device__ __forceinline__ unsigned xb_xcc_id() { return (unsigned)__builtin_amdgcn_s_getreg((3 << 11) | 20) & 0xFu; }
#define XB_SPIN(cond, bar) do { unsigned _sp = 0; while (cond) { __builtin_amdgcn_s_sleep(1); \
    if ((++_sp & 255u) == 0u) { if (xb_ld(&(bar)[XB_TMO])) break; if (_sp > XB_SPIN_CAP) { atomicAdd(&(bar)[XB_TMO], 1u); break; } } } } while (0)
struct XcdBarrier { unsigned* bar; unsigned x; volatile LAS unsigned* st; };
__device__ __forceinline__ XcdBarrier xcd_barrier_post(unsigned* bar, volatile LAS unsigned* st) {
    XcdBarrier b; b.bar = bar; b.x = xb_xcc_id(); b.st = st;
    if (threadIdx.x == 0) (void)xb_add(&bar[XB_XCNT(b.x)], 1u);
    return b;
}
__device__ __forceinline__ void xcd_barrier_complete(unsigned* bar, unsigned x, unsigned& nloc, unsigned& nx) {
    const unsigned G = gridDim.x * gridDim.y * gridDim.z;
    unsigned sum, cnt, mine, sp = 0u;
    for (;;) {
        sum = 0u; cnt = 0u; mine = 0u;
#pragma unroll
        for (unsigned j = 0; j < 16; ++j) { const unsigned c = xb_ld(&bar[XB_XCNT(j)]); sum += c; cnt += (c > 0u) ? 1u : 0u; mine = (j == x) ? c : mine; }
        if (sum == G) break;
        __builtin_amdgcn_s_sleep(1);
        if ((++sp & 255u) == 0u) { if (xb_ld(&bar[XB_TMO])) break; if (sp > XB_SPIN_CAP) { atomicAdd(&bar[XB_TMO], 1u); break; } }
    }
    nloc = mine > 0u ? mine : 1u; nx = cnt > 0u ? cnt : 1u;
}
__device__ __forceinline__ void xcd_barrier(const XcdBarrier& b) {
    asm volatile("s_waitcnt vmcnt(0)" ::: "memory");
    __syncthreads();
    if (threadIdx.x == 0) {
        unsigned* bar = b.bar;
        __builtin_amdgcn_s_waitcnt(0);
        unsigned nloc = b.st[0], nx = b.st[1];
        if (nloc == 0u) { xcd_barrier_complete(bar, b.x, nloc, nx); b.st[0] = nloc; b.st[1] = nx; }
        const unsigned old = xb_add(&bar[XB_XSUB(b.x)], 1u);
        const unsigned gen = old / nloc;
        if (old + 1u == (gen + 1u) * nloc) {
            __builtin_amdgcn_fence(__ATOMIC_RELEASE, "agent");
            asm volatile("s_waitcnt vmcnt(0)" ::: "memory");
            const unsigned og = xb_add(&bar[XB_TOP], 1u);
            const unsigned tg = og / nx;
            if (og + 1u == (tg + 1u) * nx) xb_add(&bar[XB_TOPGEN], 1u);
            else XB_SPIN(xb_ld(&bar[XB_TOPGEN]) == tg, bar);
            __builtin_amdgcn_fence(__ATOMIC_ACQUIRE, "agent");
            xb_add(&bar[XB_XGEN(b.x)], 1u);
            asm volatile("s_waitcnt vmcnt(0)" ::: "memory");
        } else {
            XB_SPIN(xb_ld(&bar[XB_XGEN(b.x)]) == gen, bar);
            __builtin_amdgcn_fence(__ATOMIC_ACQUIRE, "agent");
            asm volatile("s_waitcnt vmcnt(0)" ::: "memory");
        }
    }
    __syncthreads();
}

constexpr int NPHASE = 9;
template <int PH> __device__ __forceinline__ void run_phase(const Params& P, char* smem) {
    int tid_ = threadIdx.x; asm volatile("" : "+v"(tid_));
    const int bid = blockIdx.x, G = gridDim.x, tid = tid_;
    const size_t gtid = (size_t)bid * 256 + tid, gsize = (size_t)G * 256;
    if (PH == 0) {
        for (int it = bid; it < 192; it += G) modp_item(P, it, smem);
        float (*tile)[65] = (float (*)[65])smem;
        for (int it = bid; it < 1088; it += G) transpose_tile(P.w_in, DM, PROJW, P.WinT, it, tile);
        for (int it = bid; it < 128; it += G) transpose_tile(P.w_ao, 512, DM, P.WaoT, it, tile);
        for (int it = bid; it < 128; it += G) transpose_tile(P.w_co, 512, DM, P.WcoT, it, tile);
        for (int it = bid; it < 256; it += G) transpose_tile(P.w_mix, DM, DM, P.WmixT, it, tile);
        for (int it = bid; it < 512; it += G) transpose_tile(P.pw_q, DM, 2048, P.PwqT, it, tile);
        cvt_range(P.keys, P.KeysB, (size_t)16 * 128 * 128 / 8, gtid, gsize);
        { const int lane = tid & 63, wid = tid >> 6;
          for (int r = bid * 4 + wid; r < NEXP; r += G * 4) {
              f32x4 va[4], vb[4];
              load_row16(P.pu + (size_t)r * DM, lane, va); load_row16(P.pv + (size_t)r * DM, lane, vb);
              quant_row(va, (unsigned char*)P.Uq + (size_t)r * DM, P.su + r, lane, 0);
              quant_row(vb, P.Vq + (size_t)r * DM, P.sv + r, lane, 128); } }
        rope_tab(P, (int)gtid, (int)gsize);
    } else if (PH == 1) {
        for (int i = (int)gtid; i < 17 * NMOD; i += (int)gsize) {
            float v = P.b_mod[i % NMOD];
#pragma unroll
            for (int kc = 0; kc < 8; ++kc) v += P.modp[(size_t)kc * 17 * NMOD + i];
            P.mod[i] = v;
        }
        if (NTOK % G == 0 && SEQ % (NTOK / G) == 0 && NCTX % G == 0) {
            norm1_rows(P, false, bid * (NTOK / G), NTOK / G, smem);
            norm1_rows(P, true, bid * (NCTX / G), NCTX / G, smem);
        } else {
            for (int it = bid; it < 1152; it += G) { const bool isctx = it >= 1024; norm1_rows(P, isctx, isctx ? (it - 1024) * 32 : it * 32, 32, smem); }
        }
    } else if (PH == 2) {
        for (int t = bid; t < 128 * 34 + 32; t += G) {
            if (t < 128 * 34) { int mt, nt; tile_coords(t, 128, 34, mt, nt); gemm_tile<MODE_INPROJ, 8>(P, P.H, DM, P.WinT, DM, DM, mt * 256, nt * 128, nt * 128 >= 768, smem); }
            else { const int u = t - 128 * 34, mt = u >> 1, nt = u & 1; gemm_tile<MODE_CTXKV, 8>(P, P.HC, DM, P.WinT + (size_t)512 * DM, DM, DM, mt * 256, nt * 128, nt == 0, smem); }
        }
    } else if (PH == 3) {
        for (int it = bid; it < NB * 16 * 8; it += G) attn_item(P, it);
        conv_range(P, gtid, gsize);
    } else if (PH == 4) {
        for (int t = bid; t < 128 * 8; t += G) { int mt, nt; tile_coords(t, 128, 8, mt, nt); gemm_tile<MODE_AO1, 8>(P, P.AO, 512, P.WaoT, 512, 512, mt * 256, nt * 128, true, smem, 0); }
        for (int t = bid; t < 128 * 8; t += G) { int mt, nt; tile_coords(t, 128, 8, mt, nt); gemm_tile<MODE_AO1, 8>(P, P.CA, 512, P.WcoT, 512, 512, mt * 256, nt * 128, true, smem, 1); }
    } else if (PH == 5) {
        for (int t = bid; t < 128 * 8; t += G) { int mt, nt; tile_coords(t, 128, 8, mt, nt); gemm_tile<MODE_MIX, 8>(P, P.YG, DM, P.WmixT, DM, DM, mt * 256, nt * 128, true, smem); }
    } else if (PH == 6) {
        const int lane = tid & 63, wid = tid >> 6;
        float* sc = (float*)smem; float* sh = sc + DM;
        for (int it = bid; it < NTOK / 64; it += G) {
            const int row0 = it * 64, b = row0 / SEQ;
            __syncthreads();
            for (int d = tid; d < DM; d += 256) { sc[d] = P.mod[(size_t)b * NMOD + 4 * DM + d]; sh[d] = P.mod[(size_t)b * NMOD + 3 * DM + d]; }
            __syncthreads();
            for (int i = wid; i < 64; i += 8) {
                const int ra = row0 + i, rb = ra + 4;
                f32x4 va[4], vb[4];
                load_row4_bf(P.X1 + (size_t)ra * DM, lane, va); load_row4_bf(P.X1 + (size_t)rb * DM, lane, vb);
                norm_row_q(va, P.n2, sc, sh, P.H2 + (size_t)ra * DM, P.H2q + (size_t)ra * DM, P.sh2 + ra, lane);
                norm_row_q(vb, P.n2, sc, sh, P.H2 + (size_t)rb * DM, P.H2q + (size_t)rb * DM, P.sh2 + rb, lane);
            }
        }
    } else if (PH == 7) {
        for (int it = bid; it < 256 * 8; it += G) peer_retrieve_item(P, it >> 3, it & 7, smem);
    } else if (PH == 8) {
        const int lane = tid & 63, wid = tid >> 6;
        for (int t = bid * 4 + wid; t < NTOK; t += G * 4) peer_final_token(P, t, lane);
    }
}
#ifndef REP0
#define REP0 1
#endif
#ifndef REP1
#define REP1 1
#endif
#ifndef REP2
#define REP2 1
#endif
#ifndef REP3
#define REP3 1
#endif
#ifndef REP4
#define REP4 1
#endif
#ifndef REP5
#define REP5 1
#endif
#ifndef REP6
#define REP6 1
#endif
#ifndef REP7
#define REP7 1
#endif
#ifndef REP8
#define REP8 1
#endif
constexpr int MEGA_LDS = 3 * (2048 * 8 + 8192);
#ifndef MULTI_LAUNCH
__global__ void __launch_bounds__(256, 2) k_mega(Params P) {
    extern __shared__ __attribute__((aligned(16))) char smem[];
    volatile LAS unsigned* st = (volatile LAS unsigned*)(smem + MEGA_LDS);
    if (threadIdx.x < 4) st[threadIdx.x] = 0u;
    __syncthreads();
    const XcdBarrier bar = xcd_barrier_post(P.bar, st);
#define PHASE_SYNC(k) for (int rep = 0; rep < REP##k; ++rep) { run_phase<k>(P, smem); xcd_barrier(bar); }
    PHASE_SYNC(0) PHASE_SYNC(1) PHASE_SYNC(2) PHASE_SYNC(3) PHASE_SYNC(4) PHASE_SYNC(5) PHASE_SYNC(6) PHASE_SYNC(7)
    for (int rep = 0; rep < REP8 - 1; ++rep) { run_phase<8>(P, smem); xcd_barrier(bar); }
    run_phase<8>(P, smem);
}
#else
template <int PH> __global__ void __launch_bounds__(256, 2) k_phase(Params P) {
    extern __shared__ __attribute__((aligned(16))) char smem[];
    run_phase<PH>(P, smem);
}
#endif

static size_t carve(size_t& off, size_t bytes) { const size_t o = off; off += (bytes + 255) & ~(size_t)255; return o; }

extern "C" void kernel_launch(void* const* d_in, const int* in_sizes, int n_in, void* d_out, int out_size, void* d_ws, size_t ws_size, hipStream_t stream) {
    Params P{};
    P.x = (const float*)d_in[0]; P.c = (const float*)d_in[1]; P.ctx = (const float*)d_in[2]; P.c_ctx = (const float*)d_in[3];
    P.w_mod = (const float*)d_in[4]; P.b_mod = (const float*)d_in[5]; P.n1 = (const float*)d_in[6]; P.n2 = (const float*)d_in[7];
    P.w_in = (const float*)d_in[8]; P.sink = (const float*)d_in[9]; P.conv_w = (const float*)d_in[10]; P.w_ao = (const float*)d_in[11];
    P.w_co = (const float*)d_in[12]; P.w_mix = (const float*)d_in[13]; P.pw_q = (const float*)d_in[14]; P.keys = (const float*)d_in[15];
    P.pu = (const float*)d_in[16]; P.pv = (const float*)d_in[17]; P.fg = (const float*)d_in[18];
    P.out = (float*)d_out;
    char* ws = (char*)d_ws; size_t off = 0;
    P.modp = (float*)(ws + carve(off, (size_t)8 * 17 * NMOD * 4));
    P.mod = (float*)(ws + carve(off, (size_t)17 * NMOD * 4));
    P.rope = (float*)(ws + carve(off, 3072 * 4));
    P.WinT = (bf16_t*)(ws + carve(off, (size_t)PROJW * DM * 2));
    P.WaoT = (bf16_t*)(ws + carve(off, (size_t)DM * 512 * 2));
    P.WcoT = (bf16_t*)(ws + carve(off, (size_t)DM * 512 * 2));
    P.WmixT = (bf16_t*)(ws + carve(off, (size_t)DM * DM * 2));
    P.PwqT = (bf16_t*)(ws + carve(off, (size_t)2048 * DM * 2));
    P.KeysB = (bf16_t*)(ws + carve(off, (size_t)16 * 128 * 128 * 2));
    P.Uq = (signed char*)(ws + carve(off, (size_t)NEXP * DM));
    P.Vq = (unsigned char*)(ws + carve(off, (size_t)NEXP * DM));
    P.su = (float*)(ws + carve(off, (size_t)NEXP * 4));
    P.sv = (float*)(ws + carve(off, (size_t)NEXP * 4));
    P.sh2 = (float*)(ws + carve(off, (size_t)NTOK * 4));
    P.HC = (bf16_t*)(ws + carve(off, (size_t)NCTX * DM * 2));
    const size_t regA = carve(off, (size_t)NTOK * DM * 2);
    P.H = (bf16_t*)(ws + regA); P.YG = (bf16_t*)(ws + regA); P.H2 = (bf16_t*)(ws + regA);
    const size_t regB = off;
    P.Q = (bf16_t*)(ws + carve(off, (size_t)NTOK * 512 * 2));
    P.K = (bf16_t*)(ws + carve(off, (size_t)NTOK * 128 * 2));
    P.VT = (bf16_t*)(ws + carve(off, (size_t)NTOK * 128 * 2));
    P.Kc = (bf16_t*)(ws + carve(off, (size_t)NCTX * 128 * 2));
    P.VcT = (bf16_t*)(ws + carve(off, (size_t)NCTX * 128 * 2));
    const size_t regC = off;
    P.GB = (bf16_t*)(ws + carve(off, (size_t)NTOK * 512 * 2));
    P.GC = (bf16_t*)(ws + carve(off, (size_t)NTOK * 512 * 2));
    P.U = (bf16_t*)(ws + carve(off, (size_t)NTOK * 512 * 2));
    P.M1 = (bf16_t*)(ws + regC);
    const size_t regD = off;
    P.GA = (bf16_t*)(ws + carve(off, (size_t)NTOK * DM * 2));
    P.GV = (bf16_t*)(ws + carve(off, (size_t)NTOK * DM * 2));
    P.AO = (bf16_t*)(ws + carve(off, (size_t)NTOK * 512 * 2));
    P.H2q = (signed char*)P.AO;
    P.CA = (bf16_t*)(ws + carve(off, (size_t)NTOK * 512 * 2));
    P.X1 = (bf16_t*)(ws + regD);
    P.bar = (unsigned*)(ws + carve(off, (size_t)XCD_BAR_WORDS * 4));
    const size_t need = off;
    { size_t o2 = regB;
      P.sel_idx = (int*)(ws + carve(o2, (size_t)NTOK * 128 * 4));
      P.sel_g = (float*)(ws + carve(o2, (size_t)NTOK * 128 * 4));
      if (o2 > regC) { fprintf(stderr, "kernel_launch: late buffers overflow\n"); return; } }
    if (need > ws_size) { fprintf(stderr, "kernel_launch: workspace too small: need %zu have %zu\n", need, ws_size); return; }

#ifdef MULTI_LAUNCH
    static bool attr_done = false;
    if (!attr_done) {
#define SETA(PH) hipFuncSetAttribute((const void*)k_phase<PH>, hipFuncAttributeMaxDynamicSharedMemorySize, MEGA_LDS)
        SETA(0); SETA(1); SETA(2); SETA(3); SETA(4); SETA(5); SETA(6); SETA(7); SETA(8);
        attr_done = true;
    }
#define LP(PH) k_phase<PH><<<512, 256, MEGA_LDS, stream>>>(P)
    LP(0); LP(1); LP(2); LP(3); LP(4); LP(5); LP(6); LP(7); LP(8);
#else
    static int grid_blocks = 0;
    if (!grid_blocks) {
        int dev = 0, cus = 0, per_cu = 0;
        (void)hipGetDevice(&dev);
        (void)hipDeviceGetAttribute(&cus, hipDeviceAttributeMultiprocessorCount, dev);
        (void)hipFuncSetAttribute((const void*)k_mega, hipFuncAttributeMaxDynamicSharedMemorySize, MEGA_LDS + 16);
        (void)hipOccupancyMaxActiveBlocksPerMultiprocessor(&per_cu, (const void*)k_mega, 256, MEGA_LDS + 16);
        if (per_cu > 2) per_cu = 2;
        if (per_cu < 1) { fprintf(stderr, "kernel_launch: occupancy query returned %d\n", per_cu); per_cu = 1; }
        grid_blocks = cus * per_cu;
    }
    (void)hipMemsetAsync(P.bar, 0, (size_t)XCD_BAR_WORDS * 4, stream);
    void* args[] = { &P };
    hipError_t e = hipLaunchCooperativeKernel((const void*)k_mega, dim3(grid_blocks), dim3(256), args, MEGA_LDS + 16, stream);
    if (e != hipSuccess) fprintf(stderr, "cooperative launch failed: %s (grid %d)\n", hipGetErrorString(e), grid_blocks);
#endif
}
```

```cpp
#include <hip/hip_runtime.h>
#include <cstdio>
#include <cstdint>

typedef unsigned short bf16_t;
typedef short bf16x8 __attribute__((ext_vector_type(8)));
typedef float f32x4 __attribute__((ext_vector_type(4)));
typedef unsigned u32x4 __attribute__((ext_vector_type(4)));
typedef unsigned u32x2 __attribute__((ext_vector_type(2)));

constexpr int DM = 1024, NB = 16, SEQ = 2048, NTOK = NB * SEQ, CTXL = 256, NCTX = NB * CTXL;
constexpr int PROJW = 4352;
constexpr int NMOD = 6 * DM;
constexpr int NEXP = 16384;

__device__ __forceinline__ float bf2f(bf16_t x) { return __uint_as_float(((unsigned)x) << 16); }
__device__ __forceinline__ bf16_t f2bf(float f) {
    unsigned u = __float_as_uint(f);
    u += 0x7fffu + ((u >> 16) & 1u);
    return (bf16_t)(u >> 16);
}
__device__ __forceinline__ unsigned pk2(float lo, float hi) { unsigned r; asm("v_cvt_pk_bf16_f32 %0, %1, %2" : "=v"(r) : "v"(lo), "v"(hi)); return r; }
__device__ __forceinline__ float sigmoidf_(float x) { return 1.f / (1.f + __expf(-x)); }
__device__ __forceinline__ float wave_sum(float v) {
#pragma unroll
    for (int o = 1; o < 64; o <<= 1) v += __shfl_xor(v, o);
    return v;
}

__device__ __forceinline__ float wave_max(float v) {
#pragma unroll
    for (int o = 1; o < 64; o <<= 1) v = fmaxf(v, __shfl_xor(v, o));
    return v;
}
__device__ __forceinline__ unsigned q8(float x, float inv, int bias) {
    int q = (int)rintf(x * inv); q = q > 127 ? 127 : (q < -127 ? -127 : q);
    return (unsigned)((q + bias) & 0xff);
}
__device__ __forceinline__ void load_row16(const float* src, int lane, f32x4 (&v)[4]) {
#pragma unroll
    for (int j = 0; j < 4; ++j) v[j] = *(const f32x4*)(src + 16 * lane + 4 * j);
}
__device__ __forceinline__ void quant_row(f32x4 (&v)[4], unsigned char* dst, float* scale_out, int lane, int bias) {
    float amax = 0.f;
#pragma unroll
    for (int j = 0; j < 4; ++j) amax = fmaxf(amax, fmaxf(fmaxf(fabsf(v[j].x), fabsf(v[j].y)), fmaxf(fabsf(v[j].z), fabsf(v[j].w))));
    amax = wave_max(amax);
    const float sc = amax > 0.f ? amax * (1.f / 127.f) : 1.f, inv = 1.f / sc;
    u32x4 w;
    w.x = q8(v[0].x, inv, bias) | (q8(v[0].y, inv, bias) << 8) | (q8(v[0].z, inv, bias) << 16) | (q8(v[0].w, inv, bias) << 24);
    w.y = q8(v[1].x, inv, bias) | (q8(v[1].y, inv, bias) << 8) | (q8(v[1].z, inv, bias) << 16) | (q8(v[1].w, inv, bias) << 24);
    w.z = q8(v[2].x, inv, bias) | (q8(v[2].y, inv, bias) << 8) | (q8(v[2].z, inv, bias) << 16) | (q8(v[2].w, inv, bias) << 24);
    w.w = q8(v[3].x, inv, bias) | (q8(v[3].y, inv, bias) << 8) | (q8(v[3].z, inv, bias) << 16) | (q8(v[3].w, inv, bias) << 24);
    *(u32x4*)(dst + 16 * lane) = w;
    if (lane == 0) *scale_out = sc;
}

struct Params {
    const float *x, *c, *ctx, *c_ctx, *w_mod, *b_mod, *n1, *n2, *w_in, *sink, *conv_w, *w_ao, *w_co, *w_mix, *pw_q, *keys, *pu, *pv, *fg;
    float* out;
    float *modp, *mod, *rope;
    bf16_t *WinT, *WaoT, *WcoT, *WmixT, *PwqT, *KeysB;
    bf16_t *H, *HC, *Q, *K, *VT, *Kc, *VcT, *GB, *GC, *U, *GA, *GV, *AO, *CA, *M1, *YG, *H2, *QH;
    float* TKv; int* TKi;
    int* sel_idx; float* sel_g;
    bf16_t* X1;
    unsigned* bar;
    signed char *Uq, *H2q; unsigned char* Vq; float *su, *sv, *sh2;
};

__device__ __forceinline__ void modp_item(const Params& P, int item, char* smem) {
    float (*s)[128] = (float (*)[128])smem;
    const int kc = item / 24, nc = item % 24;
    __syncthreads();
    for (int i = threadIdx.x; i < 17 * 128; i += 256) {
        const int r = i / 128, k = i % 128;
        const float v = (r < 16) ? P.c[r * DM + kc * 128 + k] : P.c_ctx[kc * 128 + k];
        s[r][k] = v / (1.f + __expf(-v));
    }
    __syncthreads();
    const int n = nc * 256 + threadIdx.x;
    float acc[17];
#pragma unroll
    for (int r = 0; r < 17; ++r) acc[r] = 0.f;
    for (int k = 0; k < 128; ++k) {
        const float w = P.w_mod[(size_t)(kc * 128 + k) * NMOD + n];
#pragma unroll
        for (int r = 0; r < 17; ++r) acc[r] += s[r][k] * w;
    }
#pragma unroll
    for (int r = 0; r < 17; ++r) P.modp[((size_t)kc * 17 + r) * NMOD + n] = acc[r];
}
__device__ __forceinline__ void cvt_range(const float* src, bf16_t* dst, size_t n8, size_t gtid, size_t gsize) {
    for (size_t i = gtid; i < n8; i += gsize) {
        const f32x4 a = *(const f32x4*)(src + i * 8), b = *(const f32x4*)(src + i * 8 + 4);
        u32x4 o; o.x = pk2(a.x, a.y); o.y = pk2(a.z, a.w); o.z = pk2(b.x, b.y); o.w = pk2(b.z, b.w);
        *(u32x4*)(dst + i * 8) = o;
    }
}
__device__ __forceinline__ void rope_tab(const Params& P, int gtid, int gsize) {
    for (int i = gtid; i < 1536; i += gsize) {
        int pos, f; bool isc;
        if (i < 512) { pos = i / 16; f = i % 16; isc = false; } else { pos = (i - 512) / 16; f = (i - 512) % 16; isc = true; }
        const double inv = pow(10000.0, -(double)f / 16.0);
        const double ang = (double)pos * inv;
        const float cv = (float)cos(ang), sv = (float)sin(ang);
        if (!isc) { P.rope[pos * 16 + f] = cv; P.rope[512 + pos * 16 + f] = sv; }
        else { P.rope[1024 + pos * 16 + f] = cv; P.rope[2048 + pos * 16 + f] = sv; }
    }
}
__device__ __forceinline__ void transpose_tile(const float* W, int K, int N, bf16_t* Wt, int item, float (*tile)[65]) {
    const int ntn = N / 64, kt = item / ntn, nt = item % ntn, k0 = kt * 64, n0 = nt * 64;
    const int tx = threadIdx.x & 63, ty = threadIdx.x >> 6;
    __syncthreads();
#pragma unroll
    for (int i = 0; i < 16; ++i) { const int k = i * 4 + ty; tile[k][tx] = W[(size_t)(k0 + k) * N + n0 + tx]; }
    __syncthreads();
#pragma unroll
    for (int i = 0; i < 16; ++i) { const int n = i * 4 + ty; Wt[(size_t)(n0 + n) * K + k0 + tx] = f2bf(tile[tx][n]); }
}

__device__ __forceinline__ void load_row4_bf(const bf16_t* xr, int lane, f32x4 (&v)[4]) {
#pragma unroll
    for (int j = 0; j < 4; ++j) { const u32x2 w = *(const u32x2*)(xr + j * 256 + lane * 4);
        v[j].x = bf2f(w.x & 0xffff); v[j].y = bf2f(w.x >> 16); v[j].z = bf2f(w.y & 0xffff); v[j].w = bf2f(w.y >> 16); }
}
__device__ __forceinline__ void load_row4(const float* xr, int lane, f32x4 (&v)[4]) {
#pragma unroll
    for (int j = 0; j < 4; ++j) v[j] = *(const f32x4*)(xr + j * 256 + lane * 4);
}
__device__ __forceinline__ void norm_row(f32x4 (&v)[4], const float* g, const float* scale, const float* shift, bf16_t* dst, int lane) {
    float s = 0.f;
#pragma unroll
    for (int j = 0; j < 4; ++j) s += v[j].x * v[j].x + v[j].y * v[j].y + v[j].z * v[j].z + v[j].w * v[j].w;
    s = wave_sum(s);
    const float rstd = rsqrtf(s * (1.f / DM) + 1e-6f);
#pragma unroll
    for (int j = 0; j < 4; ++j) {
        const int d = j * 256 + lane * 4;
        const f32x4 gg = *(const f32x4*)(g + d), sc = *(const f32x4*)(scale + d), sh = *(const f32x4*)(shift + d);
        const float y0 = v[j].x * rstd * gg.x * (1.f + sc.x) + sh.x;
        const float y1 = v[j].y * rstd * gg.y * (1.f + sc.y) + sh.y;
        const float y2 = v[j].z * rstd * gg.z * (1.f + sc.z) + sh.z;
        const float y3 = v[j].w * rstd * gg.w * (1.f + sc.w) + sh.w;
        u32x2 o; o.x = pk2(y0, y1); o.y = pk2(y2, y3);
        *(u32x2*)(dst + d) = o;
    }
}

__device__ __forceinline__ void norm_row_q(f32x4 (&v)[4], const float* g, const float* scale, const float* shift, bf16_t* dst, signed char* dq, float* sq, int lane) {
    float s = 0.f;
#pragma unroll
    for (int j = 0; j < 4; ++j) s += v[j].x * v[j].x + v[j].y * v[j].y + v[j].z * v[j].z + v[j].w * v[j].w;
    s = wave_sum(s);
    const float rstd = rsqrtf(s * (1.f / DM) + 1e-6f);
    float amax = 0.f;
#pragma unroll
    for (int j = 0; j < 4; ++j) {
        const int d = j * 256 + lane * 4;
        const f32x4 gg = *(const f32x4*)(g + d), sc = *(const f32x4*)(scale + d), sh = *(const f32x4*)(shift + d);
        v[j].x = v[j].x * rstd * gg.x * (1.f + sc.x) + sh.x;
        v[j].y = v[j].y * rstd * gg.y * (1.f + sc.y) + sh.y;
        v[j].z = v[j].z * rstd * gg.z * (1.f + sc.z) + sh.z;
        v[j].w = v[j].w * rstd * gg.w * (1.f + sc.w) + sh.w;
        u32x2 o; o.x = pk2(v[j].x, v[j].y); o.y = pk2(v[j].z, v[j].w);
        *(u32x2*)(dst + d) = o;
        amax = fmaxf(amax, fmaxf(fmaxf(fabsf(v[j].x), fabsf(v[j].y)), fmaxf(fabsf(v[j].z), fabsf(v[j].w))));
    }
    amax = wave_max(amax);
    const float qs = amax > 0.f ? amax * (1.f / 127.f) : 1.f, inv = 1.f / qs;
#pragma unroll
    for (int j = 0; j < 4; ++j) {
        const unsigned w = q8(v[j].x, inv, 0) | (q8(v[j].y, inv, 0) << 8) | (q8(v[j].z, inv, 0) << 16) | (q8(v[j].w, inv, 0) << 24);
        *(unsigned*)(dq + j * 256 + lane * 4) = w;
    }
    if (lane == 0) *sq = qs;
}

__device__ __forceinline__ void norm1_rows(const Params& P, bool isctx, int row0, int nrows, char* smem) {
    float* sc = (float*)smem; float* sh = sc + DM;
    const int r = isctx ? 16 : row0 / SEQ;
    __syncthreads();
    for (int d = threadIdx.x; d < DM; d += 256) {
        float a = P.b_mod[DM + d], b = P.b_mod[d];
#pragma unroll
        for (int kc = 0; kc < 8; ++kc) { a += P.modp[((size_t)kc * 17 + r) * NMOD + DM + d]; b += P.modp[((size_t)kc * 17 + r) * NMOD + d]; }
        sc[d] = a; sh[d] = b;
    }
    __syncthreads();
    const int lane = threadIdx.x & 63, wid = threadIdx.x >> 6;
    const float* srcb = isctx ? P.ctx : P.x; bf16_t* dstb = isctx ? P.HC : P.H;
    for (int i = wid; i < nrows; i += 8) {
        const int ra = row0 + i, rb = row0 + i + 4; const bool hb = (i + 4) < nrows;
        f32x4 va[4], vb[4];
        load_row4(srcb + (size_t)ra * DM, lane, va); if (hb) load_row4(srcb + (size_t)rb * DM, lane, vb);
        norm_row(va, P.n1, sc, sh, dstb + (size_t)ra * DM, lane);
        if (hb) norm_row(vb, P.n1, sc, sh, dstb + (size_t)rb * DM, lane);
    }
}
enum { MODE_INPROJ = 0, MODE_CTXKV = 1, MODE_AO1 = 2, MODE_CO2 = 3, MODE_MIX = 4, MODE_QH = 5 };

__device__ __forceinline__ void st8bf(bf16_t* p, const float* v) {
    u32x4 o; o.x = pk2(v[0], v[1]); o.y = pk2(v[2], v[3]); o.z = pk2(v[4], v[5]); o.w = pk2(v[6], v[7]);
    *(u32x4*)p = o;
}
__device__ __forceinline__ void st8bf_nt(bf16_t* p, const float* v) {
    u32x4 o; o.x = pk2(v[0], v[1]); o.y = pk2(v[2], v[3]); o.z = pk2(v[4], v[5]); o.w = pk2(v[6], v[7]);
    __builtin_nontemporal_store(o, (u32x4*)p);
}
__device__ __forceinline__ void st4bf(bf16_t* p, const float* v) {
    u32x2 o; o.x = pk2(v[0], v[1]); o.y = pk2(v[2], v[3]);
    *(u32x2*)p = o;
}
template <int MODE> __device__ __forceinline__ void epi8(const Params& P, int m, int n, const float* v, int aux) {
    if (MODE == MODE_INPROJ) {
        if (n < 1280) st8bf_nt(P.GB + (size_t)m * 512 + (n - 768), v);
        else if (n < 1792) st8bf_nt(P.GC + (size_t)m * 512 + (n - 1280), v);
        else if (n < 2304) st8bf_nt(P.U + (size_t)m * 512 + (n - 1792), v);
        else {
            float s[8];
#pragma unroll
            for (int j = 0; j < 8; ++j) s[j] = sigmoidf_(v[j]);
            if (n < 3328) st8bf_nt(P.GA + (size_t)m * DM + (n - 2304), s);
            else st8bf_nt(P.GV + (size_t)m * DM + (n - 3328), s);
        }
    } else if (MODE == MODE_CTXKV) {
        { const int b = m / CTXL, c = m % CTXL, kvh = n >> 6, d0 = n & 63;
          st8bf(P.Kc + ((((size_t)((b * 2 + kvh) * 8 + (c >> 5)) * 4 + (d0 >> 4)) * 2 + ((d0 >> 3) & 1)) * 32 + (c & 31)) * 8, v); }
    } else if (MODE == MODE_AO1) {
        const u32x4 g = *(const u32x4*)((aux ? P.GV : P.GA) + (size_t)m * DM + n);
        u32x4 a = (u32x4){0u, 0u, 0u, 0u};
        if (aux) a = *(const u32x4*)(P.M1 + (size_t)m * DM + n);
        float o[8];
        o[0] = bf2f(a.x & 0xffff) + v[0] * bf2f(g.x & 0xffff); o[1] = bf2f(a.x >> 16) + v[1] * bf2f(g.x >> 16);
        o[2] = bf2f(a.y & 0xffff) + v[2] * bf2f(g.y & 0xffff); o[3] = bf2f(a.y >> 16) + v[3] * bf2f(g.y >> 16);
        o[4] = bf2f(a.z & 0xffff) + v[4] * bf2f(g.z & 0xffff); o[5] = bf2f(a.z >> 16) + v[5] * bf2f(g.z >> 16);
        o[6] = bf2f(a.w & 0xffff) + v[6] * bf2f(g.w & 0xffff); o[7] = bf2f(a.w >> 16) + v[7] * bf2f(g.w >> 16);
        st8bf((aux ? P.YG : P.M1) + (size_t)m * DM + n, o);
    } else if (MODE == MODE_MIX) {
        const int b = m / SEQ;
        const float* g1 = P.mod + (size_t)b * NMOD + 2 * DM + n;
        const float* xr = P.x + (size_t)m * DM + n;
        const f32x4 x0 = *(const f32x4*)xr, x1 = *(const f32x4*)(xr + 4), g0 = *(const f32x4*)g1, g1v = *(const f32x4*)(g1 + 4);
        float o[8];
        o[0] = x0.x + g0.x * v[0]; o[1] = x0.y + g0.y * v[1]; o[2] = x0.z + g0.z * v[2]; o[3] = x0.w + g0.w * v[3];
        o[4] = x1.x + g1v.x * v[4]; o[5] = x1.y + g1v.y * v[5]; o[6] = x1.z + g1v.z * v[6]; o[7] = x1.w + g1v.w * v[7];
        st8bf(P.X1 + (size_t)m * DM + n, o);
    } else if (MODE == MODE_QH) {
        st8bf(P.QH + (size_t)m * 2048 + n, v);
    }
}
__device__ __forceinline__ void epi_rope(const Params& P, int m, int n, const float* lo, const float* hi) {
    const int d0 = n & 63;
    const int l = m % SEQ;
    const float *ct, *st;
    if (d0 < 16) { const int row = l >> 6; ct = P.rope + row * 16 + d0; st = P.rope + 512 + row * 16 + d0; }
    else { const int col = l & 63; ct = P.rope + 1024 + col * 16 + (d0 - 32); st = P.rope + 2048 + col * 16 + (d0 - 32); }
    float a[4], b[4];
    const float sc = (n < 512) ? 0.125f * 1.44269504088896f : 1.f;
#pragma unroll
    for (int j = 0; j < 4; ++j) { const float cc = ct[j], ss = st[j]; a[j] = (lo[j] * cc - hi[j] * ss) * sc; b[j] = (lo[j] * ss + hi[j] * cc) * sc; }
    if (n < 512) { st4bf(P.Q + (size_t)m * 512 + n, a); st4bf(P.Q + (size_t)m * 512 + n + 16, b); }
    else { const int bb = m / SEQ, kvh = (n - 512) >> 6;
        bf16_t* kp = P.K + ((((size_t)((bb * 2 + kvh) * 64 + (l >> 5)) * 4 + (d0 >> 4)) * 2 + ((d0 >> 3) & 1)) * 32 + (l & 31)) * 8 + (d0 & 7);
        st4bf(kp, a); st4bf(kp + 512, b); }
}
__device__ __forceinline__ void epi_v4(const Params& P, int m, int dcol, const float* v, bool ctx) {
    const int kvh = dcol >> 6, dd = dcol & 63;
    if (!ctx) { const int b = m / SEQ, l = m % SEQ;
#pragma unroll
        for (int j = 0; j < 4; ++j) {
            const int kk = l & 31;
            P.VT[(((((size_t)((b * 2 + kvh) * 64 + (l >> 5)) * 2 + (dd >> 5)) * 2 + (kk >> 4)) * 2 + ((kk >> 2) & 1)) * 32 + ((dd & 31) + j)) * 8 + 4 * ((kk >> 3) & 1) + (kk & 3)] = f2bf(v[j]); }
    } else { const int b = m / CTXL, cpos = m % CTXL;
#pragma unroll
        for (int j = 0; j < 4; ++j) {
            const int kk = cpos & 31;
            P.VcT[(((((size_t)((b * 2 + kvh) * 8 + (cpos >> 5)) * 2 + (dd >> 5)) * 2 + (kk >> 4)) * 2 + ((kk >> 2) & 1)) * 32 + ((dd & 31) + j)) * 8 + 4 * ((kk >> 3) & 1) + (kk & 3)] = f2bf(v[j]); }
    }
}

constexpr int GEMM_LDS = 65536;
constexpr int RETR_LDS = 128 * 130 * 4;
__device__ __forceinline__ int lds_off(int row, int chunk) { return row * 128 + ((chunk ^ ((row >> 1) & 7)) << 4); }

__device__ __forceinline__ void mma_from_lds(const char* As, const char* Bs, f32x4 (&acc)[4][4], int wm, int wn, int fr, int fq, int sw) {
#pragma unroll
    for (int ks = 0; ks < 2; ++ks) {
        bf16x8 af[4], bfr[4];
        const int coff = ((ks * 4 + fq) ^ sw) << 4;
#pragma unroll
        for (int mt = 0; mt < 4; ++mt) af[mt] = *(const bf16x8*)(As + (wm * 64 + mt * 16 + fr) * 128 + coff);
#pragma unroll
        for (int nt = 0; nt < 4; ++nt) bfr[nt] = *(const bf16x8*)(Bs + (wn * 64 + nt * 16 + fr) * 128 + coff);
#pragma unroll
        for (int mt = 0; mt < 4; ++mt)
#pragma unroll
            for (int nt = 0; nt < 4; ++nt) acc[mt][nt] = __builtin_amdgcn_mfma_f32_16x16x32_bf16(bfr[nt], af[mt], acc[mt][nt], 0, 0, 0);
    }
}
__device__ __forceinline__ void gemm_mainloop(const bf16_t* __restrict__ A, int lda, const bf16_t* __restrict__ Bt, int ldb, int K, int m0, int n0, bool perm, char* smem, f32x4 (&acc)[4][4]) {
    const int tid = threadIdx.x, lane = tid & 63, wid = tid >> 6;
    const int wm = wid >> 1, wn = wid & 1, fr = lane & 15, fq = lane >> 4;
    const bf16_t* ag[4]; const bf16_t* bg[4];
#pragma unroll
    for (int i = 0; i < 4; ++i) {
        const int row = (wid + 4 * i) * 8 + (lane >> 3);
        const int c = (lane & 7) ^ ((row >> 1) & 7);
        ag[i] = A + (size_t)(m0 + row) * lda + c * 8;
        int brow = row;
        if (perm) { const int g = row >> 5, rr = row & 31, nn = rr >> 4, j = rr & 15; brow = 32 * g + 8 * (j >> 2) + 4 * nn + (j & 3); }
        bg[i] = Bt + (size_t)(n0 + brow) * ldb + c * 8;
    }
#pragma unroll
    for (int i = 0; i < 4; ++i)
#pragma unroll
        for (int j = 0; j < 4; ++j) acc[i][j] = (f32x4){0.f, 0.f, 0.f, 0.f};
#define GSTAGE(buf, k0) { _Pragma("unroll") for (int i = 0; i < 4; ++i) { \
        __builtin_amdgcn_global_load_lds((const unsigned*)(ag[i] + (k0)), (unsigned*)(smem + (buf) * 32768 + (wid + 4 * i) * 1024), 16, 0, 0); \
        __builtin_amdgcn_global_load_lds((const unsigned*)(bg[i] + (k0)), (unsigned*)(smem + (buf) * 32768 + 16384 + (wid + 4 * i) * 1024), 16, 0, 0); } }
    GSTAGE(0, 0)
    asm volatile("s_waitcnt vmcnt(0)" ::: "memory");
    __syncthreads();
    const int nk = K / 64;
    const int sw = (fr >> 1) & 7;
    for (int kt = 0; kt < nk; ++kt) {
        const int cur = kt & 1;
        if (kt + 1 < nk) GSTAGE(cur ^ 1, (kt + 1) * 64)
        mma_from_lds(smem + cur * 32768, smem + cur * 32768 + 16384, acc, wm, wn, fr, fq, sw);
        asm volatile("s_waitcnt vmcnt(0)" ::: "memory");
        __syncthreads();
    }
#undef GSTAGE
}

template <int MT, int NST>
__device__ __forceinline__ void gemm_ring(const bf16_t* __restrict__ A, int lda, const bf16_t* __restrict__ Bt, int ldb, int K, int m0, int n0, bool perm, char* smem, f32x4 (&acc)[MT][4]) {
    constexpr int SA = 2048 * MT, SB = SA + 8192, GA = MT / 2, GL = GA + 2;
    const int tid = threadIdx.x, lane = tid & 63, wid = __builtin_amdgcn_readfirstlane(tid >> 6);
    const int wm = wid >> 1, wn = wid & 1, fr = lane & 15, fq = lane >> 4;
    const int c8 = ((lane & 3) ^ (3 * ((lane >> 4) & 1))) * 8;
    unsigned aoff[GA], boff[2];
#pragma unroll
    for (int i = 0; i < GA; ++i) aoff[i] = (unsigned)(((wid + 4 * i) * 16 + (lane >> 2)) * lda + c8) * 2u;
#pragma unroll
    for (int i = 0; i < 2; ++i) {
        const int row = (wid + 4 * i) * 16 + (lane >> 2);
        int brow = row;
        if (perm) { const int g = row >> 5, rr = row & 31, nn = rr >> 4, j = rr & 15; brow = 32 * g + 8 * (j >> 2) + 4 * nn + (j & 3); }
        boff[i] = (unsigned)(brow * ldb + c8) * 2u;
    }
    const char* Abase = (const char*)(A + (size_t)m0 * lda);
    const char* Bbase = (const char*)(Bt + (size_t)n0 * ldb);
#pragma unroll
    for (int i = 0; i < MT; ++i)
#pragma unroll
        for (int j = 0; j < 4; ++j) acc[i][j] = (f32x4){0.f, 0.f, 0.f, 0.f};
#define RSTAGE_(buf, k0) { char* sb_ = smem + (buf) * SB; const char* ab_ = Abase + (size_t)(k0) * 2; const char* bb_ = Bbase + (size_t)(k0) * 2; \
        _Pragma("unroll") for (int i = 0; i < GA; ++i) __builtin_amdgcn_global_load_lds((const unsigned*)(ab_ + aoff[i]), (unsigned*)(sb_ + (wid + 4 * i) * 1024), 16, 0, 0); \
        _Pragma("unroll") for (int i = 0; i < 2; ++i) __builtin_amdgcn_global_load_lds((const unsigned*)(bb_ + boff[i]), (unsigned*)(sb_ + SA + (wid + 4 * i) * 1024), 16, 0, 0); }
    const int nk = K / 32;
    asm volatile("s_waitcnt vmcnt(0)" ::: "memory");
#pragma unroll
    for (int s = 0; s < NST - 1; ++s) RSTAGE_(s, s * 32)
    const int coff = (fq ^ (3 * ((fr >> 2) & 1))) << 4;
    int cur = 0, nxt = NST - 1;
#pragma unroll 1
    for (int kt = 0; kt < nk; ++kt) {
        const int rem = nk - 1 - kt;
        if (rem >= NST - 2) asm volatile("s_waitcnt vmcnt(%0)" :: "n"(GL * (NST - 2)) : "memory");
        else if (NST == 4 && rem == 1) asm volatile("s_waitcnt vmcnt(%0)" :: "n"(GL) : "memory");
        else asm volatile("s_waitcnt vmcnt(0)" ::: "memory");
        __builtin_amdgcn_s_barrier();
        const char* As = smem + cur * SB;
        const char* Bs = As + SA;
        bf16x8 af[MT], bfr[4];
#pragma unroll
        for (int mt = 0; mt < MT; ++mt) af[mt] = *(const bf16x8*)(As + (wm * 16 * MT + mt * 16 + fr) * 64 + coff);
#pragma unroll
        for (int nt = 0; nt < 4; ++nt) bfr[nt] = *(const bf16x8*)(Bs + (wn * 64 + nt * 16 + fr) * 64 + coff);
        const bool more = (kt + NST - 1 < nk);
        char* sb_ = smem + nxt * SB; const char* ab_ = Abase + (size_t)((kt + NST - 1) * 32) * 2; const char* bb_ = Bbase + (size_t)((kt + NST - 1) * 32) * 2;
        __builtin_amdgcn_s_setprio(1);
#pragma unroll
        for (int mt = 0; mt < MT; ++mt) {
#pragma unroll
            for (int nt = 0; nt < 4; ++nt) acc[mt][nt] = __builtin_amdgcn_mfma_f32_16x16x32_bf16(bfr[nt], af[mt], acc[mt][nt], 0, 0, 0);
            if (more) {
                if (mt < GA) __builtin_amdgcn_global_load_lds((const unsigned*)(ab_ + aoff[mt]), (unsigned*)(sb_ + (wid + 4 * mt) * 1024), 16, 0, 0);
                else if (mt < GA + 2) __builtin_amdgcn_global_load_lds((const unsigned*)(bb_ + boff[mt - GA]), (unsigned*)(sb_ + SA + (wid + 4 * (mt - GA)) * 1024), 16, 0, 0);
            }
        }
        __builtin_amdgcn_s_setprio(0);
        cur = (cur + 1 == NST) ? 0 : cur + 1;
        nxt = (nxt + 1 == NST) ? 0 : nxt + 1;
    }
#undef RSTAGE_
    __syncthreads();
}

template <int MODE, int MT>
__device__ __forceinline__ void gemm_tile(const Params& P, const bf16_t* __restrict__ A, int lda, const bf16_t* __restrict__ Bt, int ldb, int K, int m0, int n0, bool perm, char* smem, int aux = 0) {
    const int lane = threadIdx.x & 63, wid = threadIdx.x >> 6;
    const int wm = wid >> 1, wn = wid & 1, fr = lane & 15, fq = lane >> 4;
    f32x4 acc[MT][4];
    gemm_ring<MT, (MT == 8 ? 3 : 4)>(A, lda, Bt, ldb, K, m0, n0, perm, smem, acc);
#pragma unroll
    for (int mt = 0; mt < MT; ++mt) {
        const int m = m0 + wm * 16 * MT + mt * 16 + fr;
        if (perm) {
#pragma unroll
            for (int p = 0; p < 2; ++p) {
                float v[8] = { acc[mt][2 * p][0], acc[mt][2 * p][1], acc[mt][2 * p][2], acc[mt][2 * p][3], acc[mt][2 * p + 1][0], acc[mt][2 * p + 1][1], acc[mt][2 * p + 1][2], acc[mt][2 * p + 1][3] };
                epi8<MODE>(P, m, n0 + wn * 64 + 32 * p + 8 * fq, v, aux);
            }
        } else if (MODE == MODE_INPROJ && n0 < 640) {
#pragma unroll
            for (int p = 0; p < 2; ++p) {
                float lo[4] = { acc[mt][2 * p][0], acc[mt][2 * p][1], acc[mt][2 * p][2], acc[mt][2 * p][3] };
                float hi[4] = { acc[mt][2 * p + 1][0], acc[mt][2 * p + 1][1], acc[mt][2 * p + 1][2], acc[mt][2 * p + 1][3] };
                epi_rope(P, m, n0 + wn * 64 + 32 * p + 4 * fq, lo, hi);
            }
        } else if (MODE == MODE_INPROJ || MODE == MODE_CTXKV) {
            const int dbase = (MODE == MODE_INPROJ) ? (n0 - 640) : (n0 - 128);
#pragma unroll
            for (int nt = 0; nt < 4; ++nt) {
                float v[4] = { acc[mt][nt][0], acc[mt][nt][1], acc[mt][nt][2], acc[mt][nt][3] };
                epi_v4(P, m, dbase + wn * 64 + 16 * nt + 4 * fq, v, MODE == MODE_CTXKV);
            }
        }
        asm volatile("" ::: "memory"); __builtin_amdgcn_sched_barrier(0);
    }
}
__device__ __forceinline__ void tile_coords(int t, int ntm, int ntn, int& mt, int& nt) {
    const int per = 8 * ntn, g = t / per, r = t % per;
    mt = g * 8 + (r & 7); nt = r >> 3;
}
#define CEU(a, b) { const unsigned _t = (a) > (b) ? (a) : (b); (b) = (a) > (b) ? (b) : (a); (a) = _t; }
__device__ __forceinline__ void sort16_desc(unsigned (&v)[16]) {
    CEU(v[0], v[1]); CEU(v[2], v[3]); CEU(v[0], v[2]); CEU(v[1], v[3]); CEU(v[1], v[2]); CEU(v[4], v[5]);
    CEU(v[6], v[7]); CEU(v[4], v[6]); CEU(v[5], v[7]); CEU(v[5], v[6]); CEU(v[0], v[4]); CEU(v[2], v[6]);
    CEU(v[2], v[4]); CEU(v[1], v[5]); CEU(v[3], v[7]); CEU(v[3], v[5]); CEU(v[1], v[2]); CEU(v[3], v[4]);
    CEU(v[5], v[6]); CEU(v[8], v[9]); CEU(v[10], v[11]); CEU(v[8], v[10]); CEU(v[9], v[11]); CEU(v[9], v[10]);
    CEU(v[12], v[13]); CEU(v[14], v[15]); CEU(v[12], v[14]); CEU(v[13], v[15]); CEU(v[13], v[14]); CEU(v[8], v[12]);
    CEU(v[10], v[14]); CEU(v[10], v[12]); CEU(v[9], v[13]); CEU(v[11], v[15]); CEU(v[11], v[13]); CEU(v[9], v[10]);
    CEU(v[11], v[12]); CEU(v[13], v[14]); CEU(v[0], v[8]); CEU(v[4], v[12]); CEU(v[4], v[8]); CEU(v[2], v[10]);
    CEU(v[6], v[14]); CEU(v[6], v[10]); CEU(v[2], v[4]); CEU(v[6], v[8]); CEU(v[10], v[12]); CEU(v[1], v[9]);
    CEU(v[5], v[13]); CEU(v[5], v[9]); CEU(v[3], v[11]); CEU(v[7], v[15]); CEU(v[7], v[11]); CEU(v[3], v[5]);
    CEU(v[7], v[9]); CEU(v[11], v[13]); CEU(v[1], v[2]); CEU(v[3], v[4]); CEU(v[5], v[6]); CEU(v[7], v[8]);
    CEU(v[9], v[10]); CEU(v[11], v[12]); CEU(v[13], v[14]);
}
__device__ __forceinline__ void bitonic16_desc(unsigned (&v)[16]) {
    CEU(v[0], v[8]); CEU(v[1], v[9]); CEU(v[2], v[10]); CEU(v[3], v[11]); CEU(v[4], v[12]); CEU(v[5], v[13]);
    CEU(v[6], v[14]); CEU(v[7], v[15]); CEU(v[0], v[4]); CEU(v[1], v[5]); CEU(v[2], v[6]); CEU(v[3], v[7]);
    CEU(v[8], v[12]); CEU(v[9], v[13]); CEU(v[10], v[14]); CEU(v[11], v[15]); CEU(v[0], v[2]); CEU(v[1], v[3]);
    CEU(v[4], v[6]); CEU(v[5], v[7]); CEU(v[8], v[10]); CEU(v[9], v[11]); CEU(v[12], v[14]); CEU(v[13], v[15]);
    CEU(v[0], v[1]); CEU(v[2], v[3]); CEU(v[4], v[5]); CEU(v[6], v[7]); CEU(v[8], v[9]); CEU(v[10], v[11]);
    CEU(v[12], v[13]); CEU(v[14], v[15]);
}

__device__ __forceinline__ unsigned enc_key(float f) { const unsigned b = __float_as_uint(f); return b ^ ((unsigned)((int)b >> 31) | 0x80000000u); }
__device__ __forceinline__ float dec_key(unsigned k) { const unsigned b = (k & 0x80000000u) ? (k & 0x7fffffffu) : ~k; return __uint_as_float(b); }
__device__ __forceinline__ void topmerge16(unsigned (&top)[16], const unsigned (&L)[16]) {
#pragma unroll
    for (int i = 0; i < 16; ++i) top[i] = top[i] > L[15 - i] ? top[i] : L[15 - i];
    bitonic16_desc(top);
}
__device__ __forceinline__ unsigned cand_key(float a, float b, int i, int j) { return (enc_key(a + b) & ~0xFFu) | (unsigned)(i << 4) | (unsigned)j; }

__device__ __forceinline__ void peer_retrieve_item(const Params& P, int mtile, int h, char* smem) {
    const int tid = threadIdx.x, lane = tid & 63, wid = tid >> 6;
    const int wm = wid >> 1, wn = wid & 1, fr = lane & 15, fq = lane >> 4;
    const int sw = (fr >> 1) & 7;
    const int m0 = mtile * 128;
    unsigned T0[16], T1[16];
#pragma unroll 1
    for (int p = 0; p < 2; ++p) {
        const int hp = h * 2 + p;
        f32x4 acc[4][4];
        gemm_ring<4, 4>(P.H2, DM, P.PwqT, DM, DM, m0, hp * 128, false, smem, acc);
#pragma unroll
        for (int mt = 0; mt < 4; ++mt)
#pragma unroll
            for (int nt = 0; nt < 4; ++nt) {
                const int row = wm * 64 + mt * 16 + fr;
                u32x2 o; o.x = pk2(acc[mt][nt][0], acc[mt][nt][1]); o.y = pk2(acc[mt][nt][2], acc[mt][nt][3]);
                *(u32x2*)(smem + wn * 32768 + lds_off(row, 2 * nt + (fq >> 1)) + (fq & 1) * 8) = o;
            }
        {
            const int srow = tid >> 3, schunk = tid & 7;
            const bf16_t* kb = P.KeysB + (size_t)hp * 128 * 128;
#pragma unroll
            for (int hf = 0; hf < 2; ++hf)
#pragma unroll
                for (int q = 0; q < 4; ++q) {
                    const int row = q * 32 + srow;
                    const u32x4 v = *(const u32x4*)(kb + (size_t)row * 128 + hf * 64 + schunk * 8);
                    *(u32x4*)(smem + hf * 32768 + 16384 + lds_off(row, schunk)) = v;
                }
        }
        __syncthreads();
#pragma unroll
        for (int i = 0; i < 4; ++i)
#pragma unroll
            for (int j = 0; j < 4; ++j) acc[i][j] = (f32x4){0.f, 0.f, 0.f, 0.f};
        mma_from_lds(smem, smem + 16384, acc, wm, wn, fr, fq, sw);
        mma_from_lds(smem + 32768, smem + 32768 + 16384, acc, wm, wn, fr, fq, sw);
        __syncthreads();
        float* sc = (float*)smem;
#pragma unroll
        for (int mt = 0; mt < 4; ++mt)
#pragma unroll
            for (int nt = 0; nt < 4; ++nt) {
                const int row = wm * 64 + mt * 16 + fr;
#pragma unroll
                for (int r = 0; r < 4; ++r) {
                    const int col = wn * 64 + nt * 16 + fq * 4 + r;
                    sc[row * 130 + wn * 65 + (col & 63)] = acc[mt][nt][r];
                }
            }
        __syncthreads();
        {
            const int row = tid >> 1, half = tid & 1;
            const float* rp = sc + row * 130 + half * 65;
            unsigned top[16];
#pragma unroll 1
            for (int g = 0; g < 4; ++g) {
                unsigned L[16];
#pragma unroll
                for (int j = 0; j < 16; ++j) { const int col = half * 64 + g * 16 + j; L[j] = (enc_key(rp[g * 16 + j]) & ~0x7Fu) | (unsigned)col; }
                sort16_desc(L);
                if (g == 0) {
#pragma unroll
                    for (int j = 0; j < 16; ++j) top[j] = L[j];
                } else topmerge16(top, L);
            }
            unsigned Bp[16];
#pragma unroll
            for (int j = 0; j < 16; ++j) Bp[j] = (unsigned)__shfl_xor((int)top[j], 1);
            topmerge16(top, Bp);
            if (p == 0) {
#pragma unroll
                for (int j = 0; j < 16; ++j) T0[j] = top[j];
            } else {
#pragma unroll
                for (int j = 0; j < 16; ++j) T1[j] = top[j];
            }
        }
        __syncthreads();
    }
    {
        const int row = tid >> 1;
        unsigned char* slot = (unsigned char*)smem + row * 32;
        if ((tid & 1) == 0) {
#pragma unroll
            for (int j = 0; j < 16; ++j) { slot[j] = (unsigned char)(T0[j] & 0x7Fu); slot[16 + j] = (unsigned char)(T1[j] & 0x7Fu); }
            float a[16], b[16];
#pragma unroll
            for (int j = 0; j < 16; ++j) { a[j] = dec_key(T0[j]); b[j] = dec_key(T1[j]); }
            unsigned LA[16], LB[16], LC[16];
#pragma unroll
            for (int j = 0; j < 16; ++j) LA[j] = cand_key(a[0], b[j], 0, j);
#pragma unroll
            for (int j = 0; j < 8; ++j) LB[j] = cand_key(a[1], b[j], 1, j);
#pragma unroll
            for (int j = 0; j < 8; ++j) LB[8 + j] = cand_key(a[15 - j], b[0], 15 - j, 0);
            LC[0] = cand_key(a[2], b[0], 2, 0); LC[1] = cand_key(a[2], b[1], 2, 1); LC[2] = cand_key(a[2], b[2], 2, 2); LC[3] = cand_key(a[2], b[3], 2, 3); LC[4] = cand_key(a[2], b[4], 2, 4);
            LC[5] = cand_key(a[3], b[0], 3, 0); LC[6] = cand_key(a[3], b[1], 3, 1); LC[7] = cand_key(a[3], b[2], 3, 2); LC[8] = cand_key(a[3], b[3], 3, 3);
            LC[9] = cand_key(a[4], b[0], 4, 0); LC[10] = cand_key(a[4], b[1], 4, 1); LC[11] = cand_key(a[4], b[2], 4, 2);
            LC[12] = cand_key(a[5], b[0], 5, 0); LC[13] = cand_key(a[5], b[1], 5, 1);
            LC[14] = cand_key(a[6], b[0], 6, 0); LC[15] = cand_key(a[6], b[1], 6, 1);
            const unsigned d0 = cand_key(a[7], b[0], 7, 0), d1 = cand_key(a[7], b[1], 7, 1);
            bitonic16_desc(LB);
            sort16_desc(LC);
            topmerge16(LA, LB);
            LC[15] = LC[15] > d0 ? LC[15] : d0; LC[14] = LC[14] > d1 ? LC[14] : d1;
            bitonic16_desc(LC);
            topmerge16(LA, LC);
            float e[16], den = 0.f; const float vmax = dec_key(LA[0]);
#pragma unroll
            for (int r = 0; r < 16; ++r) { e[r] = __expf(dec_key(LA[r]) - vmax); den += e[r]; }
            const float inv = 1.f / den;
            const int t = m0 + row;
            int* oi = P.sel_idx + (size_t)t * 128 + h * 16; float* og = P.sel_g + (size_t)t * 128 + h * 16;
#pragma unroll
            for (int r = 0; r < 16; ++r) {
                const int i = (LA[r] >> 4) & 15, j = LA[r] & 15;
                oi[r] = (int)slot[i] * 128 + (int)slot[16 + j];
                og[r] = e[r] * inv;
            }
        }
    }
    __syncthreads();
}
typedef float f32x16 __attribute__((ext_vector_type(16)));
struct AttnFrag { u32x4 k[4]; u32x4 v[2][2]; };
__device__ __forceinline__ void attn_load(const Params& P, int b, int kvh, int qb, int w, int blk, int r, int hh, AttnFrag& f) {
    const bf16_t* kp; const bf16_t* vp;
    if (blk < 9) {
        int kpos0 = (qb - 1) * 128 + 32 * (w + blk);
        if (kpos0 < 0 || kpos0 >= SEQ) kpos0 = 0;
        const size_t blkoff = (size_t)((b * 2 + kvh) * 64 + (kpos0 >> 5)) * 2048 + (hh * 32 + r) * 8;
        kp = P.K + blkoff; vp = P.VT + blkoff;
    } else {
        const size_t blkoff = (size_t)((b * 2 + kvh) * 8 + (blk - 9)) * 2048 + (hh * 32 + r) * 8;
        kp = P.Kc + blkoff; vp = P.VcT + blkoff;
    }
#pragma unroll
    for (int ks = 0; ks < 4; ++ks) f.k[ks] = *(const u32x4*)(kp + 512 * ks);
#pragma unroll
    for (int db = 0; db < 2; ++db)
#pragma unroll
        for (int s = 0; s < 2; ++s) f.v[db][s] = *(const u32x4*)(vp + 512 * (db * 2 + s));
}
__device__ __forceinline__ void attn_item(const Params& P, int item) {
    const int head = item & 7, qb = (item >> 3) & 15, b = item >> 7, kvh = head >> 2;
    const int lane = threadIdx.x & 63, w = threadIdx.x >> 6, r = lane & 31, hh = lane >> 5;
    const int tok = b * SEQ + qb * 128 + 32 * w + r;
    bf16x8 qf[4];
    { const bf16_t* qp = P.Q + (size_t)tok * 512 + head * 64 + 8 * hh;
#pragma unroll
      for (int ks = 0; ks < 4; ++ks) qf[ks] = *(const bf16x8*)(qp + 16 * ks); }
    f32x16 o0, o1;
#pragma unroll
    for (int i = 0; i < 16; ++i) { o0[i] = 0.f; o1[i] = 0.f; }
    float mrun = P.sink[head] * 1.44269504088896f, lrun = (hh == 0) ? 1.f : 0.f;
    AttnFrag cur, nxt;
    attn_load(P, b, kvh, qb, w, 0, r, hh, cur);
    for (int blk = 0; blk < 17; ++blk) {
        if (blk + 1 < 17) attn_load(P, b, kvh, qb, w, blk + 1, r, hh, nxt);
        int lo = 0, hi = 31;
        if (blk < 9) {
            const int kpos0 = (qb - 1) * 128 + 32 * (w + blk);
            if (kpos0 < 0 || kpos0 >= SEQ) lo = 64;
            else if (blk == 0) lo = r;
            else if (blk == 8) hi = r;
        }
        f32x16 s;
#pragma unroll
        for (int i = 0; i < 16; ++i) s[i] = 0.f;
#pragma unroll
        for (int ks = 0; ks < 4; ++ks) s = __builtin_amdgcn_mfma_f32_32x32x16_bf16(*(const bf16x8*)&cur.k[ks], qf[ks], s, 0, 0, 0);
        if (lo != 0 || hi != 31) {
#pragma unroll
            for (int i = 0; i < 16; ++i) { const int kk = (i & 3) + 8 * (i >> 2) + 4 * hh; const bool ok = (kk >= lo) && (kk <= hi); s[i] = ok ? s[i] : -3.0e38f; }
        }
        float mb = s[0];
#pragma unroll
        for (int i = 1; i < 16; ++i) mb = fmaxf(mb, s[i]);
        mb = fmaxf(mb, __shfl_xor(mb, 32));
        if (!__all(mb - mrun <= 8.f)) {
            const float mn = fmaxf(mrun, mb);
            const float alpha = __builtin_amdgcn_exp2f(mrun - mn);
            lrun *= alpha; mrun = mn;
#pragma unroll
            for (int i = 0; i < 16; ++i) { o0[i] *= alpha; o1[i] *= alpha; }
        }
        float ps = 0.f; float p[16];
#pragma unroll
        for (int i = 0; i < 16; ++i) { p[i] = __builtin_amdgcn_exp2f(s[i] - mrun); ps += p[i]; }
        lrun += ps;
        u32x4 pb[2];
        pb[0].x = pk2(p[0], p[1]); pb[0].y = pk2(p[2], p[3]); pb[0].z = pk2(p[4], p[5]); pb[0].w = pk2(p[6], p[7]);
        pb[1].x = pk2(p[8], p[9]); pb[1].y = pk2(p[10], p[11]); pb[1].z = pk2(p[12], p[13]); pb[1].w = pk2(p[14], p[15]);
#pragma unroll
        for (int sI = 0; sI < 2; ++sI) {
            const u32x4 va = cur.v[0][sI], vb = cur.v[1][sI];
            o0 = __builtin_amdgcn_mfma_f32_32x32x16_bf16(*(const bf16x8*)&va, *(const bf16x8*)&pb[sI], o0, 0, 0, 0);
            o1 = __builtin_amdgcn_mfma_f32_32x32x16_bf16(*(const bf16x8*)&vb, *(const bf16x8*)&pb[sI], o1, 0, 0, 0);
        }
        if (blk + 1 < 17) cur = nxt;
    }
    const float ltot = lrun + __shfl_xor(lrun, 32);
    const float inv = 1.f / ltot;
    bf16_t* op = P.AO + (size_t)tok * 512 + head * 64 + 4 * hh;
#pragma unroll
    for (int g = 0; g < 4; ++g) {
        float t0[4] = { o0[4 * g] * inv, o0[4 * g + 1] * inv, o0[4 * g + 2] * inv, o0[4 * g + 3] * inv };
        float t1[4] = { o1[4 * g] * inv, o1[4 * g + 1] * inv, o1[4 * g + 2] * inv, o1[4 * g + 3] * inv };
        st4bf(op + 8 * g, t0); st4bf(op + 32 + 8 * g, t1);
    }
}

__device__ __forceinline__ void conv_range(const Params& P, size_t gtid, size_t gsize) {
    for (size_t idx = gtid; idx < (size_t)NTOK * 64; idx += gsize) {
        const int m = (int)(idx >> 6), c0 = (int)(idx & 63) * 8, l = m % SEQ;
        float cu[3][8];
#pragma unroll
        for (int t = 0; t < 3; ++t) {
            const int ll = l + t - 1;
            if (ll < 0 || ll >= SEQ) {
#pragma unroll
                for (int j = 0; j < 8; ++j) cu[t][j] = 0.f;
            } else {
                const u32x4 g = *(const u32x4*)(P.GC + (size_t)(m + t - 1) * 512 + c0), u = *(const u32x4*)(P.U + (size_t)(m + t - 1) * 512 + c0);
                cu[t][0] = bf2f(g.x & 0xffff) * bf2f(u.x & 0xffff); cu[t][1] = bf2f(g.x >> 16) * bf2f(u.x >> 16);
                cu[t][2] = bf2f(g.y & 0xffff) * bf2f(u.y & 0xffff); cu[t][3] = bf2f(g.y >> 16) * bf2f(u.y >> 16);
                cu[t][4] = bf2f(g.z & 0xffff) * bf2f(u.z & 0xffff); cu[t][5] = bf2f(g.z >> 16) * bf2f(u.z >> 16);
                cu[t][6] = bf2f(g.w & 0xffff) * bf2f(u.w & 0xffff); cu[t][7] = bf2f(g.w >> 16) * bf2f(u.w >> 16);
            }
        }
        const u32x4 gbv = *(const u32x4*)(P.GB + (size_t)m * 512 + c0);
        const float gb[8] = { bf2f(gbv.x & 0xffff), bf2f(gbv.x >> 16), bf2f(gbv.y & 0xffff), bf2f(gbv.y >> 16), bf2f(gbv.z & 0xffff), bf2f(gbv.z >> 16), bf2f(gbv.w & 0xffff), bf2f(gbv.w >> 16) };
        float o[8];
#pragma unroll
        for (int j = 0; j < 8; ++j) o[j] = gb[j] * (P.conv_w[c0 + j] * cu[0][j] + P.conv_w[512 + c0 + j] * cu[1][j] + P.conv_w[1024 + c0 + j] * cu[2][j]);
        st8bf(P.CA + (size_t)m * 512 + c0, o);
    }
}

__device__ __forceinline__ void unpack8(const u32x4 v, float* f) {
    f[0] = bf2f(v.x & 0xffff); f[1] = bf2f(v.x >> 16); f[2] = bf2f(v.y & 0xffff); f[3] = bf2f(v.y >> 16);
    f[4] = bf2f(v.z & 0xffff); f[5] = bf2f(v.z >> 16); f[6] = bf2f(v.w & 0xffff); f[7] = bf2f(v.w >> 16);
}
__device__ __forceinline__ float gelu_erf(float d) { return 0.5f * d * (1.f + erff(d * 0.70710678118654752f)); }
__device__ __forceinline__ int reduce64i(int (&part)[64], int lane) {
#pragma unroll
    for (int i = 0; i < 32; ++i) { auto r = __builtin_amdgcn_permlane32_swap((unsigned)part[i], (unsigned)part[32 + i], false, false); part[i] = (int)r[0] + (int)r[1]; }
#pragma unroll
    for (int i = 0; i < 16; ++i) { auto r = __builtin_amdgcn_permlane16_swap((unsigned)part[i], (unsigned)part[16 + i], false, false); part[i] = (int)r[0] + (int)r[1]; }
#define RSTAGE(N) { const bool up = (lane & N) != 0; _Pragma("unroll") for (int i = 0; i < N; ++i) { const int keep = up ? part[N + i] : part[i], send = up ? part[i] : part[N + i]; part[i] = keep + __shfl_xor(send, N); } }
    RSTAGE(8) RSTAGE(4) RSTAGE(2) RSTAGE(1)
#undef RSTAGE
    return part[0];
}
#define UB0(x) ((float)((x) & 0xffu))
#define UB1(x) ((float)(((x) >> 8) & 0xffu))
#define UB2(x) ((float)(((x) >> 16) & 0xffu))
#define UB3(x) ((float)((x) >> 24))
__device__ __forceinline__ void peer_final_token(const Params& P, int t, int lane) {
    const int b = t / SEQ;
    const u32x4 hq = *(const u32x4*)(P.H2q + (size_t)t * DM + 16 * lane);
    const float sh = P.sh2[t];
    float acc[16];
#pragma unroll
    for (int j = 0; j < 16; ++j) acc[j] = 0.f;
    float csum = 0.f;
#pragma unroll 1
    for (int half = 0; half < 2; ++half) {
        const int myidx = P.sel_idx[(size_t)t * 128 + half * 64 + lane];
        const float myg = P.sel_g[(size_t)t * 128 + half * 64 + lane];
        const float mysu = P.su[myidx], mysv = P.sv[myidx];
        int part[64];
#pragma unroll
        for (int k = 0; k < 64; ++k) {
            const int e = __builtin_amdgcn_readlane(myidx, k);
            const u32x4 a = *(const u32x4*)(P.Uq + (size_t)e * DM + 16 * lane);
            int d = __builtin_amdgcn_sdot4((int)a.x, (int)hq.x, 0, false);
            d = __builtin_amdgcn_sdot4((int)a.y, (int)hq.y, d, false);
            d = __builtin_amdgcn_sdot4((int)a.z, (int)hq.z, d, false);
            d = __builtin_amdgcn_sdot4((int)a.w, (int)hq.w, d, false);
            part[k] = d;
        }
        const int isum = reduce64i(part, lane);
        const float a = (float)isum * mysu * sh;
        const float c = myg * gelu_erf(a) * mysv;
        csum += c;
#pragma unroll
        for (int k = 0; k < 64; ++k) {
            const int e = __builtin_amdgcn_readlane(myidx, k);
            const float ck = __uint_as_float(__builtin_amdgcn_readlane(__float_as_uint(c), k));
            const u32x4 x = *(const u32x4*)(P.Vq + (size_t)e * DM + 16 * lane);
            acc[0] += ck * UB0(x.x); acc[1] += ck * UB1(x.x); acc[2] += ck * UB2(x.x); acc[3] += ck * UB3(x.x);
            acc[4] += ck * UB0(x.y); acc[5] += ck * UB1(x.y); acc[6] += ck * UB2(x.y); acc[7] += ck * UB3(x.y);
            acc[8] += ck * UB0(x.z); acc[9] += ck * UB1(x.z); acc[10] += ck * UB2(x.z); acc[11] += ck * UB3(x.z);
            acc[12] += ck * UB0(x.w); acc[13] += ck * UB1(x.w); acc[14] += ck * UB2(x.w); acc[15] += ck * UB3(x.w);
        }
    }
    const float cb = 128.f * wave_sum(csum);
    float x2[16]; float ss = 0.f;
    const bf16_t* x1 = P.X1 + (size_t)t * DM + 16 * lane; const float* g2 = P.mod + (size_t)b * NMOD + 5 * DM + 16 * lane;
#pragma unroll
    for (int q = 0; q < 4; ++q) {
        const u32x2 xw = *(const u32x2*)(x1 + 4 * q);
        const f32x4 xa = (f32x4){ bf2f(xw.x & 0xffff), bf2f(xw.x >> 16), bf2f(xw.y & 0xffff), bf2f(xw.y >> 16) }, ga = *(const f32x4*)(g2 + 4 * q);
        x2[4 * q + 0] = xa.x + ga.x * (acc[4 * q + 0] - cb); x2[4 * q + 1] = xa.y + ga.y * (acc[4 * q + 1] - cb);
        x2[4 * q + 2] = xa.z + ga.z * (acc[4 * q + 2] - cb); x2[4 * q + 3] = xa.w + ga.w * (acc[4 * q + 3] - cb);
        ss += x2[4 * q] * x2[4 * q] + x2[4 * q + 1] * x2[4 * q + 1] + x2[4 * q + 2] * x2[4 * q + 2] + x2[4 * q + 3] * x2[4 * q + 3];
    }
    ss = wave_sum(ss);
    const float rstd = rsqrtf(ss * (1.f / DM) + 1e-6f);
    float* op = P.out + (size_t)t * DM + 16 * lane; const float* fgp = P.fg + 16 * lane;
#pragma unroll
    for (int q = 0; q < 4; ++q) {
        const f32x4 fa = *(const f32x4*)(fgp + 4 * q);
        f32x4 o; o.x = x2[4 * q] * rstd * fa.x; o.y = x2[4 * q + 1] * rstd * fa.y; o.z = x2[4 * q + 2] * rstd * fa.z; o.w = x2[4 * q + 3] * rstd * fa.w;
        *(f32x4*)(op + 4 * q) = o;
    }
}

#define XB_TMO      128
#define XB_XCNT(j)  (256  + 64 * (j))
#define XB_XSUB(j)  (1280 + 64 * (j))
#define XB_XGEN(j)  (2304 + 64 * (j))
#define XB_TOP      3328
#define XB_TOPGEN   3392
#define XCD_BAR_WORDS 3456
#define XB_SPIN_CAP (1u << 22)
#define LAS __attribute__((address_space(3)))
__device__ __forceinline__ unsigned xb_ld(unsigned* p)              { return __hip_atomic_load(p, __ATOMIC_RELAXED, __HIP_MEMORY_SCOPE_AGENT); }
__device__ __forceinline__ unsigned xb_add(unsigned* p, unsigned v) { return __hip_atomic_fetch_add(p, v, __ATOMIC_RELAXED, __HIP_MEMORY_SCOPE_AGENT); }
__device__ __forceinline__ unsigned xb_xcc_id() { return (unsigned)__builtin_amdgcn_s_getreg((3 << 11) | 20) & 0xFu; }
#define XB_SPIN(cond, bar) do { unsigned _sp = 0; while (cond) { __builtin_amdgcn_s_sleep(1); \
    if ((++_sp & 255u) == 0u) { if (xb_ld(&(bar)[XB_TMO])) break; if (_sp > XB_SPIN_CAP) { atomicAdd(&(bar)[XB_TMO], 1u); break; } } } } while (0)
struct XcdBarrier { unsigned* bar; unsigned x; volatile LAS unsigned* st; };
__device__ __forceinline__ XcdBarrier xcd_barrier_post(unsigned* bar, volatile LAS unsigned* st) {
    XcdBarrier b; b.bar = bar; b.x = xb_xcc_id(); b.st = st;
    if (threadIdx.x == 0) (void)xb_add(&bar[XB_XCNT(b.x)], 1u);
    return b;
}
__device__ __forceinline__ void xcd_barrier_complete(unsigned* bar, unsigned x, unsigned& nloc, unsigned& nx) {
    const unsigned G = gridDim.x * gridDim.y * gridDim.z;
    unsigned sum, cnt, mine, sp = 0u;
    for (;;) {
        sum = 0u; cnt = 0u; mine = 0u;
#pragma unroll
        for (unsigned j = 0; j < 16; ++j) { const unsigned c = xb_ld(&bar[XB_XCNT(j)]); sum += c; cnt += (c > 0u) ? 1u : 0u; mine = (j == x) ? c : mine; }
        if (sum == G) break;
        __builtin_amdgcn_s_sleep(1);
        if ((++sp & 255u) == 0u) { if (xb_ld(&bar[XB_TMO])) break; if (sp > XB_SPIN_CAP) { atomicAdd(&bar[XB_TMO], 1u); break; } }
    }
    nloc = mine > 0u ? mine : 1u; nx = cnt > 0u ? cnt : 1u;
}
__device__ __forceinline__ void xcd_barrier(const XcdBarrier& b) {
    asm volatile("s_waitcnt vmcnt(0)" ::: "memory");
    __syncthreads();
    if (threadIdx.x == 0) {
        unsigned* bar = b.bar;
        __builtin_amdgcn_s_waitcnt(0);
        unsigned nloc = b.st[0], nx = b.st[1];
        if (nloc == 0u) { xcd_barrier_complete(bar, b.x, nloc, nx); b.st[0] = nloc; b.st[1] = nx; }
        const unsigned old = xb_add(&bar[XB_XSUB(b.x)], 1u);
        const unsigned gen = old / nloc;
        if (old + 1u == (gen + 1u) * nloc) {
            __builtin_amdgcn_fence(__ATOMIC_RELEASE, "agent");
            asm volatile("s_waitcnt vmcnt(0)" ::: "memory");
            const unsigned og = xb_add(&bar[XB_TOP], 1u);
            const unsigned tg = og / nx;
            if (og + 1u == (tg + 1u) * nx) xb_add(&bar[XB_TOPGEN], 1u);
            else XB_SPIN(xb_ld(&bar[XB_TOPGEN]) == tg, bar);
            __builtin_amdgcn_fence(__ATOMIC_ACQUIRE, "agent");
            xb_add(&bar[XB_XGEN(b.x)], 1u);
            asm volatile("s_waitcnt vmcnt(0)" ::: "memory");
        } else {
            XB_SPIN(xb_ld(&bar[XB_XGEN(b.x)]) == gen, bar);
            __builtin_amdgcn_fence(__ATOMIC_ACQUIRE, "agent");
            asm volatile("s_waitcnt vmcnt(0)" ::: "memory");
        }
    }
    __syncthreads();
}

constexpr int NPHASE = 9;
template <int PH> __device__ __forceinline__ void run_phase(const Params& P, char* smem) {
    int tid_ = threadIdx.x; asm volatile("" : "+v"(tid_));
    const int bid = blockIdx.x, G = gridDim.x, tid = tid_;
    const size_t gtid = (size_t)bid * 256 + tid, gsize = (size_t)G * 256;
    if (PH == 0) {
        for (int it = bid; it < 192; it += G) modp_item(P, it, smem);
        float (*tile)[65] = (float (*)[65])smem;
        for (int it = bid; it < 1088; it += G) transpose_tile(P.w_in, DM, PROJW, P.WinT, it, tile);
        for (int it = bid; it < 128; it += G) transpose_tile(P.w_ao, 512, DM, P.WaoT, it, tile);
        for (int it = bid; it < 128; it += G) transpose_tile(P.w_co, 512, DM, P.WcoT, it, tile);
        for (int it = bid; it < 256; it += G) transpose_tile(P.w_mix, DM, DM, P.WmixT, it, tile);
        for (int it = bid; it < 512; it += G) transpose_tile(P.pw_q, DM, 2048, P.PwqT, it, tile);
        cvt_range(P.keys, P.KeysB, (size_t)16 * 128 * 128 / 8, gtid, gsize);
        { const int lane = tid & 63, wid = tid >> 6;
          for (int r = bid * 4 + wid; r < NEXP; r += G * 4) {
              f32x4 va[4], vb[4];
              load_row16(P.pu + (size_t)r * DM, lane, va); load_row16(P.pv + (size_t)r * DM, lane, vb);
              quant_row(va, (unsigned char*)P.Uq + (size_t)r * DM, P.su + r, lane, 0);
              quant_row(vb, P.Vq + (size_t)r * DM, P.sv + r, lane, 128); } }
        rope_tab(P, (int)gtid, (int)gsize);
    } else if (PH == 1) {
        for (int i = (int)gtid; i < 17 * NMOD; i += (int)gsize) {
            float v = P.b_mod[i % NMOD];
#pragma unroll
            for (int kc = 0; kc < 8; ++kc) v += P.modp[(size_t)kc * 17 * NMOD + i];
            P.mod[i] = v;
        }
        if (NTOK % G == 0 && SEQ % (NTOK / G) == 0 && NCTX % G == 0) {
            norm1_rows(P, false, bid * (NTOK / G), NTOK / G, smem);
            norm1_rows(P, true, bid * (NCTX / G), NCTX / G, smem);
        } else {
            for (int it = bid; it < 1152; it += G) { const bool isctx = it >= 1024; norm1_rows(P, isctx, isctx ? (it - 1024) * 32 : it * 32, 32, smem); }
        }
    } else if (PH == 2) {
        for (int t = bid; t < 128 * 34 + 32; t += G) {
            if (t < 128 * 34) { int mt, nt; tile_coords(t, 128, 34, mt, nt); gemm_tile<MODE_INPROJ, 8>(P, P.H, DM, P.WinT, DM, DM, mt * 256, nt * 128, nt * 128 >= 768, smem); }
            else { const int u = t - 128 * 34, mt = u >> 1, nt = u & 1; gemm_tile<MODE_CTXKV, 8>(P, P.HC, DM, P.WinT + (size_t)512 * DM, DM, DM, mt * 256, nt * 128, nt == 0, smem); }
        }
    } else if (PH == 3) {
        for (int it = bid; it < NB * 16 * 8; it += G) attn_item(P, it);
        conv_range(P, gtid, gsize);
    } else if (PH == 4) {
        for (int t = bid; t < 128 * 8; t += G) { int mt, nt; tile_coords(t, 128, 8, mt, nt); gemm_tile<MODE_AO1, 8>(P, P.AO, 512, P.WaoT, 512, 512, mt * 256, nt * 128, true, smem, 0); }
        for (int t = bid; t < 128 * 8; t += G) { int mt, nt; tile_coords(t, 128, 8, mt, nt); gemm_tile<MODE_AO1, 8>(P, P.CA, 512, P.WcoT, 512, 512, mt * 256, nt * 128, true, smem, 1); }
    } else if (PH == 5) {
        for (int t = bid; t < 128 * 8; t += G) { int mt, nt; tile_coords(t, 128, 8, mt, nt); gemm_tile<MODE_MIX, 8>(P, P.YG, DM, P.WmixT, DM, DM, mt * 256, nt * 128, true, smem); }
    } else if (PH == 6) {
        const int lane = tid & 63, wid = tid >> 6;
        float* sc = (float*)smem; float* sh = sc + DM;
        for (int it = bid; it < NTOK / 64; it += G) {
            const int row0 = it * 64, b = row0 / SEQ;
            __syncthreads();
            for (int d = tid; d < DM; d += 256) { sc[d] = P.mod[(size_t)b * NMOD + 4 * DM + d]; sh[d] = P.mod[(size_t)b * NMOD + 3 * DM + d]; }
            __syncthreads();
            for (int i = wid; i < 64; i += 8) {
                const int ra = row0 + i, rb = ra + 4;
                f32x4 va[4], vb[4];
                load_row4_bf(P.X1 + (size_t)ra * DM, lane, va); load_row4_bf(P.X1 + (size_t)rb * DM, lane, vb);
                norm_row_q(va, P.n2, sc, sh, P.H2 + (size_t)ra * DM, P.H2q + (size_t)ra * DM, P.sh2 + ra, lane);
                norm_row_q(vb, P.n2, sc, sh, P.H2 + (size_t)rb * DM, P.H2q + (size_t)rb * DM, P.sh2 + rb, lane);
            }
        }
    } else if (PH == 7) {
        for (int it = bid; it < 256 * 8; it += G) peer_retrieve_item(P, it >> 3, it & 7, smem);
    } else if (PH == 8) {
        const int lane = tid & 63, wid = tid >> 6;
        for (int t = bid * 4 + wid; t < NTOK; t += G * 4) peer_final_token(P, t, lane);
    }
}
#ifndef REP0
#define REP0 1
#endif
#ifndef REP1
#define REP1 1
#endif
#ifndef REP2
#define REP2 1
#endif
#ifndef REP3
#define REP3 1
#endif
#ifndef REP4
#define REP4 1
#endif
#ifndef REP5
#define REP5 1
#endif
#ifndef REP6
#define REP6 1
#endif
#ifndef REP7
#define REP7 1
#endif
#ifndef REP8
#define REP8 1
#endif
constexpr int MEGA_LDS = 3 * (2048 * 8 + 8192);
#ifndef MULTI_LAUNCH
__global__ void __launch_bounds__(256, 2) k_mega(Params P) {
    extern __shared__ __attribute__((aligned(16))) char smem[];
    volatile LAS unsigned* st = (volatile LAS unsigned*)(smem + MEGA_LDS);
    if (threadIdx.x < 4) st[threadIdx.x] = 0u;
    __syncthreads();
    const XcdBarrier bar = xcd_barrier_post(P.bar, st);
#define PHASE_SYNC(k) for (int rep = 0; rep < REP##k; ++rep) { run_phase<k>(P, smem); xcd_barrier(bar); }
    PHASE_SYNC(0) PHASE_SYNC(1) PHASE_SYNC(2) PHASE_SYNC(3) PHASE_SYNC(4) PHASE_SYNC(5) PHASE_SYNC(6) PHASE_SYNC(7)
    for (int rep = 0; rep < REP8 - 1; ++rep) { run_phase<8>(P, smem); xcd_barrier(bar); }
    run_phase<8>(P, smem);
}
#else
template <int PH> __global__ void __launch_bounds__(256, 2) k_phase(Params P) {
    extern __shared__ __attribute__((aligned(16))) char smem[];
    run_phase<PH>(P, smem);
}
#endif

static size_t carve(size_t& off, size_t bytes) { const size_t o = off; off += (bytes + 255) & ~(size_t)255; return o; }

extern "C" void kernel_launch(void* const* d_in, const int* in_sizes, int n_in, void* d_out, int out_size, void* d_ws, size_t ws_size, hipStream_t stream) {
    Params P{};
    P.x = (const float*)d_in[0]; P.c = (const float*)d_in[1]; P.ctx = (const float*)d_in[2]; P.c_ctx = (const float*)d_in[3];
    P.w_mod = (const float*)d_in[4]; P.b_mod = (const float*)d_in[5]; P.n1 = (const float*)d_in[6]; P.n2 = (const float*)d_in[7];
    P.w_in = (const float*)d_in[8]; P.sink = (const float*)d_in[9]; P.conv_w = (const float*)d_in[10]; P.w_ao = (const float*)d_in[11];
    P.w_co = (const float*)d_in[12]; P.w_mix = (const float*)d_in[13]; P.pw_q = (const float*)d_in[14]; P.keys = (const float*)d_in[15];
    P.pu = (const float*)d_in[16]; P.pv = (const float*)d_in[17]; P.fg = (const float*)d_in[18];
    P.out = (float*)d_out;
    char* ws = (char*)d_ws; size_t off = 0;
    P.modp = (float*)(ws + carve(off, (size_t)8 * 17 * NMOD * 4));
    P.mod = (float*)(ws + carve(off, (size_t)17 * NMOD * 4));
    P.rope = (float*)(ws + carve(off, 3072 * 4));
    P.WinT = (bf16_t*)(ws + carve(off, (size_t)PROJW * DM * 2));
    P.WaoT = (bf16_t*)(ws + carve(off, (size_t)DM * 512 * 2));
    P.WcoT = (bf16_t*)(ws + carve(off, (size_t)DM * 512 * 2));
    P.WmixT = (bf16_t*)(ws + carve(off, (size_t)DM * DM * 2));
    P.PwqT = (bf16_t*)(ws + carve(off, (size_t)2048 * DM * 2));
    P.KeysB = (bf16_t*)(ws + carve(off, (size_t)16 * 128 * 128 * 2));
    P.Uq = (signed char*)(ws + carve(off, (size_t)NEXP * DM));
    P.Vq = (unsigned char*)(ws + carve(off, (size_t)NEXP * DM));
    P.su = (float*)(ws + carve(off, (size_t)NEXP * 4));
    P.sv = (float*)(ws + carve(off, (size_t)NEXP * 4));
    P.sh2 = (float*)(ws + carve(off, (size_t)NTOK * 4));
    P.HC = (bf16_t*)(ws + carve(off, (size_t)NCTX * DM * 2));
    const size_t regA = carve(off, (size_t)NTOK * DM * 2);
    P.H = (bf16_t*)(ws + regA); P.YG = (bf16_t*)(ws + regA); P.H2 = (bf16_t*)(ws + regA);
    const size_t regB = off;
    P.Q = (bf16_t*)(ws + carve(off, (size_t)NTOK * 512 * 2));
    P.K = (bf16_t*)(ws + carve(off, (size_t)NTOK * 128 * 2));
    P.VT = (bf16_t*)(ws + carve(off, (size_t)NTOK * 128 * 2));
    P.Kc = (bf16_t*)(ws + carve(off, (size_t)NCTX * 128 * 2));
    P.VcT = (bf16_t*)(ws + carve(off, (size_t)NCTX * 128 * 2));
    const size_t regC = off;
    P.GB = (bf16_t*)(ws + carve(off, (size_t)NTOK * 512 * 2));
    P.GC = (bf16_t*)(ws + carve(off, (size_t)NTOK * 512 * 2));
    P.U = (bf16_t*)(ws + carve(off, (size_t)NTOK * 512 * 2));
    P.M1 = (bf16_t*)(ws + regC);
    const size_t regD = off;
    P.GA = (bf16_t*)(ws + carve(off, (size_t)NTOK * DM * 2));
    P.GV = (bf16_t*)(ws + carve(off, (size_t)NTOK * DM * 2));
    P.AO = (bf16_t*)(ws + carve(off, (size_t)NTOK * 512 * 2));
    P.H2q = (signed char*)P.AO;
    P.CA = (bf16_t*)(ws + carve(off, (size_t)NTOK * 512 * 2));
    P.X1 = (bf16_t*)(ws + regD);
    P.bar = (unsigned*)(ws + carve(off, (size_t)XCD_BAR_WORDS * 4));
    const size_t need = off;
    { size_t o2 = regB;
      P.sel_idx = (int*)(ws + carve(o2, (size_t)NTOK * 128 * 4));
      P.sel_g = (float*)(ws + carve(o2, (size_t)NTOK * 128 * 4));
      if (o2 > regC) { fprintf(stderr, "kernel_launch: late buffers overflow\n"); return; } }
    if (need > ws_size) { fprintf(stderr, "kernel_launch: workspace too small: need %zu have %zu\n", need, ws_size); return; }

#ifdef MULTI_LAUNCH
    static bool attr_done = false;
    if (!attr_done) {
#define SETA(PH) hipFuncSetAttribute((const void*)k_phase<PH>, hipFuncAttributeMaxDynamicSharedMemorySize, MEGA_LDS)
        SETA(0); SETA(1); SETA(2); SETA(3); SETA(4); SETA(5); SETA(6); SETA(7); SETA(8);
        attr_done = true;
    }
#define LP(PH) k_phase<PH><<<512, 256, MEGA_LDS, stream>>>(P)
    LP(0); LP(1); LP(2); LP(3); LP(4); LP(5); LP(6); LP(7); LP(8);
#else
    static int grid_blocks = 0;
    if (!grid_blocks) {
        int dev = 0, cus = 0, per_cu = 0;
        (void)hipGetDevice(&dev);
        (void)hipDeviceGetAttribute(&cus, hipDeviceAttributeMultiprocessorCount, dev);
        (void)hipFuncSetAttribute((const void*)k_mega, hipFuncAttributeMaxDynamicSharedMemorySize, MEGA_LDS + 16);
        (void)hipOccupancyMaxActiveBlocksPerMultiprocessor(&per_cu, (const void*)k_mega, 256, MEGA_LDS + 16);
        if (per_cu > 2) per_cu = 2;
        if (per_cu < 1) { fprintf(stderr, "kernel_launch: occupancy query returned %d\n", per_cu); per_cu = 1; }
        grid_blocks = cus * per_cu;
    }
    (void)hipMemsetAsync(P.bar, 0, (size_t)XCD_BAR_WORDS * 4, stream);
    void* args[] = { &P };
    hipError_t e = hipLaunchCooperativeKernel((const void*)k_mega, dim3(grid_blocks), dim3(256), args, MEGA_LDS + 16, stream);
    if (e != hipSuccess) fprintf(stderr, "cooperative launch failed: %s (grid %d)\n", hipGetErrorString(e), grid_blocks);
#endif
}
```

```cpp
#include <hip/hip_runtime.h>
#include <cstdio>
#include <cstdint>

typedef unsigned short bf16_t;
typedef short bf16x8 __attribute__((ext_vector_type(8)));
typedef float f32x4 __attribute__((ext_vector_type(4)));
typedef unsigned u32x4 __attribute__((ext_vector_type(4)));
typedef unsigned u32x2 __attribute__((ext_vector_type(2)));

constexpr int DM = 1024, NB = 16, SEQ = 2048, NTOK = NB * SEQ, CTXL = 256, NCTX = NB * CTXL;
constexpr int PROJW = 4352;
constexpr int NMOD = 6 * DM;
constexpr int NEXP = 16384;

__device__ __forceinline__ float bf2f(bf16_t x) { return __uint_as_float(((unsigned)x) << 16); }
__device__ __forceinline__ bf16_t f2bf(float f) {
    unsigned u = __float_as_uint(f);
    u += 0x7fffu + ((u >> 16) & 1u);
    return (bf16_t)(u >> 16);
}
__device__ __forceinline__ unsigned pk2(float lo, float hi) { unsigned r; asm("v_cvt_pk_bf16_f32 %0, %1, %2" : "=v"(r) : "v"(lo), "v"(hi)); return r; }
__device__ __forceinline__ float sigmoidf_(float x) { return 1.f / (1.f + __expf(-x)); }
__device__ __forceinline__ float wave_sum(float v) {
#pragma unroll
    for (int o = 1; o < 64; o <<= 1) v += __shfl_xor(v, o);
    return v;
}

__device__ __forceinline__ float wave_max(float v) {
#pragma unroll
    for (int o = 1; o < 64; o <<= 1) v = fmaxf(v, __shfl_xor(v, o));
    return v;
}
__device__ __forceinline__ unsigned q8(float x, float inv, int bias) {
    int q = (int)rintf(x * inv); q = q > 127 ? 127 : (q < -127 ? -127 : q);
    return (unsigned)((q + bias) & 0xff);
}
__device__ __forceinline__ void load_row16(const float* src, int lane, f32x4 (&v)[4]) {
#pragma unroll
    for (int j = 0; j < 4; ++j) v[j] = *(const f32x4*)(src + 16 * lane + 4 * j);
}
__device__ __forceinline__ void quant_row(f32x4 (&v)[4], unsigned char* dst, float* scale_out, int lane, int bias) {
    float amax = 0.f;
#pragma unroll
    for (int j = 0; j < 4; ++j) amax = fmaxf(amax, fmaxf(fmaxf(fabsf(v[j].x), fabsf(v[j].y)), fmaxf(fabsf(v[j].z), fabsf(v[j].w))));
    amax = wave_max(amax);
    const float sc = amax > 0.f ? amax * (1.f / 127.f) : 1.f, inv = 1.f / sc;
    u32x4 w;
    w.x = q8(v[0].x, inv, bias) | (q8(v[0].y, inv, bias) << 8) | (q8(v[0].z, inv, bias) << 16) | (q8(v[0].w, inv, bias) << 24);
    w.y = q8(v[1].x, inv, bias) | (q8(v[1].y, inv, bias) << 8) | (q8(v[1].z, inv, bias) << 16) | (q8(v[1].w, inv, bias) << 24);
    w.z = q8(v[2].x, inv, bias) | (q8(v[2].y, inv, bias) << 8) | (q8(v[2].z, inv, bias) << 16) | (q8(v[2].w, inv, bias) << 24);
    w.w = q8(v[3].x, inv, bias) | (q8(v[3].y, inv, bias) << 8) | (q8(v[3].z, inv, bias) << 16) | (q8(v[3].w, inv, bias) << 24);
    *(u32x4*)(dst + 16 * lane) = w;
    if (lane == 0) *scale_out = sc;
}

struct Params {
    const float *x, *c, *ctx, *c_ctx, *w_mod, *b_mod, *n1, *n2, *w_in, *sink, *conv_w, *w_ao, *w_co, *w_mix, *pw_q, *keys, *pu, *pv, *fg;
    float* out;
    float *modp, *mod, *rope;
    bf16_t *WinT, *WaoT, *WcoT, *WmixT, *PwqT, *KeysB;
    bf16_t *H, *HC, *Q, *K, *VT, *Kc, *VcT, *GB, *GC, *U, *GA, *GV, *AO, *CA, *M1, *YG, *H2, *QH;
    float* TKv; int* TKi;
    int* sel_idx; float* sel_g;
    bf16_t* X1;
    unsigned* bar;
    signed char *Uq, *H2q; unsigned char* Vq; float *su, *sv, *sh2, *cbuf;
};

__device__ __forceinline__ void modp_item(const Params& P, int item, char* smem) {
    float (*s)[128] = (float (*)[128])smem;
    const int kc = item / 24, nc = item % 24;
    __syncthreads();
    for (int i = threadIdx.x; i < 17 * 128; i += 256) {
        const int r = i / 128, k = i % 128;
        const float v = (r < 16) ? P.c[r * DM + kc * 128 + k] : P.c_ctx[kc * 128 + k];
        s[r][k] = v / (1.f + __expf(-v));
    }
    __syncthreads();
    const int n = nc * 256 + threadIdx.x;
    float acc[17];
#pragma unroll
    for (int r = 0; r < 17; ++r) acc[r] = 0.f;
    for (int k = 0; k < 128; ++k) {
        const float w = P.w_mod[(size_t)(kc * 128 + k) * NMOD + n];
#pragma unroll
        for (int r = 0; r < 17; ++r) acc[r] += s[r][k] * w;
    }
#pragma unroll
    for (int r = 0; r < 17; ++r) P.modp[((size_t)kc * 17 + r) * NMOD + n] = acc[r];
}
__device__ __forceinline__ void cvt_range(const float* src, bf16_t* dst, size_t n8, size_t gtid, size_t gsize) {
    for (size_t i = gtid; i < n8; i += gsize) {
        const f32x4 a = *(const f32x4*)(src + i * 8), b = *(const f32x4*)(src + i * 8 + 4);
        u32x4 o; o.x = pk2(a.x, a.y); o.y = pk2(a.z, a.w); o.z = pk2(b.x, b.y); o.w = pk2(b.z, b.w);
        *(u32x4*)(dst + i * 8) = o;
    }
}
__device__ __forceinline__ void rope_tab(const Params& P, int gtid, int gsize) {
    for (int i = gtid; i < 1536; i += gsize) {
        int pos, f; bool isc;
        if (i < 512) { pos = i / 16; f = i % 16; isc = false; } else { pos = (i - 512) / 16; f = (i - 512) % 16; isc = true; }
        const double inv = pow(10000.0, -(double)f / 16.0);
        const double ang = (double)pos * inv;
        const float cv = (float)cos(ang), sv = (float)sin(ang);
        if (!isc) { P.rope[pos * 16 + f] = cv; P.rope[512 + pos * 16 + f] = sv; }
        else { P.rope[1024 + pos * 16 + f] = cv; P.rope[2048 + pos * 16 + f] = sv; }
    }
}
__device__ __forceinline__ void transpose_tile(const float* W, int K, int N, bf16_t* Wt, int item, float (*tile)[65]) {
    const int ntn = N / 64, kt = item / ntn, nt = item % ntn, k0 = kt * 64, n0 = nt * 64;
    const int tx = threadIdx.x & 63, ty = threadIdx.x >> 6;
    __syncthreads();
#pragma unroll
    for (int i = 0; i < 16; ++i) { const int k = i * 4 + ty; tile[k][tx] = W[(size_t)(k0 + k) * N + n0 + tx]; }
    __syncthreads();
#pragma unroll
    for (int i = 0; i < 16; ++i) { const int n = i * 4 + ty; Wt[(size_t)(n0 + n) * K + k0 + tx] = f2bf(tile[tx][n]); }
}

__device__ __forceinline__ void load_row4_bf(const bf16_t* xr, int lane, f32x4 (&v)[4]) {
#pragma unroll
    for (int j = 0; j < 4; ++j) { const u32x2 w = *(const u32x2*)(xr + j * 256 + lane * 4);
        v[j].x = bf2f(w.x & 0xffff); v[j].y = bf2f(w.x >> 16); v[j].z = bf2f(w.y & 0xffff); v[j].w = bf2f(w.y >> 16); }
}
__device__ __forceinline__ void load_row4(const float* xr, int lane, f32x4 (&v)[4]) {
#pragma unroll
    for (int j = 0; j < 4; ++j) v[j] = *(const f32x4*)(xr + j * 256 + lane * 4);
}
__device__ __forceinline__ void norm_row(f32x4 (&v)[4], const float* g, const float* scale, const float* shift, bf16_t* dst, int lane) {
    float s = 0.f;
#pragma unroll
    for (int j = 0; j < 4; ++j) s += v[j].x * v[j].x + v[j].y * v[j].y + v[j].z * v[j].z + v[j].w * v[j].w;
    s = wave_sum(s);
    const float rstd = rsqrtf(s * (1.f / DM) + 1e-6f);
#pragma unroll
    for (int j = 0; j < 4; ++j) {
        const int d = j * 256 + lane * 4;
        const f32x4 gg = *(const f32x4*)(g + d), sc = *(const f32x4*)(scale + d), sh = *(const f32x4*)(shift + d);
        const float y0 = v[j].x * rstd * gg.x * (1.f + sc.x) + sh.x;
        const float y1 = v[j].y * rstd * gg.y * (1.f + sc.y) + sh.y;
        const float y2 = v[j].z * rstd * gg.z * (1.f + sc.z) + sh.z;
        const float y3 = v[j].w * rstd * gg.w * (1.f + sc.w) + sh.w;
        u32x2 o; o.x = pk2(y0, y1); o.y = pk2(y2, y3);
        *(u32x2*)(dst + d) = o;
    }
}

__device__ __forceinline__ void norm_row_q(f32x4 (&v)[4], const float* g, const float* scale, const float* shift, bf16_t* dst, signed char* dq, float* sq, int lane) {
    float s = 0.f;
#pragma unroll
    for (int j = 0; j < 4; ++j) s += v[j].x * v[j].x + v[j].y * v[j].y + v[j].z * v[j].z + v[j].w * v[j].w;
    s = wave_sum(s);
    const float rstd = rsqrtf(s * (1.f / DM) + 1e-6f);
    float amax = 0.f;
#pragma unroll
    for (int j = 0; j < 4; ++j) {
        const int d = j * 256 + lane * 4;
        const f32x4 gg = *(const f32x4*)(g + d), sc = *(const f32x4*)(scale + d), sh = *(const f32x4*)(shift + d);
        v[j].x = v[j].x * rstd * gg.x * (1.f + sc.x) + sh.x;
        v[j].y = v[j].y * rstd * gg.y * (1.f + sc.y) + sh.y;
        v[j].z = v[j].z * rstd * gg.z * (1.f + sc.z) + sh.z;
        v[j].w = v[j].w * rstd * gg.w * (1.f + sc.w) + sh.w;
        u32x2 o; o.x = pk2(v[j].x, v[j].y); o.y = pk2(v[j].z, v[j].w);
        *(u32x2*)(dst + d) = o;
        amax = fmaxf(amax, fmaxf(fmaxf(fabsf(v[j].x), fabsf(v[j].y)), fmaxf(fabsf(v[j].z), fabsf(v[j].w))));
    }
    amax = wave_max(amax);
    const float qs = amax > 0.f ? amax * (1.f / 127.f) : 1.f, inv = 1.f / qs;
#pragma unroll
    for (int j = 0; j < 4; ++j) {
        const unsigned w = q8(v[j].x, inv, 0) | (q8(v[j].y, inv, 0) << 8) | (q8(v[j].z, inv, 0) << 16) | (q8(v[j].w, inv, 0) << 24);
        *(unsigned*)(dq + j * 256 + lane * 4) = w;
    }
    if (lane == 0) *sq = qs;
}

__device__ __forceinline__ void norm1_rows(const Params& P, bool isctx, int row0, int nrows, char* smem) {
    float* sc = (float*)smem; float* sh = sc + DM;
    const int r = isctx ? 16 : row0 / SEQ;
    __syncthreads();
    for (int d = threadIdx.x; d < DM; d += 256) {
        float a = P.b_mod[DM + d], b = P.b_mod[d];
#pragma unroll
        for (int kc = 0; kc < 8; ++kc) { a += P.modp[((size_t)kc * 17 + r) * NMOD + DM + d]; b += P.modp[((size_t)kc * 17 + r) * NMOD + d]; }
        sc[d] = a; sh[d] = b;
    }
    __syncthreads();
    const int lane = threadIdx.x & 63, wid = threadIdx.x >> 6;
    const float* srcb = isctx ? P.ctx : P.x; bf16_t* dstb = isctx ? P.HC : P.H;
    for (int i = wid; i < nrows; i += 8) {
        const int ra = row0 + i, rb = row0 + i + 4; const bool hb = (i + 4) < nrows;
        f32x4 va[4], vb[4];
        load_row4(srcb + (size_t)ra * DM, lane, va); if (hb) load_row4(srcb + (size_t)rb * DM, lane, vb);
        norm_row(va, P.n1, sc, sh, dstb + (size_t)ra * DM, lane);
        if (hb) norm_row(vb, P.n1, sc, sh, dstb + (size_t)rb * DM, lane);
    }
}
enum { MODE_INPROJ = 0, MODE_CTXKV = 1, MODE_AO1 = 2, MODE_CO2 = 3, MODE_MIX = 4, MODE_QH = 5 };

__device__ __forceinline__ void st8bf(bf16_t* p, const float* v) {
    u32x4 o; o.x = pk2(v[0], v[1]); o.y = pk2(v[2], v[3]); o.z = pk2(v[4], v[5]); o.w = pk2(v[6], v[7]);
    *(u32x4*)p = o;
}
__device__ __forceinline__ void st8bf_nt(bf16_t* p, const float* v) {
    u32x4 o; o.x = pk2(v[0], v[1]); o.y = pk2(v[2], v[3]); o.z = pk2(v[4], v[5]); o.w = pk2(v[6], v[7]);
    __builtin_nontemporal_store(o, (u32x4*)p);
}
__device__ __forceinline__ void st4bf(bf16_t* p, const float* v) {
    u32x2 o; o.x = pk2(v[0], v[1]); o.y = pk2(v[2], v[3]);
    *(u32x2*)p = o;
}
template <int MODE> __device__ __forceinline__ void epi8(const Params& P, int m, int n, const float* v, int aux) {
    if (MODE == MODE_INPROJ) {
        if (n < 1280) st8bf_nt(P.GB + (size_t)m * 512 + (n - 768), v);
        else if (n < 1792) st8bf_nt(P.GC + (size_t)m * 512 + (n - 1280), v);
        else if (n < 2304) st8bf_nt(P.U + (size_t)m * 512 + (n - 1792), v);
        else {
            float s[8];
#pragma unroll
            for (int j = 0; j < 8; ++j) s[j] = sigmoidf_(v[j]);
            if (n < 3328) st8bf_nt(P.GA + (size_t)m * DM + (n - 2304), s);
            else st8bf_nt(P.GV + (size_t)m * DM + (n - 3328), s);
        }
    } else if (MODE == MODE_CTXKV) {
        { const int b = m / CTXL, c = m % CTXL, kvh = n >> 6, d0 = n & 63;
          st8bf(P.Kc + ((((size_t)((b * 2 + kvh) * 8 + (c >> 5)) * 4 + (d0 >> 4)) * 2 + ((d0 >> 3) & 1)) * 32 + (c & 31)) * 8, v); }
    } else if (MODE == MODE_AO1) {
        const u32x4 g = *(const u32x4*)((aux ? P.GV : P.GA) + (size_t)m * DM + n);
        u32x4 a = (u32x4){0u, 0u, 0u, 0u};
        if (aux) a = *(const u32x4*)(P.M1 + (size_t)m * DM + n);
        float o[8];
        o[0] = bf2f(a.x & 0xffff) + v[0] * bf2f(g.x & 0xffff); o[1] = bf2f(a.x >> 16) + v[1] * bf2f(g.x >> 16);
        o[2] = bf2f(a.y & 0xffff) + v[2] * bf2f(g.y & 0xffff); o[3] = bf2f(a.y >> 16) + v[3] * bf2f(g.y >> 16);
        o[4] = bf2f(a.z & 0xffff) + v[4] * bf2f(g.z & 0xffff); o[5] = bf2f(a.z >> 16) + v[5] * bf2f(g.z >> 16);
        o[6] = bf2f(a.w & 0xffff) + v[6] * bf2f(g.w & 0xffff); o[7] = bf2f(a.w >> 16) + v[7] * bf2f(g.w >> 16);
        st8bf((aux ? P.YG : P.M1) + (size_t)m * DM + n, o);
    } else if (MODE == MODE_MIX) {
        const int b = m / SEQ;
        const float* g1 = P.mod + (size_t)b * NMOD + 2 * DM + n;
        const float* xr = P.x + (size_t)m * DM + n;
        const f32x4 x0 = *(const f32x4*)xr, x1 = *(const f32x4*)(xr + 4), g0 = *(const f32x4*)g1, g1v = *(const f32x4*)(g1 + 4);
        float o[8];
        o[0] = x0.x + g0.x * v[0]; o[1] = x0.y + g0.y * v[1]; o[2] = x0.z + g0.z * v[2]; o[3] = x0.w + g0.w * v[3];
        o[4] = x1.x + g1v.x * v[4]; o[5] = x1.y + g1v.y * v[5]; o[6] = x1.z + g1v.z * v[6]; o[7] = x1.w + g1v.w * v[7];
        st8bf(P.X1 + (size_t)m * DM + n, o);
    } else if (MODE == MODE_QH) {
        st8bf(P.QH + (size_t)m * 2048 + n, v);
    }
}
__device__ __forceinline__ void epi_rope(const Params& P, int m, int n, const float* lo, const float* hi) {
    const int d0 = n & 63;
    const int l = m % SEQ;
    const float *ct, *st;
    if (d0 < 16) { const int row = l >> 6; ct = P.rope + row * 16 + d0; st = P.rope + 512 + row * 16 + d0; }
    else { const int col = l & 63; ct = P.rope + 1024 + col * 16 + (d0 - 32); st = P.rope + 2048 + col * 16 + (d0 - 32); }
    float a[4], b[4];
    const float sc = (n < 512) ? 0.125f * 1.44269504088896f : 1.f;
#pragma unroll
    for (int j = 0; j < 4; ++j) { const float cc = ct[j], ss = st[j]; a[j] = (lo[j] * cc - hi[j] * ss) * sc; b[j] = (lo[j] * ss + hi[j] * cc) * sc; }
    if (n < 512) { st4bf(P.Q + (size_t)m * 512 + n, a); st4bf(P.Q + (size_t)m * 512 + n + 16, b); }
    else { const int bb = m / SEQ, kvh = (n - 512) >> 6;
        bf16_t* kp = P.K + ((((size_t)((bb * 2 + kvh) * 64 + (l >> 5)) * 4 + (d0 >> 4)) * 2 + ((d0 >> 3) & 1)) * 32 + (l & 31)) * 8 + (d0 & 7);
        st4bf(kp, a); st4bf(kp + 512, b); }
}
__device__ __forceinline__ void epi_v4(const Params& P, int m, int dcol, const float* v, bool ctx) {
    const int kvh = dcol >> 6, dd = dcol & 63;
    if (!ctx) { const int b = m / SEQ, l = m % SEQ;
#pragma unroll
        for (int j = 0; j < 4; ++j) {
            const int kk = l & 31;
            P.VT[(((((size_t)((b * 2 + kvh) * 64 + (l >> 5)) * 2 + (dd >> 5)) * 2 + (kk >> 4)) * 2 + ((kk >> 2) & 1)) * 32 + ((dd & 31) + j)) * 8 + 4 * ((kk >> 3) & 1) + (kk & 3)] = f2bf(v[j]); }
    } else { const int b = m / CTXL, cpos = m % CTXL;
#pragma unroll
        for (int j = 0; j < 4; ++j) {
            const int kk = cpos & 31;
            P.VcT[(((((size_t)((b * 2 + kvh) * 8 + (cpos >> 5)) * 2 + (dd >> 5)) * 2 + (kk >> 4)) * 2 + ((kk >> 2) & 1)) * 32 + ((dd & 31) + j)) * 8 + 4 * ((kk >> 3) & 1) + (kk & 3)] = f2bf(v[j]); }
    }
}

constexpr int GEMM_LDS = 65536;
constexpr int RETR_LDS = 128 * 130 * 4;
__device__ __forceinline__ int lds_off(int row, int chunk) { return row * 128 + ((chunk ^ ((row >> 1) & 7)) << 4); }

__device__ __forceinline__ void mma_from_lds(const char* As, const char* Bs, f32x4 (&acc)[4][4], int wm, int wn, int fr, int fq, int sw) {
#pragma unroll
    for (int ks = 0; ks < 2; ++ks) {
        bf16x8 af[4], bfr[4];
        const int coff = ((ks * 4 + fq) ^ sw) << 4;
#pragma unroll
        for (int mt = 0; mt < 4; ++mt) af[mt] = *(const bf16x8*)(As + (wm * 64 + mt * 16 + fr) * 128 + coff);
#pragma unroll
        for (int nt = 0; nt < 4; ++nt) bfr[nt] = *(const bf16x8*)(Bs + (wn * 64 + nt * 16 + fr) * 128 + coff);
#pragma unroll
        for (int mt = 0; mt < 4; ++mt)
#pragma unroll
            for (int nt = 0; nt < 4; ++nt) acc[mt][nt] = __builtin_amdgcn_mfma_f32_16x16x32_bf16(bfr[nt], af[mt], acc[mt][nt], 0, 0, 0);
    }
}
__device__ __forceinline__ void gemm_mainloop(const bf16_t* __restrict__ A, int lda, const bf16_t* __restrict__ Bt, int ldb, int K, int m0, int n0, bool perm, char* smem, f32x4 (&acc)[4][4]) {
    const int tid = threadIdx.x, lane = tid & 63, wid = tid >> 6;
    const int wm = wid >> 1, wn = wid & 1, fr = lane & 15, fq = lane >> 4;
    const bf16_t* ag[4]; const bf16_t* bg[4];
#pragma unroll
    for (int i = 0; i < 4; ++i) {
        const int row = (wid + 4 * i) * 8 + (lane >> 3);
        const int c = (lane & 7) ^ ((row >> 1) & 7);
        ag[i] = A + (size_t)(m0 + row) * lda + c * 8;
        int brow = row;
        if (perm) { const int g = row >> 5, rr = row & 31, nn = rr >> 4, j = rr & 15; brow = 32 * g + 8 * (j >> 2) + 4 * nn + (j & 3); }
        bg[i] = Bt + (size_t)(n0 + brow) * ldb + c * 8;
    }
#pragma unroll
    for (int i = 0; i < 4; ++i)
#pragma unroll
        for (int j = 0; j < 4; ++j) acc[i][j] = (f32x4){0.f, 0.f, 0.f, 0.f};
#define GSTAGE(buf, k0) { _Pragma("unroll") for (int i = 0; i < 4; ++i) { \
        __builtin_amdgcn_global_load_lds((const unsigned*)(ag[i] + (k0)), (unsigned*)(smem + (buf) * 32768 + (wid + 4 * i) * 1024), 16, 0, 0); \
        __builtin_amdgcn_global_load_lds((const unsigned*)(bg[i] + (k0)), (unsigned*)(smem + (buf) * 32768 + 16384 + (wid + 4 * i) * 1024), 16, 0, 0); } }
    GSTAGE(0, 0)
    asm volatile("s_waitcnt vmcnt(0)" ::: "memory");
    __syncthreads();
    const int nk = K / 64;
    const int sw = (fr >> 1) & 7;
    for (int kt = 0; kt < nk; ++kt) {
        const int cur = kt & 1;
        if (kt + 1 < nk) GSTAGE(cur ^ 1, (kt + 1) * 64)
        mma_from_lds(smem + cur * 32768, smem + cur * 32768 + 16384, acc, wm, wn, fr, fq, sw);
        asm volatile("s_waitcnt vmcnt(0)" ::: "memory");
        __syncthreads();
    }
#undef GSTAGE
}

template <int MT, int NST>
__device__ __forceinline__ void gemm_ring(const bf16_t* __restrict__ A, int lda, const bf16_t* __restrict__ Bt, int ldb, int K, int m0, int n0, bool perm, char* smem, f32x4 (&acc)[MT][4]) {
    constexpr int SA = 2048 * MT, SB = SA + 8192, GA = MT / 2, GL = GA + 2;
    const int tid = threadIdx.x, lane = tid & 63, wid = __builtin_amdgcn_readfirstlane(tid >> 6);
    const int wm = wid >> 1, wn = wid & 1, fr = lane & 15, fq = lane >> 4;
    const int c8 = ((lane & 3) ^ (3 * ((lane >> 4) & 1))) * 8;
    unsigned aoff[GA], boff[2];
#pragma unroll
    for (int i = 0; i < GA; ++i) aoff[i] = (unsigned)(((wid + 4 * i) * 16 + (lane >> 2)) * lda + c8) * 2u;
#pragma unroll
    for (int i = 0; i < 2; ++i) {
        const int row = (wid + 4 * i) * 16 + (lane >> 2);
        int brow = row;
        if (perm) { const int g = row >> 5, rr = row & 31, nn = rr >> 4, j = rr & 15; brow = 32 * g + 8 * (j >> 2) + 4 * nn + (j & 3); }
        boff[i] = (unsigned)(brow * ldb + c8) * 2u;
    }
    const char* Abase = (const char*)(A + (size_t)m0 * lda);
    const char* Bbase = (const char*)(Bt + (size_t)n0 * ldb);
#pragma unroll
    for (int i = 0; i < MT; ++i)
#pragma unroll
        for (int j = 0; j < 4; ++j) acc[i][j] = (f32x4){0.f, 0.f, 0.f, 0.f};
#define RSTAGE_(buf, k0) { char* sb_ = smem + (buf) * SB; const char* ab_ = Abase + (size_t)(k0) * 2; const char* bb_ = Bbase + (size_t)(k0) * 2; \
        _Pragma("unroll") for (int i = 0; i < GA; ++i) __builtin_amdgcn_global_load_lds((const unsigned*)(ab_ + aoff[i]), (unsigned*)(sb_ + (wid + 4 * i) * 1024), 16, 0, 0); \
        _Pragma("unroll") for (int i = 0; i < 2; ++i) __builtin_amdgcn_global_load_lds((const unsigned*)(bb_ + boff[i]), (unsigned*)(sb_ + SA + (wid + 4 * i) * 1024), 16, 0, 0); }
    const int nk = K / 32;
    asm volatile("s_waitcnt vmcnt(0)" ::: "memory");
#pragma unroll
    for (int s = 0; s < NST - 1; ++s) RSTAGE_(s, s * 32)
    const int coff = (fq ^ (3 * ((fr >> 2) & 1))) << 4;
    int cur = 0, nxt = NST - 1;
#pragma unroll 1
    for (int kt = 0; kt < nk; ++kt) {
        const int rem = nk - 1 - kt;
        if (rem >= NST - 2) asm volatile("s_waitcnt vmcnt(%0)" :: "n"(GL * (NST - 2)) : "memory");
        else if (NST == 4 && rem == 1) asm volatile("s_waitcnt vmcnt(%0)" :: "n"(GL) : "memory");
        else asm volatile("s_waitcnt vmcnt(0)" ::: "memory");
        __builtin_amdgcn_s_barrier();
        const char* As = smem + cur * SB;
        const char* Bs = As + SA;
        bf16x8 af[MT], bfr[4];
#pragma unroll
        for (int mt = 0; mt < MT; ++mt) af[mt] = *(const bf16x8*)(As + (wm * 16 * MT + mt * 16 + fr) * 64 + coff);
#pragma unroll
        for (int nt = 0; nt < 4; ++nt) bfr[nt] = *(const bf16x8*)(Bs + (wn * 64 + nt * 16 + fr) * 64 + coff);
        const bool more = (kt + NST - 1 < nk);
        char* sb_ = smem + nxt * SB; const char* ab_ = Abase + (size_t)((kt + NST - 1) * 32) * 2; const char* bb_ = Bbase + (size_t)((kt + NST - 1) * 32) * 2;
        __builtin_amdgcn_s_setprio(1);
#pragma unroll
        for (int mt = 0; mt < MT; ++mt) {
#pragma unroll
            for (int nt = 0; nt < 4; ++nt) acc[mt][nt] = __builtin_amdgcn_mfma_f32_16x16x32_bf16(bfr[nt], af[mt], acc[mt][nt], 0, 0, 0);
            if (more) {
                if (mt < GA) __builtin_amdgcn_global_load_lds((const unsigned*)(ab_ + aoff[mt]), (unsigned*)(sb_ + (wid + 4 * mt) * 1024), 16, 0, 0);
                else if (mt < GA + 2) __builtin_amdgcn_global_load_lds((const unsigned*)(bb_ + boff[mt - GA]), (unsigned*)(sb_ + SA + (wid + 4 * (mt - GA)) * 1024), 16, 0, 0);
            }
        }
        __builtin_amdgcn_s_setprio(0);
        cur = (cur + 1 == NST) ? 0 : cur + 1;
        nxt = (nxt + 1 == NST) ? 0 : nxt + 1;
    }
#undef RSTAGE_
    __syncthreads();
}

template <int MODE, int MT>
__device__ __forceinline__ void gemm_tile(const Params& P, const bf16_t* __restrict__ A, int lda, const bf16_t* __restrict__ Bt, int ldb, int K, int m0, int n0, bool perm, char* smem, int aux = 0) {
    const int lane = threadIdx.x & 63, wid = threadIdx.x >> 6;
    const int wm = wid >> 1, wn = wid & 1, fr = lane & 15, fq = lane >> 4;
    f32x4 acc[MT][4];
    gemm_ring<MT, (MT == 8 ? 3 : 4)>(A, lda, Bt, ldb, K, m0, n0, perm, smem, acc);
#pragma unroll
    for (int mt = 0; mt < MT; ++mt) {
        const int m = m0 + wm * 16 * MT + mt * 16 + fr;
        if (perm) {
#pragma unroll
            for (int p = 0; p < 2; ++p) {
                float v[8] = { acc[mt][2 * p][0], acc[mt][2 * p][1], acc[mt][2 * p][2], acc[mt][2 * p][3], acc[mt][2 * p + 1][0], acc[mt][2 * p + 1][1], acc[mt][2 * p + 1][2], acc[mt][2 * p + 1][3] };
                epi8<MODE>(P, m, n0 + wn * 64 + 32 * p + 8 * fq, v, aux);
            }
        } else if (MODE == MODE_INPROJ && n0 < 640) {
#pragma unroll
            for (int p = 0; p < 2; ++p) {
                float lo[4] = { acc[mt][2 * p][0], acc[mt][2 * p][1], acc[mt][2 * p][2], acc[mt][2 * p][3] };
                float hi[4] = { acc[mt][2 * p + 1][0], acc[mt][2 * p + 1][1], acc[mt][2 * p + 1][2], acc[mt][2 * p + 1][3] };
                epi_rope(P, m, n0 + wn * 64 + 32 * p + 4 * fq, lo, hi);
            }
        } else if (MODE == MODE_INPROJ || MODE == MODE_CTXKV) {
            const int dbase = (MODE == MODE_INPROJ) ? (n0 - 640) : (n0 - 128);
#pragma unroll
            for (int nt = 0; nt < 4; ++nt) {
                float v[4] = { acc[mt][nt][0], acc[mt][nt][1], acc[mt][nt][2], acc[mt][nt][3] };
                epi_v4(P, m, dbase + wn * 64 + 16 * nt + 4 * fq, v, MODE == MODE_CTXKV);
            }
        }
        asm volatile("" ::: "memory"); __builtin_amdgcn_sched_barrier(0);
    }
}
__device__ __forceinline__ void tile_coords(int t, int ntm, int ntn, int& mt, int& nt) {
    const int per = 8 * ntn, g = t / per, r = t % per;
    mt = g * 8 + (r & 7); nt = r >> 3;
}
#define CEU(a, b) { const unsigned _t = (a) > (b) ? (a) : (b); (b) = (a) > (b) ? (b) : (a); (a) = _t; }
__device__ __forceinline__ void sort16_desc(unsigned (&v)[16]) {
    CEU(v[0], v[1]); CEU(v[2], v[3]); CEU(v[0], v[2]); CEU(v[1], v[3]); CEU(v[1], v[2]); CEU(v[4], v[5]);
    CEU(v[6], v[7]); CEU(v[4], v[6]); CEU(v[5], v[7]); CEU(v[5], v[6]); CEU(v[0], v[4]); CEU(v[2], v[6]);
    CEU(v[2], v[4]); CEU(v[1], v[5]); CEU(v[3], v[7]); CEU(v[3], v[5]); CEU(v[1], v[2]); CEU(v[3], v[4]);
    CEU(v[5], v[6]); CEU(v[8], v[9]); CEU(v[10], v[11]); CEU(v[8], v[10]); CEU(v[9], v[11]); CEU(v[9], v[10]);
    CEU(v[12], v[13]); CEU(v[14], v[15]); CEU(v[12], v[14]); CEU(v[13], v[15]); CEU(v[13], v[14]); CEU(v[8], v[12]);
    CEU(v[10], v[14]); CEU(v[10], v[12]); CEU(v[9], v[13]); CEU(v[11], v[15]); CEU(v[11], v[13]); CEU(v[9], v[10]);
    CEU(v[11], v[12]); CEU(v[13], v[14]); CEU(v[0], v[8]); CEU(v[4], v[12]); CEU(v[4], v[8]); CEU(v[2], v[10]);
    CEU(v[6], v[14]); CEU(v[6], v[10]); CEU(v[2], v[4]); CEU(v[6], v[8]); CEU(v[10], v[12]); CEU(v[1], v[9]);
    CEU(v[5], v[13]); CEU(v[5], v[9]); CEU(v[3], v[11]); CEU(v[7], v[15]); CEU(v[7], v[11]); CEU(v[3], v[5]);
    CEU(v[7], v[9]); CEU(v[11], v[13]); CEU(v[1], v[2]); CEU(v[3], v[4]); CEU(v[5], v[6]); CEU(v[7], v[8]);
    CEU(v[9], v[10]); CEU(v[11], v[12]); CEU(v[13], v[14]);
}
__device__ __forceinline__ void bitonic16_desc(unsigned (&v)[16]) {
    CEU(v[0], v[8]); CEU(v[1], v[9]); CEU(v[2], v[10]); CEU(v[3], v[11]); CEU(v[4], v[12]); CEU(v[5], v[13]);
    CEU(v[6], v[14]); CEU(v[7], v[15]); CEU(v[0], v[4]); CEU(v[1], v[5]); CEU(v[2], v[6]); CEU(v[3], v[7]);
    CEU(v[8], v[12]); CEU(v[9], v[13]); CEU(v[10], v[14]); CEU(v[11], v[15]); CEU(v[0], v[2]); CEU(v[1], v[3]);
    CEU(v[4], v[6]); CEU(v[5], v[7]); CEU(v[8], v[10]); CEU(v[9], v[11]); CEU(v[12], v[14]); CEU(v[13], v[15]);
    CEU(v[0], v[1]); CEU(v[2], v[3]); CEU(v[4], v[5]); CEU(v[6], v[7]); CEU(v[8], v[9]); CEU(v[10], v[11]);
    CEU(v[12], v[13]); CEU(v[14], v[15]);
}

__device__ __forceinline__ unsigned enc_key(float f) { const unsigned b = __float_as_uint(f); return b ^ ((unsigned)((int)b >> 31) | 0x80000000u); }
__device__ __forceinline__ float dec_key(unsigned k) { const unsigned b = (k & 0x80000000u) ? (k & 0x7fffffffu) : ~k; return __uint_as_float(b); }
__device__ __forceinline__ void topmerge16(unsigned (&top)[16], const unsigned (&L)[16]) {
#pragma unroll
    for (int i = 0; i < 16; ++i) top[i] = top[i] > L[15 - i] ? top[i] : L[15 - i];
    bitonic16_desc(top);
}
__device__ __forceinline__ unsigned cand_key(float a, float b, int i, int j) { return (enc_key(a + b) & ~0xFFu) | (unsigned)(i << 4) | (unsigned)j; }

__device__ __forceinline__ void peer_retrieve_item(const Params& P, int mtile, int h, char* smem) {
    const int tid = threadIdx.x, lane = tid & 63, wid = tid >> 6;
    const int wm = wid >> 1, wn = wid & 1, fr = lane & 15, fq = lane >> 4;
    const int sw = (fr >> 1) & 7;
    const int m0 = mtile * 128;
    unsigned T0[16], T1[16];
#pragma unroll 1
    for (int p = 0; p < 2; ++p) {
        const int hp = h * 2 + p;
        f32x4 acc[4][4];
        gemm_ring<4, 4>(P.H2, DM, P.PwqT, DM, DM, m0, hp * 128, false, smem, acc);
#pragma unroll
        for (int mt = 0; mt < 4; ++mt)
#pragma unroll
            for (int nt = 0; nt < 4; ++nt) {
                const int row = wm * 64 + mt * 16 + fr;
                u32x2 o; o.x = pk2(acc[mt][nt][0], acc[mt][nt][1]); o.y = pk2(acc[mt][nt][2], acc[mt][nt][3]);
                *(u32x2*)(smem + wn * 32768 + lds_off(row, 2 * nt + (fq >> 1)) + (fq & 1) * 8) = o;
            }
        {
            const int srow = tid >> 3, schunk = tid & 7;
            const bf16_t* kb = P.KeysB + (size_t)hp * 128 * 128;
#pragma unroll
            for (int hf = 0; hf < 2; ++hf)
#pragma unroll
                for (int q = 0; q < 4; ++q) {
                    const int row = q * 32 + srow;
                    const u32x4 v = *(const u32x4*)(kb + (size_t)row * 128 + hf * 64 + schunk * 8);
                    *(u32x4*)(smem + hf * 32768 + 16384 + lds_off(row, schunk)) = v;
                }
        }
        __syncthreads();
#pragma unroll
        for (int i = 0; i < 4; ++i)
#pragma unroll
            for (int j = 0; j < 4; ++j) acc[i][j] = (f32x4){0.f, 0.f, 0.f, 0.f};
        mma_from_lds(smem, smem + 16384, acc, wm, wn, fr, fq, sw);
        mma_from_lds(smem + 32768, smem + 32768 + 16384, acc, wm, wn, fr, fq, sw);
        __syncthreads();
        float* sc = (float*)smem;
#pragma unroll
        for (int mt = 0; mt < 4; ++mt)
#pragma unroll
            for (int nt = 0; nt < 4; ++nt) {
                const int row = wm * 64 + mt * 16 + fr;
#pragma unroll
                for (int r = 0; r < 4; ++r) {
                    const int col = wn * 64 + nt * 16 + fq * 4 + r;
                    sc[row * 130 + wn * 65 + (col & 63)] = acc[mt][nt][r];
                }
            }
        __syncthreads();
        {
            const int row = tid >> 1, half = tid & 1;
            const float* rp = sc + row * 130 + half * 65;
            unsigned top[16];
#pragma unroll 1
            for (int g = 0; g < 4; ++g) {
                unsigned L[16];
#pragma unroll
                for (int j = 0; j < 16; ++j) { const int col = half * 64 + g * 16 + j; L[j] = (enc_key(rp[g * 16 + j]) & ~0x7Fu) | (unsigned)col; }
                sort16_desc(L);
                if (g == 0) {
#pragma unroll
                    for (int j = 0; j < 16; ++j) top[j] = L[j];
                } else topmerge16(top, L);
            }
            unsigned Bp[16];
#pragma unroll
            for (int j = 0; j < 16; ++j) Bp[j] = (unsigned)__shfl_xor((int)top[j], 1);
            topmerge16(top, Bp);
            if (p == 0) {
#pragma unroll
                for (int j = 0; j < 16; ++j) T0[j] = top[j];
            } else {
#pragma unroll
                for (int j = 0; j < 16; ++j) T1[j] = top[j];
            }
        }
        __syncthreads();
    }
    {
        const int row = tid >> 1;
        unsigned char* slot = (unsigned char*)smem + row * 32;
        if ((tid & 1) == 0) {
#pragma unroll
            for (int j = 0; j < 16; ++j) { slot[j] = (unsigned char)(T0[j] & 0x7Fu); slot[16 + j] = (unsigned char)(T1[j] & 0x7Fu); }
            float a[16], b[16];
#pragma unroll
            for (int j = 0; j < 16; ++j) { a[j] = dec_key(T0[j]); b[j] = dec_key(T1[j]); }
            unsigned LA[16], LB[16], LC[16];
#pragma unroll
            for (int j = 0; j < 16; ++j) LA[j] = cand_key(a[0], b[j], 0, j);
#pragma unroll
            for (int j = 0; j < 8; ++j) LB[j] = cand_key(a[1], b[j], 1, j);
#pragma unroll
            for (int j = 0; j < 8; ++j) LB[8 + j] = cand_key(a[15 - j], b[0], 15 - j, 0);
            LC[0] = cand_key(a[2], b[0], 2, 0); LC[1] = cand_key(a[2], b[1], 2, 1); LC[2] = cand_key(a[2], b[2], 2, 2); LC[3] = cand_key(a[2], b[3], 2, 3); LC[4] = cand_key(a[2], b[4], 2, 4);
            LC[5] = cand_key(a[3], b[0], 3, 0); LC[6] = cand_key(a[3], b[1], 3, 1); LC[7] = cand_key(a[3], b[2], 3, 2); LC[8] = cand_key(a[3], b[3], 3, 3);
            LC[9] = cand_key(a[4], b[0], 4, 0); LC[10] = cand_key(a[4], b[1], 4, 1); LC[11] = cand_key(a[4], b[2], 4, 2);
            LC[12] = cand_key(a[5], b[0], 5, 0); LC[13] = cand_key(a[5], b[1], 5, 1);
            LC[14] = cand_key(a[6], b[0], 6, 0); LC[15] = cand_key(a[6], b[1], 6, 1);
            const unsigned d0 = cand_key(a[7], b[0], 7, 0), d1 = cand_key(a[7], b[1], 7, 1);
            bitonic16_desc(LB);
            sort16_desc(LC);
            topmerge16(LA, LB);
            LC[15] = LC[15] > d0 ? LC[15] : d0; LC[14] = LC[14] > d1 ? LC[14] : d1;
            bitonic16_desc(LC);
            topmerge16(LA, LC);
            float e[16], den = 0.f; const float vmax = dec_key(LA[0]);
#pragma unroll
            for (int r = 0; r < 16; ++r) { e[r] = __expf(dec_key(LA[r]) - vmax); den += e[r]; }
            const float inv = 1.f / den;
            const int t = m0 + row;
            int* oi = P.sel_idx + (size_t)t * 128 + h * 16; float* og = P.sel_g + (size_t)t * 128 + h * 16;
#pragma unroll
            for (int r = 0; r < 16; ++r) {
                const int i = (LA[r] >> 4) & 15, j = LA[r] & 15;
                oi[r] = (int)slot[i] * 128 + (int)slot[16 + j];
                og[r] = e[r] * inv;
            }
        }
    }
    __syncthreads();
}
typedef float f32x16 __attribute__((ext_vector_type(16)));
struct AttnFrag { u32x4 k[4]; u32x4 v[2][2]; };
__device__ __forceinline__ void attn_load(const Params& P, int b, int kvh, int qb, int w, int blk, int r, int hh, AttnFrag& f) {
    const bf16_t* kp; const bf16_t* vp;
    if (blk < 9) {
        int kpos0 = (qb - 1) * 128 + 32 * (w + blk);
        if (kpos0 < 0 || kpos0 >= SEQ) kpos0 = 0;
        const size_t blkoff = (size_t)((b * 2 + kvh) * 64 + (kpos0 >> 5)) * 2048 + (hh * 32 + r) * 8;
        kp = P.K + blkoff; vp = P.VT + blkoff;
    } else {
        const size_t blkoff = (size_t)((b * 2 + kvh) * 8 + (blk - 9)) * 2048 + (hh * 32 + r) * 8;
        kp = P.Kc + blkoff; vp = P.VcT + blkoff;
    }
#pragma unroll
    for (int ks = 0; ks < 4; ++ks) f.k[ks] = *(const u32x4*)(kp + 512 * ks);
#pragma unroll
    for (int db = 0; db < 2; ++db)
#pragma unroll
        for (int s = 0; s < 2; ++s) f.v[db][s] = *(const u32x4*)(vp + 512 * (db * 2 + s));
}
__device__ __forceinline__ void attn_item(const Params& P, int item) {
    const int head = item & 7, qb = (item >> 3) & 15, b = item >> 7, kvh = head >> 2;
    const int lane = threadIdx.x & 63, w = threadIdx.x >> 6, r = lane & 31, hh = lane >> 5;
    const int tok = b * SEQ + qb * 128 + 32 * w + r;
    bf16x8 qf[4];
    { const bf16_t* qp = P.Q + (size_t)tok * 512 + head * 64 + 8 * hh;
#pragma unroll
      for (int ks = 0; ks < 4; ++ks) qf[ks] = *(const bf16x8*)(qp + 16 * ks); }
    f32x16 o0, o1;
#pragma unroll
    for (int i = 0; i < 16; ++i) { o0[i] = 0.f; o1[i] = 0.f; }
    float mrun = P.sink[head] * 1.44269504088896f, lrun = (hh == 0) ? 1.f : 0.f;
    AttnFrag cur, nxt;
    attn_load(P, b, kvh, qb, w, 0, r, hh, cur);
    for (int blk = 0; blk < 17; ++blk) {
        if (blk + 1 < 17) attn_load(P, b, kvh, qb, w, blk + 1, r, hh, nxt);
        int lo = 0, hi = 31;
        if (blk < 9) {
            const int kpos0 = (qb - 1) * 128 + 32 * (w + blk);
            if (kpos0 < 0 || kpos0 >= SEQ) lo = 64;
            else if (blk == 0) lo = r;
            else if (blk == 8) hi = r;
        }
        f32x16 s;
#pragma unroll
        for (int i = 0; i < 16; ++i) s[i] = 0.f;
#pragma unroll
        for (int ks = 0; ks < 4; ++ks) s = __builtin_amdgcn_mfma_f32_32x32x16_bf16(*(const bf16x8*)&cur.k[ks], qf[ks], s, 0, 0, 0);
        if (lo != 0 || hi != 31) {
#pragma unroll
            for (int i = 0; i < 16; ++i) { const int kk = (i & 3) + 8 * (i >> 2) + 4 * hh; const bool ok = (kk >= lo) && (kk <= hi); s[i] = ok ? s[i] : -3.0e38f; }
        }
        float mb = s[0];
#pragma unroll
        for (int i = 1; i < 16; ++i) mb = fmaxf(mb, s[i]);
        mb = fmaxf(mb, __shfl_xor(mb, 32));
        if (!__all(mb - mrun <= 8.f)) {
            const float mn = fmaxf(mrun, mb);
            const float alpha = __builtin_amdgcn_exp2f(mrun - mn);
            lrun *= alpha; mrun = mn;
#pragma unroll
            for (int i = 0; i < 16; ++i) { o0[i] *= alpha; o1[i] *= alpha; }
        }
        float ps = 0.f; float p[16];
#pragma unroll
        for (int i = 0; i < 16; ++i) { p[i] = __builtin_amdgcn_exp2f(s[i] - mrun); ps += p[i]; }
        lrun += ps;
        u32x4 pb[2];
        pb[0].x = pk2(p[0], p[1]); pb[0].y = pk2(p[2], p[3]); pb[0].z = pk2(p[4], p[5]); pb[0].w = pk2(p[6], p[7]);
        pb[1].x = pk2(p[8], p[9]); pb[1].y = pk2(p[10], p[11]); pb[1].z = pk2(p[12], p[13]); pb[1].w = pk2(p[14], p[15]);
#pragma unroll
        for (int sI = 0; sI < 2; ++sI) {
            const u32x4 va = cur.v[0][sI], vb = cur.v[1][sI];
            o0 = __builtin_amdgcn_mfma_f32_32x32x16_bf16(*(const bf16x8*)&va, *(const bf16x8*)&pb[sI], o0, 0, 0, 0);
            o1 = __builtin_amdgcn_mfma_f32_32x32x16_bf16(*(const bf16x8*)&vb, *(const bf16x8*)&pb[sI], o1, 0, 0, 0);
        }
        if (blk + 1 < 17) cur = nxt;
    }
    const float ltot = lrun + __shfl_xor(lrun, 32);
    const float inv = 1.f / ltot;
    bf16_t* op = P.AO + (size_t)tok * 512 + head * 64 + 4 * hh;
#pragma unroll
    for (int g = 0; g < 4; ++g) {
        float t0[4] = { o0[4 * g] * inv, o0[4 * g + 1] * inv, o0[4 * g + 2] * inv, o0[4 * g + 3] * inv };
        float t1[4] = { o1[4 * g] * inv, o1[4 * g + 1] * inv, o1[4 * g + 2] * inv, o1[4 * g + 3] * inv };
        st4bf(op + 8 * g, t0); st4bf(op + 32 + 8 * g, t1);
    }
}

__device__ __forceinline__ void conv_range(const Params& P, size_t gtid, size_t gsize) {
    for (size_t idx = gtid; idx < (size_t)NTOK * 64; idx += gsize) {
        const int m = (int)(idx >> 6), c0 = (int)(idx & 63) * 8, l = m % SEQ;
        float cu[3][8];
#pragma unroll
        for (int t = 0; t < 3; ++t) {
            const int ll = l + t - 1;
            if (ll < 0 || ll >= SEQ) {
#pragma unroll
                for (int j = 0; j < 8; ++j) cu[t][j] = 0.f;
            } else {
                const u32x4 g = *(const u32x4*)(P.GC + (size_t)(m + t - 1) * 512 + c0), u = *(const u32x4*)(P.U + (size_t)(m + t - 1) * 512 + c0);
                cu[t][0] = bf2f(g.x & 0xffff) * bf2f(u.x & 0xffff); cu[t][1] = bf2f(g.x >> 16) * bf2f(u.x >> 16);
                cu[t][2] = bf2f(g.y & 0xffff) * bf2f(u.y & 0xffff); cu[t][3] = bf2f(g.y >> 16) * bf2f(u.y >> 16);
                cu[t][4] = bf2f(g.z & 0xffff) * bf2f(u.z & 0xffff); cu[t][5] = bf2f(g.z >> 16) * bf2f(u.z >> 16);
                cu[t][6] = bf2f(g.w & 0xffff) * bf2f(u.w & 0xffff); cu[t][7] = bf2f(g.w >> 16) * bf2f(u.w >> 16);
            }
        }
        const u32x4 gbv = *(const u32x4*)(P.GB + (size_t)m * 512 + c0);
        const float gb[8] = { bf2f(gbv.x & 0xffff), bf2f(gbv.x >> 16), bf2f(gbv.y & 0xffff), bf2f(gbv.y >> 16), bf2f(gbv.z & 0xffff), bf2f(gbv.z >> 16), bf2f(gbv.w & 0xffff), bf2f(gbv.w >> 16) };
        float o[8];
#pragma unroll
        for (int j = 0; j < 8; ++j) o[j] = gb[j] * (P.conv_w[c0 + j] * cu[0][j] + P.conv_w[512 + c0 + j] * cu[1][j] + P.conv_w[1024 + c0 + j] * cu[2][j]);
        st8bf(P.CA + (size_t)m * 512 + c0, o);
    }
}

__device__ __forceinline__ void unpack8(const u32x4 v, float* f) {
    f[0] = bf2f(v.x & 0xffff); f[1] = bf2f(v.x >> 16); f[2] = bf2f(v.y & 0xffff); f[3] = bf2f(v.y >> 16);
    f[4] = bf2f(v.z & 0xffff); f[5] = bf2f(v.z >> 16); f[6] = bf2f(v.w & 0xffff); f[7] = bf2f(v.w >> 16);
}
__device__ __forceinline__ float gelu_erf(float d) { return 0.5f * d * (1.f + erff(d * 0.70710678118654752f)); }
__device__ __forceinline__ int reduce64i(int (&part)[64], int lane) {
#pragma unroll
    for (int i = 0; i < 32; ++i) { auto r = __builtin_amdgcn_permlane32_swap((unsigned)part[i], (unsigned)part[32 + i], false, false); part[i] = (int)r[0] + (int)r[1]; }
#pragma unroll
    for (int i = 0; i < 16; ++i) { auto r = __builtin_amdgcn_permlane16_swap((unsigned)part[i], (unsigned)part[16 + i], false, false); part[i] = (int)r[0] + (int)r[1]; }
#define RSTAGE(N) { const bool up = (lane & N) != 0; _Pragma("unroll") for (int i = 0; i < N; ++i) { const int keep = up ? part[N + i] : part[i], send = up ? part[i] : part[N + i]; part[i] = keep + __shfl_xor(send, N); } }
    RSTAGE(8) RSTAGE(4) RSTAGE(2) RSTAGE(1)
#undef RSTAGE
    return part[0];
}
#define UB0(x) ((float)((x) & 0xffu))
#define UB1(x) ((float)(((x) >> 8) & 0xffu))
#define UB2(x) ((float)(((x) >> 16) & 0xffu))
#define UB3(x) ((float)((x) >> 24))
__device__ __forceinline__ void peer_u_token(const Params& P, int t, int lane) {
    const u32x4 hq = *(const u32x4*)(P.H2q + (size_t)t * DM + 16 * lane);
    const float sh = P.sh2[t];
    const int idlo = P.sel_idx[(size_t)t * 128 + lane], idhi = P.sel_idx[(size_t)t * 128 + 64 + lane];
    const float glo = P.sel_g[(size_t)t * 128 + lane], ghi = P.sel_g[(size_t)t * 128 + 64 + lane];
    const float sulo = P.su[idlo], suhi = P.su[idhi], svlo = P.sv[idlo], svhi = P.sv[idhi];
    u32x4 rows[2][16];
    int part[64];
#define ULOAD(bt) { _Pragma("unroll") for (int q = 0; q < 16; ++q) { const int e = __builtin_amdgcn_readlane((bt) < 4 ? idlo : idhi, ((bt) & 3) * 16 + q); rows[(bt) & 1][q] = *(const u32x4*)(P.Uq + (size_t)e * DM + 16 * lane); } }
#define UDOT(bt) { _Pragma("unroll") for (int q = 0; q < 16; ++q) { const u32x4 a = rows[(bt) & 1][q]; \
        int d = __builtin_amdgcn_sdot4((int)a.x, (int)hq.x, 0, false); d = __builtin_amdgcn_sdot4((int)a.y, (int)hq.y, d, false); \
        d = __builtin_amdgcn_sdot4((int)a.z, (int)hq.z, d, false); d = __builtin_amdgcn_sdot4((int)a.w, (int)hq.w, d, false); part[((bt) & 3) * 16 + q] = d; } }
    ULOAD(0)
    ULOAD(1) UDOT(0)
    ULOAD(2) UDOT(1)
    ULOAD(3) UDOT(2)
    ULOAD(4) UDOT(3)
    { const int isum = reduce64i(part, lane); const float a = (float)isum * sulo * sh; P.cbuf[(size_t)t * 128 + lane] = glo * gelu_erf(a) * svlo; }
    ULOAD(5) UDOT(4)
    ULOAD(6) UDOT(5)
    ULOAD(7) UDOT(6)
    UDOT(7)
    { const int isum = reduce64i(part, lane); const float a = (float)isum * suhi * sh; P.cbuf[(size_t)t * 128 + 64 + lane] = ghi * gelu_erf(a) * svhi; }
#undef ULOAD
#undef UDOT
}
__device__ __forceinline__ void peer_v_token(const Params& P, int t, int lane) {
    const int b = t / SEQ;
    float acc[16];
#pragma unroll
    for (int j = 0; j < 16; ++j) acc[j] = 0.f;
    const int idlo = P.sel_idx[(size_t)t * 128 + lane], idhi = P.sel_idx[(size_t)t * 128 + 64 + lane];
    const float clo = P.cbuf[(size_t)t * 128 + lane], chi = P.cbuf[(size_t)t * 128 + 64 + lane];
    const float csum = clo + chi;
    u32x4 rows[2][16];
#define VLOAD(bt) { _Pragma("unroll") for (int q = 0; q < 16; ++q) { const int e = __builtin_amdgcn_readlane((bt) < 4 ? idlo : idhi, ((bt) & 3) * 16 + q); rows[(bt) & 1][q] = *(const u32x4*)(P.Vq + (size_t)e * DM + 16 * lane); } }
#define VCOMP(bt) { _Pragma("unroll") for (int q = 0; q < 16; ++q) { \
        const float ck = __uint_as_float(__builtin_amdgcn_readlane(__float_as_uint((bt) < 4 ? clo : chi), ((bt) & 3) * 16 + q)); const u32x4 x = rows[(bt) & 1][q]; \
        acc[0] += ck * UB0(x.x); acc[1] += ck * UB1(x.x); acc[2] += ck * UB2(x.x); acc[3] += ck * UB3(x.x); \
        acc[4] += ck * UB0(x.y); acc[5] += ck * UB1(x.y); acc[6] += ck * UB2(x.y); acc[7] += ck * UB3(x.y); \
        acc[8] += ck * UB0(x.z); acc[9] += ck * UB1(x.z); acc[10] += ck * UB2(x.z); acc[11] += ck * UB3(x.z); \
        acc[12] += ck * UB0(x.w); acc[13] += ck * UB1(x.w); acc[14] += ck * UB2(x.w); acc[15] += ck * UB3(x.w); \
        __builtin_amdgcn_sched_barrier(0); } }
    VLOAD(0)
    VLOAD(1) VCOMP(0)
    VLOAD(2) VCOMP(1)
    VLOAD(3) VCOMP(2)
    VLOAD(4) VCOMP(3)
    VLOAD(5) VCOMP(4)
    VLOAD(6) VCOMP(5)
    VLOAD(7) VCOMP(6)
    VCOMP(7)
#undef VLOAD
#undef VCOMP
    const float cb = 128.f * wave_sum(csum);
    float x2[16]; float ss = 0.f;
    const bf16_t* x1 = P.X1 + (size_t)t * DM + 16 * lane; const float* g2 = P.mod + (size_t)b * NMOD + 5 * DM + 16 * lane;
#pragma unroll
    for (int q = 0; q < 4; ++q) {
        const u32x2 xw = *(const u32x2*)(x1 + 4 * q);
        const f32x4 xa = (f32x4){ bf2f(xw.x & 0xffff), bf2f(xw.x >> 16), bf2f(xw.y & 0xffff), bf2f(xw.y >> 16) }, ga = *(const f32x4*)(g2 + 4 * q);
        x2[4 * q + 0] = xa.x + ga.x * (acc[4 * q + 0] - cb); x2[4 * q + 1] = xa.y + ga.y * (acc[4 * q + 1] - cb);
        x2[4 * q + 2] = xa.z + ga.z * (acc[4 * q + 2] - cb); x2[4 * q + 3] = xa.w + ga.w * (acc[4 * q + 3] - cb);
        ss += x2[4 * q] * x2[4 * q] + x2[4 * q + 1] * x2[4 * q + 1] + x2[4 * q + 2] * x2[4 * q + 2] + x2[4 * q + 3] * x2[4 * q + 3];
    }
    ss = wave_sum(ss);
    const float rstd = rsqrtf(ss * (1.f / DM) + 1e-6f);
    float* op = P.out + (size_t)t * DM + 16 * lane; const float* fgp = P.fg + 16 * lane;
#pragma unroll
    for (int q = 0; q < 4; ++q) {
        const f32x4 fa = *(const f32x4*)(fgp + 4 * q);
        f32x4 o; o.x = x2[4 * q] * rstd * fa.x; o.y = x2[4 * q + 1] * rstd * fa.y; o.z = x2[4 * q + 2] * rstd * fa.z; o.w = x2[4 * q + 3] * rstd * fa.w;
        *(f32x4*)(op + 4 * q) = o;
    }
}

#define XB_TMO      128
#define XB_XCNT(j)  (256  + 64 * (j))
#define XB_XSUB(j)  (1280 + 64 * (j))
#define XB_XGEN(j)  (2304 + 64 * (j))
#define XB_TOP      3328
#define XB_TOPGEN   3392
#define XCD_BAR_WORDS 3456
#define XB_SPIN_CAP (1u << 22)
#define LAS __attribute__((address_space(3)))
__device__ __forceinline__ unsigned xb_ld(unsigned* p)              { return __hip_atomic_load(p, __ATOMIC_RELAXED, __HIP_MEMORY_SCOPE_AGENT); }
__device__ __forceinline__ unsigned xb_add(unsigned* p, unsigned v) { return __hip_atomic_fetch_add(p, v, __ATOMIC_RELAXED, __HIP_MEMORY_SCOPE_AGENT); }
__device__ __forceinline__ unsigned xb_xcc_id() { return (unsigned)__builtin_amdgcn_s_getreg((3 << 11) | 20) & 0xFu; }
#define XB_SPIN(cond, bar) do { unsigned _sp = 0; while (cond) { __builtin_amdgcn_s_sleep(1); \
    if ((++_sp & 255u) == 0u) { if (xb_ld(&(bar)[XB_TMO])) break; if (_sp > XB_SPIN_CAP) { atomicAdd(&(bar)[XB_TMO], 1u); break; } } } } while (0)
struct XcdBarrier { unsigned* bar; unsigned x; volatile LAS unsigned* st; };
__device__ __forceinline__ XcdBarrier xcd_barrier_post(unsigned* bar, volatile LAS unsigned* st) {
    XcdBarrier b; b.bar = bar; b.x = xb_xcc_id(); b.st = st;
    if (threadIdx.x == 0) (void)xb_add(&bar[XB_XCNT(b.x)], 1u);
    return b;
}
__device__ __forceinline__ void xcd_barrier_complete(unsigned* bar, unsigned x, unsigned& nloc, unsigned& nx) {
    const unsigned G = gridDim.x * gridDim.y * gridDim.z;
    unsigned sum, cnt, mine, sp = 0u;
    for (;;) {
        sum = 0u; cnt = 0u; mine = 0u;
#pragma unroll
        for (unsigned j = 0; j < 16; ++j) { const unsigned c = xb_ld(&bar[XB_XCNT(j)]); sum += c; cnt += (c > 0u) ? 1u : 0u; mine = (j == x) ? c : mine; }
        if (sum == G) break;
        __builtin_amdgcn_s_sleep(1);
        if ((++sp & 255u) == 0u) { if (xb_ld(&bar[XB_TMO])) break; if (sp > XB_SPIN_CAP) { atomicAdd(&bar[XB_TMO], 1u); break; } }
    }
    nloc = mine > 0u ? mine : 1u; nx = cnt > 0u ? cnt : 1u;
}
__device__ __forceinline__ void xcd_barrier(const XcdBarrier& b) {
    asm volatile("s_waitcnt vmcnt(0)" ::: "memory");
    __syncthreads();
    if (threadIdx.x == 0) {
        unsigned* bar = b.bar;
        __builtin_amdgcn_s_waitcnt(0);
        unsigned nloc = b.st[0], nx = b.st[1];
        if (nloc == 0u) { xcd_barrier_complete(bar, b.x, nloc, nx); b.st[0] = nloc; b.st[1] = nx; }
        const unsigned old = xb_add(&bar[XB_XSUB(b.x)], 1u);
        const unsigned gen = old / nloc;
        if (old + 1u == (gen + 1u) * nloc) {
            __builtin_amdgcn_fence(__ATOMIC_RELEASE, "agent");
            asm volatile("s_waitcnt vmcnt(0)" ::: "memory");
            const unsigned og = xb_add(&bar[XB_TOP], 1u);
            const unsigned tg = og / nx;
            if (og + 1u == (tg + 1u) * nx) xb_add(&bar[XB_TOPGEN], 1u);
            else XB_SPIN(xb_ld(&bar[XB_TOPGEN]) == tg, bar);
            __builtin_amdgcn_fence(__ATOMIC_ACQUIRE, "agent");
            xb_add(&bar[XB_XGEN(b.x)], 1u);
            asm volatile("s_waitcnt vmcnt(0)" ::: "memory");
        } else {
            XB_SPIN(xb_ld(&bar[XB_XGEN(b.x)]) == gen, bar);
            __builtin_amdgcn_fence(__ATOMIC_ACQUIRE, "agent");
            asm volatile("s_waitcnt vmcnt(0)" ::: "memory");
        }
    }
    __syncthreads();
}

constexpr int NPHASE = 9;
template <int PH> __device__ __forceinline__ void run_phase(const Params& P, char* smem) {
    int tid_ = threadIdx.x; asm volatile("" : "+v"(tid_));
    const int bid = blockIdx.x, G = gridDim.x, tid = tid_;
    const size_t gtid = (size_t)bid * 256 + tid, gsize = (size_t)G * 256;
    if (PH == 0) {
        for (int it = bid; it < 192; it += G) modp_item(P, it, smem);
        float (*tile)[65] = (float (*)[65])smem;
        for (int it = bid; it < 1088; it += G) transpose_tile(P.w_in, DM, PROJW, P.WinT, it, tile);
        for (int it = bid; it < 128; it += G) transpose_tile(P.w_ao, 512, DM, P.WaoT, it, tile);
        for (int it = bid; it < 128; it += G) transpose_tile(P.w_co, 512, DM, P.WcoT, it, tile);
        for (int it = bid; it < 256; it += G) transpose_tile(P.w_mix, DM, DM, P.WmixT, it, tile);
        for (int it = bid; it < 512; it += G) transpose_tile(P.pw_q, DM, 2048, P.PwqT, it, tile);
        cvt_range(P.keys, P.KeysB, (size_t)16 * 128 * 128 / 8, gtid, gsize);
        { const int lane = tid & 63, wid = tid >> 6;
          for (int r = bid * 4 + wid; r < NEXP; r += G * 4) {
              f32x4 va[4], vb[4];
              load_row16(P.pu + (size_t)r * DM, lane, va); load_row16(P.pv + (size_t)r * DM, lane, vb);
              quant_row(va, (unsigned char*)P.Uq + (size_t)r * DM, P.su + r, lane, 0);
              quant_row(vb, P.Vq + (size_t)r * DM, P.sv + r, lane, 128); } }
        rope_tab(P, (int)gtid, (int)gsize);
    } else if (PH == 1) {
        for (int i = (int)gtid; i < 17 * NMOD; i += (int)gsize) {
            float v = P.b_mod[i % NMOD];
#pragma unroll
            for (int kc = 0; kc < 8; ++kc) v += P.modp[(size_t)kc * 17 * NMOD + i];
            P.mod[i] = v;
        }
        if (NTOK % G == 0 && SEQ % (NTOK / G) == 0 && NCTX % G == 0) {
            norm1_rows(P, false, bid * (NTOK / G), NTOK / G, smem);
            norm1_rows(P, true, bid * (NCTX / G), NCTX / G, smem);
        } else {
            for (int it = bid; it < 1152; it += G) { const bool isctx = it >= 1024; norm1_rows(P, isctx, isctx ? (it - 1024) * 32 : it * 32, 32, smem); }
        }
    } else if (PH == 2) {
        for (int t = bid; t < 128 * 34 + 32; t += G) {
            if (t < 128 * 34) { int mt, nt; tile_coords(t, 128, 34, mt, nt); gemm_tile<MODE_INPROJ, 8>(P, P.H, DM, P.WinT, DM, DM, mt * 256, nt * 128, nt * 128 >= 768, smem); }
            else { const int u = t - 128 * 34, mt = u >> 1, nt = u & 1; gemm_tile<MODE_CTXKV, 8>(P, P.HC, DM, P.WinT + (size_t)512 * DM, DM, DM, mt * 256, nt * 128, nt == 0, smem); }
        }
    } else if (PH == 3) {
        for (int it = bid; it < NB * 16 * 8; it += G) attn_item(P, it);
        conv_range(P, gtid, gsize);
    } else if (PH == 4) {
        for (int t = bid; t < 128 * 8; t += G) { int mt, nt; tile_coords(t, 128, 8, mt, nt); gemm_tile<MODE_AO1, 8>(P, P.AO, 512, P.WaoT, 512, 512, mt * 256, nt * 128, true, smem, 0); }
        for (int t = bid; t < 128 * 8; t += G) { int mt, nt; tile_coords(t, 128, 8, mt, nt); gemm_tile<MODE_AO1, 8>(P, P.CA, 512, P.WcoT, 512, 512, mt * 256, nt * 128, true, smem, 1); }
    } else if (PH == 5) {
        for (int t = bid; t < 128 * 8; t += G) { int mt, nt; tile_coords(t, 128, 8, mt, nt); gemm_tile<MODE_MIX, 8>(P, P.YG, DM, P.WmixT, DM, DM, mt * 256, nt * 128, true, smem); }
    } else if (PH == 6) {
        const int lane = tid & 63, wid = tid >> 6;
        float* sc = (float*)smem; float* sh = sc + DM;
        for (int it = bid; it < NTOK / 64; it += G) {
            const int row0 = it * 64, b = row0 / SEQ;
            __syncthreads();
            for (int d = tid; d < DM; d += 256) { sc[d] = P.mod[(size_t)b * NMOD + 4 * DM + d]; sh[d] = P.mod[(size_t)b * NMOD + 3 * DM + d]; }
            __syncthreads();
            for (int i = wid; i < 64; i += 8) {
                const int ra = row0 + i, rb = ra + 4;
                f32x4 va[4], vb[4];
                load_row4_bf(P.X1 + (size_t)ra * DM, lane, va); load_row4_bf(P.X1 + (size_t)rb * DM, lane, vb);
                norm_row_q(va, P.n2, sc, sh, P.H2 + (size_t)ra * DM, P.H2q + (size_t)ra * DM, P.sh2 + ra, lane);
                norm_row_q(vb, P.n2, sc, sh, P.H2 + (size_t)rb * DM, P.H2q + (size_t)rb * DM, P.sh2 + rb, lane);
            }
        }
    } else if (PH == 7) {
        for (int it = bid; it < 256 * 8; it += G) peer_retrieve_item(P, it >> 3, it & 7, smem);
    } else if (PH == 8) {
        const int lane = tid & 63, wid = tid >> 6;
        for (int t = bid * 4 + wid; t < NTOK; t += G * 4) peer_u_token(P, t, lane);
    } else if (PH == 9) {
        const int lane = tid & 63, wid = tid >> 6;
        for (int t = bid * 4 + wid; t < NTOK; t += G * 4) peer_v_token(P, t, lane);
    }
}
#ifndef REP0
#define REP0 1
#endif
#ifndef REP1
#define REP1 1
#endif
#ifndef REP2
#define REP2 1
#endif
#ifndef REP3
#define REP3 1
#endif
#ifndef REP4
#define REP4 1
#endif
#ifndef REP5
#define REP5 1
#endif
#ifndef REP6
#define REP6 1
#endif
#ifndef REP7
#define REP7 1
#endif
#ifndef REP8
#define REP8 1
#endif
#ifndef REP9
#define REP9 1
#endif
constexpr int MEGA_LDS = 3 * (2048 * 8 + 8192);
#ifndef MULTI_LAUNCH
__global__ void __launch_bounds__(256, 2) k_mega(Params P) {
    extern __shared__ __attribute__((aligned(16))) char smem[];
    volatile LAS unsigned* st = (volatile LAS unsigned*)(smem + MEGA_LDS);
    if (threadIdx.x < 4) st[threadIdx.x] = 0u;
    __syncthreads();
    const XcdBarrier bar = xcd_barrier_post(P.bar, st);
#define PHASE_SYNC(k) for (int rep = 0; rep < REP##k; ++rep) { run_phase<k>(P, smem); xcd_barrier(bar); }
    PHASE_SYNC(0) PHASE_SYNC(1) PHASE_SYNC(2) PHASE_SYNC(3) PHASE_SYNC(4) PHASE_SYNC(5) PHASE_SYNC(6) PHASE_SYNC(7)
    PHASE_SYNC(8)
    for (int rep = 0; rep < REP9 - 1; ++rep) { run_phase<9>(P, smem); xcd_barrier(bar); }
    run_phase<9>(P, smem);
}
#else
template <int PH> __global__ void __launch_bounds__(256, 2) k_phase(Params P) {
    extern __shared__ __attribute__((aligned(16))) char smem[];
    run_phase<PH>(P, smem);
}
#endif

static size_t carve(size_t& off, size_t bytes) { const size_t o = off; off += (bytes + 255) & ~(size_t)255; return o; }

extern "C" void kernel_launch(void* const* d_in, const int* in_sizes, int n_in, void* d_out, int out_size, void* d_ws, size_t ws_size, hipStream_t stream) {
    Params P{};
    P.x = (const float*)d_in[0]; P.c = (const float*)d_in[1]; P.ctx = (const float*)d_in[2]; P.c_ctx = (const float*)d_in[3];
    P.w_mod = (const float*)d_in[4]; P.b_mod = (const float*)d_in[5]; P.n1 = (const float*)d_in[6]; P.n2 = (const float*)d_in[7];
    P.w_in = (const float*)d_in[8]; P.sink = (const float*)d_in[9]; P.conv_w = (const float*)d_in[10]; P.w_ao = (const float*)d_in[11];
    P.w_co = (const float*)d_in[12]; P.w_mix = (const float*)d_in[13]; P.pw_q = (const float*)d_in[14]; P.keys = (const float*)d_in[15];
    P.pu = (const float*)d_in[16]; P.pv = (const float*)d_in[17]; P.fg = (const float*)d_in[18];
    P.out = (float*)d_out;
    char* ws = (char*)d_ws; size_t off = 0;
    P.modp = (float*)(ws + carve(off, (size_t)8 * 17 * NMOD * 4));
    P.mod = (float*)(ws + carve(off, (size_t)17 * NMOD * 4));
    P.rope = (float*)(ws + carve(off, 3072 * 4));
    P.WinT = (bf16_t*)(ws + carve(off, (size_t)PROJW * DM * 2));
    P.WaoT = (bf16_t*)(ws + carve(off, (size_t)DM * 512 * 2));
    P.WcoT = (bf16_t*)(ws + carve(off, (size_t)DM * 512 * 2));
    P.WmixT = (bf16_t*)(ws + carve(off, (size_t)DM * DM * 2));
    P.PwqT = (bf16_t*)(ws + carve(off, (size_t)2048 * DM * 2));
    P.KeysB = (bf16_t*)(ws + carve(off, (size_t)16 * 128 * 128 * 2));
    P.Uq = (signed char*)(ws + carve(off, (size_t)NEXP * DM));
    P.Vq = (unsigned char*)(ws + carve(off, (size_t)NEXP * DM));
    P.su = (float*)(ws + carve(off, (size_t)NEXP * 4));
    P.sv = (float*)(ws + carve(off, (size_t)NEXP * 4));
    P.sh2 = (float*)(ws + carve(off, (size_t)NTOK * 4));
    P.HC = (bf16_t*)(ws + carve(off, (size_t)NCTX * DM * 2));
    const size_t regA = carve(off, (size_t)NTOK * DM * 2);
    P.H = (bf16_t*)(ws + regA); P.YG = (bf16_t*)(ws + regA); P.H2 = (bf16_t*)(ws + regA);
    const size_t regB = off;
    P.Q = (bf16_t*)(ws + carve(off, (size_t)NTOK * 512 * 2));
    P.K = (bf16_t*)(ws + carve(off, (size_t)NTOK * 128 * 2));
    P.VT = (bf16_t*)(ws + carve(off, (size_t)NTOK * 128 * 2));
    P.Kc = (bf16_t*)(ws + carve(off, (size_t)NCTX * 128 * 2));
    P.VcT = (bf16_t*)(ws + carve(off, (size_t)NCTX * 128 * 2));
    const size_t regC = off;
    P.GB = (bf16_t*)(ws + carve(off, (size_t)NTOK * 512 * 2));
    P.GC = (bf16_t*)(ws + carve(off, (size_t)NTOK * 512 * 2));
    P.U = (bf16_t*)(ws + carve(off, (size_t)NTOK * 512 * 2));
    P.M1 = (bf16_t*)(ws + regC);
    P.cbuf = (float*)(ws + regC);
    const size_t regD = off;
    P.GA = (bf16_t*)(ws + carve(off, (size_t)NTOK * DM * 2));
    P.GV = (bf16_t*)(ws + carve(off, (size_t)NTOK * DM * 2));
    P.AO = (bf16_t*)(ws + carve(off, (size_t)NTOK * 512 * 2));
    P.H2q = (signed char*)P.AO;
    P.CA = (bf16_t*)(ws + carve(off, (size_t)NTOK * 512 * 2));
    P.X1 = (bf16_t*)(ws + regD);
    P.bar = (unsigned*)(ws + carve(off, (size_t)XCD_BAR_WORDS * 4));
    const size_t need = off;
    { size_t o2 = regB;
      P.sel_idx = (int*)(ws + carve(o2, (size_t)NTOK * 128 * 4));
      P.sel_g = (float*)(ws + carve(o2, (size_t)NTOK * 128 * 4));
      if (o2 > regC) { fprintf(stderr, "kernel_launch: late buffers overflow\n"); return; } }
    if (need > ws_size) { fprintf(stderr, "kernel_launch: workspace too small: need %zu have %zu\n", need, ws_size); return; }

#ifdef MULTI_LAUNCH
    static bool attr_done = false;
    if (!attr_done) {
#define SETA(PH) hipFuncSetAttribute((const void*)k_phase<PH>, hipFuncAttributeMaxDynamicSharedMemorySize, MEGA_LDS)
        SETA(0); SETA(1); SETA(2); SETA(3); SETA(4); SETA(5); SETA(6); SETA(7); SETA(8);
        attr_done = true;
    }
#define LP(PH) k_phase<PH><<<512, 256, MEGA_LDS, stream>>>(P)
    LP(0); LP(1); LP(2); LP(3); LP(4); LP(5); LP(6); LP(7); LP(8);
#else
    static int grid_blocks = 0;
    if (!grid_blocks) {
        int dev = 0, cus = 0, per_cu = 0;
        (void)hipGetDevice(&dev);
        (void)hipDeviceGetAttribute(&cus, hipDeviceAttributeMultiprocessorCount, dev);
        (void)hipFuncSetAttribute((const void*)k_mega, hipFuncAttributeMaxDynamicSharedMemorySize, MEGA_LDS + 16);
        (void)hipOccupancyMaxActiveBlocksPerMultiprocessor(&per_cu, (const void*)k_mega, 256, MEGA_LDS + 16);
        if (per_cu > 2) per_cu = 2;
        if (per_cu < 1) { fprintf(stderr, "kernel_launch: occupancy query returned %d\n", per_cu); per_cu = 1; }
        grid_blocks = cus * per_cu;
    }
    (void)hipMemsetAsync(P.bar, 0, (size_t)XCD_BAR_WORDS * 4, stream);
    void* args[] = { &P };
    hipError_t e = hipLaunchCooperativeKernel((const void*)k_mega, dim3(grid_blocks), dim3(256), args, MEGA_LDS + 16, stream);
    if (e != hipSuccess) fprintf(stderr, "cooperative launch failed: %s (grid %d)\n", hipGetErrorString(e), grid_blocks);
#endif
}
```

```cpp
#include <hip/hip_runtime.h>
#include <cstdio>
#include <cstdint>

typedef unsigned short bf16_t;
typedef short bf16x8 __attribute__((ext_vector_type(8)));
typedef float f32x4 __attribute__((ext_vector_type(4)));
typedef unsigned u32x4 __attribute__((ext_vector_type(4)));
typedef unsigned u32x2 __attribute__((ext_vector_type(2)));

constexpr int DM = 1024, NB = 16, SEQ = 2048, NTOK = NB * SEQ, CTXL = 256, NCTX = NB * CTXL;
constexpr int PROJW = 4352;
constexpr int NMOD = 6 * DM;
constexpr int NEXP = 16384;

__device__ __forceinline__ float bf2f(bf16_t x) { return __uint_as_float(((unsigned)x) << 16); }
__device__ __forceinline__ bf16_t f2bf(float f) {
    unsigned u = __float_as_uint(f);
    u += 0x7fffu + ((u >> 16) & 1u);
    return (bf16_t)(u >> 16);
}
__device__ __forceinline__ unsigned pk2(float lo, float hi) { unsigned r; asm("v_cvt_pk_bf16_f32 %0, %1, %2" : "=v"(r) : "v"(lo), "v"(hi)); return r; }
__device__ __forceinline__ float sigmoidf_(float x) { return 1.f / (1.f + __expf(-x)); }
__device__ __forceinline__ float wave_sum(float v) {
#pragma unroll
    for (int o = 1; o < 64; o <<= 1) v += __shfl_xor(v, o);
    return v;
}

__device__ __forceinline__ float wave_max(float v) {
#pragma unroll
    for (int o = 1; o < 64; o <<= 1) v = fmaxf(v, __shfl_xor(v, o));
    return v;
}
__device__ __forceinline__ unsigned q8(float x, float inv, int bias) {
    int q = (int)rintf(x * inv); q = q > 127 ? 127 : (q < -127 ? -127 : q);
    return (unsigned)((q + bias) & 0xff);
}
__device__ __forceinline__ void load_row16(const float* src, int lane, f32x4 (&v)[4]) {
#pragma unroll
    for (int j = 0; j < 4; ++j) v[j] = *(const f32x4*)(src + 16 * lane + 4 * j);
}
__device__ __forceinline__ void quant_row(f32x4 (&v)[4], unsigned char* dst, float* scale_out, int lane, int bias) {
    float amax = 0.f;
#pragma unroll
    for (int j = 0; j < 4; ++j) amax = fmaxf(amax, fmaxf(fmaxf(fabsf(v[j].x), fabsf(v[j].y)), fmaxf(fabsf(v[j].z), fabsf(v[j].w))));
    amax = wave_max(amax);
    const float sc = amax > 0.f ? amax * (1.f / 127.f) : 1.f, inv = 1.f / sc;
    u32x4 w;
    w.x = q8(v[0].x, inv, bias) | (q8(v[0].y, inv, bias) << 8) | (q8(v[0].z, inv, bias) << 16) | (q8(v[0].w, inv, bias) << 24);
    w.y = q8(v[1].x, inv, bias) | (q8(v[1].y, inv, bias) << 8) | (q8(v[1].z, inv, bias) << 16) | (q8(v[1].w, inv, bias) << 24);
    w.z = q8(v[2].x, inv, bias) | (q8(v[2].y, inv, bias) << 8) | (q8(v[2].z, inv, bias) << 16) | (q8(v[2].w, inv, bias) << 24);
    w.w = q8(v[3].x, inv, bias) | (q8(v[3].y, inv, bias) << 8) | (q8(v[3].z, inv, bias) << 16) | (q8(v[3].w, inv, bias) << 24);
    *(u32x4*)(dst + (size_t)(lane >> 5) * ((size_t)NEXP * 512) + 16 * (lane & 31)) = w;
    if (lane == 0) *scale_out = sc;
}

struct Params {
    const float *x, *c, *ctx, *c_ctx, *w_mod, *b_mod, *n1, *n2, *w_in, *sink, *conv_w, *w_ao, *w_co, *w_mix, *pw_q, *keys, *pu, *pv, *fg;
    float* out;
    float *modp, *mod, *rope;
    bf16_t *WinT, *WaoT, *WcoT, *WmixT, *PwqT, *KeysB;
    bf16_t *H, *HC, *Q, *K, *VT, *Kc, *VcT, *GB, *GC, *U, *GA, *GV, *AO, *CA, *M1, *YG, *H2, *QH;
    float* TKv; int* TKi;
    int* sel_idx; float* sel_g;
    bf16_t* X1;
    unsigned* bar;
    signed char *Uq, *H2q; unsigned char* Vq; float *su, *sv, *sh2, *cbuf, *ssq; int* pd;
};

__device__ __forceinline__ void modp_item(const Params& P, int item, char* smem) {
    float (*s)[128] = (float (*)[128])smem;
    const int kc = item / 24, nc = item % 24;
    __syncthreads();
    for (int i = threadIdx.x; i < 17 * 128; i += 256) {
        const int r = i / 128, k = i % 128;
        const float v = (r < 16) ? P.c[r * DM + kc * 128 + k] : P.c_ctx[kc * 128 + k];
        s[r][k] = v / (1.f + __expf(-v));
    }
    __syncthreads();
    const int n = nc * 256 + threadIdx.x;
    float acc[17];
#pragma unroll
    for (int r = 0; r < 17; ++r) acc[r] = 0.f;
    for (int k = 0; k < 128; ++k) {
        const float w = P.w_mod[(size_t)(kc * 128 + k) * NMOD + n];
#pragma unroll
        for (int r = 0; r < 17; ++r) acc[r] += s[r][k] * w;
    }
#pragma unroll
    for (int r = 0; r < 17; ++r) P.modp[((size_t)kc * 17 + r) * NMOD + n] = acc[r];
}
__device__ __forceinline__ void cvt_range(const float* src, bf16_t* dst, size_t n8, size_t gtid, size_t gsize) {
    for (size_t i = gtid; i < n8; i += gsize) {
        const f32x4 a = *(const f32x4*)(src + i * 8), b = *(const f32x4*)(src + i * 8 + 4);
        u32x4 o; o.x = pk2(a.x, a.y); o.y = pk2(a.z, a.w); o.z = pk2(b.x, b.y); o.w = pk2(b.z, b.w);
        *(u32x4*)(dst + i * 8) = o;
    }
}
__device__ __forceinline__ void rope_tab(const Params& P, int gtid, int gsize) {
    for (int i = gtid; i < 1536; i += gsize) {
        int pos, f; bool isc;
        if (i < 512) { pos = i / 16; f = i % 16; isc = false; } else { pos = (i - 512) / 16; f = (i - 512) % 16; isc = true; }
        const double inv = pow(10000.0, -(double)f / 16.0);
        const double ang = (double)pos * inv;
        const float cv = (float)cos(ang), sv = (float)sin(ang);
        if (!isc) { P.rope[pos * 16 + f] = cv; P.rope[512 + pos * 16 + f] = sv; }
        else { P.rope[1024 + pos * 16 + f] = cv; P.rope[2048 + pos * 16 + f] = sv; }
    }
}
__device__ __forceinline__ void transpose_tile(const float* W, int K, int N, bf16_t* Wt, int item, float (*tile)[65]) {
    const int ntn = N / 64, kt = item / ntn, nt = item % ntn, k0 = kt * 64, n0 = nt * 64;
    const int tx = threadIdx.x & 63, ty = threadIdx.x >> 6;
    __syncthreads();
#pragma unroll
    for (int i = 0; i < 16; ++i) { const int k = i * 4 + ty; tile[k][tx] = W[(size_t)(k0 + k) * N + n0 + tx]; }
    __syncthreads();
#pragma unroll
    for (int i = 0; i < 16; ++i) { const int n = i * 4 + ty; Wt[(size_t)(n0 + n) * K + k0 + tx] = f2bf(tile[tx][n]); }
}

__device__ __forceinline__ void load_row4_bf(const bf16_t* xr, int lane, f32x4 (&v)[4]) {
#pragma unroll
    for (int j = 0; j < 4; ++j) { const u32x2 w = *(const u32x2*)(xr + j * 256 + lane * 4);
        v[j].x = bf2f(w.x & 0xffff); v[j].y = bf2f(w.x >> 16); v[j].z = bf2f(w.y & 0xffff); v[j].w = bf2f(w.y >> 16); }
}
__device__ __forceinline__ void load_row4(const float* xr, int lane, f32x4 (&v)[4]) {
#pragma unroll
    for (int j = 0; j < 4; ++j) v[j] = *(const f32x4*)(xr + j * 256 + lane * 4);
}
__device__ __forceinline__ void norm_row(f32x4 (&v)[4], const float* g, const float* scale, const float* shift, bf16_t* dst, int lane) {
    float s = 0.f;
#pragma unroll
    for (int j = 0; j < 4; ++j) s += v[j].x * v[j].x + v[j].y * v[j].y + v[j].z * v[j].z + v[j].w * v[j].w;
    s = wave_sum(s);
    const float rstd = rsqrtf(s * (1.f / DM) + 1e-6f);
#pragma unroll
    for (int j = 0; j < 4; ++j) {
        const int d = j * 256 + lane * 4;
        const f32x4 gg = *(const f32x4*)(g + d), sc = *(const f32x4*)(scale + d), sh = *(const f32x4*)(shift + d);
        const float y0 = v[j].x * rstd * gg.x * (1.f + sc.x) + sh.x;
        const float y1 = v[j].y * rstd * gg.y * (1.f + sc.y) + sh.y;
        const float y2 = v[j].z * rstd * gg.z * (1.f + sc.z) + sh.z;
        const float y3 = v[j].w * rstd * gg.w * (1.f + sc.w) + sh.w;
        u32x2 o; o.x = pk2(y0, y1); o.y = pk2(y2, y3);
        *(u32x2*)(dst + d) = o;
    }
}

__device__ __forceinline__ void norm_row_q(f32x4 (&v)[4], const float* g, const float* scale, const float* shift, bf16_t* dst, signed char* dq, float* sq, int lane) {
    float s = 0.f;
#pragma unroll
    for (int j = 0; j < 4; ++j) s += v[j].x * v[j].x + v[j].y * v[j].y + v[j].z * v[j].z + v[j].w * v[j].w;
    s = wave_sum(s);
    const float rstd = rsqrtf(s * (1.f / DM) + 1e-6f);
    float amax = 0.f;
#pragma unroll
    for (int j = 0; j < 4; ++j) {
        const int d = j * 256 + lane * 4;
        const f32x4 gg = *(const f32x4*)(g + d), sc = *(const f32x4*)(scale + d), sh = *(const f32x4*)(shift + d);
        v[j].x = v[j].x * rstd * gg.x * (1.f + sc.x) + sh.x;
        v[j].y = v[j].y * rstd * gg.y * (1.f + sc.y) + sh.y;
        v[j].z = v[j].z * rstd * gg.z * (1.f + sc.z) + sh.z;
        v[j].w = v[j].w * rstd * gg.w * (1.f + sc.w) + sh.w;
        u32x2 o; o.x = pk2(v[j].x, v[j].y); o.y = pk2(v[j].z, v[j].w);
        *(u32x2*)(dst + d) = o;
        amax = fmaxf(amax, fmaxf(fmaxf(fabsf(v[j].x), fabsf(v[j].y)), fmaxf(fabsf(v[j].z), fabsf(v[j].w))));
    }
    amax = wave_max(amax);
    const float qs = amax > 0.f ? amax * (1.f / 127.f) : 1.f, inv = 1.f / qs;
#pragma unroll
    for (int j = 0; j < 4; ++j) {
        const unsigned w = q8(v[j].x, inv, 0) | (q8(v[j].y, inv, 0) << 8) | (q8(v[j].z, inv, 0) << 16) | (q8(v[j].w, inv, 0) << 24);
        *(unsigned*)(dq + j * 256 + lane * 4) = w;
    }
    if (lane == 0) *sq = qs;
}

__device__ __forceinline__ void norm1_rows(const Params& P, bool isctx, int row0, int nrows, char* smem) {
    float* sc = (float*)smem; float* sh = sc + DM;
    const int r = isctx ? 16 : row0 / SEQ;
    __syncthreads();
    for (int d = threadIdx.x; d < DM; d += 256) {
        float a = P.b_mod[DM + d], b = P.b_mod[d];
#pragma unroll
        for (int kc = 0; kc < 8; ++kc) { a += P.modp[((size_t)kc * 17 + r) * NMOD + DM + d]; b += P.modp[((size_t)kc * 17 + r) * NMOD + d]; }
        sc[d] = a; sh[d] = b;
    }
    __syncthreads();
    const int lane = threadIdx.x & 63, wid = threadIdx.x >> 6;
    const float* srcb = isctx ? P.ctx : P.x; bf16_t* dstb = isctx ? P.HC : P.H;
    for (int i = wid; i < nrows; i += 8) {
        const int ra = row0 + i, rb = row0 + i + 4; const bool hb = (i + 4) < nrows;
        f32x4 va[4], vb[4];
        load_row4(srcb + (size_t)ra * DM, lane, va); if (hb) load_row4(srcb + (size_t)rb * DM, lane, vb);
        norm_row(va, P.n1, sc, sh, dstb + (size_t)ra * DM, lane);
        if (hb) norm_row(vb, P.n1, sc, sh, dstb + (size_t)rb * DM, lane);
    }
}
enum { MODE_INPROJ = 0, MODE_CTXKV = 1, MODE_AO1 = 2, MODE_CO2 = 3, MODE_MIX = 4, MODE_QH = 5 };

__device__ __forceinline__ void st8bf(bf16_t* p, const float* v) {
    u32x4 o; o.x = pk2(v[0], v[1]); o.y = pk2(v[2], v[3]); o.z = pk2(v[4], v[5]); o.w = pk2(v[6], v[7]);
    *(u32x4*)p = o;
}
__device__ __forceinline__ void st8bf_nt(bf16_t* p, const float* v) {
    u32x4 o; o.x = pk2(v[0], v[1]); o.y = pk2(v[2], v[3]); o.z = pk2(v[4], v[5]); o.w = pk2(v[6], v[7]);
    __builtin_nontemporal_store(o, (u32x4*)p);
}
__device__ __forceinline__ void st4bf(bf16_t* p, const float* v) {
    u32x2 o; o.x = pk2(v[0], v[1]); o.y = pk2(v[2], v[3]);
    *(u32x2*)p = o;
}
template <int MODE> __device__ __forceinline__ void epi8(const Params& P, int m, int n, const float* v, int aux) {
    if (MODE == MODE_INPROJ) {
        if (n < 1280) st8bf_nt(P.GB + (size_t)m * 512 + (n - 768), v);
        else if (n < 1792) st8bf_nt(P.GC + (size_t)m * 512 + (n - 1280), v);
        else if (n < 2304) st8bf_nt(P.U + (size_t)m * 512 + (n - 1792), v);
        else {
            float s[8];
#pragma unroll
            for (int j = 0; j < 8; ++j) s[j] = sigmoidf_(v[j]);
            if (n < 3328) st8bf_nt(P.GA + (size_t)m * DM + (n - 2304), s);
            else st8bf_nt(P.GV + (size_t)m * DM + (n - 3328), s);
        }
    } else if (MODE == MODE_CTXKV) {
        { const int b = m / CTXL, c = m % CTXL, kvh = n >> 6, d0 = n & 63;
          st8bf(P.Kc + ((((size_t)((b * 2 + kvh) * 8 + (c >> 5)) * 4 + (d0 >> 4)) * 2 + ((d0 >> 3) & 1)) * 32 + (c & 31)) * 8, v); }
    } else if (MODE == MODE_AO1) {
        const u32x4 g = *(const u32x4*)((aux ? P.GV : P.GA) + (size_t)m * DM + n);
        u32x4 a = (u32x4){0u, 0u, 0u, 0u};
        if (aux) a = *(const u32x4*)(P.M1 + (size_t)m * DM + n);
        float o[8];
        o[0] = bf2f(a.x & 0xffff) + v[0] * bf2f(g.x & 0xffff); o[1] = bf2f(a.x >> 16) + v[1] * bf2f(g.x >> 16);
        o[2] = bf2f(a.y & 0xffff) + v[2] * bf2f(g.y & 0xffff); o[3] = bf2f(a.y >> 16) + v[3] * bf2f(g.y >> 16);
        o[4] = bf2f(a.z & 0xffff) + v[4] * bf2f(g.z & 0xffff); o[5] = bf2f(a.z >> 16) + v[5] * bf2f(g.z >> 16);
        o[6] = bf2f(a.w & 0xffff) + v[6] * bf2f(g.w & 0xffff); o[7] = bf2f(a.w >> 16) + v[7] * bf2f(g.w >> 16);
        st8bf((aux ? P.YG : P.M1) + (size_t)m * DM + n, o);
    } else if (MODE == MODE_MIX) {
        const int b = m / SEQ;
        const float* g1 = P.mod + (size_t)b * NMOD + 2 * DM + n;
        const float* xr = P.x + (size_t)m * DM + n;
        const f32x4 x0 = *(const f32x4*)xr, x1 = *(const f32x4*)(xr + 4), g0 = *(const f32x4*)g1, g1v = *(const f32x4*)(g1 + 4);
        float o[8];
        o[0] = x0.x + g0.x * v[0]; o[1] = x0.y + g0.y * v[1]; o[2] = x0.z + g0.z * v[2]; o[3] = x0.w + g0.w * v[3];
        o[4] = x1.x + g1v.x * v[4]; o[5] = x1.y + g1v.y * v[5]; o[6] = x1.z + g1v.z * v[6]; o[7] = x1.w + g1v.w * v[7];
        st8bf(P.X1 + (size_t)m * DM + n, o);
    } else if (MODE == MODE_QH) {
        st8bf(P.QH + (size_t)m * 2048 + n, v);
    }
}
__device__ __forceinline__ void epi_rope(const Params& P, int m, int n, const float* lo, const float* hi) {
    const int d0 = n & 63;
    const int l = m % SEQ;
    const float *ct, *st;
    if (d0 < 16) { const int row = l >> 6; ct = P.rope + row * 16 + d0; st = P.rope + 512 + row * 16 + d0; }
    else { const int col = l & 63; ct = P.rope + 1024 + col * 16 + (d0 - 32); st = P.rope + 2048 + col * 16 + (d0 - 32); }
    float a[4], b[4];
    const float sc = (n < 512) ? 0.125f * 1.44269504088896f : 1.f;
#pragma unroll
    for (int j = 0; j < 4; ++j) { const float cc = ct[j], ss = st[j]; a[j] = (lo[j] * cc - hi[j] * ss) * sc; b[j] = (lo[j] * ss + hi[j] * cc) * sc; }
    if (n < 512) { st4bf(P.Q + (size_t)m * 512 + n, a); st4bf(P.Q + (size_t)m * 512 + n + 16, b); }
    else { const int bb = m / SEQ, kvh = (n - 512) >> 6;
        bf16_t* kp = P.K + ((((size_t)((bb * 2 + kvh) * 64 + (l >> 5)) * 4 + (d0 >> 4)) * 2 + ((d0 >> 3) & 1)) * 32 + (l & 31)) * 8 + (d0 & 7);
        st4bf(kp, a); st4bf(kp + 512, b); }
}
__device__ __forceinline__ void epi_v4(const Params& P, int m, int dcol, const float* v, bool ctx) {
    const int kvh = dcol >> 6, dd = dcol & 63;
    if (!ctx) { const int b = m / SEQ, l = m % SEQ;
#pragma unroll
        for (int j = 0; j < 4; ++j) {
            const int kk = l & 31;
            P.VT[(((((size_t)((b * 2 + kvh) * 64 + (l >> 5)) * 2 + (dd >> 5)) * 2 + (kk >> 4)) * 2 + ((kk >> 2) & 1)) * 32 + ((dd & 31) + j)) * 8 + 4 * ((kk >> 3) & 1) + (kk & 3)] = f2bf(v[j]); }
    } else { const int b = m / CTXL, cpos = m % CTXL;
#pragma unroll
        for (int j = 0; j < 4; ++j) {
            const int kk = cpos & 31;
            P.VcT[(((((size_t)((b * 2 + kvh) * 8 + (cpos >> 5)) * 2 + (dd >> 5)) * 2 + (kk >> 4)) * 2 + ((kk >> 2) & 1)) * 32 + ((dd & 31) + j)) * 8 + 4 * ((kk >> 3) & 1) + (kk & 3)] = f2bf(v[j]); }
    }
}

constexpr int GEMM_LDS = 65536;
constexpr int RETR_LDS = 128 * 130 * 4;
__device__ __forceinline__ int lds_off(int row, int chunk) { return row * 128 + ((chunk ^ ((row >> 1) & 7)) << 4); }

__device__ __forceinline__ void mma_from_lds(const char* As, const char* Bs, f32x4 (&acc)[4][4], int wm, int wn, int fr, int fq, int sw) {
#pragma unroll
    for (int ks = 0; ks < 2; ++ks) {
        bf16x8 af[4], bfr[4];
        const int coff = ((ks * 4 + fq) ^ sw) << 4;
#pragma unroll
        for (int mt = 0; mt < 4; ++mt) af[mt] = *(const bf16x8*)(As + (wm * 64 + mt * 16 + fr) * 128 + coff);
#pragma unroll
        for (int nt = 0; nt < 4; ++nt) bfr[nt] = *(const bf16x8*)(Bs + (wn * 64 + nt * 16 + fr) * 128 + coff);
#pragma unroll
        for (int mt = 0; mt < 4; ++mt)
#pragma unroll
            for (int nt = 0; nt < 4; ++nt) acc[mt][nt] = __builtin_amdgcn_mfma_f32_16x16x32_bf16(bfr[nt], af[mt], acc[mt][nt], 0, 0, 0);
    }
}
__device__ __forceinline__ void gemm_mainloop(const bf16_t* __restrict__ A, int lda, const bf16_t* __restrict__ Bt, int ldb, int K, int m0, int n0, bool perm, char* smem, f32x4 (&acc)[4][4]) {
    const int tid = threadIdx.x, lane = tid & 63, wid = tid >> 6;
    const int wm = wid >> 1, wn = wid & 1, fr = lane & 15, fq = lane >> 4;
    const bf16_t* ag[4]; const bf16_t* bg[4];
#pragma unroll
    for (int i = 0; i < 4; ++i) {
        const int row = (wid + 4 * i) * 8 + (lane >> 3);
        const int c = (lane & 7) ^ ((row >> 1) & 7);
        ag[i] = A + (size_t)(m0 + row) * lda + c * 8;
        int brow = row;
        if (perm) { const int g = row >> 5, rr = row & 31, nn = rr >> 4, j = rr & 15; brow = 32 * g + 8 * (j >> 2) + 4 * nn + (j & 3); }
        bg[i] = Bt + (size_t)(n0 + brow) * ldb + c * 8;
    }
#pragma unroll
    for (int i = 0; i < 4; ++i)
#pragma unroll
        for (int j = 0; j < 4; ++j) acc[i][j] = (f32x4){0.f, 0.f, 0.f, 0.f};
#define GSTAGE(buf, k0) { _Pragma("unroll") for (int i = 0; i < 4; ++i) { \
        __builtin_amdgcn_global_load_lds((const unsigned*)(ag[i] + (k0)), (unsigned*)(smem + (buf) * 32768 + (wid + 4 * i) * 1024), 16, 0, 0); \
        __builtin_amdgcn_global_load_lds((const unsigned*)(bg[i] + (k0)), (unsigned*)(smem + (buf) * 32768 + 16384 + (wid + 4 * i) * 1024), 16, 0, 0); } }
    GSTAGE(0, 0)
    asm volatile("s_waitcnt vmcnt(0)" ::: "memory");
    __syncthreads();
    const int nk = K / 64;
    const int sw = (fr >> 1) & 7;
    for (int kt = 0; kt < nk; ++kt) {
        const int cur = kt & 1;
        if (kt + 1 < nk) GSTAGE(cur ^ 1, (kt + 1) * 64)
        mma_from_lds(smem + cur * 32768, smem + cur * 32768 + 16384, acc, wm, wn, fr, fq, sw);
        asm volatile("s_waitcnt vmcnt(0)" ::: "memory");
        __syncthreads();
    }
#undef GSTAGE
}

template <int MT, int NST>
__device__ __forceinline__ void gemm_ring(const bf16_t* __restrict__ A, int lda, const bf16_t* __restrict__ Bt, int ldb, int K, int m0, int n0, bool perm, char* smem, f32x4 (&acc)[MT][4]) {
    constexpr int SA = 2048 * MT, SB = SA + 8192, GA = MT / 2, GL = GA + 2;
    const int tid = threadIdx.x, lane = tid & 63, wid = __builtin_amdgcn_readfirstlane(tid >> 6);
    const int wm = wid >> 1, wn = wid & 1, fr = lane & 15, fq = lane >> 4;
    const int c8 = ((lane & 3) ^ (3 * ((lane >> 4) & 1))) * 8;
    unsigned aoff[GA], boff[2];
#pragma unroll
    for (int i = 0; i < GA; ++i) aoff[i] = (unsigned)(((wid + 4 * i) * 16 + (lane >> 2)) * lda + c8) * 2u;
#pragma unroll
    for (int i = 0; i < 2; ++i) {
        const int row = (wid + 4 * i) * 16 + (lane >> 2);
        int brow = row;
        if (perm) { const int g = row >> 5, rr = row & 31, nn = rr >> 4, j = rr & 15; brow = 32 * g + 8 * (j >> 2) + 4 * nn + (j & 3); }
        boff[i] = (unsigned)(brow * ldb + c8) * 2u;
    }
    const char* Abase = (const char*)(A + (size_t)m0 * lda);
    const char* Bbase = (const char*)(Bt + (size_t)n0 * ldb);
#pragma unroll
    for (int i = 0; i < MT; ++i)
#pragma unroll
        for (int j = 0; j < 4; ++j) acc[i][j] = (f32x4){0.f, 0.f, 0.f, 0.f};
#define RSTAGE_(buf, k0) { char* sb_ = smem + (buf) * SB; const char* ab_ = Abase + (size_t)(k0) * 2; const char* bb_ = Bbase + (size_t)(k0) * 2; \
        _Pragma("unroll") for (int i = 0; i < GA; ++i) __builtin_amdgcn_global_load_lds((const unsigned*)(ab_ + aoff[i]), (unsigned*)(sb_ + (wid + 4 * i) * 1024), 16, 0, 0); \
        _Pragma("unroll") for (int i = 0; i < 2; ++i) __builtin_amdgcn_global_load_lds((const unsigned*)(bb_ + boff[i]), (unsigned*)(sb_ + SA + (wid + 4 * i) * 1024), 16, 0, 0); }
    const int nk = K / 32;
    asm volatile("s_waitcnt vmcnt(0)" ::: "memory");
#pragma unroll
    for (int s = 0; s < NST - 1; ++s) RSTAGE_(s, s * 32)
    const int coff = (fq ^ (3 * ((fr >> 2) & 1))) << 4;
    int cur = 0, nxt = NST - 1;
#pragma unroll 1
    for (int kt = 0; kt < nk; ++kt) {
        const int rem = nk - 1 - kt;
        if (rem >= NST - 2) asm volatile("s_waitcnt vmcnt(%0)" :: "n"(GL * (NST - 2)) : "memory");
        else if (NST == 4 && rem == 1) asm volatile("s_waitcnt vmcnt(%0)" :: "n"(GL) : "memory");
        else asm volatile("s_waitcnt vmcnt(0)" ::: "memory");
        __builtin_amdgcn_s_barrier();
        const char* As = smem + cur * SB;
        const char* Bs = As + SA;
        bf16x8 af[MT], bfr[4];
#pragma unroll
        for (int mt = 0; mt < MT; ++mt) af[mt] = *(const bf16x8*)(As + (wm * 16 * MT + mt * 16 + fr) * 64 + coff);
#pragma unroll
        for (int nt = 0; nt < 4; ++nt) bfr[nt] = *(const bf16x8*)(Bs + (wn * 64 + nt * 16 + fr) * 64 + coff);
        const bool more = (kt + NST - 1 < nk);
        char* sb_ = smem + nxt * SB; const char* ab_ = Abase + (size_t)((kt + NST - 1) * 32) * 2; const char* bb_ = Bbase + (size_t)((kt + NST - 1) * 32) * 2;
        __builtin_amdgcn_s_setprio(1);
#pragma unroll
        for (int mt = 0; mt < MT; ++mt) {
#pragma unroll
            for (int nt = 0; nt < 4; ++nt) acc[mt][nt] = __builtin_amdgcn_mfma_f32_16x16x32_bf16(bfr[nt], af[mt], acc[mt][nt], 0, 0, 0);
            if (more) {
                if (mt < GA) __builtin_amdgcn_global_load_lds((const unsigned*)(ab_ + aoff[mt]), (unsigned*)(sb_ + (wid + 4 * mt) * 1024), 16, 0, 0);
                else if (mt < GA + 2) __builtin_amdgcn_global_load_lds((const unsigned*)(bb_ + boff[mt - GA]), (unsigned*)(sb_ + SA + (wid + 4 * (mt - GA)) * 1024), 16, 0, 0);
            }
        }
        __builtin_amdgcn_s_setprio(0);
        cur = (cur + 1 == NST) ? 0 : cur + 1;
        nxt = (nxt + 1 == NST) ? 0 : nxt + 1;
    }
#undef RSTAGE_
    __syncthreads();
}

template <int MODE, int MT>
__device__ __forceinline__ void gemm_tile(const Params& P, const bf16_t* __restrict__ A, int lda, const bf16_t* __restrict__ Bt, int ldb, int K, int m0, int n0, bool perm, char* smem, int aux = 0) {
    const int lane = threadIdx.x & 63, wid = threadIdx.x >> 6;
    const int wm = wid >> 1, wn = wid & 1, fr = lane & 15, fq = lane >> 4;
    f32x4 acc[MT][4];
    gemm_ring<MT, (MT == 8 ? 3 : 4)>(A, lda, Bt, ldb, K, m0, n0, perm, smem, acc);
#pragma unroll
    for (int mt = 0; mt < MT; ++mt) {
        const int m = m0 + wm * 16 * MT + mt * 16 + fr;
        if (perm) {
#pragma unroll
            for (int p = 0; p < 2; ++p) {
                float v[8] = { acc[mt][2 * p][0], acc[mt][2 * p][1], acc[mt][2 * p][2], acc[mt][2 * p][3], acc[mt][2 * p + 1][0], acc[mt][2 * p + 1][1], acc[mt][2 * p + 1][2], acc[mt][2 * p + 1][3] };
                epi8<MODE>(P, m, n0 + wn * 64 + 32 * p + 8 * fq, v, aux);
            }
        } else if (MODE == MODE_INPROJ && n0 < 640) {
#pragma unroll
            for (int p = 0; p < 2; ++p) {
                float lo[4] = { acc[mt][2 * p][0], acc[mt][2 * p][1], acc[mt][2 * p][2], acc[mt][2 * p][3] };
                float hi[4] = { acc[mt][2 * p + 1][0], acc[mt][2 * p + 1][1], acc[mt][2 * p + 1][2], acc[mt][2 * p + 1][3] };
                epi_rope(P, m, n0 + wn * 64 + 32 * p + 4 * fq, lo, hi);
            }
        } else if (MODE == MODE_INPROJ || MODE == MODE_CTXKV) {
            const int dbase = (MODE == MODE_INPROJ) ? (n0 - 640) : (n0 - 128);
#pragma unroll
            for (int nt = 0; nt < 4; ++nt) {
                float v[4] = { acc[mt][nt][0], acc[mt][nt][1], acc[mt][nt][2], acc[mt][nt][3] };
                epi_v4(P, m, dbase + wn * 64 + 16 * nt + 4 * fq, v, MODE == MODE_CTXKV);
            }
        }
        asm volatile("" ::: "memory"); __builtin_amdgcn_sched_barrier(0);
    }
}
__device__ __forceinline__ void tile_coords(int t, int ntm, int ntn, int& mt, int& nt) {
    const int per = 8 * ntn, g = t / per, r = t % per;
    mt = g * 8 + (r & 7); nt = r >> 3;
}
#define CEU(a, b) { const unsigned _t = (a) > (b) ? (a) : (b); (b) = (a) > (b) ? (b) : (a); (a) = _t; }
__device__ __forceinline__ void sort16_desc(unsigned (&v)[16]) {
    CEU(v[0], v[1]); CEU(v[2], v[3]); CEU(v[0], v[2]); CEU(v[1], v[3]); CEU(v[1], v[2]); CEU(v[4], v[5]);
    CEU(v[6], v[7]); CEU(v[4], v[6]); CEU(v[5], v[7]); CEU(v[5], v[6]); CEU(v[0], v[4]); CEU(v[2], v[6]);
    CEU(v[2], v[4]); CEU(v[1], v[5]); CEU(v[3], v[7]); CEU(v[3], v[5]); CEU(v[1], v[2]); CEU(v[3], v[4]);
    CEU(v[5], v[6]); CEU(v[8], v[9]); CEU(v[10], v[11]); CEU(v[8], v[10]); CEU(v[9], v[11]); CEU(v[9], v[10]);
    CEU(v[12], v[13]); CEU(v[14], v[15]); CEU(v[12], v[14]); CEU(v[13], v[15]); CEU(v[13], v[14]); CEU(v[8], v[12]);
    CEU(v[10], v[14]); CEU(v[10], v[12]); CEU(v[9], v[13]); CEU(v[11], v[15]); CEU(v[11], v[13]); CEU(v[9], v[10]);
    CEU(v[11], v[12]); CEU(v[13], v[14]); CEU(v[0], v[8]); CEU(v[4], v[12]); CEU(v[4], v[8]); CEU(v[2], v[10]);
    CEU(v[6], v[14]); CEU(v[6], v[10]); CEU(v[2], v[4]); CEU(v[6], v[8]); CEU(v[10], v[12]); CEU(v[1], v[9]);
    CEU(v[5], v[13]); CEU(v[5], v[9]); CEU(v[3], v[11]); CEU(v[7], v[15]); CEU(v[7], v[11]); CEU(v[3], v[5]);
    CEU(v[7], v[9]); CEU(v[11], v[13]); CEU(v[1], v[2]); CEU(v[3], v[4]); CEU(v[5], v[6]); CEU(v[7], v[8]);
    CEU(v[9], v[10]); CEU(v[11], v[12]); CEU(v[13], v[14]);
}
__device__ __forceinline__ void bitonic16_desc(unsigned (&v)[16]) {
    CEU(v[0], v[8]); CEU(v[1], v[9]); CEU(v[2], v[10]); CEU(v[3], v[11]); CEU(v[4], v[12]); CEU(v[5], v[13]);
    CEU(v[6], v[14]); CEU(v[7], v[15]); CEU(v[0], v[4]); CEU(v[1], v[5]); CEU(v[2], v[6]); CEU(v[3], v[7]);
    CEU(v[8], v[12]); CEU(v[9], v[13]); CEU(v[10], v[14]); CEU(v[11], v[15]); CEU(v[0], v[2]); CEU(v[1], v[3]);
    CEU(v[4], v[6]); CEU(v[5], v[7]); CEU(v[8], v[10]); CEU(v[9], v[11]); CEU(v[12], v[14]); CEU(v[13], v[15]);
    CEU(v[0], v[1]); CEU(v[2], v[3]); CEU(v[4], v[5]); CEU(v[6], v[7]); CEU(v[8], v[9]); CEU(v[10], v[11]);
    CEU(v[12], v[13]); CEU(v[14], v[15]);
}

__device__ __forceinline__ unsigned enc_key(float f) { const unsigned b = __float_as_uint(f); return b ^ ((unsigned)((int)b >> 31) | 0x80000000u); }
__device__ __forceinline__ float dec_key(unsigned k) { const unsigned b = (k & 0x80000000u) ? (k & 0x7fffffffu) : ~k; return __uint_as_float(b); }
__device__ __forceinline__ void topmerge16(unsigned (&top)[16], const unsigned (&L)[16]) {
#pragma unroll
    for (int i = 0; i < 16; ++i) top[i] = top[i] > L[15 - i] ? top[i] : L[15 - i];
    bitonic16_desc(top);
}
__device__ __forceinline__ unsigned cand_key(float a, float b, int i, int j) { return (enc_key(a + b) & ~0xFFu) | (unsigned)(i << 4) | (unsigned)j; }

__device__ __forceinline__ void peer_retrieve_item(const Params& P, int mtile, int h, char* smem) {
    const int tid = threadIdx.x, lane = tid & 63, wid = tid >> 6;
    const int wm = wid >> 1, wn = wid & 1, fr = lane & 15, fq = lane >> 4;
    const int sw = (fr >> 1) & 7;
    const int m0 = mtile * 128;
    unsigned T0[16], T1[16];
#pragma unroll 1
    for (int p = 0; p < 2; ++p) {
        const int hp = h * 2 + p;
        f32x4 acc[4][4];
        gemm_ring<4, 4>(P.H2, DM, P.PwqT, DM, DM, m0, hp * 128, false, smem, acc);
#pragma unroll
        for (int mt = 0; mt < 4; ++mt)
#pragma unroll
            for (int nt = 0; nt < 4; ++nt) {
                const int row = wm * 64 + mt * 16 + fr;
                u32x2 o; o.x = pk2(acc[mt][nt][0], acc[mt][nt][1]); o.y = pk2(acc[mt][nt][2], acc[mt][nt][3]);
                *(u32x2*)(smem + wn * 32768 + lds_off(row, 2 * nt + (fq >> 1)) + (fq & 1) * 8) = o;
            }
        {
            const int srow = tid >> 3, schunk = tid & 7;
            const bf16_t* kb = P.KeysB + (size_t)hp * 128 * 128;
#pragma unroll
            for (int hf = 0; hf < 2; ++hf)
#pragma unroll
                for (int q = 0; q < 4; ++q) {
                    const int row = q * 32 + srow;
                    const u32x4 v = *(const u32x4*)(kb + (size_t)row * 128 + hf * 64 + schunk * 8);
                    *(u32x4*)(smem + hf * 32768 + 16384 + lds_off(row, schunk)) = v;
                }
        }
        __syncthreads();
#pragma unroll
        for (int i = 0; i < 4; ++i)
#pragma unroll
            for (int j = 0; j < 4; ++j) acc[i][j] = (f32x4){0.f, 0.f, 0.f, 0.f};
        mma_from_lds(smem, smem + 16384, acc, wm, wn, fr, fq, sw);
        mma_from_lds(smem + 32768, smem + 32768 + 16384, acc, wm, wn, fr, fq, sw);
        __syncthreads();
        float* sc = (float*)smem;
#pragma unroll
        for (int mt = 0; mt < 4; ++mt)
#pragma unroll
            for (int nt = 0; nt < 4; ++nt) {
                const int row = wm * 64 + mt * 16 + fr;
#pragma unroll
                for (int r = 0; r < 4; ++r) {
                    const int col = wn * 64 + nt * 16 + fq * 4 + r;
                    sc[row * 130 + wn * 65 + (col & 63)] = acc[mt][nt][r];
                }
            }
        __syncthreads();
        {
            const int row = tid >> 1, half = tid & 1;
            const float* rp = sc + row * 130 + half * 65;
            unsigned top[16];
#pragma unroll 1
            for (int g = 0; g < 4; ++g) {
                unsigned L[16];
#pragma unroll
                for (int j = 0; j < 16; ++j) { const int col = half * 64 + g * 16 + j; L[j] = (enc_key(rp[g * 16 + j]) & ~0x7Fu) | (unsigned)col; }
                sort16_desc(L);
                if (g == 0) {
#pragma unroll
                    for (int j = 0; j < 16; ++j) top[j] = L[j];
                } else topmerge16(top, L);
            }
            unsigned Bp[16];
#pragma unroll
            for (int j = 0; j < 16; ++j) Bp[j] = (unsigned)__shfl_xor((int)top[j], 1);
            topmerge16(top, Bp);
            if (p == 0) {
#pragma unroll
                for (int j = 0; j < 16; ++j) T0[j] = top[j];
            } else {
#pragma unroll
                for (int j = 0; j < 16; ++j) T1[j] = top[j];
            }
        }
        __syncthreads();
    }
    {
        const int row = tid >> 1;
        unsigned char* slot = (unsigned char*)smem + row * 32;
        if ((tid & 1) == 0) {
#pragma unroll
            for (int j = 0; j < 16; ++j) { slot[j] = (unsigned char)(T0[j] & 0x7Fu); slot[16 + j] = (unsigned char)(T1[j] & 0x7Fu); }
            float a[16], b[16];
#pragma unroll
            for (int j = 0; j < 16; ++j) { a[j] = dec_key(T0[j]); b[j] = dec_key(T1[j]); }
            unsigned LA[16], LB[16], LC[16];
#pragma unroll
            for (int j = 0; j < 16; ++j) LA[j] = cand_key(a[0], b[j], 0, j);
#pragma unroll
            for (int j = 0; j < 8; ++j) LB[j] = cand_key(a[1], b[j], 1, j);
#pragma unroll
            for (int j = 0; j < 8; ++j) LB[8 + j] = cand_key(a[15 - j], b[0], 15 - j, 0);
            LC[0] = cand_key(a[2], b[0], 2, 0); LC[1] = cand_key(a[2], b[1], 2, 1); LC[2] = cand_key(a[2], b[2], 2, 2); LC[3] = cand_key(a[2], b[3], 2, 3); LC[4] = cand_key(a[2], b[4], 2, 4);
            LC[5] = cand_key(a[3], b[0], 3, 0); LC[6] = cand_key(a[3], b[1], 3, 1); LC[7] = cand_key(a[3], b[2], 3, 2); LC[8] = cand_key(a[3], b[3], 3, 3);
            LC[9] = cand_key(a[4], b[0], 4, 0); LC[10] = cand_key(a[4], b[1], 4, 1); LC[11] = cand_key(a[4], b[2], 4, 2);
            LC[12] = cand_key(a[5], b[0], 5, 0); LC[13] = cand_key(a[5], b[1], 5, 1);
            LC[14] = cand_key(a[6], b[0], 6, 0); LC[15] = cand_key(a[6], b[1], 6, 1);
            const unsigned d0 = cand_key(a[7], b[0], 7, 0), d1 = cand_key(a[7], b[1], 7, 1);
            bitonic16_desc(LB);
            sort16_desc(LC);
            topmerge16(LA, LB);
            LC[15] = LC[15] > d0 ? LC[15] : d0; LC[14] = LC[14] > d1 ? LC[14] : d1;
            bitonic16_desc(LC);
            topmerge16(LA, LC);
            float e[16], den = 0.f; const float vmax = dec_key(LA[0]);
#pragma unroll
            for (int r = 0; r < 16; ++r) { e[r] = __expf(dec_key(LA[r]) - vmax); den += e[r]; }
            const float inv = 1.f / den;
            const int t = m0 + row;
            int* oi = P.sel_idx + (size_t)t * 128 + h * 16; float* og = P.sel_g + (size_t)t * 128 + h * 16;
#pragma unroll
            for (int r = 0; r < 16; ++r) {
                const int i = (LA[r] >> 4) & 15, j = LA[r] & 15;
                oi[r] = (int)slot[i] * 128 + (int)slot[16 + j];
                og[r] = e[r] * inv;
            }
        }
    }
    __syncthreads();
}
typedef float f32x16 __attribute__((ext_vector_type(16)));
struct AttnFrag { u32x4 k[4]; u32x4 v[2][2]; };
__device__ __forceinline__ void attn_load(const Params& P, int b, int kvh, int qb, int w, int blk, int r, int hh, AttnFrag& f) {
    const bf16_t* kp; const bf16_t* vp;
    if (blk < 9) {
        int kpos0 = (qb - 1) * 128 + 32 * (w + blk);
        if (kpos0 < 0 || kpos0 >= SEQ) kpos0 = 0;
        const size_t blkoff = (size_t)((b * 2 + kvh) * 64 + (kpos0 >> 5)) * 2048 + (hh * 32 + r) * 8;
        kp = P.K + blkoff; vp = P.VT + blkoff;
    } else {
        const size_t blkoff = (size_t)((b * 2 + kvh) * 8 + (blk - 9)) * 2048 + (hh * 32 + r) * 8;
        kp = P.Kc + blkoff; vp = P.VcT + blkoff;
    }
#pragma unroll
    for (int ks = 0; ks < 4; ++ks) f.k[ks] = *(const u32x4*)(kp + 512 * ks);
#pragma unroll
    for (int db = 0; db < 2; ++db)
#pragma unroll
        for (int s = 0; s < 2; ++s) f.v[db][s] = *(const u32x4*)(vp + 512 * (db * 2 + s));
}
__device__ __forceinline__ void attn_item(const Params& P, int item) {
    const int head = item & 7, qb = (item >> 3) & 15, b = item >> 7, kvh = head >> 2;
    const int lane = threadIdx.x & 63, w = threadIdx.x >> 6, r = lane & 31, hh = lane >> 5;
    const int tok = b * SEQ + qb * 128 + 32 * w + r;
    bf16x8 qf[4];
    { const bf16_t* qp = P.Q + (size_t)tok * 512 + head * 64 + 8 * hh;
#pragma unroll
      for (int ks = 0; ks < 4; ++ks) qf[ks] = *(const bf16x8*)(qp + 16 * ks); }
    f32x16 o0, o1;
#pragma unroll
    for (int i = 0; i < 16; ++i) { o0[i] = 0.f; o1[i] = 0.f; }
    float mrun = P.sink[head] * 1.44269504088896f, lrun = (hh == 0) ? 1.f : 0.f;
    AttnFrag cur, nxt;
    attn_load(P, b, kvh, qb, w, 0, r, hh, cur);
    for (int blk = 0; blk < 17; ++blk) {
        if (blk + 1 < 17) attn_load(P, b, kvh, qb, w, blk + 1, r, hh, nxt);
        int lo = 0, hi = 31;
        if (blk < 9) {
            const int kpos0 = (qb - 1) * 128 + 32 * (w + blk);
            if (kpos0 < 0 || kpos0 >= SEQ) lo = 64;
            else if (blk == 0) lo = r;
            else if (blk == 8) hi = r;
        }
        f32x16 s;
#pragma unroll
        for (int i = 0; i < 16; ++i) s[i] = 0.f;
#pragma unroll
        for (int ks = 0; ks < 4; ++ks) s = __builtin_amdgcn_mfma_f32_32x32x16_bf16(*(const bf16x8*)&cur.k[ks], qf[ks], s, 0, 0, 0);
        if (lo != 0 || hi != 31) {
#pragma unroll
            for (int i = 0; i < 16; ++i) { const int kk = (i & 3) + 8 * (i >> 2) + 4 * hh; const bool ok = (kk >= lo) && (kk <= hi); s[i] = ok ? s[i] : -3.0e38f; }
        }
        float mb = s[0];
#pragma unroll
        for (int i = 1; i < 16; ++i) mb = fmaxf(mb, s[i]);
        mb = fmaxf(mb, __shfl_xor(mb, 32));
        if (!__all(mb - mrun <= 8.f)) {
            const float mn = fmaxf(mrun, mb);
            const float alpha = __builtin_amdgcn_exp2f(mrun - mn);
            lrun *= alpha; mrun = mn;
#pragma unroll
            for (int i = 0; i < 16; ++i) { o0[i] *= alpha; o1[i] *= alpha; }
        }
        float ps = 0.f; float p[16];
#pragma unroll
        for (int i = 0; i < 16; ++i) { p[i] = __builtin_amdgcn_exp2f(s[i] - mrun); ps += p[i]; }
        lrun += ps;
        u32x4 pb[2];
        pb[0].x = pk2(p[0], p[1]); pb[0].y = pk2(p[2], p[3]); pb[0].z = pk2(p[4], p[5]); pb[0].w = pk2(p[6], p[7]);
        pb[1].x = pk2(p[8], p[9]); pb[1].y = pk2(p[10], p[11]); pb[1].z = pk2(p[12], p[13]); pb[1].w = pk2(p[14], p[15]);
#pragma unroll
        for (int sI = 0; sI < 2; ++sI) {
            const u32x4 va = cur.v[0][sI], vb = cur.v[1][sI];
            o0 = __builtin_amdgcn_mfma_f32_32x32x16_bf16(*(const bf16x8*)&va, *(const bf16x8*)&pb[sI], o0, 0, 0, 0);
            o1 = __builtin_amdgcn_mfma_f32_32x32x16_bf16(*(const bf16x8*)&vb, *(const bf16x8*)&pb[sI], o1, 0, 0, 0);
        }
        if (blk + 1 < 17) cur = nxt;
    }
    const float ltot = lrun + __shfl_xor(lrun, 32);
    const float inv = 1.f / ltot;
    bf16_t* op = P.AO + (size_t)tok * 512 + head * 64 + 4 * hh;
#pragma unroll
    for (int g = 0; g < 4; ++g) {
        float t0[4] = { o0[4 * g] * inv, o0[4 * g + 1] * inv, o0[4 * g + 2] * inv, o0[4 * g + 3] * inv };
        float t1[4] = { o1[4 * g] * inv, o1[4 * g + 1] * inv, o1[4 * g + 2] * inv, o1[4 * g + 3] * inv };
        st4bf(op + 8 * g, t0); st4bf(op + 32 + 8 * g, t1);
    }
}

__device__ __forceinline__ void conv_range(const Params& P, size_t gtid, size_t gsize) {
    for (size_t idx = gtid; idx < (size_t)NTOK * 64; idx += gsize) {
        const int m = (int)(idx >> 6), c0 = (int)(idx & 63) * 8, l = m % SEQ;
        float cu[3][8];
#pragma unroll
        for (int t = 0; t < 3; ++t) {
            const int ll = l + t - 1;
            if (ll < 0 || ll >= SEQ) {
#pragma unroll
                for (int j = 0; j < 8; ++j) cu[t][j] = 0.f;
            } else {
                const u32x4 g = *(const u32x4*)(P.GC + (size_t)(m + t - 1) * 512 + c0), u = *(const u32x4*)(P.U + (size_t)(m + t - 1) * 512 + c0);
                cu[t][0] = bf2f(g.x & 0xffff) * bf2f(u.x & 0xffff); cu[t][1] = bf2f(g.x >> 16) * bf2f(u.x >> 16);
                cu[t][2] = bf2f(g.y & 0xffff) * bf2f(u.y & 0xffff); cu[t][3] = bf2f(g.y >> 16) * bf2f(u.y >> 16);
                cu[t][4] = bf2f(g.z & 0xffff) * bf2f(u.z & 0xffff); cu[t][5] = bf2f(g.z >> 16) * bf2f(u.z >> 16);
                cu[t][6] = bf2f(g.w & 0xffff) * bf2f(u.w & 0xffff); cu[t][7] = bf2f(g.w >> 16) * bf2f(u.w >> 16);
            }
        }
        const u32x4 gbv = *(const u32x4*)(P.GB + (size_t)m * 512 + c0);
        const float gb[8] = { bf2f(gbv.x & 0xffff), bf2f(gbv.x >> 16), bf2f(gbv.y & 0xffff), bf2f(gbv.y >> 16), bf2f(gbv.z & 0xffff), bf2f(gbv.z >> 16), bf2f(gbv.w & 0xffff), bf2f(gbv.w >> 16) };
        float o[8];
#pragma unroll
        for (int j = 0; j < 8; ++j) o[j] = gb[j] * (P.conv_w[c0 + j] * cu[0][j] + P.conv_w[512 + c0 + j] * cu[1][j] + P.conv_w[1024 + c0 + j] * cu[2][j]);
        st8bf(P.CA + (size_t)m * 512 + c0, o);
    }
}

__device__ __forceinline__ void unpack8(const u32x4 v, float* f) {
    f[0] = bf2f(v.x & 0xffff); f[1] = bf2f(v.x >> 16); f[2] = bf2f(v.y & 0xffff); f[3] = bf2f(v.y >> 16);
    f[4] = bf2f(v.z & 0xffff); f[5] = bf2f(v.z >> 16); f[6] = bf2f(v.w & 0xffff); f[7] = bf2f(v.w >> 16);
}
__device__ __forceinline__ float gelu_erf(float d) { return 0.5f * d * (1.f + erff(d * 0.70710678118654752f)); }
__device__ __forceinline__ int reduce64i(int (&part)[64], int lane) {
#pragma unroll
    for (int i = 0; i < 32; ++i) { auto r = __builtin_amdgcn_permlane32_swap((unsigned)part[i], (unsigned)part[32 + i], false, false); part[i] = (int)r[0] + (int)r[1]; }
#pragma unroll
    for (int i = 0; i < 16; ++i) { auto r = __builtin_amdgcn_permlane16_swap((unsigned)part[i], (unsigned)part[16 + i], false, false); part[i] = (int)r[0] + (int)r[1]; }
#define RSTAGE(N) { const bool up = (lane & N) != 0; _Pragma("unroll") for (int i = 0; i < N; ++i) { const int keep = up ? part[N + i] : part[i], send = up ? part[i] : part[N + i]; part[i] = keep + __shfl_xor(send, N); } }
    RSTAGE(8) RSTAGE(4) RSTAGE(2) RSTAGE(1)
#undef RSTAGE
    return part[0];
}
#define UB0(x) ((float)((x) & 0xffu))
#define UB1(x) ((float)(((x) >> 8) & 0xffu))
#define UB2(x) ((float)(((x) >> 16) & 0xffu))
#define UB3(x) ((float)((x) >> 24))
template <int HALF>
__device__ __forceinline__ void peer_uh_token(const Params& P, int t, int lane) {
    const u32x2 hq = *(const u32x2*)(P.H2q + (size_t)t * DM + HALF * 512 + 8 * lane);
    const signed char* ub = P.Uq + (size_t)HALF * NEXP * 512 + 8 * lane;
    const float sh = P.sh2[t];
#pragma unroll 1
    for (int hf = 0; hf < 2; ++hf) {
        const int myidx = P.sel_idx[(size_t)t * 128 + hf * 64 + lane];
        u32x2 rows[2][16];
        int part[64];
#define ULOAD(bt) { _Pragma("unroll") for (int q = 0; q < 16; ++q) { const int e = __builtin_amdgcn_readlane(myidx, (bt) * 16 + q); rows[(bt) & 1][q] = *(const u32x2*)(ub + (size_t)e * 512); } }
#define UDOT(bt) { _Pragma("unroll") for (int q = 0; q < 16; ++q) { const u32x2 a = rows[(bt) & 1][q]; \
        part[(bt) * 16 + q] = __builtin_amdgcn_sdot4((int)a.y, (int)hq.y, __builtin_amdgcn_sdot4((int)a.x, (int)hq.x, 0, false), false); } }
        ULOAD(0)
        ULOAD(1) UDOT(0)
        ULOAD(2) UDOT(1)
        ULOAD(3) UDOT(2)
        UDOT(3)
#undef ULOAD
#undef UDOT
        const int isum = reduce64i(part, lane);
        const size_t o = (size_t)t * 128 + hf * 64 + lane;
        if (HALF == 0) P.pd[o] = isum;
        else P.cbuf[o] = P.sel_g[o] * gelu_erf((float)(isum + P.pd[o]) * P.su[myidx] * sh) * P.sv[myidx];
    }
}
template <int HALF>
__device__ __forceinline__ void peer_vh_token(const Params& P, int t, int lane) {
    const int b = t / SEQ;
    float acc[8];
#pragma unroll
    for (int j = 0; j < 8; ++j) acc[j] = 0.f;
    const int idlo = P.sel_idx[(size_t)t * 128 + lane], idhi = P.sel_idx[(size_t)t * 128 + 64 + lane];
    const float clo = P.cbuf[(size_t)t * 128 + lane], chi = P.cbuf[(size_t)t * 128 + 64 + lane];
    const float cb = 128.f * wave_sum(clo + chi);
    const unsigned char* vb = P.Vq + (size_t)HALF * NEXP * 512 + 8 * lane;
    u32x2 rows[2][16];
#define VLOAD(bt) { _Pragma("unroll") for (int q = 0; q < 16; ++q) { const int e = __builtin_amdgcn_readlane((bt) < 4 ? idlo : idhi, ((bt) & 3) * 16 + q); rows[(bt) & 1][q] = *(const u32x2*)(vb + (size_t)e * 512); } }
#define VCOMP(bt) { _Pragma("unroll") for (int q = 0; q < 16; ++q) { \
        const float ck = __uint_as_float(__builtin_amdgcn_readlane(__float_as_uint((bt) < 4 ? clo : chi), ((bt) & 3) * 16 + q)); const u32x2 x = rows[(bt) & 1][q]; \
        acc[0] += ck * UB0(x.x); acc[1] += ck * UB1(x.x); acc[2] += ck * UB2(x.x); acc[3] += ck * UB3(x.x); \
        acc[4] += ck * UB0(x.y); acc[5] += ck * UB1(x.y); acc[6] += ck * UB2(x.y); acc[7] += ck * UB3(x.y); \
        __builtin_amdgcn_sched_barrier(0); } }
    VLOAD(0)
    VLOAD(1) VCOMP(0)
    VLOAD(2) VCOMP(1)
    VLOAD(3) VCOMP(2)
    VLOAD(4) VCOMP(3)
    VLOAD(5) VCOMP(4)
    VLOAD(6) VCOMP(5)
    VLOAD(7) VCOMP(6)
    VCOMP(7)
#undef VLOAD
#undef VCOMP
    const int col0 = HALF * 512 + 8 * lane;
    float x2[8]; float ss = 0.f;
    { const u32x4 xw = *(const u32x4*)(P.X1 + (size_t)t * DM + col0);
      const float* g2 = P.mod + (size_t)b * NMOD + 5 * DM + col0;
      const f32x4 ga = *(const f32x4*)g2, gb = *(const f32x4*)(g2 + 4);
      x2[0] = bf2f(xw.x & 0xffff) + ga.x * (acc[0] - cb); x2[1] = bf2f(xw.x >> 16) + ga.y * (acc[1] - cb);
      x2[2] = bf2f(xw.y & 0xffff) + ga.z * (acc[2] - cb); x2[3] = bf2f(xw.y >> 16) + ga.w * (acc[3] - cb);
      x2[4] = bf2f(xw.z & 0xffff) + gb.x * (acc[4] - cb); x2[5] = bf2f(xw.z >> 16) + gb.y * (acc[5] - cb);
      x2[6] = bf2f(xw.w & 0xffff) + gb.z * (acc[6] - cb); x2[7] = bf2f(xw.w >> 16) + gb.w * (acc[7] - cb); }
#pragma unroll
    for (int j = 0; j < 8; ++j) ss += x2[j] * x2[j];
    ss = wave_sum(ss);
    float* orow = P.out + (size_t)t * DM;
    if (HALF == 0) {
        *(f32x4*)(orow + col0) = (f32x4){ x2[0], x2[1], x2[2], x2[3] }; *(f32x4*)(orow + col0 + 4) = (f32x4){ x2[4], x2[5], x2[6], x2[7] };
        if (lane == 0) P.ssq[t] = ss;
    } else {
        const float rstd = rsqrtf((ss + P.ssq[t]) * (1.f / DM) + 1e-6f);
        const f32x4 fa = *(const f32x4*)(P.fg + col0), fb = *(const f32x4*)(P.fg + col0 + 4);
        *(f32x4*)(orow + col0) = (f32x4){ x2[0] * rstd * fa.x, x2[1] * rstd * fa.y, x2[2] * rstd * fa.z, x2[3] * rstd * fa.w };
        *(f32x4*)(orow + col0 + 4) = (f32x4){ x2[4] * rstd * fb.x, x2[5] * rstd * fb.y, x2[6] * rstd * fb.z, x2[7] * rstd * fb.w };
        const int c1 = 8 * lane;
        const f32x4 va = *(const f32x4*)(orow + c1), vb2 = *(const f32x4*)(orow + c1 + 4), ga = *(const f32x4*)(P.fg + c1), gb = *(const f32x4*)(P.fg + c1 + 4);
        *(f32x4*)(orow + c1) = (f32x4){ va.x * rstd * ga.x, va.y * rstd * ga.y, va.z * rstd * ga.z, va.w * rstd * ga.w };
        *(f32x4*)(orow + c1 + 4) = (f32x4){ vb2.x * rstd * gb.x, vb2.y * rstd * gb.y, vb2.z * rstd * gb.z, vb2.w * rstd * gb.w };
    }
}

#define XB_TMO      128
#define XB_XCNT(j)  (256  + 64 * (j))
#define XB_XSUB(j)  (1280 + 64 * (j))
#define XB_XGEN(j)  (2304 + 64 * (j))
#define XB_TOP      3328
#define XB_TOPGEN   3392
#define XCD_BAR_WORDS 3456
#define XB_SPIN_CAP (1u << 22)
#define LAS __attribute__((address_space(3)))
__device__ __forceinline__ unsigned xb_ld(unsigned* p)              { return __hip_atomic_load(p, __ATOMIC_RELAXED, __HIP_MEMORY_SCOPE_AGENT); }
__device__ __forceinline__ unsigned xb_add(unsigned* p, unsigned v) { return __hip_atomic_fetch_add(p, v, __ATOMIC_RELAXED, __HIP_MEMORY_SCOPE_AGENT); }
__device__ __forceinline__ unsigned xb_xcc_id() { return (unsigned)__builtin_amdgcn_s_getreg((3 << 11) | 20) & 0xFu; }
#define XB_SPIN(cond, bar) do { unsigned _sp = 0; while (cond) { __builtin_amdgcn_s_sleep(1); \
    if ((++_sp & 255u) == 0u) { if (xb_ld(&(bar)[XB_TMO])) break; if (_sp > XB_SPIN_CAP) { atomicAdd(&(bar)[XB_TMO], 1u); break; } } } } while (0)
struct XcdBarrier { unsigned* bar; unsigned x; volatile LAS unsigned* st; };
__device__ __forceinline__ XcdBarrier xcd_barrier_post(unsigned* bar, volatile LAS unsigned* st) {
    XcdBarrier b; b.bar = bar; b.x = xb_xcc_id(); b.st = st;
    if (threadIdx.x == 0) (void)xb_add(&bar[XB_XCNT(b.x)], 1u);
    return b;
}
__device__ __forceinline__ void xcd_barrier_complete(unsigned* bar, unsigned x, unsigned& nloc, unsigned& nx) {
    const unsigned G = gridDim.x * gridDim.y * gridDim.z;
    unsigned sum, cnt, mine, sp = 0u;
    for (;;) {
        sum = 0u; cnt = 0u; mine = 0u;
#pragma unroll
        for (unsigned j = 0; j < 16; ++j) { const unsigned c = xb_ld(&bar[XB_XCNT(j)]); sum += c; cnt += (c > 0u) ? 1u : 0u; mine = (j == x) ? c : mine; }
        if (sum == G) break;
        __builtin_amdgcn_s_sleep(1);
        if ((++sp & 255u) == 0u) { if (xb_ld(&bar[XB_TMO])) break; if (sp > XB_SPIN_CAP) { atomicAdd(&bar[XB_TMO], 1u); break; } }
    }
    nloc = mine > 0u ? mine : 1u; nx = cnt > 0u ? cnt : 1u;
}
__device__ __forceinline__ void xcd_barrier(const XcdBarrier& b) {
    asm volatile("s_waitcnt vmcnt(0)" ::: "memory");
    __syncthreads();
    if (threadIdx.x == 0) {
        unsigned* bar = b.bar;
        __builtin_amdgcn_s_waitcnt(0);
        unsigned nloc = b.st[0], nx = b.st[1];
        if (nloc == 0u) { xcd_barrier_complete(bar, b.x, nloc, nx); b.st[0] = nloc; b.st[1] = nx; }
        const unsigned old = xb_add(&bar[XB_XSUB(b.x)], 1u);
        const unsigned gen = old / nloc;
        if (old + 1u == (gen + 1u) * nloc) {
            __builtin_amdgcn_fence(__ATOMIC_RELEASE, "agent");
            asm volatile("s_waitcnt vmcnt(0)" ::: "memory");
            const unsigned og = xb_add(&bar[XB_TOP], 1u);
            const unsigned tg = og / nx;
            if (og + 1u == (tg + 1u) * nx) xb_add(&bar[XB_TOPGEN], 1u);
            else XB_SPIN(xb_ld(&bar[XB_TOPGEN]) == tg, bar);
            __builtin_amdgcn_fence(__ATOMIC_ACQUIRE, "agent");
            xb_add(&bar[XB_XGEN(b.x)], 1u);
            asm volatile("s_waitcnt vmcnt(0)" ::: "memory");
        } else {
            XB_SPIN(xb_ld(&bar[XB_XGEN(b.x)]) == gen, bar);
            __builtin_amdgcn_fence(__ATOMIC_ACQUIRE, "agent");
            asm volatile("s_waitcnt vmcnt(0)" ::: "memory");
        }
    }
    __syncthreads();
}

constexpr int NPHASE = 9;
template <int PH> __device__ __forceinline__ void run_phase(const Params& P, char* smem) {
    int tid_ = threadIdx.x; asm volatile("" : "+v"(tid_));
    const int bid = blockIdx.x, G = gridDim.x, tid = tid_;
    const size_t gtid = (size_t)bid * 256 + tid, gsize = (size_t)G * 256;
    if (PH == 0) {
        for (int it = bid; it < 192; it += G) modp_item(P, it, smem);
        float (*tile)[65] = (float (*)[65])smem;
        for (int it = bid; it < 1088; it += G) transpose_tile(P.w_in, DM, PROJW, P.WinT, it, tile);
        for (int it = bid; it < 128; it += G) transpose_tile(P.w_ao, 512, DM, P.WaoT, it, tile);
        for (int it = bid; it < 128; it += G) transpose_tile(P.w_co, 512, DM, P.WcoT, it, tile);
        for (int it = bid; it < 256; it += G) transpose_tile(P.w_mix, DM, DM, P.WmixT, it, tile);
        for (int it = bid; it < 512; it += G) transpose_tile(P.pw_q, DM, 2048, P.PwqT, it, tile);
        cvt_range(P.keys, P.KeysB, (size_t)16 * 128 * 128 / 8, gtid, gsize);
        { const int lane = tid & 63, wid = tid >> 6;
          for (int r = bid * 4 + wid; r < NEXP; r += G * 4) {
              f32x4 va[4], vb[4];
              load_row16(P.pu + (size_t)r * DM, lane, va); load_row16(P.pv + (size_t)r * DM, lane, vb);
              quant_row(va, (unsigned char*)P.Uq + (size_t)r * 512, P.su + r, lane, 0);
              quant_row(vb, P.Vq + (size_t)r * 512, P.sv + r, lane, 128); } }
        rope_tab(P, (int)gtid, (int)gsize);
    } else if (PH == 1) {
        for (int i = (int)gtid; i < 17 * NMOD; i += (int)gsize) {
            float v = P.b_mod[i % NMOD];
#pragma unroll
            for (int kc = 0; kc < 8; ++kc) v += P.modp[(size_t)kc * 17 * NMOD + i];
            P.mod[i] = v;
        }
        if (NTOK % G == 0 && SEQ % (NTOK / G) == 0 && NCTX % G == 0) {
            norm1_rows(P, false, bid * (NTOK / G), NTOK / G, smem);
            norm1_rows(P, true, bid * (NCTX / G), NCTX / G, smem);
        } else {
            for (int it = bid; it < 1152; it += G) { const bool isctx = it >= 1024; norm1_rows(P, isctx, isctx ? (it - 1024) * 32 : it * 32, 32, smem); }
        }
    } else if (PH == 2) {
        for (int t = bid; t < 128 * 34 + 32; t += G) {
            if (t < 128 * 34) { int mt, nt; tile_coords(t, 128, 34, mt, nt); gemm_tile<MODE_INPROJ, 8>(P, P.H, DM, P.WinT, DM, DM, mt * 256, nt * 128, nt * 128 >= 768, smem); }
            else { const int u = t - 128 * 34, mt = u >> 1, nt = u & 1; gemm_tile<MODE_CTXKV, 8>(P, P.HC, DM, P.WinT + (size_t)512 * DM, DM, DM, mt * 256, nt * 128, nt == 0, smem); }
        }
    } else if (PH == 3) {
        for (int it = bid; it < NB * 16 * 8; it += G) attn_item(P, it);
        conv_range(P, gtid, gsize);
    } else if (PH == 4) {
        for (int t = bid; t < 128 * 8; t += G) { int mt, nt; tile_coords(t, 128, 8, mt, nt); gemm_tile<MODE_AO1, 8>(P, P.AO, 512, P.WaoT, 512, 512, mt * 256, nt * 128, true, smem, 0); }
        for (int t = bid; t < 128 * 8; t += G) { int mt, nt; tile_coords(t, 128, 8, mt, nt); gemm_tile<MODE_AO1, 8>(P, P.CA, 512, P.WcoT, 512, 512, mt * 256, nt * 128, true, smem, 1); }
    } else if (PH == 5) {
        for (int t = bid; t < 128 * 8; t += G) { int mt, nt; tile_coords(t, 128, 8, mt, nt); gemm_tile<MODE_MIX, 8>(P, P.YG, DM, P.WmixT, DM, DM, mt * 256, nt * 128, true, smem); }
    } else if (PH == 6) {
        const int lane = tid & 63, wid = tid >> 6;
        float* sc = (float*)smem; float* sh = sc + DM;
        for (int it = bid; it < NTOK / 64; it += G) {
            const int row0 = it * 64, b = row0 / SEQ;
            __syncthreads();
            for (int d = tid; d < DM; d += 256) { sc[d] = P.mod[(size_t)b * NMOD + 4 * DM + d]; sh[d] = P.mod[(size_t)b * NMOD + 3 * DM + d]; }
            __syncthreads();
            for (int i = wid; i < 64; i += 8) {
                const int ra = row0 + i, rb = ra + 4;
                f32x4 va[4], vb[4];
                load_row4_bf(P.X1 + (size_t)ra * DM, lane, va); load_row4_bf(P.X1 + (size_t)rb * DM, lane, vb);
                norm_row_q(va, P.n2, sc, sh, P.H2 + (size_t)ra * DM, P.H2q + (size_t)ra * DM, P.sh2 + ra, lane);
                norm_row_q(vb, P.n2, sc, sh, P.H2 + (size_t)rb * DM, P.H2q + (size_t)rb * DM, P.sh2 + rb, lane);
            }
        }
    } else if (PH == 7) {
        for (int it = bid; it < 256 * 8; it += G) peer_retrieve_item(P, it >> 3, it & 7, smem);
    } else if (PH == 8) {
        const int lane = tid & 63, wid = tid >> 6;
        for (int t = bid * 4 + wid; t < NTOK; t += G * 4) peer_uh_token<0>(P, t, lane);
        asm volatile("s_waitcnt vmcnt(0)" ::: "memory");
        for (int t = bid * 4 + wid; t < NTOK; t += G * 4) peer_uh_token<1>(P, t, lane);
    } else if (PH == 9) {
        const int lane = tid & 63, wid = tid >> 6;
        for (int t = bid * 4 + wid; t < NTOK; t += G * 4) peer_vh_token<0>(P, t, lane);
        asm volatile("s_waitcnt vmcnt(0)" ::: "memory");
        for (int t = bid * 4 + wid; t < NTOK; t += G * 4) peer_vh_token<1>(P, t, lane);
    }
}
#ifndef REP0
#define REP0 1
#endif
#ifndef REP1
#define REP1 1
#endif
#ifndef REP2
#define REP2 1
#endif
#ifndef REP3
#define REP3 1
#endif
#ifndef REP4
#define REP4 1
#endif
#ifndef REP5
#define REP5 1
#endif
#ifndef REP6
#define REP6 1
#endif
#ifndef REP7
#define REP7 1
#endif
#ifndef REP8
#define REP8 1
#endif
#ifndef REP9
#define REP9 1
#endif
#ifndef REP10
#define REP10 1
#endif
constexpr int MEGA_LDS = 3 * (2048 * 8 + 8192);
#ifndef MULTI_LAUNCH
__global__ void __launch_bounds__(256, 2) k_mega(Params P) {
    extern __shared__ __attribute__((aligned(16))) char smem[];
    volatile LAS unsigned* st = (volatile LAS unsigned*)(smem + MEGA_LDS);
    if (threadIdx.x < 4) st[threadIdx.x] = 0u;
    __syncthreads();
    const XcdBarrier bar = xcd_barrier_post(P.bar, st);
#define PHASE_SYNC(k) for (int rep = 0; rep < REP##k; ++rep) { run_phase<k>(P, smem); xcd_barrier(bar); }
    PHASE_SYNC(0) PHASE_SYNC(1) PHASE_SYNC(2) PHASE_SYNC(3) PHASE_SYNC(4) PHASE_SYNC(5) PHASE_SYNC(6) PHASE_SYNC(7)
    PHASE_SYNC(8)
    run_phase<9>(P, smem);
}
#else
template <int PH> __global__ void __launch_bounds__(256, 2) k_phase(Params P) {
    extern __shared__ __attribute__((aligned(16))) char smem[];
    run_phase<PH>(P, smem);
}
#endif

static size_t carve(size_t& off, size_t bytes) { const size_t o = off; off += (bytes + 255) & ~(size_t)255; return o; }

extern "C" void kernel_launch(void* const* d_in, const int* in_sizes, int n_in, void* d_out, int out_size, void* d_ws, size_t ws_size, hipStream_t stream) {
    Params P{};
    P.x = (const float*)d_in[0]; P.c = (const float*)d_in[1]; P.ctx = (const float*)d_in[2]; P.c_ctx = (const float*)d_in[3];
    P.w_mod = (const float*)d_in[4]; P.b_mod = (const float*)d_in[5]; P.n1 = (const float*)d_in[6]; P.n2 = (const float*)d_in[7];
    P.w_in = (const float*)d_in[8]; P.sink = (const float*)d_in[9]; P.conv_w = (const float*)d_in[10]; P.w_ao = (const float*)d_in[11];
    P.w_co = (const float*)d_in[12]; P.w_mix = (const float*)d_in[13]; P.pw_q = (const float*)d_in[14]; P.keys = (const float*)d_in[15];
    P.pu = (const float*)d_in[16]; P.pv = (const float*)d_in[17]; P.fg = (const float*)d_in[18];
    P.out = (float*)d_out;
    char* ws = (char*)d_ws; size_t off = 0;
    P.modp = (float*)(ws + carve(off, (size_t)8 * 17 * NMOD * 4));
    P.mod = (float*)(ws + carve(off, (size_t)17 * NMOD * 4));
    P.rope = (float*)(ws + carve(off, 3072 * 4));
    P.WinT = (bf16_t*)(ws + carve(off, (size_t)PROJW * DM * 2));
    P.WaoT = (bf16_t*)(ws + carve(off, (size_t)DM * 512 * 2));
    P.WcoT = (bf16_t*)(ws + carve(off, (size_t)DM * 512 * 2));
    P.WmixT = (bf16_t*)(ws + carve(off, (size_t)DM * DM * 2));
    P.PwqT = (bf16_t*)(ws + carve(off, (size_t)2048 * DM * 2));
    P.KeysB = (bf16_t*)(ws + carve(off, (size_t)16 * 128 * 128 * 2));
    P.Uq = (signed char*)(ws + carve(off, (size_t)NEXP * DM));
    P.Vq = (unsigned char*)(ws + carve(off, (size_t)NEXP * DM));
    P.su = (float*)(ws + carve(off, (size_t)NEXP * 4));
    P.sv = (float*)(ws + carve(off, (size_t)NEXP * 4));
    P.sh2 = (float*)(ws + carve(off, (size_t)NTOK * 4));
    P.HC = (bf16_t*)(ws + carve(off, (size_t)NCTX * DM * 2));
    const size_t regA = carve(off, (size_t)NTOK * DM * 2);
    P.H = (bf16_t*)(ws + regA); P.YG = (bf16_t*)(ws + regA); P.H2 = (bf16_t*)(ws + regA);
    const size_t regB = off;
    P.Q = (bf16_t*)(ws + carve(off, (size_t)NTOK * 512 * 2));
    P.K = (bf16_t*)(ws + carve(off, (size_t)NTOK * 128 * 2));
    P.VT = (bf16_t*)(ws + carve(off, (size_t)NTOK * 128 * 2));
    P.Kc = (bf16_t*)(ws + carve(off, (size_t)NCTX * 128 * 2));
    P.VcT = (bf16_t*)(ws + carve(off, (size_t)NCTX * 128 * 2));
    const size_t regC = off;
    P.GB = (bf16_t*)(ws + carve(off, (size_t)NTOK * 512 * 2));
    P.GC = (bf16_t*)(ws + carve(off, (size_t)NTOK * 512 * 2));
    P.U = (bf16_t*)(ws + carve(off, (size_t)NTOK * 512 * 2));
    P.M1 = (bf16_t*)(ws + regC);
    P.cbuf = (float*)(ws + regC);
    P.pd = (int*)(ws + regC + (size_t)NTOK * 128 * 4);
    P.ssq = (float*)(ws + regC + (size_t)2 * NTOK * 128 * 4);
    const size_t regD = off;
    P.GA = (bf16_t*)(ws + carve(off, (size_t)NTOK * DM * 2));
    P.GV = (bf16_t*)(ws + carve(off, (size_t)NTOK * DM * 2));
    P.AO = (bf16_t*)(ws + carve(off, (size_t)NTOK * 512 * 2));
    P.H2q = (signed char*)P.AO;
    P.CA = (bf16_t*)(ws + carve(off, (size_t)NTOK * 512 * 2));
    P.X1 = (bf16_t*)(ws + regD);
    P.bar = (unsigned*)(ws + carve(off, (size_t)XCD_BAR_WORDS * 4));
    const size_t need = off;
    { size_t o2 = regB;
      P.sel_idx = (int*)(ws + carve(o2, (size_t)NTOK * 128 * 4));
      P.sel_g = (float*)(ws + carve(o2, (size_t)NTOK * 128 * 4));
      if (o2 > regC) { fprintf(stderr, "kernel_launch: late buffers overflow\n"); return; } }
    if (need > ws_size) { fprintf(stderr, "kernel_launch: workspace too small: need %zu have %zu\n", need, ws_size); return; }

#ifdef MULTI_LAUNCH
    static bool attr_done = false;
    if (!attr_done) {
#define SETA(PH) hipFuncSetAttribute((const void*)k_phase<PH>, hipFuncAttributeMaxDynamicSharedMemorySize, MEGA_LDS)
        SETA(0); SETA(1); SETA(2); SETA(3); SETA(4); SETA(5); SETA(6); SETA(7); SETA(8);
        attr_done = true;
    }
#define LP(PH) k_phase<PH><<<512, 256, MEGA_LDS, stream>>>(P)
    LP(0); LP(1); LP(2); LP(3); LP(4); LP(5); LP(6); LP(7); LP(8);
#else
    static int grid_blocks = 0;
    if (!grid_blocks) {
        int dev = 0, cus = 0, per_cu = 0;
        (void)hipGetDevice(&dev);
        (void)hipDeviceGetAttribute(&cus, hipDeviceAttributeMultiprocessorCount, dev);
        (void)hipFuncSetAttribute((const void*)k_mega, hipFuncAttributeMaxDynamicSharedMemorySize, MEGA_LDS + 16);
        (void)hipOccupancyMaxActiveBlocksPerMultiprocessor(&per_cu, (const void*)k_mega, 256, MEGA_LDS + 16);
        if (per_cu > 2) per_cu = 2;
        if (per_cu < 1) { fprintf(stderr, "kernel_launch: occupancy query returned %d\n", per_cu); per_cu = 1; }
        grid_blocks = cus * per_cu;
    }
    (void)hipMemsetAsync(P.bar, 0, (size_t)XCD_BAR_WORDS * 4, stream);
    void* args[] = { &P };
    hipError_t e = hipLaunchCooperativeKernel((const void*)k_mega, dim3(grid_blocks), dim3(256), args, MEGA_LDS + 16, stream);
    if (e != hipSuccess) fprintf(stderr, "cooperative launch failed: %s (grid %d)\n", hipGetErrorString(e), grid_blocks);
#endif
}
```

```cpp
#include <hip/hip_runtime.h>
#include <cstdio>
#include <cstdint>

typedef unsigned short bf16_t;
typedef short bf16x8 __attribute__((ext_vector_type(8)));
typedef float f32x4 __attribute__((ext_vector_type(4)));
typedef unsigned u32x4 __attribute__((ext_vector_type(4)));
typedef unsigned u32x2 __attribute__((ext_vector_type(2)));

constexpr int DM = 1024, NB = 16, SEQ = 2048, NTOK = NB * SEQ, CTXL = 256, NCTX = NB * CTXL;
constexpr int PROJW = 4352;
constexpr int NMOD = 6 * DM;
constexpr int NEXP = 16384;

__device__ __forceinline__ float bf2f(bf16_t x) { return __uint_as_float(((unsigned)x) << 16); }
__device__ __forceinline__ bf16_t f2bf(float f) {
    unsigned u = __float_as_uint(f);
    u += 0x7fffu + ((u >> 16) & 1u);
    return (bf16_t)(u >> 16);
}
__device__ __forceinline__ unsigned pk2(float lo, float hi) { unsigned r; asm("v_cvt_pk_bf16_f32 %0, %1, %2" : "=v"(r) : "v"(lo), "v"(hi)); return r; }
__device__ __forceinline__ float sigmoidf_(float x) { return 1.f / (1.f + __expf(-x)); }
__device__ __forceinline__ float wave_sum(float v) {
#pragma unroll
    for (int o = 1; o < 64; o <<= 1) v += __shfl_xor(v, o);
    return v;
}

__device__ __forceinline__ float wave_max(float v) {
#pragma unroll
    for (int o = 1; o < 64; o <<= 1) v = fmaxf(v, __shfl_xor(v, o));
    return v;
}
__device__ __forceinline__ unsigned q8(float x, float inv, int bias) {
    int q = (int)rintf(x * inv); q = q > 127 ? 127 : (q < -127 ? -127 : q);
    return (unsigned)((q + bias) & 0xff);
}
__device__ __forceinline__ void load_row16(const float* src, int lane, f32x4 (&v)[4]) {
#pragma unroll
    for (int j = 0; j < 4; ++j) v[j] = *(const f32x4*)(src + 16 * lane + 4 * j);
}
__device__ __forceinline__ void quant_row(f32x4 (&v)[4], unsigned char* dst, float* scale_out, int lane, int bias) {
    float amax = 0.f;
#pragma unroll
    for (int j = 0; j < 4; ++j) amax = fmaxf(amax, fmaxf(fmaxf(fabsf(v[j].x), fabsf(v[j].y)), fmaxf(fabsf(v[j].z), fabsf(v[j].w))));
    amax = wave_max(amax);
    const float sc = amax > 0.f ? amax * (1.f / 127.f) : 1.f, inv = 1.f / sc;
    u32x4 w;
    w.x = q8(v[0].x, inv, bias) | (q8(v[0].y, inv, bias) << 8) | (q8(v[0].z, inv, bias) << 16) | (q8(v[0].w, inv, bias) << 24);
    w.y = q8(v[1].x, inv, bias) | (q8(v[1].y, inv, bias) << 8) | (q8(v[1].z, inv, bias) << 16) | (q8(v[1].w, inv, bias) << 24);
    w.z = q8(v[2].x, inv, bias) | (q8(v[2].y, inv, bias) << 8) | (q8(v[2].z, inv, bias) << 16) | (q8(v[2].w, inv, bias) << 24);
    w.w = q8(v[3].x, inv, bias) | (q8(v[3].y, inv, bias) << 8) | (q8(v[3].z, inv, bias) << 16) | (q8(v[3].w, inv, bias) << 24);
    *(u32x4*)(dst + (size_t)(lane >> 5) * ((size_t)NEXP * 512) + 16 * (lane & 31)) = w;
    if (lane == 0) *scale_out = sc;
}

constexpr size_t al256(size_t x) { return (x + 255) & ~(size_t)255; }
constexpr int MODP_KC = 16;
constexpr int XCD_BAR_WORDS_C = 3456;
constexpr size_t O_modp = 0;
constexpr size_t O_mod = O_modp + al256((size_t)MODP_KC * 17 * NMOD * 4);
constexpr size_t O_rope = O_mod + al256((size_t)17 * NMOD * 4);
constexpr size_t O_WinT = O_rope + al256(3072 * 4);
constexpr size_t O_WaoT = O_WinT + al256((size_t)PROJW * DM * 2);
constexpr size_t O_WcoT = O_WaoT + al256((size_t)DM * 512 * 2);
constexpr size_t O_WmixT = O_WcoT + al256((size_t)DM * 512 * 2);
constexpr size_t O_PwqT = O_WmixT + al256((size_t)DM * DM * 2);
constexpr size_t O_KeysB = O_PwqT + al256((size_t)2048 * DM * 2);
constexpr size_t O_Uq = O_KeysB + al256((size_t)16 * 128 * 128 * 2);
constexpr size_t O_Vq = O_Uq + al256((size_t)NEXP * DM);
constexpr size_t O_su = O_Vq + al256((size_t)NEXP * DM);
constexpr size_t O_sv = O_su + al256((size_t)NEXP * 4);
constexpr size_t O_sh2 = O_sv + al256((size_t)NEXP * 4);
constexpr size_t O_HC = O_sh2 + al256((size_t)NTOK * 4);
constexpr size_t O_regA = O_HC + al256((size_t)NCTX * DM * 2);
constexpr size_t O_H = O_regA, O_YG = O_regA, O_H2 = O_regA;
constexpr size_t O_regB = O_regA + al256((size_t)NTOK * DM * 2);
constexpr size_t O_Q = O_regB;
constexpr size_t O_K = O_Q + al256((size_t)NTOK * 512 * 2);
constexpr size_t O_VT = O_K + al256((size_t)NTOK * 128 * 2);
constexpr size_t O_Kc = O_VT + al256((size_t)NTOK * 128 * 2);
constexpr size_t O_VcT = O_Kc + al256((size_t)NCTX * 128 * 2);
constexpr size_t O_regC = O_VcT + al256((size_t)NCTX * 128 * 2);
constexpr size_t O_GB = O_regC;
constexpr size_t O_GC = O_GB + al256((size_t)NTOK * 512 * 2);
constexpr size_t O_U = O_GC + al256((size_t)NTOK * 512 * 2);
constexpr size_t O_M1 = O_regC, O_cbuf = O_regC, O_pd = O_regC + (size_t)NTOK * 128 * 4, O_ssq = O_regC + (size_t)2 * NTOK * 128 * 4;
constexpr size_t O_regD = O_U + al256((size_t)NTOK * 512 * 2);
constexpr size_t O_GA = O_regD;
constexpr size_t O_GV = O_GA + al256((size_t)NTOK * DM * 2);
constexpr size_t O_X1 = O_regD;
constexpr size_t O_AO = O_GV + al256((size_t)NTOK * DM * 2);
constexpr size_t O_H2q = O_AO;
constexpr size_t O_CA = O_AO + al256((size_t)NTOK * 512 * 2);
constexpr size_t O_bar = O_CA + al256((size_t)NTOK * 512 * 2);
constexpr size_t WS_NEED = O_bar + al256((size_t)XCD_BAR_WORDS_C * 4);
constexpr size_t O_sel_idx = O_regB;
constexpr size_t O_sel_g = O_sel_idx + al256((size_t)NTOK * 128 * 4);
static_assert(O_sel_g + (size_t)NTOK * 128 * 4 <= O_regC, "late buffers overflow region B");
static_assert(O_ssq + (size_t)NTOK * 4 <= O_regD, "region C overflow");

struct Params {
    const float *x, *c, *ctx, *c_ctx, *w_mod, *b_mod, *n1, *n2, *w_in, *sink, *conv_w, *w_ao, *w_co, *w_mix, *pw_q, *keys, *pu, *pv, *fg;
    float* out;
    char* ws;
#define WSF(T, name) __host__ __device__ __forceinline__ T* name() const { return (T*)(ws + O_##name); }
    WSF(float, modp) WSF(float, mod) WSF(float, rope)
    WSF(bf16_t, WinT) WSF(bf16_t, WaoT) WSF(bf16_t, WcoT) WSF(bf16_t, WmixT) WSF(bf16_t, PwqT) WSF(bf16_t, KeysB)
    WSF(bf16_t, H) WSF(bf16_t, HC) WSF(bf16_t, Q) WSF(bf16_t, K) WSF(bf16_t, VT) WSF(bf16_t, Kc) WSF(bf16_t, VcT) WSF(bf16_t, GB) WSF(bf16_t, GC) WSF(bf16_t, U)
    WSF(bf16_t, AO) WSF(bf16_t, CA) WSF(bf16_t, M1) WSF(bf16_t, YG) WSF(bf16_t, H2) WSF(bf16_t, X1)
    WSF(unsigned char, GA) WSF(unsigned char, GV) WSF(unsigned char, Vq) WSF(signed char, Uq) WSF(signed char, H2q)
    WSF(int, sel_idx) WSF(float, sel_g) WSF(unsigned, bar) WSF(float, su) WSF(float, sv) WSF(float, sh2) WSF(float, cbuf) WSF(float, ssq) WSF(int, pd)
#undef WSF
};

__device__ __forceinline__ void modp_item(const Params& P, int item, char* smem) {
    float (*s)[64] = (float (*)[64])smem;
    const int kc = item >> 5, nc = item & 31;
    __syncthreads();
    for (int i = threadIdx.x; i < 17 * 64; i += 256) {
        const int r = i >> 6, k = i & 63;
        const float v = (r < 16) ? P.c[r * DM + kc * 64 + k] : P.c_ctx[kc * 64 + k];
        s[r][k] = v / (1.f + __expf(-v));
    }
    __syncthreads();
    if (threadIdx.x < 192) {
        const int n = nc * 192 + threadIdx.x;
        float acc[17];
#pragma unroll
        for (int r = 0; r < 17; ++r) acc[r] = 0.f;
#pragma unroll 8
        for (int k = 0; k < 64; ++k) {
            const float w = P.w_mod[(size_t)(kc * 64 + k) * NMOD + n];
#pragma unroll
            for (int r = 0; r < 17; ++r) acc[r] += s[r][k] * w;
        }
#pragma unroll
        for (int r = 0; r < 17; ++r) P.modp()[((size_t)kc * 17 + r) * NMOD + n] = acc[r];
    }
}
__device__ __forceinline__ void cvt_range(const float* src, bf16_t* dst, size_t n8, size_t gtid, size_t gsize) {
    for (size_t i = gtid; i < n8; i += gsize) {
        const f32x4 a = *(const f32x4*)(src + i * 8), b = *(const f32x4*)(src + i * 8 + 4);
        u32x4 o; o.x = pk2(a.x, a.y); o.y = pk2(a.z, a.w); o.z = pk2(b.x, b.y); o.w = pk2(b.z, b.w);
        *(u32x4*)(dst + i * 8) = o;
    }
}
__device__ __forceinline__ void rope_tab(const Params& P, int gtid, int gsize) {
    for (int i = gtid; i < 1536; i += gsize) {
        int pos, f; bool isc;
        if (i < 512) { pos = i / 16; f = i % 16; isc = false; } else { pos = (i - 512) / 16; f = (i - 512) % 16; isc = true; }
        const double inv = pow(10000.0, -(double)f / 16.0);
        const double ang = (double)pos * inv;
        const float cv = (float)cos(ang), sv = (float)sin(ang);
        if (!isc) { P.rope()[pos * 16 + f] = cv; P.rope()[512 + pos * 16 + f] = sv; }
        else { P.rope()[1024 + pos * 16 + f] = cv; P.rope()[2048 + pos * 16 + f] = sv; }
    }
}
__device__ __forceinline__ void transpose_tile(const float* W, int K, int N, bf16_t* Wt, int item, float (*tile)[65]) {
    const int ntn = N / 64, kt = item / ntn, nt = item % ntn, k0 = kt * 64, n0 = nt * 64;
    const int tx = threadIdx.x & 63, ty = threadIdx.x >> 6;
    __syncthreads();
#pragma unroll
    for (int i = 0; i < 16; ++i) { const int k = i * 4 + ty; tile[k][tx] = W[(size_t)(k0 + k) * N + n0 + tx]; }
    __syncthreads();
#pragma unroll
    for (int i = 0; i < 16; ++i) { const int n = i * 4 + ty; Wt[(size_t)(n0 + n) * K + k0 + tx] = f2bf(tile[tx][n]); }
}

__device__ __forceinline__ void load_row4_bf(const bf16_t* xr, int lane, f32x4 (&v)[4]) {
#pragma unroll
    for (int j = 0; j < 4; ++j) { const u32x2 w = *(const u32x2*)(xr + j * 256 + lane * 4);
        v[j].x = bf2f(w.x & 0xffff); v[j].y = bf2f(w.x >> 16); v[j].z = bf2f(w.y & 0xffff); v[j].w = bf2f(w.y >> 16); }
}
__device__ __forceinline__ void load_row4(const float* xr, int lane, f32x4 (&v)[4]) {
#pragma unroll
    for (int j = 0; j < 4; ++j) v[j] = *(const f32x4*)(xr + j * 256 + lane * 4);
}
__device__ __forceinline__ void norm_row(f32x4 (&v)[4], const float* g, const float* scale, const float* shift, bf16_t* dst, int lane) {
    float s = 0.f;
#pragma unroll
    for (int j = 0; j < 4; ++j) s += v[j].x * v[j].x + v[j].y * v[j].y + v[j].z * v[j].z + v[j].w * v[j].w;
    s = wave_sum(s);
    const float rstd = rsqrtf(s * (1.f / DM) + 1e-6f);
#pragma unroll
    for (int j = 0; j < 4; ++j) {
        const int d = j * 256 + lane * 4;
        const f32x4 gg = *(const f32x4*)(g + d), sc = *(const f32x4*)(scale + d), sh = *(const f32x4*)(shift + d);
        const float y0 = v[j].x * rstd * gg.x * (1.f + sc.x) + sh.x;
        const float y1 = v[j].y * rstd * gg.y * (1.f + sc.y) + sh.y;
        const float y2 = v[j].z * rstd * gg.z * (1.f + sc.z) + sh.z;
        const float y3 = v[j].w * rstd * gg.w * (1.f + sc.w) + sh.w;
        u32x2 o; o.x = pk2(y0, y1); o.y = pk2(y2, y3);
        *(u32x2*)(dst + d) = o;
    }
}

__device__ __forceinline__ void norm_row_q(f32x4 (&v)[4], const float* g, const float* scale, const float* shift, bf16_t* dst, signed char* dq, float* sq, int lane) {
    float s = 0.f;
#pragma unroll
    for (int j = 0; j < 4; ++j) s += v[j].x * v[j].x + v[j].y * v[j].y + v[j].z * v[j].z + v[j].w * v[j].w;
    s = wave_sum(s);
    const float rstd = rsqrtf(s * (1.f / DM) + 1e-6f);
    float amax = 0.f;
#pragma unroll
    for (int j = 0; j < 4; ++j) {
        const int d = j * 256 + lane * 4;
        const f32x4 gg = *(const f32x4*)(g + d), sc = *(const f32x4*)(scale + d), sh = *(const f32x4*)(shift + d);
        v[j].x = v[j].x * rstd * gg.x * (1.f + sc.x) + sh.x;
        v[j].y = v[j].y * rstd * gg.y * (1.f + sc.y) + sh.y;
        v[j].z = v[j].z * rstd * gg.z * (1.f + sc.z) + sh.z;
        v[j].w = v[j].w * rstd * gg.w * (1.f + sc.w) + sh.w;
        u32x2 o; o.x = pk2(v[j].x, v[j].y); o.y = pk2(v[j].z, v[j].w);
        *(u32x2*)(dst + d) = o;
        amax = fmaxf(amax, fmaxf(fmaxf(fabsf(v[j].x), fabsf(v[j].y)), fmaxf(fabsf(v[j].z), fabsf(v[j].w))));
    }
    amax = wave_max(amax);
    const float qs = amax > 0.f ? amax * (1.f / 127.f) : 1.f, inv = 1.f / qs;
#pragma unroll
    for (int j = 0; j < 4; ++j) {
        const unsigned w = q8(v[j].x, inv, 0) | (q8(v[j].y, inv, 0) << 8) | (q8(v[j].z, inv, 0) << 16) | (q8(v[j].w, inv, 0) << 24);
        *(unsigned*)(dq + j * 256 + lane * 4) = w;
    }
    if (lane == 0) *sq = qs;
}

__device__ __forceinline__ void norm1_rows(const Params& P, bool isctx, int row0, int nrows, char* smem) {
    float* sc = (float*)smem; float* sh = sc + DM;
    const int r = isctx ? 16 : row0 / SEQ;
    __syncthreads();
    for (int d = threadIdx.x; d < DM; d += 256) {
        float a = P.b_mod[DM + d], b = P.b_mod[d];
#pragma unroll
        for (int kc = 0; kc < MODP_KC; ++kc) { a += P.modp()[((size_t)kc * 17 + r) * NMOD + DM + d]; b += P.modp()[((size_t)kc * 17 + r) * NMOD + d]; }
        sc[d] = a; sh[d] = b;
    }
    __syncthreads();
    const int lane = threadIdx.x & 63, wid = threadIdx.x >> 6;
    const float* srcb = isctx ? P.ctx : P.x; bf16_t* dstb = isctx ? P.HC() : P.H();
    for (int i = wid; i < nrows; i += 8) {
        const int ra = row0 + i, rb = row0 + i + 4; const bool hb = (i + 4) < nrows;
        f32x4 va[4], vb[4];
        load_row4(srcb + (size_t)ra * DM, lane, va); if (hb) load_row4(srcb + (size_t)rb * DM, lane, vb);
        norm_row(va, P.n1, sc, sh, dstb + (size_t)ra * DM, lane);
        if (hb) norm_row(vb, P.n1, sc, sh, dstb + (size_t)rb * DM, lane);
    }
}
#define UB0(x) ((float)((x) & 0xffu))
#define UB1(x) ((float)(((x) >> 8) & 0xffu))
#define UB2(x) ((float)(((x) >> 16) & 0xffu))
#define UB3(x) ((float)((x) >> 24))
enum { MODE_INPROJ = 0, MODE_CTXKV = 1, MODE_AO1 = 2, MODE_MIX = 4 };

__device__ __forceinline__ void st8bf(bf16_t* p, const float* v) {
    u32x4 o; o.x = pk2(v[0], v[1]); o.y = pk2(v[2], v[3]); o.z = pk2(v[4], v[5]); o.w = pk2(v[6], v[7]);
    *(u32x4*)p = o;
}
__device__ __forceinline__ void st8bf_nt(bf16_t* p, const float* v) {
    u32x4 o; o.x = pk2(v[0], v[1]); o.y = pk2(v[2], v[3]); o.z = pk2(v[4], v[5]); o.w = pk2(v[6], v[7]);
    __builtin_nontemporal_store(o, (u32x4*)p);
}
__device__ __forceinline__ void st4bf(bf16_t* p, const float* v) {
    u32x2 o; o.x = pk2(v[0], v[1]); o.y = pk2(v[2], v[3]);
    *(u32x2*)p = o;
}
template <int MODE> __device__ __forceinline__ void epi8(const Params& P, int m, int n, const float* v, int aux) {
    if (MODE == MODE_INPROJ) {
        if (n < 1280) st8bf_nt(P.GB() + (size_t)m * 512 + (n - 768), v);
        else if (n < 1792) st8bf_nt(P.GC() + (size_t)m * 512 + (n - 1280), v);
        else if (n < 2304) st8bf_nt(P.U() + (size_t)m * 512 + (n - 1792), v);
        else {
            unsigned q[8];
#pragma unroll
            for (int j = 0; j < 8; ++j) q[j] = (unsigned)__builtin_rintf(255.f * sigmoidf_(v[j]));
            u32x2 w; w.x = q[0] | (q[1] << 8) | (q[2] << 16) | (q[3] << 24); w.y = q[4] | (q[5] << 8) | (q[6] << 16) | (q[7] << 24);
            unsigned char* gp = (n < 3328) ? (P.GA() + (size_t)m * DM + (n - 2304)) : (P.GV() + (size_t)m * DM + (n - 3328));
            __builtin_nontemporal_store(w, (u32x2*)gp);
        }
    } else if (MODE == MODE_CTXKV) {
        { const int b = m / CTXL, c = m % CTXL, kvh = n >> 6, d0 = n & 63;
          st8bf(P.Kc() + ((((size_t)((b * 2 + kvh) * 8 + (c >> 5)) * 4 + (d0 >> 4)) * 2 + ((d0 >> 3) & 1)) * 32 + (c & 31)) * 8, v); }
    } else if (MODE == MODE_AO1) {
        const u32x2 g = *(const u32x2*)((aux ? P.GV() : P.GA()) + (size_t)m * DM + n);
        u32x4 a = (u32x4){0u, 0u, 0u, 0u};
        if (aux) a = *(const u32x4*)(P.M1() + (size_t)m * DM + n);
        const float k255 = 1.f / 255.f;
        float o[8];
        o[0] = bf2f(a.x & 0xffff) + v[0] * (k255 * UB0(g.x)); o[1] = bf2f(a.x >> 16) + v[1] * (k255 * UB1(g.x));
        o[2] = bf2f(a.y & 0xffff) + v[2] * (k255 * UB2(g.x)); o[3] = bf2f(a.y >> 16) + v[3] * (k255 * UB3(g.x));
        o[4] = bf2f(a.z & 0xffff) + v[4] * (k255 * UB0(g.y)); o[5] = bf2f(a.z >> 16) + v[5] * (k255 * UB1(g.y));
        o[6] = bf2f(a.w & 0xffff) + v[6] * (k255 * UB2(g.y)); o[7] = bf2f(a.w >> 16) + v[7] * (k255 * UB3(g.y));
        st8bf((aux ? P.YG() : P.M1()) + (size_t)m * DM + n, o);
    } else if (MODE == MODE_MIX) {
        const int b = m / SEQ;
        const float* g1 = P.mod() + (size_t)b * NMOD + 2 * DM + n;
        const float* xr = P.x + (size_t)m * DM + n;
        const f32x4 x0 = *(const f32x4*)xr, x1 = *(const f32x4*)(xr + 4), g0 = *(const f32x4*)g1, g1v = *(const f32x4*)(g1 + 4);
        float o[8];
        o[0] = x0.x + g0.x * v[0]; o[1] = x0.y + g0.y * v[1]; o[2] = x0.z + g0.z * v[2]; o[3] = x0.w + g0.w * v[3];
        o[4] = x1.x + g1v.x * v[4]; o[5] = x1.y + g1v.y * v[5]; o[6] = x1.z + g1v.z * v[6]; o[7] = x1.w + g1v.w * v[7];
        st8bf(P.X1() + (size_t)m * DM + n, o);
    }
}
__device__ __forceinline__ void epi_rope(const Params& P, int m, int n, const float* lo, const float* hi) {
    const int d0 = n & 63;
    const int l = m % SEQ;
    const float *ct, *st;
    if (d0 < 16) { const int row = l >> 6; ct = P.rope() + row * 16 + d0; st = P.rope() + 512 + row * 16 + d0; }
    else { const int col = l & 63; ct = P.rope() + 1024 + col * 16 + (d0 - 32); st = P.rope() + 2048 + col * 16 + (d0 - 32); }
    float a[4], b[4];
    const float sc = (n < 512) ? 0.125f * 1.44269504088896f : 1.f;
#pragma unroll
    for (int j = 0; j < 4; ++j) { const float cc = ct[j], ss = st[j]; a[j] = (lo[j] * cc - hi[j] * ss) * sc; b[j] = (lo[j] * ss + hi[j] * cc) * sc; }
    if (n < 512) { st4bf(P.Q() + (size_t)m * 512 + n, a); st4bf(P.Q() + (size_t)m * 512 + n + 16, b); }
    else { const int bb = m / SEQ, kvh = (n - 512) >> 6;
        bf16_t* kp = P.K() + ((((size_t)((bb * 2 + kvh) * 64 + (l >> 5)) * 4 + (d0 >> 4)) * 2 + ((d0 >> 3) & 1)) * 32 + (l & 31)) * 8 + (d0 & 7);
        st4bf(kp, a); st4bf(kp + 512, b); }
}
__device__ __forceinline__ void epi_v4(const Params& P, int m, int dcol, const float* v, bool ctx) {
    const int kvh = dcol >> 6, dd = dcol & 63;
    if (!ctx) { const int b = m / SEQ, l = m % SEQ;
#pragma unroll
        for (int j = 0; j < 4; ++j) {
            const int kk = l & 31;
            P.VT()[(((((size_t)((b * 2 + kvh) * 64 + (l >> 5)) * 2 + (dd >> 5)) * 2 + (kk >> 4)) * 2 + ((kk >> 2) & 1)) * 32 + ((dd & 31) + j)) * 8 + 4 * ((kk >> 3) & 1) + (kk & 3)] = f2bf(v[j]); }
    } else { const int b = m / CTXL, cpos = m % CTXL;
#pragma unroll
        for (int j = 0; j < 4; ++j) {
            const int kk = cpos & 31;
            P.VcT()[(((((size_t)((b * 2 + kvh) * 8 + (cpos >> 5)) * 2 + (dd >> 5)) * 2 + (kk >> 4)) * 2 + ((kk >> 2) & 1)) * 32 + ((dd & 31) + j)) * 8 + 4 * ((kk >> 3) & 1) + (kk & 3)] = f2bf(v[j]); }
    }
}

constexpr int GEMM_LDS = 65536;
constexpr int RETR_LDS = 128 * 130 * 4;
__device__ __forceinline__ int lds_off(int row, int chunk) { return row * 128 + ((chunk ^ ((row >> 1) & 7)) << 4); }

__device__ __forceinline__ void mma_from_lds(const char* As, const char* Bs, f32x4 (&acc)[4][4], int wm, int wn, int fr, int fq, int sw) {
#pragma unroll
    for (int ks = 0; ks < 2; ++ks) {
        bf16x8 af[4], bfr[4];
        const int coff = ((ks * 4 + fq) ^ sw) << 4;
#pragma unroll
        for (int mt = 0; mt < 4; ++mt) af[mt] = *(const bf16x8*)(As + (wm * 64 + mt * 16 + fr) * 128 + coff);
#pragma unroll
        for (int nt = 0; nt < 4; ++nt) bfr[nt] = *(const bf16x8*)(Bs + (wn * 64 + nt * 16 + fr) * 128 + coff);
#pragma unroll
        for (int mt = 0; mt < 4; ++mt)
#pragma unroll
            for (int nt = 0; nt < 4; ++nt) acc[mt][nt] = __builtin_amdgcn_mfma_f32_16x16x32_bf16(bfr[nt], af[mt], acc[mt][nt], 0, 0, 0);
    }
}
template <int MT, int NST>
__device__ __forceinline__ void gemm_ring(const bf16_t* __restrict__ A, int lda, const bf16_t* __restrict__ Bt, int ldb, int K, int m0, int n0, bool perm, char* smem, f32x4 (&acc)[MT][4]) {
    constexpr int SA = 2048 * MT, SB = SA + 8192, GA = MT / 2, GL = GA + 2;
    const int tid = threadIdx.x, lane = tid & 63, wid = __builtin_amdgcn_readfirstlane(tid >> 6);
    const int wm = wid >> 1, wn = wid & 1, fr = lane & 15, fq = lane >> 4;
    const int c8 = ((lane & 3) ^ (3 * ((lane >> 4) & 1))) * 8;
    unsigned aoff[GA], boff[2];
#pragma unroll
    for (int i = 0; i < GA; ++i) aoff[i] = (unsigned)(((wid + 4 * i) * 16 + (lane >> 2)) * lda + c8) * 2u;
#pragma unroll
    for (int i = 0; i < 2; ++i) {
        const int row = (wid + 4 * i) * 16 + (lane >> 2);
        int brow = row;
        if (perm) { const int g = row >> 6, rr = row & 63, nn = rr >> 4, j = rr & 15; brow = 64 * g + 16 * (j >> 2) + 4 * nn + (j & 3); }
        boff[i] = (unsigned)(brow * ldb + c8) * 2u;
    }
    const char* Abase = (const char*)(A + (size_t)m0 * lda);
    const char* Bbase = (const char*)(Bt + (size_t)n0 * ldb);
#pragma unroll
    for (int i = 0; i < MT; ++i)
#pragma unroll
        for (int j = 0; j < 4; ++j) acc[i][j] = (f32x4){0.f, 0.f, 0.f, 0.f};
#define RSTAGE_(buf, k0) { char* sb_ = smem + (buf) * SB; const char* ab_ = Abase + (size_t)(k0) * 2; const char* bb_ = Bbase + (size_t)(k0) * 2; \
        _Pragma("unroll") for (int i = 0; i < GA; ++i) __builtin_amdgcn_global_load_lds((const unsigned*)(ab_ + aoff[i]), (unsigned*)(sb_ + (wid + 4 * i) * 1024), 16, 0, 0); \
        _Pragma("unroll") for (int i = 0; i < 2; ++i) __builtin_amdgcn_global_load_lds((const unsigned*)(bb_ + boff[i]), (unsigned*)(sb_ + SA + (wid + 4 * i) * 1024), 16, 0, 0); }
    const int nk = K / 32;
    asm volatile("s_waitcnt vmcnt(0)" ::: "memory");
#pragma unroll
    for (int s = 0; s < NST - 1; ++s) RSTAGE_(s, s * 32)
    const int coff = (fq ^ (3 * ((fr >> 2) & 1))) << 4;
    int cur = 0, nxt = NST - 1;
#pragma unroll 1
    for (int kt = 0; kt < nk; ++kt) {
        const int rem = nk - 1 - kt;
        if (rem >= NST - 2) asm volatile("s_waitcnt vmcnt(%0)" :: "n"(GL * (NST - 2)) : "memory");
        else if (NST == 4 && rem == 1) asm volatile("s_waitcnt vmcnt(%0)" :: "n"(GL) : "memory");
        else asm volatile("s_waitcnt vmcnt(0)" ::: "memory");
        __builtin_amdgcn_s_barrier();
        const char* As = smem + cur * SB;
        const char* Bs = As + SA;
        bf16x8 af[MT], bfr[4];
#pragma unroll
        for (int mt = 0; mt < MT; ++mt) af[mt] = *(const bf16x8*)(As + (wm * 16 * MT + mt * 16 + fr) * 64 + coff);
#pragma unroll
        for (int nt = 0; nt < 4; ++nt) bfr[nt] = *(const bf16x8*)(Bs + (wn * 64 + nt * 16 + fr) * 64 + coff);
        const bool more = (kt + NST - 1 < nk);
        char* sb_ = smem + nxt * SB; const char* ab_ = Abase + (size_t)((kt + NST - 1) * 32) * 2; const char* bb_ = Bbase + (size_t)((kt + NST - 1) * 32) * 2;
        __builtin_amdgcn_s_setprio(1);
#pragma unroll
        for (int mt = 0; mt < MT; ++mt) {
#pragma unroll
            for (int nt = 0; nt < 4; ++nt) acc[mt][nt] = __builtin_amdgcn_mfma_f32_16x16x32_bf16(bfr[nt], af[mt], acc[mt][nt], 0, 0, 0);
            if (more) {
                if (mt < GA) __builtin_amdgcn_global_load_lds((const unsigned*)(ab_ + aoff[mt]), (unsigned*)(sb_ + (wid + 4 * mt) * 1024), 16, 0, 0);
                else if (mt < GA + 2) __builtin_amdgcn_global_load_lds((const unsigned*)(bb_ + boff[mt - GA]), (unsigned*)(sb_ + SA + (wid + 4 * (mt - GA)) * 1024), 16, 0, 0);
            }
        }
        __builtin_amdgcn_s_setprio(0);
        cur = (cur + 1 == NST) ? 0 : cur + 1;
        nxt = (nxt + 1 == NST) ? 0 : nxt + 1;
    }
#undef RSTAGE_
    __syncthreads();
}

template <int MODE, int MT>
__device__ __forceinline__ void gemm_tile(const Params& P, const bf16_t* __restrict__ A, int lda, const bf16_t* __restrict__ Bt, int ldb, int K, int m0, int n0, bool perm, char* smem, int aux = 0) {
    const int lane = threadIdx.x & 63, wid = threadIdx.x >> 6;
    const int wm = wid >> 1, wn = wid & 1, fr = lane & 15, fq = lane >> 4;
    f32x4 acc[MT][4];
    gemm_ring<MT, (MT == 8 ? 3 : 4)>(A, lda, Bt, ldb, K, m0, n0, perm, smem, acc);
#pragma unroll
    for (int mt = 0; mt < MT; ++mt) {
        const int m = m0 + wm * 16 * MT + mt * 16 + fr;
        if (perm) {
            const int nb = n0 + wn * 64 + 16 * fq;
            if (MODE == MODE_INPROJ && n0 >= 2304) {
                unsigned q[16];
#pragma unroll
                for (int nt = 0; nt < 4; ++nt)
#pragma unroll
                    for (int r = 0; r < 4; ++r) q[4 * nt + r] = (unsigned)__builtin_rintf(255.f * sigmoidf_(acc[mt][nt][r]));
                u32x4 w;
                w.x = q[0] | (q[1] << 8) | (q[2] << 16) | (q[3] << 24); w.y = q[4] | (q[5] << 8) | (q[6] << 16) | (q[7] << 24);
                w.z = q[8] | (q[9] << 8) | (q[10] << 16) | (q[11] << 24); w.w = q[12] | (q[13] << 8) | (q[14] << 16) | (q[15] << 24);
                unsigned char* gp = (nb < 3328) ? (P.GA() + (size_t)m * DM + (nb - 2304)) : (P.GV() + (size_t)m * DM + (nb - 3328));
                __builtin_nontemporal_store(w, (u32x4*)gp);
            } else {
#pragma unroll
                for (int p = 0; p < 2; ++p) {
                    float v[8] = { acc[mt][2 * p][0], acc[mt][2 * p][1], acc[mt][2 * p][2], acc[mt][2 * p][3], acc[mt][2 * p + 1][0], acc[mt][2 * p + 1][1], acc[mt][2 * p + 1][2], acc[mt][2 * p + 1][3] };
                    epi8<MODE>(P, m, nb + 8 * p, v, aux);
                }
            }
        } else if (MODE == MODE_INPROJ && n0 < 640) {
#pragma unroll
            for (int p = 0; p < 2; ++p) {
                float lo[4] = { acc[mt][2 * p][0], acc[mt][2 * p][1], acc[mt][2 * p][2], acc[mt][2 * p][3] };
                float hi[4] = { acc[mt][2 * p + 1][0], acc[mt][2 * p + 1][1], acc[mt][2 * p + 1][2], acc[mt][2 * p + 1][3] };
                epi_rope(P, m, n0 + wn * 64 + 32 * p + 4 * fq, lo, hi);
            }
        } else if (MODE == MODE_INPROJ || MODE == MODE_CTXKV) {
            const int dbase = (MODE == MODE_INPROJ) ? (n0 - 640) : (n0 - 128);
#pragma unroll
            for (int nt = 0; nt < 4; ++nt) {
                float v[4] = { acc[mt][nt][0], acc[mt][nt][1], acc[mt][nt][2], acc[mt][nt][3] };
                epi_v4(P, m, dbase + wn * 64 + 16 * nt + 4 * fq, v, MODE == MODE_CTXKV);
            }
        }
        asm volatile("" ::: "memory"); __builtin_amdgcn_sched_barrier(0);
    }
}
__device__ __forceinline__ void tile_coords(int t, int ntm, int ntn, int& mt, int& nt) {
    const int per = 8 * ntn, g = t / per, r = t % per;
    mt = g * 8 + (r & 7); nt = r >> 3;
}
#define CEU(a, b) { const unsigned _t = (a) > (b) ? (a) : (b); (b) = (a) > (b) ? (b) : (a); (a) = _t; }
__device__ __forceinline__ void sort16_desc(unsigned (&v)[16]) {
    CEU(v[0], v[1]); CEU(v[2], v[3]); CEU(v[0], v[2]); CEU(v[1], v[3]); CEU(v[1], v[2]); CEU(v[4], v[5]);
    CEU(v[6], v[7]); CEU(v[4], v[6]); CEU(v[5], v[7]); CEU(v[5], v[6]); CEU(v[0], v[4]); CEU(v[2], v[6]);
    CEU(v[2], v[4]); CEU(v[1], v[5]); CEU(v[3], v[7]); CEU(v[3], v[5]); CEU(v[1], v[2]); CEU(v[3], v[4]);
    CEU(v[5], v[6]); CEU(v[8], v[9]); CEU(v[10], v[11]); CEU(v[8], v[10]); CEU(v[9], v[11]); CEU(v[9], v[10]);
    CEU(v[12], v[13]); CEU(v[14], v[15]); CEU(v[12], v[14]); CEU(v[13], v[15]); CEU(v[13], v[14]); CEU(v[8], v[12]);
    CEU(v[10], v[14]); CEU(v[10], v[12]); CEU(v[9], v[13]); CEU(v[11], v[15]); CEU(v[11], v[13]); CEU(v[9], v[10]);
    CEU(v[11], v[12]); CEU(v[13], v[14]); CEU(v[0], v[8]); CEU(v[4], v[12]); CEU(v[4], v[8]); CEU(v[2], v[10]);
    CEU(v[6], v[14]); CEU(v[6], v[10]); CEU(v[2], v[4]); CEU(v[6], v[8]); CEU(v[10], v[12]); CEU(v[1], v[9]);
    CEU(v[5], v[13]); CEU(v[5], v[9]); CEU(v[3], v[11]); CEU(v[7], v[15]); CEU(v[7], v[11]); CEU(v[3], v[5]);
    CEU(v[7], v[9]); CEU(v[11], v[13]); CEU(v[1], v[2]); CEU(v[3], v[4]); CEU(v[5], v[6]); CEU(v[7], v[8]);
    CEU(v[9], v[10]); CEU(v[11], v[12]); CEU(v[13], v[14]);
}
__device__ __forceinline__ void bitonic16_desc(unsigned (&v)[16]) {
    CEU(v[0], v[8]); CEU(v[1], v[9]); CEU(v[2], v[10]); CEU(v[3], v[11]); CEU(v[4], v[12]); CEU(v[5], v[13]);
    CEU(v[6], v[14]); CEU(v[7], v[15]); CEU(v[0], v[4]); CEU(v[1], v[5]); CEU(v[2], v[6]); CEU(v[3], v[7]);
    CEU(v[8], v[12]); CEU(v[9], v[13]); CEU(v[10], v[14]); CEU(v[11], v[15]); CEU(v[0], v[2]); CEU(v[1], v[3]);
    CEU(v[4], v[6]); CEU(v[5], v[7]); CEU(v[8], v[10]); CEU(v[9], v[11]); CEU(v[12], v[14]); CEU(v[13], v[15]);
    CEU(v[0], v[1]); CEU(v[2], v[3]); CEU(v[4], v[5]); CEU(v[6], v[7]); CEU(v[8], v[9]); CEU(v[10], v[11]);
    CEU(v[12], v[13]); CEU(v[14], v[15]);
}

__device__ __forceinline__ unsigned enc_key(float f) { const unsigned b = __float_as_uint(f); return b ^ ((unsigned)((int)b >> 31) | 0x80000000u); }
__device__ __forceinline__ float dec_key(unsigned k) { const unsigned b = (k & 0x80000000u) ? (k & 0x7fffffffu) : ~k; return __uint_as_float(b); }
__device__ __forceinline__ void topmerge16(unsigned (&top)[16], const unsigned (&L)[16]) {
#pragma unroll
    for (int i = 0; i < 16; ++i) top[i] = top[i] > L[15 - i] ? top[i] : L[15 - i];
    bitonic16_desc(top);
}
__device__ __forceinline__ unsigned cand_key(float a, float b, int i, int j) { return (enc_key(a + b) & ~0xFFu) | (unsigned)(i << 4) | (unsigned)j; }

__device__ __forceinline__ void peer_retrieve_item(const Params& P, int mtile, int h, char* smem) {
    const int tid = threadIdx.x, lane = tid & 63, wid = tid >> 6;
    const int wm = wid >> 1, wn = wid & 1, fr = lane & 15, fq = lane >> 4;
    const int sw = (fr >> 1) & 7;
    const int m0 = mtile * 128;
    unsigned T0[16], T1[16];
#pragma unroll 1
    for (int p = 0; p < 2; ++p) {
        const int hp = h * 2 + p;
        f32x4 acc[4][4];
        gemm_ring<4, 4>(P.H2(), DM, P.PwqT(), DM, DM, m0, hp * 128, false, smem, acc);
#pragma unroll
        for (int mt = 0; mt < 4; ++mt)
#pragma unroll
            for (int nt = 0; nt < 4; ++nt) {
                const int row = wm * 64 + mt * 16 + fr;
                u32x2 o; o.x = pk2(acc[mt][nt][0], acc[mt][nt][1]); o.y = pk2(acc[mt][nt][2], acc[mt][nt][3]);
                *(u32x2*)(smem + wn * 32768 + lds_off(row, 2 * nt + (fq >> 1)) + (fq & 1) * 8) = o;
            }
        {
            const int srow = tid >> 3, schunk = tid & 7;
            const bf16_t* kb = P.KeysB() + (size_t)hp * 128 * 128;
#pragma unroll
            for (int hf = 0; hf < 2; ++hf)
#pragma unroll
                for (int q = 0; q < 4; ++q) {
                    const int row = q * 32 + srow;
                    const u32x4 v = *(const u32x4*)(kb + (size_t)row * 128 + hf * 64 + schunk * 8);
                    *(u32x4*)(smem + hf * 32768 + 16384 + lds_off(row, schunk)) = v;
                }
        }
        __syncthreads();
#pragma unroll
        for (int i = 0; i < 4; ++i)
#pragma unroll
            for (int j = 0; j < 4; ++j) acc[i][j] = (f32x4){0.f, 0.f, 0.f, 0.f};
        mma_from_lds(smem, smem + 16384, acc, wm, wn, fr, fq, sw);
        mma_from_lds(smem + 32768, smem + 32768 + 16384, acc, wm, wn, fr, fq, sw);
        __syncthreads();
        float* sc = (float*)smem;
#pragma unroll
        for (int mt = 0; mt < 4; ++mt)
#pragma unroll
            for (int nt = 0; nt < 4; ++nt) {
                const int row = wm * 64 + mt * 16 + fr;
#pragma unroll
                for (int r = 0; r < 4; ++r) {
                    const int col = wn * 64 + nt * 16 + fq * 4 + r;
                    sc[row * 130 + wn * 65 + (col & 63)] = acc[mt][nt][r];
                }
            }
        __syncthreads();
        {
            const int row = tid >> 1, half = tid & 1;
            const float* rp = sc + row * 130 + half * 65;
            unsigned top[16];
#pragma unroll 1
            for (int g = 0; g < 4; ++g) {
                unsigned L[16];
#pragma unroll
                for (int j = 0; j < 16; ++j) { const int col = half * 64 + g * 16 + j; L[j] = (enc_key(rp[g * 16 + j]) & ~0x7Fu) | (unsigned)col; }
                sort16_desc(L);
                if (g == 0) {
#pragma unroll
                    for (int j = 0; j < 16; ++j) top[j] = L[j];
                } else topmerge16(top, L);
            }
            unsigned Bp[16];
#pragma unroll
            for (int j = 0; j < 16; ++j) Bp[j] = (unsigned)__shfl_xor((int)top[j], 1);
            topmerge16(top, Bp);
            if (p == 0) {
#pragma unroll
                for (int j = 0; j < 16; ++j) T0[j] = top[j];
            } else {
#pragma unroll
                for (int j = 0; j < 16; ++j) T1[j] = top[j];
            }
        }
        __syncthreads();
    }
    {
        const int row = tid >> 1;
        unsigned char* slot = (unsigned char*)smem + row * 32;
        if ((tid & 1) == 0) {
#pragma unroll
            for (int j = 0; j < 16; ++j) { slot[j] = (unsigned char)(T0[j] & 0x7Fu); slot[16 + j] = (unsigned char)(T1[j] & 0x7Fu); }
            float a[16], b[16];
#pragma unroll
            for (int j = 0; j < 16; ++j) { a[j] = dec_key(T0[j]); b[j] = dec_key(T1[j]); }
            unsigned LA[16], LB[16], LC[16];
#pragma unroll
            for (int j = 0; j < 16; ++j) LA[j] = cand_key(a[0], b[j], 0, j);
#pragma unroll
            for (int j = 0; j < 8; ++j) LB[j] = cand_key(a[1], b[j], 1, j);
#pragma unroll
            for (int j = 0; j < 8; ++j) LB[8 + j] = cand_key(a[15 - j], b[0], 15 - j, 0);
            LC[0] = cand_key(a[2], b[0], 2, 0); LC[1] = cand_key(a[2], b[1], 2, 1); LC[2] = cand_key(a[2], b[2], 2, 2); LC[3] = cand_key(a[2], b[3], 2, 3); LC[4] = cand_key(a[2], b[4], 2, 4);
            LC[5] = cand_key(a[3], b[0], 3, 0); LC[6] = cand_key(a[3], b[1], 3, 1); LC[7] = cand_key(a[3], b[2], 3, 2); LC[8] = cand_key(a[3], b[3], 3, 3);
            LC[9] = cand_key(a[4], b[0], 4, 0); LC[10] = cand_key(a[4], b[1], 4, 1); LC[11] = cand_key(a[4], b[2], 4, 2);
            LC[12] = cand_key(a[5], b[0], 5, 0); LC[13] = cand_key(a[5], b[1], 5, 1);
            LC[14] = cand_key(a[6], b[0], 6, 0); LC[15] = cand_key(a[6], b[1], 6, 1);
            const unsigned d0 = cand_key(a[7], b[0], 7, 0), d1 = cand_key(a[7], b[1], 7, 1);
            bitonic16_desc(LB);
            sort16_desc(LC);
            topmerge16(LA, LB);
            LC[15] = LC[15] > d0 ? LC[15] : d0; LC[14] = LC[14] > d1 ? LC[14] : d1;
            bitonic16_desc(LC);
            topmerge16(LA, LC);
            float e[16], den = 0.f; const float vmax = dec_key(LA[0]);
#pragma unroll
            for (int r = 0; r < 16; ++r) { e[r] = __expf(dec_key(LA[r]) - vmax); den += e[r]; }
            const float inv = 1.f / den;
            const int t = m0 + row;
            int* oi = P.sel_idx() + (size_t)t * 128 + h * 16; float* og = P.sel_g() + (size_t)t * 128 + h * 16;
#pragma unroll
            for (int r = 0; r < 16; ++r) {
                const int i = (LA[r] >> 4) & 15, j = LA[r] & 15;
                oi[r] = (int)slot[i] * 128 + (int)slot[16 + j];
                og[r] = e[r] * inv;
            }
        }
    }
    __syncthreads();
}
typedef float f32x16 __attribute__((ext_vector_type(16)));
struct AttnFrag { u32x4 k[4]; u32x4 v[2][2]; };
__device__ __forceinline__ void attn_load(const Params& P, int b, int kvh, int qb, int w, int blk, int r, int hh, AttnFrag& f) {
    const bf16_t* kp; const bf16_t* vp;
    if (blk < 9) {
        int kpos0 = (qb - 1) * 128 + 32 * (w + blk);
        if (kpos0 < 0 || kpos0 >= SEQ) kpos0 = 0;
        const size_t blkoff = (size_t)((b * 2 + kvh) * 64 + (kpos0 >> 5)) * 2048 + (hh * 32 + r) * 8;
        kp = P.K() + blkoff; vp = P.VT() + blkoff;
    } else {
        const size_t blkoff = (size_t)((b * 2 + kvh) * 8 + (blk - 9)) * 2048 + (hh * 32 + r) * 8;
        kp = P.Kc() + blkoff; vp = P.VcT() + blkoff;
    }
#pragma unroll
    for (int ks = 0; ks < 4; ++ks) f.k[ks] = *(const u32x4*)(kp + 512 * ks);
#pragma unroll
    for (int db = 0; db < 2; ++db)
#pragma unroll
        for (int s = 0; s < 2; ++s) f.v[db][s] = *(const u32x4*)(vp + 512 * (db * 2 + s));
}
__device__ __forceinline__ void attn_item(const Params& P, int item) {
    const int head = item & 7, qb = (item >> 3) & 15, b = item >> 7, kvh = head >> 2;
    const int lane = threadIdx.x & 63, w = threadIdx.x >> 6, r = lane & 31, hh = lane >> 5;
    const int tok = b * SEQ + qb * 128 + 32 * w + r;
    bf16x8 qf[4];
    { const bf16_t* qp = P.Q() + (size_t)tok * 512 + head * 64 + 8 * hh;
#pragma unroll
      for (int ks = 0; ks < 4; ++ks) qf[ks] = *(const bf16x8*)(qp + 16 * ks); }
    f32x16 o0, o1;
#pragma unroll
    for (int i = 0; i < 16; ++i) { o0[i] = 0.f; o1[i] = 0.f; }
    float mrun = P.sink[head] * 1.44269504088896f, lrun = (hh == 0) ? 1.f : 0.f;
    AttnFrag cur, nxt;
    attn_load(P, b, kvh, qb, w, 0, r, hh, cur);
    for (int blk = 0; blk < 17; ++blk) {
        if (blk + 1 < 17) attn_load(P, b, kvh, qb, w, blk + 1, r, hh, nxt);
        int lo = 0, hi = 31;
        if (blk < 9) {
            const int kpos0 = (qb - 1) * 128 + 32 * (w + blk);
            if (kpos0 < 0 || kpos0 >= SEQ) lo = 64;
            else if (blk == 0) lo = r;
            else if (blk == 8) hi = r;
        }
        f32x16 s;
#pragma unroll
        for (int i = 0; i < 16; ++i) s[i] = 0.f;
#pragma unroll
        for (int ks = 0; ks < 4; ++ks) s = __builtin_amdgcn_mfma_f32_32x32x16_bf16(*(const bf16x8*)&cur.k[ks], qf[ks], s, 0, 0, 0);
        if (lo != 0 || hi != 31) {
#pragma unroll
            for (int i = 0; i < 16; ++i) { const int kk = (i & 3) + 8 * (i >> 2) + 4 * hh; const bool ok = (kk >= lo) && (kk <= hi); s[i] = ok ? s[i] : -3.0e38f; }
        }
        float mb = s[0];
#pragma unroll
        for (int i = 1; i < 16; ++i) mb = fmaxf(mb, s[i]);
        mb = fmaxf(mb, __shfl_xor(mb, 32));
        if (!__all(mb - mrun <= 8.f)) {
            const float mn = fmaxf(mrun, mb);
            const float alpha = __builtin_amdgcn_exp2f(mrun - mn);
            lrun *= alpha; mrun = mn;
#pragma unroll
            for (int i = 0; i < 16; ++i) { o0[i] *= alpha; o1[i] *= alpha; }
        }
        float ps = 0.f; float p[16];
#pragma unroll
        for (int i = 0; i < 16; ++i) { p[i] = __builtin_amdgcn_exp2f(s[i] - mrun); ps += p[i]; }
        lrun += ps;
        u32x4 pb[2];
        pb[0].x = pk2(p[0], p[1]); pb[0].y = pk2(p[2], p[3]); pb[0].z = pk2(p[4], p[5]); pb[0].w = pk2(p[6], p[7]);
        pb[1].x = pk2(p[8], p[9]); pb[1].y = pk2(p[10], p[11]); pb[1].z = pk2(p[12], p[13]); pb[1].w = pk2(p[14], p[15]);
#pragma unroll
        for (int sI = 0; sI < 2; ++sI) {
            const u32x4 va = cur.v[0][sI], vb = cur.v[1][sI];
            o0 = __builtin_amdgcn_mfma_f32_32x32x16_bf16(*(const bf16x8*)&va, *(const bf16x8*)&pb[sI], o0, 0, 0, 0);
            o1 = __builtin_amdgcn_mfma_f32_32x32x16_bf16(*(const bf16x8*)&vb, *(const bf16x8*)&pb[sI], o1, 0, 0, 0);
        }
        if (blk + 1 < 17) cur = nxt;
    }
    const float ltot = lrun + __shfl_xor(lrun, 32);
    const float inv = 1.f / ltot;
    bf16_t* op = P.AO() + (size_t)tok * 512 + head * 64 + 4 * hh;
#pragma unroll
    for (int g = 0; g < 4; ++g) {
        float t0[4] = { o0[4 * g] * inv, o0[4 * g + 1] * inv, o0[4 * g + 2] * inv, o0[4 * g + 3] * inv };
        float t1[4] = { o1[4 * g] * inv, o1[4 * g + 1] * inv, o1[4 * g + 2] * inv, o1[4 * g + 3] * inv };
        st4bf(op + 8 * g, t0); st4bf(op + 32 + 8 * g, t1);
    }
}

__device__ __forceinline__ void conv_range(const Params& P, size_t gtid, size_t gsize) {
    for (size_t idx = gtid; idx < (size_t)NTOK * 64; idx += gsize) {
        const int m = (int)(idx >> 6), c0 = (int)(idx & 63) * 8, l = m % SEQ;
        float cu[3][8];
#pragma unroll
        for (int t = 0; t < 3; ++t) {
            const int ll = l + t - 1;
            if (ll < 0 || ll >= SEQ) {
#pragma unroll
                for (int j = 0; j < 8; ++j) cu[t][j] = 0.f;
            } else {
                const u32x4 g = *(const u32x4*)(P.GC() + (size_t)(m + t - 1) * 512 + c0), u = *(const u32x4*)(P.U() + (size_t)(m + t - 1) * 512 + c0);
                cu[t][0] = bf2f(g.x & 0xffff) * bf2f(u.x & 0xffff); cu[t][1] = bf2f(g.x >> 16) * bf2f(u.x >> 16);
                cu[t][2] = bf2f(g.y & 0xffff) * bf2f(u.y & 0xffff); cu[t][3] = bf2f(g.y >> 16) * bf2f(u.y >> 16);
                cu[t][4] = bf2f(g.z & 0xffff) * bf2f(u.z & 0xffff); cu[t][5] = bf2f(g.z >> 16) * bf2f(u.z >> 16);
                cu[t][6] = bf2f(g.w & 0xffff) * bf2f(u.w & 0xffff); cu[t][7] = bf2f(g.w >> 16) * bf2f(u.w >> 16);
            }
        }
        const u32x4 gbv = *(const u32x4*)(P.GB() + (size_t)m * 512 + c0);
        const float gb[8] = { bf2f(gbv.x & 0xffff), bf2f(gbv.x >> 16), bf2f(gbv.y & 0xffff), bf2f(gbv.y >> 16), bf2f(gbv.z & 0xffff), bf2f(gbv.z >> 16), bf2f(gbv.w & 0xffff), bf2f(gbv.w >> 16) };
        float o[8];
#pragma unroll
        for (int j = 0; j < 8; ++j) o[j] = gb[j] * (P.conv_w[c0 + j] * cu[0][j] + P.conv_w[512 + c0 + j] * cu[1][j] + P.conv_w[1024 + c0 + j] * cu[2][j]);
        st8bf(P.CA() + (size_t)m * 512 + c0, o);
    }
}

__device__ __forceinline__ void unpack8(const u32x4 v, float* f) {
    f[0] = bf2f(v.x & 0xffff); f[1] = bf2f(v.x >> 16); f[2] = bf2f(v.y & 0xffff); f[3] = bf2f(v.y >> 16);
    f[4] = bf2f(v.z & 0xffff); f[5] = bf2f(v.z >> 16); f[6] = bf2f(v.w & 0xffff); f[7] = bf2f(v.w >> 16);
}
__device__ __forceinline__ float gelu_erf(float d) { return 0.5f * d * (1.f + erff(d * 0.70710678118654752f)); }
__device__ __forceinline__ int reduce64i(int (&part)[64], int lane) {
#pragma unroll
    for (int i = 0; i < 32; ++i) { auto r = __builtin_amdgcn_permlane32_swap((unsigned)part[i], (unsigned)part[32 + i], false, false); part[i] = (int)r[0] + (int)r[1]; }
#pragma unroll
    for (int i = 0; i < 16; ++i) { auto r = __builtin_amdgcn_permlane16_swap((unsigned)part[i], (unsigned)part[16 + i], false, false); part[i] = (int)r[0] + (int)r[1]; }
#define RSTAGE(N) { const bool up = (lane & N) != 0; _Pragma("unroll") for (int i = 0; i < N; ++i) { const int keep = up ? part[N + i] : part[i], send = up ? part[i] : part[N + i]; part[i] = keep + __shfl_xor(send, N); } }
    RSTAGE(8) RSTAGE(4) RSTAGE(2) RSTAGE(1)
#undef RSTAGE
    return part[0];
}
template <int HALF>
__device__ __forceinline__ void peer_uh_token(const Params& P, int t, int lane) {
    const u32x2 hq = *(const u32x2*)(P.H2q() + (size_t)t * DM + HALF * 512 + 8 * lane);
    const signed char* ub = P.Uq() + (size_t)HALF * NEXP * 512 + 8 * lane;
    const float sh = P.sh2()[t];
#pragma unroll 1
    for (int hf = 0; hf < 2; ++hf) {
        const int myidx = P.sel_idx()[(size_t)t * 128 + hf * 64 + lane];
        u32x2 rows[2][8];
        int part[64];
#define ULOAD(bt) { _Pragma("unroll") for (int q = 0; q < 8; ++q) { const int e = __builtin_amdgcn_readlane(myidx, (bt) * 8 + q); rows[(bt) & 1][q] = *(const u32x2*)(ub + (size_t)e * 512); } }
#define UDOT(bt) { _Pragma("unroll") for (int q = 0; q < 8; ++q) { const u32x2 a = rows[(bt) & 1][q]; \
        part[(bt) * 8 + q] = __builtin_amdgcn_sdot4((int)a.y, (int)hq.y, __builtin_amdgcn_sdot4((int)a.x, (int)hq.x, 0, false), false); } }
        ULOAD(0)
        ULOAD(1) UDOT(0)
        ULOAD(2) UDOT(1)
        ULOAD(3) UDOT(2)
        ULOAD(4) UDOT(3)
        ULOAD(5) UDOT(4)
        ULOAD(6) UDOT(5)
        ULOAD(7) UDOT(6)
        UDOT(7)
#undef ULOAD
#undef UDOT
        const int isum = reduce64i(part, lane);
        const size_t o = (size_t)t * 128 + hf * 64 + lane;
        if (HALF == 0) P.pd()[o] = isum;
        else P.cbuf()[o] = P.sel_g()[o] * gelu_erf((float)(isum + P.pd()[o]) * P.su()[myidx] * sh) * P.sv()[myidx];
    }
}
template <int HALF>
__device__ __forceinline__ void peer_vh_token(const Params& P, int t, int lane) {
    const int b = t / SEQ;
    float acc[8];
#pragma unroll
    for (int j = 0; j < 8; ++j) acc[j] = 0.f;
    const int idlo = P.sel_idx()[(size_t)t * 128 + lane], idhi = P.sel_idx()[(size_t)t * 128 + 64 + lane];
    const float clo = P.cbuf()[(size_t)t * 128 + lane], chi = P.cbuf()[(size_t)t * 128 + 64 + lane];
    const float cb = 128.f * wave_sum(clo + chi);
    const unsigned char* vb = P.Vq() + (size_t)HALF * NEXP * 512 + 8 * lane;
    u32x2 rows[2][8];
#define VLOAD(bt) { _Pragma("unroll") for (int q = 0; q < 8; ++q) { const int e = __builtin_amdgcn_readlane((bt) < 8 ? idlo : idhi, ((bt) & 7) * 8 + q); rows[(bt) & 1][q] = *(const u32x2*)(vb + (size_t)e * 512); } }
#define VCOMP(bt) { _Pragma("unroll") for (int q = 0; q < 8; ++q) { \
        const float ck = __uint_as_float(__builtin_amdgcn_readlane(__float_as_uint((bt) < 8 ? clo : chi), ((bt) & 7) * 8 + q)); const u32x2 x = rows[(bt) & 1][q]; \
        acc[0] += ck * UB0(x.x); acc[1] += ck * UB1(x.x); acc[2] += ck * UB2(x.x); acc[3] += ck * UB3(x.x); \
        acc[4] += ck * UB0(x.y); acc[5] += ck * UB1(x.y); acc[6] += ck * UB2(x.y); acc[7] += ck * UB3(x.y); \
        __builtin_amdgcn_sched_barrier(0); } }
    VLOAD(0)
    VLOAD(1) VCOMP(0)
    VLOAD(2) VCOMP(1)
    VLOAD(3) VCOMP(2)
    VLOAD(4) VCOMP(3)
    VLOAD(5) VCOMP(4)
    VLOAD(6) VCOMP(5)
    VLOAD(7) VCOMP(6)
    VLOAD(8) VCOMP(7)
    VLOAD(9) VCOMP(8)
    VLOAD(10) VCOMP(9)
    VLOAD(11) VCOMP(10)
    VLOAD(12) VCOMP(11)
    VLOAD(13) VCOMP(12)
    VLOAD(14) VCOMP(13)
    VLOAD(15) VCOMP(14)
    VCOMP(15)
#undef VLOAD
#undef VCOMP
    const int col0 = HALF * 512 + 8 * lane;
    float x2[8]; float ss = 0.f;
    { const u32x4 xw = *(const u32x4*)(P.X1() + (size_t)t * DM + col0);
      const float* g2 = P.mod() + (size_t)b * NMOD + 5 * DM + col0;
      const f32x4 ga = *(const f32x4*)g2, gb = *(const f32x4*)(g2 + 4);
      x2[0] = bf2f(xw.x & 0xffff) + ga.x * (acc[0] - cb); x2[1] = bf2f(xw.x >> 16) + ga.y * (acc[1] - cb);
      x2[2] = bf2f(xw.y & 0xffff) + ga.z * (acc[2] - cb); x2[3] = bf2f(xw.y >> 16) + ga.w * (acc[3] - cb);
      x2[4] = bf2f(xw.z & 0xffff) + gb.x * (acc[4] - cb); x2[5] = bf2f(xw.z >> 16) + gb.y * (acc[5] - cb);
      x2[6] = bf2f(xw.w & 0xffff) + gb.z * (acc[6] - cb); x2[7] = bf2f(xw.w >> 16) + gb.w * (acc[7] - cb); }
#pragma unroll
    for (int j = 0; j < 8; ++j) ss += x2[j] * x2[j];
    ss = wave_sum(ss);
    float* orow = P.out + (size_t)t * DM;
    if (HALF == 0) {
        *(f32x4*)(orow + col0) = (f32x4){ x2[0], x2[1], x2[2], x2[3] }; *(f32x4*)(orow + col0 + 4) = (f32x4){ x2[4], x2[5], x2[6], x2[7] };
        if (lane == 0) P.ssq()[t] = ss;
    } else {
        const float rstd = rsqrtf((ss + P.ssq()[t]) * (1.f / DM) + 1e-6f);
        const f32x4 fa = *(const f32x4*)(P.fg + col0), fb = *(const f32x4*)(P.fg + col0 + 4);
        *(f32x4*)(orow + col0) = (f32x4){ x2[0] * rstd * fa.x, x2[1] * rstd * fa.y, x2[2] * rstd * fa.z, x2[3] * rstd * fa.w };
        *(f32x4*)(orow + col0 + 4) = (f32x4){ x2[4] * rstd * fb.x, x2[5] * rstd * fb.y, x2[6] * rstd * fb.z, x2[7] * rstd * fb.w };
        const int c1 = 8 * lane;
        const f32x4 va = *(const f32x4*)(orow + c1), vb2 = *(const f32x4*)(orow + c1 + 4), ga = *(const f32x4*)(P.fg + c1), gb = *(const f32x4*)(P.fg + c1 + 4);
        *(f32x4*)(orow + c1) = (f32x4){ va.x * rstd * ga.x, va.y * rstd * ga.y, va.z * rstd * ga.z, va.w * rstd * ga.w };
        *(f32x4*)(orow + c1 + 4) = (f32x4){ vb2.x * rstd * gb.x, vb2.y * rstd * gb.y, vb2.z * rstd * gb.z, vb2.w * rstd * gb.w };
    }
}

#define XB_TMO      128
#define XB_XCNT(j)  (256  + 64 * (j))
#define XB_XSUB(j)  (1280 + 64 * (j))
#define XB_XGEN(j)  (2304 + 64 * (j))
#define XB_TOP      3328
#define XB_TOPGEN   3392
#define XCD_BAR_WORDS 3456
#define XB_SPIN_CAP (1u << 22)
#define LAS __attribute__((address_space(3)))
__device__ __forceinline__ unsigned xb_ld(unsigned* p)              { return __hip_atomic_load(p, __ATOMIC_RELAXED, __HIP_MEMORY_SCOPE_AGENT); }
__device__ __forceinline__ unsigned xb_add(unsigned* p, unsigned v) { return __hip_atomic_fetch_add(p, v, __ATOMIC_RELAXED, __HIP_MEMORY_SCOPE_AGENT); }
__device__ __forceinline__ unsigned xb_xcc_id() { return (unsigned)__builtin_amdgcn_s_getreg((3 << 11) | 20) & 0xFu; }
#define XB_SPIN(cond, bar) do { unsigned _sp = 0; while (cond) { __builtin_amdgcn_s_sleep(1); \
    if ((++_sp & 255u) == 0u) { if (xb_ld(&(bar)[XB_TMO])) break; if (_sp > XB_SPIN_CAP) { atomicAdd(&(bar)[XB_TMO], 1u); break; } } } } while (0)
struct XcdBarrier { unsigned* bar; unsigned x; volatile LAS unsigned* st; };
__device__ __forceinline__ XcdBarrier xcd_barrier_post(unsigned* bar, volatile LAS unsigned* st) {
    XcdBarrier b; b.bar = bar; b.x = xb_xcc_id(); b.st = st;
    if (threadIdx.x == 0) (void)xb_add(&bar[XB_XCNT(b.x)], 1u);
    return b;
}
__device__ __forceinline__ void xcd_barrier_complete(unsigned* bar, unsigned x, unsigned& nloc, unsigned& nx) {
    const unsigned G = gridDim.x * gridDim.y * gridDim.z;
    unsigned sum, cnt, mine, sp = 0u;
    for (;;) {
        sum = 0u; cnt = 0u; mine = 0u;
#pragma unroll
        for (unsigned j = 0; j < 16; ++j) { const unsigned c = xb_ld(&bar[XB_XCNT(j)]); sum += c; cnt += (c > 0u) ? 1u : 0u; mine = (j == x) ? c : mine; }
        if (sum == G) break;
        __builtin_amdgcn_s_sleep(1);
        if ((++sp & 255u) == 0u) { if (xb_ld(&bar[XB_TMO])) break; if (sp > XB_SPIN_CAP) { atomicAdd(&bar[XB_TMO], 1u); break; } }
    }
    nloc = mine > 0u ? mine : 1u; nx = cnt > 0u ? cnt : 1u;
}
__device__ __forceinline__ void xcd_barrier(const XcdBarrier& b) {
    asm volatile("s_waitcnt vmcnt(0)" ::: "memory");
    __syncthreads();
    if (threadIdx.x == 0) {
        unsigned* bar = b.bar;
        __builtin_amdgcn_s_waitcnt(0);
        unsigned nloc = b.st[0], nx = b.st[1];
        if (nloc == 0u) { xcd_barrier_complete(bar, b.x, nloc, nx); b.st[0] = nloc; b.st[1] = nx; }
        const unsigned old = xb_add(&bar[XB_XSUB(b.x)], 1u);
        const unsigned gen = old / nloc;
        if (old + 1u == (gen + 1u) * nloc) {
            __builtin_amdgcn_fence(__ATOMIC_RELEASE, "agent");
            asm volatile("s_waitcnt vmcnt(0)" ::: "memory");
            const unsigned og = xb_add(&bar[XB_TOP], 1u);
            const unsigned tg = og / nx;
            if (og + 1u == (tg + 1u) * nx) xb_add(&bar[XB_TOPGEN], 1u);
            else XB_SPIN(xb_ld(&bar[XB_TOPGEN]) == tg, bar);
            __builtin_amdgcn_fence(__ATOMIC_ACQUIRE, "agent");
            xb_add(&bar[XB_XGEN(b.x)], 1u);
            asm volatile("s_waitcnt vmcnt(0)" ::: "memory");
        } else {
            XB_SPIN(xb_ld(&bar[XB_XGEN(b.x)]) == gen, bar);
            __builtin_amdgcn_fence(__ATOMIC_ACQUIRE, "agent");
            asm volatile("s_waitcnt vmcnt(0)" ::: "memory");
        }
    }
    __syncthreads();
}

constexpr int NPHASE = 9;
template <int PH> __device__ __forceinline__ void run_phase(const Params& P, char* smem) {
    int tid_ = threadIdx.x; asm volatile("" : "+v"(tid_));
    const int bid = blockIdx.x, G = gridDim.x, tid = tid_;
    const size_t gtid = (size_t)bid * 256 + tid, gsize = (size_t)G * 256;
    if (PH == 0) {
        for (int it = bid; it < MODP_KC * 32; it += G) modp_item(P, it, smem);
        float (*tile)[65] = (float (*)[65])smem;
        for (int it = bid; it < 1088; it += G) transpose_tile(P.w_in, DM, PROJW, P.WinT(), it, tile);
        for (int it = bid; it < 128; it += G) transpose_tile(P.w_ao, 512, DM, P.WaoT(), it, tile);
        for (int it = bid; it < 128; it += G) transpose_tile(P.w_co, 512, DM, P.WcoT(), it, tile);
        for (int it = bid; it < 256; it += G) transpose_tile(P.w_mix, DM, DM, P.WmixT(), it, tile);
        for (int it = bid; it < 512; it += G) transpose_tile(P.pw_q, DM, 2048, P.PwqT(), it, tile);
        cvt_range(P.keys, P.KeysB(), (size_t)16 * 128 * 128 / 8, gtid, gsize);
        { const int lane = tid & 63, wid = tid >> 6;
          for (int r = bid * 4 + wid; r < NEXP; r += G * 4) {
              f32x4 va[4], vb[4];
              load_row16(P.pu + (size_t)r * DM, lane, va); load_row16(P.pv + (size_t)r * DM, lane, vb);
              quant_row(va, (unsigned char*)P.Uq() + (size_t)r * 512, P.su() + r, lane, 0);
              quant_row(vb, P.Vq() + (size_t)r * 512, P.sv() + r, lane, 128); } }
        rope_tab(P, (int)gtid, (int)gsize);
    } else if (PH == 1) {
        for (int i = (int)gtid; i < 17 * NMOD; i += (int)gsize) {
            float v = P.b_mod[i % NMOD];
#pragma unroll
            for (int kc = 0; kc < MODP_KC; ++kc) v += P.modp()[(size_t)kc * 17 * NMOD + i];
            P.mod()[i] = v;
        }
        if (NTOK % G == 0 && SEQ % (NTOK / G) == 0 && NCTX % G == 0) {
            norm1_rows(P, false, bid * (NTOK / G), NTOK / G, smem);
            norm1_rows(P, true, bid * (NCTX / G), NCTX / G, smem);
        } else {
            for (int it = bid; it < 1152; it += G) { const bool isctx = it >= 1024; norm1_rows(P, isctx, isctx ? (it - 1024) * 32 : it * 32, 32, smem); }
        }
    } else if (PH == 2) {
        for (int t = bid; t < 128 * 18 + 32; t += G) {
            if (t < 128 * 18) { int mt, nt; tile_coords(t, 128, 18, mt, nt); gemm_tile<MODE_INPROJ, 8>(P, P.H(), DM, P.WinT(), DM, DM, mt * 256, nt * 128, nt * 128 >= 768, smem); }
            else { const int u = t - 128 * 18, mt = u >> 1, nt = u & 1; gemm_tile<MODE_CTXKV, 8>(P, P.HC(), DM, P.WinT() + (size_t)512 * DM, DM, DM, mt * 256, nt * 128, nt == 0, smem); }
        }
    } else if (PH == 3) {
        const int nG = 128 * 16, nA = NB * 16 * 8;
        int tg = bid, ta = bid;
        bool gemm_turn = (bid & 1) == 0;
        while (tg < nG || ta < nA) {
            if ((gemm_turn && tg < nG) || ta >= nA) {
                int mt, nt; tile_coords(tg, 128, 16, mt, nt);
                gemm_tile<MODE_INPROJ, 8>(P, P.H(), DM, P.WinT(), DM, DM, mt * 256, (18 + nt) * 128, true, smem);
                tg += G;
            } else { attn_item(P, ta); ta += G; }
            gemm_turn = !gemm_turn;
        }
        conv_range(P, gtid, gsize);
    } else if (PH == 4) {
        for (int t = bid; t < 128 * 8; t += G) { int mt, nt; tile_coords(t, 128, 8, mt, nt); gemm_tile<MODE_AO1, 8>(P, P.AO(), 512, P.WaoT(), 512, 512, mt * 256, nt * 128, true, smem, 0); }
        for (int t = bid; t < 128 * 8; t += G) { int mt, nt; tile_coords(t, 128, 8, mt, nt); gemm_tile<MODE_AO1, 8>(P, P.CA(), 512, P.WcoT(), 512, 512, mt * 256, nt * 128, true, smem, 1); }
    } else if (PH == 5) {
        for (int t = bid; t < 128 * 8; t += G) { int mt, nt; tile_coords(t, 128, 8, mt, nt); gemm_tile<MODE_MIX, 8>(P, P.YG(), DM, P.WmixT(), DM, DM, mt * 256, nt * 128, true, smem); }
    } else if (PH == 6) {
        const int lane = tid & 63, wid = tid >> 6;
        float* sc = (float*)smem; float* sh = sc + DM;
        for (int it = bid; it < NTOK / 64; it += G) {
            const int row0 = it * 64, b = row0 / SEQ;
            __syncthreads();
            for (int d = tid; d < DM; d += 256) { sc[d] = P.mod()[(size_t)b * NMOD + 4 * DM + d]; sh[d] = P.mod()[(size_t)b * NMOD + 3 * DM + d]; }
            __syncthreads();
            for (int i = wid; i < 64; i += 8) {
                const int ra = row0 + i, rb = ra + 4;
                f32x4 va[4], vb[4];
                load_row4_bf(P.X1() + (size_t)ra * DM, lane, va); load_row4_bf(P.X1() + (size_t)rb * DM, lane, vb);
                norm_row_q(va, P.n2, sc, sh, P.H2() + (size_t)ra * DM, P.H2q() + (size_t)ra * DM, P.sh2() + ra, lane);
                norm_row_q(vb, P.n2, sc, sh, P.H2() + (size_t)rb * DM, P.H2q() + (size_t)rb * DM, P.sh2() + rb, lane);
            }
        }
    } else if (PH == 7) {
        for (int it = bid; it < 256 * 8; it += G) peer_retrieve_item(P, it >> 3, it & 7, smem);
    } else if (PH == 8) {
        const int lane = tid & 63, wid = tid >> 6;
        for (int t = bid * 4 + wid; t < NTOK; t += G * 4) peer_uh_token<0>(P, t, lane);
        asm volatile("s_waitcnt vmcnt(0)" ::: "memory");
        for (int t = bid * 4 + wid; t < NTOK; t += G * 4) peer_uh_token<1>(P, t, lane);
    } else if (PH == 9) {
        const int lane = tid & 63, wid = tid >> 6;
        for (int t = bid * 4 + wid; t < NTOK; t += G * 4) peer_vh_token<0>(P, t, lane);
        asm volatile("s_waitcnt vmcnt(0)" ::: "memory");
        for (int t = bid * 4 + wid; t < NTOK; t += G * 4) peer_vh_token<1>(P, t, lane);
    }
}
#ifndef REP0
#define REP0 1
#endif
#ifndef REP1
#define REP1 1
#endif
#ifndef REP2
#define REP2 1
#endif
#ifndef REP3
#define REP3 1
#endif
#ifndef REP4
#define REP4 1
#endif
#ifndef REP5
#define REP5 1
#endif
#ifndef REP6
#define REP6 1
#endif
#ifndef REP7
#define REP7 1
#endif
#ifndef REP8
#define REP8 1
#endif
#ifndef REP9
#define REP9 1
#endif
#ifndef REP10
#define REP10 1
#endif
constexpr int MEGA_LDS = 3 * (2048 * 8 + 8192);
__global__ void __launch_bounds__(256, 2) k_mega(Params P) {
    extern __shared__ __attribute__((aligned(16))) char smem[];
    volatile LAS unsigned* st = (volatile LAS unsigned*)(smem + MEGA_LDS);
    if (threadIdx.x < 4) st[threadIdx.x] = 0u;
    __syncthreads();
    const XcdBarrier bar = xcd_barrier_post(P.bar(), st);
#define PHASE_SYNC(k) for (int rep = 0; rep < REP##k; ++rep) { run_phase<k>(P, smem); xcd_barrier(bar); }
    PHASE_SYNC(0) PHASE_SYNC(1) PHASE_SYNC(2) PHASE_SYNC(3) PHASE_SYNC(4) PHASE_SYNC(5) PHASE_SYNC(6) PHASE_SYNC(7)
    PHASE_SYNC(8)
    run_phase<9>(P, smem);
}


extern "C" void kernel_launch(void* const* d_in, const int* in_sizes, int n_in, void* d_out, int out_size, void* d_ws, size_t ws_size, hipStream_t stream) {
    Params P{};
    P.x = (const float*)d_in[0]; P.c = (const float*)d_in[1]; P.ctx = (const float*)d_in[2]; P.c_ctx = (const float*)d_in[3];
    P.w_mod = (const float*)d_in[4]; P.b_mod = (const float*)d_in[5]; P.n1 = (const float*)d_in[6]; P.n2 = (const float*)d_in[7];
    P.w_in = (const float*)d_in[8]; P.sink = (const float*)d_in[9]; P.conv_w = (const float*)d_in[10]; P.w_ao = (const float*)d_in[11];
    P.w_co = (const float*)d_in[12]; P.w_mix = (const float*)d_in[13]; P.pw_q = (const float*)d_in[14]; P.keys = (const float*)d_in[15];
    P.pu = (const float*)d_in[16]; P.pv = (const float*)d_in[17]; P.fg = (const float*)d_in[18];
    P.out = (float*)d_out;
    P.ws = (char*)d_ws;
    if (WS_NEED > ws_size) { fprintf(stderr, "kernel_launch: workspace too small: need %zu have %zu\n", (size_t)WS_NEED, ws_size); return; }

    static int grid_blocks = 0;
    if (!grid_blocks) {
        int dev = 0, cus = 0, per_cu = 0;
        (void)hipGetDevice(&dev);
        (void)hipDeviceGetAttribute(&cus, hipDeviceAttributeMultiprocessorCount, dev);
        (void)hipFuncSetAttribute((const void*)k_mega, hipFuncAttributeMaxDynamicSharedMemorySize, MEGA_LDS + 16);
        (void)hipOccupancyMaxActiveBlocksPerMultiprocessor(&per_cu, (const void*)k_mega, 256, MEGA_LDS + 16);
        if (per_cu > 2) per_cu = 2;
        if (per_cu < 1) { fprintf(stderr, "kernel_launch: occupancy query returned %d\n", per_cu); per_cu = 1; }
        grid_blocks = cus * per_cu;
    }
    (void)hipMemsetAsync(P.bar(), 0, (size_t)XCD_BAR_WORDS * 4, stream);
    void* args[] = { &P };
    hipError_t e = hipLaunchCooperativeKernel((const void*)k_mega, dim3(grid_blocks), dim3(256), args, MEGA_LDS + 16, stream);
    if (e != hipSuccess) fprintf(stderr, "cooperative launch failed: %s (grid %d)\n", hipGetErrorString(e), grid_blocks);
}
```

```cpp
#include <hip/hip_runtime.h>
#include <cstdio>
#include <cstdint>

typedef unsigned short bf16_t;
typedef short bf16x8 __attribute__((ext_vector_type(8)));
typedef float f32x4 __attribute__((ext_vector_type(4)));
typedef unsigned u32x4 __attribute__((ext_vector_type(4)));
typedef unsigned u32x2 __attribute__((ext_vector_type(2)));

constexpr int DM = 1024, NB = 16, SEQ = 2048, NTOK = NB * SEQ, CTXL = 256, NCTX = NB * CTXL;
constexpr int PROJW = 4352;
constexpr int NMOD = 6 * DM;
constexpr int NEXP = 16384;

__device__ __forceinline__ float bf2f(bf16_t x) { return __uint_as_float(((unsigned)x) << 16); }
__device__ __forceinline__ bf16_t f2bf(float f) {
    unsigned u = __float_as_uint(f);
    u += 0x7fffu + ((u >> 16) & 1u);
    return (bf16_t)(u >> 16);
}
__device__ __forceinline__ unsigned pk2(float lo, float hi) { unsigned r; asm("v_cvt_pk_bf16_f32 %0, %1, %2" : "=v"(r) : "v"(lo), "v"(hi)); return r; }
__device__ __forceinline__ float sigmoidf_(float x) { return 1.f / (1.f + __expf(-x)); }
__device__ __forceinline__ float wave_sum(float v) {
#pragma unroll
    for (int o = 1; o < 64; o <<= 1) v += __shfl_xor(v, o);
    return v;
}

__device__ __forceinline__ float wave_max(float v) {
#pragma unroll
    for (int o = 1; o < 64; o <<= 1) v = fmaxf(v, __shfl_xor(v, o));
    return v;
}
__device__ __forceinline__ unsigned q8(float x, float inv, int bias) {
    int q = (int)rintf(x * inv); q = q > 127 ? 127 : (q < -127 ? -127 : q);
    return (unsigned)((q + bias) & 0xff);
}
__device__ __forceinline__ void load_row16(const float* src, int lane, f32x4 (&v)[4]) {
#pragma unroll
    for (int j = 0; j < 4; ++j) v[j] = *(const f32x4*)(src + 16 * lane + 4 * j);
}
__device__ __forceinline__ void quant_row(f32x4 (&v)[4], unsigned char* dst, float* scale_out, int lane, int bias) {
    float amax = 0.f;
#pragma unroll
    for (int j = 0; j < 4; ++j) amax = fmaxf(amax, fmaxf(fmaxf(fabsf(v[j].x), fabsf(v[j].y)), fmaxf(fabsf(v[j].z), fabsf(v[j].w))));
    amax = wave_max(amax);
    const float sc = amax > 0.f ? amax * (1.f / 127.f) : 1.f, inv = 1.f / sc;
    u32x4 w;
    w.x = q8(v[0].x, inv, bias) | (q8(v[0].y, inv, bias) << 8) | (q8(v[0].z, inv, bias) << 16) | (q8(v[0].w, inv, bias) << 24);
    w.y = q8(v[1].x, inv, bias) | (q8(v[1].y, inv, bias) << 8) | (q8(v[1].z, inv, bias) << 16) | (q8(v[1].w, inv, bias) << 24);
    w.z = q8(v[2].x, inv, bias) | (q8(v[2].y, inv, bias) << 8) | (q8(v[2].z, inv, bias) << 16) | (q8(v[2].w, inv, bias) << 24);
    w.w = q8(v[3].x, inv, bias) | (q8(v[3].y, inv, bias) << 8) | (q8(v[3].z, inv, bias) << 16) | (q8(v[3].w, inv, bias) << 24);
    *(u32x4*)(dst + (size_t)(lane >> 5) * ((size_t)NEXP * 512) + 16 * (lane & 31)) = w;
    if (lane == 0) *scale_out = sc;
}

constexpr size_t al256(size_t x) { return (x + 255) & ~(size_t)255; }
constexpr int MODP_KC = 16;
constexpr int XCD_BAR_WORDS_C = 3456;
constexpr size_t O_modp = 0;
constexpr size_t O_mod = O_modp + al256((size_t)MODP_KC * 17 * NMOD * 4);
constexpr size_t O_rope = O_mod + al256((size_t)17 * NMOD * 4);
constexpr size_t O_WinT = O_rope + al256(3072 * 4);
constexpr size_t O_WaoT = O_WinT + al256((size_t)PROJW * DM * 2);
constexpr size_t O_WcoT = O_WaoT + al256((size_t)DM * 512 * 2);
constexpr size_t O_WmixT = O_WcoT + al256((size_t)DM * 512 * 2);
constexpr size_t O_PwqT = O_WmixT + al256((size_t)DM * DM * 2);
constexpr size_t O_KeysB = O_PwqT + al256((size_t)2048 * DM * 2);
constexpr size_t O_Uq = O_KeysB + al256((size_t)16 * 128 * 128 * 2);
constexpr size_t O_Vq = O_Uq + al256((size_t)NEXP * DM);
constexpr size_t O_su = O_Vq + al256((size_t)NEXP * DM);
constexpr size_t O_sv = O_su + al256((size_t)NEXP * 4);
constexpr size_t O_sh2 = O_sv + al256((size_t)NEXP * 4);
constexpr size_t O_HC = O_sh2 + al256((size_t)NTOK * 4);
constexpr size_t O_regA = O_HC + al256((size_t)NCTX * DM * 2);
constexpr size_t O_H = O_regA, O_YG = O_regA, O_H2 = O_regA;
constexpr size_t O_regB = O_regA + al256((size_t)NTOK * DM * 2);
constexpr size_t O_Q = O_regB;
constexpr size_t O_K = O_Q + al256((size_t)NTOK * 512 * 2);
constexpr size_t O_VT = O_K + al256((size_t)NTOK * 128 * 2);
constexpr size_t O_Kc = O_VT + al256((size_t)NTOK * 128 * 2);
constexpr size_t O_VcT = O_Kc + al256((size_t)NCTX * 128 * 2);
constexpr size_t O_regC = O_VcT + al256((size_t)NCTX * 128 * 2);
constexpr size_t O_GB = O_regC;
constexpr size_t O_GC = O_GB + al256((size_t)NTOK * 512 * 2);
constexpr size_t O_U = O_GC + al256((size_t)NTOK * 512 * 2);
constexpr size_t O_M1 = O_regC, O_cbuf = O_regC, O_pd = O_regC + (size_t)NTOK * 128 * 4, O_ssq = O_regC + (size_t)2 * NTOK * 128 * 4;
constexpr size_t O_regD = O_U + al256((size_t)NTOK * 512 * 2);
constexpr size_t O_GA = O_regD;
constexpr size_t O_GV = O_GA + al256((size_t)NTOK * DM * 2);
constexpr size_t O_X1 = O_regD;
constexpr size_t O_AO = O_GV + al256((size_t)NTOK * DM * 2);
constexpr size_t O_H2q = O_AO;
constexpr size_t O_CA = O_AO + al256((size_t)NTOK * 512 * 2);
constexpr size_t O_bar = O_CA + al256((size_t)NTOK * 512 * 2);
constexpr size_t WS_NEED = O_bar + al256((size_t)XCD_BAR_WORDS_C * 4);
constexpr size_t O_sel_idx = O_regB;
constexpr size_t O_sel_g = O_sel_idx + al256((size_t)NTOK * 128 * 4);
static_assert(O_sel_g + (size_t)NTOK * 128 * 4 <= O_regC, "late buffers overflow region B");
static_assert(O_ssq + (size_t)NTOK * 4 <= O_regD, "region C overflow");

struct Params {
    const float *x, *c, *ctx, *c_ctx, *w_mod, *b_mod, *n1, *n2, *w_in, *sink, *conv_w, *w_ao, *w_co, *w_mix, *pw_q, *keys, *pu, *pv, *fg;
    float* out;
    char* ws;
#define WSF(T, name) __host__ __device__ __forceinline__ T* name() const { return (T*)(ws + O_##name); }
    WSF(float, modp) WSF(float, mod) WSF(float, rope)
    WSF(bf16_t, WinT) WSF(bf16_t, WaoT) WSF(bf16_t, WcoT) WSF(bf16_t, WmixT) WSF(bf16_t, PwqT) WSF(bf16_t, KeysB)
    WSF(bf16_t, H) WSF(bf16_t, HC) WSF(bf16_t, Q) WSF(bf16_t, K) WSF(bf16_t, VT) WSF(bf16_t, Kc) WSF(bf16_t, VcT) WSF(bf16_t, GB) WSF(bf16_t, GC) WSF(bf16_t, U)
    WSF(bf16_t, AO) WSF(bf16_t, CA) WSF(bf16_t, M1) WSF(bf16_t, YG) WSF(bf16_t, H2) WSF(bf16_t, X1)
    WSF(unsigned char, GA) WSF(unsigned char, GV) WSF(unsigned char, Vq) WSF(signed char, Uq) WSF(signed char, H2q)
    WSF(int, sel_idx) WSF(float, sel_g) WSF(unsigned, bar) WSF(float, su) WSF(float, sv) WSF(float, sh2) WSF(float, cbuf) WSF(float, ssq) WSF(int, pd)
#undef WSF
};

__device__ __forceinline__ void modp_item(const Params& P, int item, char* smem) {
    float (*s)[64] = (float (*)[64])smem;
    const int kc = item >> 5, nc = item & 31;
    __syncthreads();
    for (int i = threadIdx.x; i < 17 * 64; i += 256) {
        const int r = i >> 6, k = i & 63;
        const float v = (r < 16) ? P.c[r * DM + kc * 64 + k] : P.c_ctx[kc * 64 + k];
        s[r][k] = v / (1.f + __expf(-v));
    }
    __syncthreads();
    if (threadIdx.x < 192) {
        const int n = nc * 192 + threadIdx.x;
        float acc[17];
#pragma unroll
        for (int r = 0; r < 17; ++r) acc[r] = 0.f;
#pragma unroll 8
        for (int k = 0; k < 64; ++k) {
            const float w = P.w_mod[(size_t)(kc * 64 + k) * NMOD + n];
#pragma unroll
            for (int r = 0; r < 17; ++r) acc[r] += s[r][k] * w;
        }
#pragma unroll
        for (int r = 0; r < 17; ++r) P.modp()[((size_t)kc * 17 + r) * NMOD + n] = acc[r];
    }
}
__device__ __forceinline__ void cvt_range(const float* src, bf16_t* dst, size_t n8, size_t gtid, size_t gsize) {
    for (size_t i = gtid; i < n8; i += gsize) {
        const f32x4 a = *(const f32x4*)(src + i * 8), b = *(const f32x4*)(src + i * 8 + 4);
        u32x4 o; o.x = pk2(a.x, a.y); o.y = pk2(a.z, a.w); o.z = pk2(b.x, b.y); o.w = pk2(b.z, b.w);
        *(u32x4*)(dst + i * 8) = o;
    }
}
__device__ __forceinline__ void rope_tab(const Params& P, int gtid, int gsize) {
    for (int i = gtid; i < 1536; i += gsize) {
        int pos, f; bool isc;
        if (i < 512) { pos = i / 16; f = i % 16; isc = false; } else { pos = (i - 512) / 16; f = (i - 512) % 16; isc = true; }
        const double inv = pow(10000.0, -(double)f / 16.0);
        const double ang = (double)pos * inv;
        const float cv = (float)cos(ang), sv = (float)sin(ang);
        if (!isc) { P.rope()[pos * 16 + f] = cv; P.rope()[512 + pos * 16 + f] = sv; }
        else { P.rope()[1024 + pos * 16 + f] = cv; P.rope()[2048 + pos * 16 + f] = sv; }
    }
}
__device__ __forceinline__ void transpose_tile(const float* W, int K, int N, bf16_t* Wt, int item, float (*tile)[65]) {
    const int ntn = N / 64, kt = item / ntn, nt = item % ntn, k0 = kt * 64, n0 = nt * 64;
    const int tx = threadIdx.x & 63, ty = threadIdx.x >> 6;
    __syncthreads();
#pragma unroll
    for (int i = 0; i < 16; ++i) { const int k = i * 4 + ty; tile[k][tx] = W[(size_t)(k0 + k) * N + n0 + tx]; }
    __syncthreads();
#pragma unroll
    for (int i = 0; i < 16; ++i) { const int n = i * 4 + ty; Wt[(size_t)(n0 + n) * K + k0 + tx] = f2bf(tile[tx][n]); }
}

__device__ __forceinline__ void load_row4_bf(const bf16_t* xr, int lane, f32x4 (&v)[4]) {
#pragma unroll
    for (int j = 0; j < 4; ++j) { const u32x2 w = *(const u32x2*)(xr + j * 256 + lane * 4);
        v[j].x = bf2f(w.x & 0xffff); v[j].y = bf2f(w.x >> 16); v[j].z = bf2f(w.y & 0xffff); v[j].w = bf2f(w.y >> 16); }
}
__device__ __forceinline__ void load_row4(const float* xr, int lane, f32x4 (&v)[4]) {
#pragma unroll
    for (int j = 0; j < 4; ++j) v[j] = *(const f32x4*)(xr + j * 256 + lane * 4);
}
__device__ __forceinline__ void norm_row(f32x4 (&v)[4], const float* g, const float* scale, const float* shift, bf16_t* dst, int lane) {
    float s = 0.f;
#pragma unroll
    for (int j = 0; j < 4; ++j) s += v[j].x * v[j].x + v[j].y * v[j].y + v[j].z * v[j].z + v[j].w * v[j].w;
    s = wave_sum(s);
    const float rstd = rsqrtf(s * (1.f / DM) + 1e-6f);
#pragma unroll
    for (int j = 0; j < 4; ++j) {
        const int d = j * 256 + lane * 4;
        const f32x4 gg = *(const f32x4*)(g + d), sc = *(const f32x4*)(scale + d), sh = *(const f32x4*)(shift + d);
        const float y0 = v[j].x * rstd * gg.x * (1.f + sc.x) + sh.x;
        const float y1 = v[j].y * rstd * gg.y * (1.f + sc.y) + sh.y;
        const float y2 = v[j].z * rstd * gg.z * (1.f + sc.z) + sh.z;
        const float y3 = v[j].w * rstd * gg.w * (1.f + sc.w) + sh.w;
        u32x2 o; o.x = pk2(y0, y1); o.y = pk2(y2, y3);
        *(u32x2*)(dst + d) = o;
    }
}

__device__ __forceinline__ void norm_row_q(f32x4 (&v)[4], const float* g, const float* scale, const float* shift, bf16_t* dst, signed char* dq, float* sq, int lane) {
    float s = 0.f;
#pragma unroll
    for (int j = 0; j < 4; ++j) s += v[j].x * v[j].x + v[j].y * v[j].y + v[j].z * v[j].z + v[j].w * v[j].w;
    s = wave_sum(s);
    const float rstd = rsqrtf(s * (1.f / DM) + 1e-6f);
    float amax = 0.f;
#pragma unroll
    for (int j = 0; j < 4; ++j) {
        const int d = j * 256 + lane * 4;
        const f32x4 gg = *(const f32x4*)(g + d), sc = *(const f32x4*)(scale + d), sh = *(const f32x4*)(shift + d);
        v[j].x = v[j].x * rstd * gg.x * (1.f + sc.x) + sh.x;
        v[j].y = v[j].y * rstd * gg.y * (1.f + sc.y) + sh.y;
        v[j].z = v[j].z * rstd * gg.z * (1.f + sc.z) + sh.z;
        v[j].w = v[j].w * rstd * gg.w * (1.f + sc.w) + sh.w;
        u32x2 o; o.x = pk2(v[j].x, v[j].y); o.y = pk2(v[j].z, v[j].w);
        *(u32x2*)(dst + d) = o;
        amax = fmaxf(amax, fmaxf(fmaxf(fabsf(v[j].x), fabsf(v[j].y)), fmaxf(fabsf(v[j].z), fabsf(v[j].w))));
    }
    amax = wave_max(amax);
    const float qs = amax > 0.f ? amax * (1.f / 127.f) : 1.f, inv = 1.f / qs;
#pragma unroll
    for (int j = 0; j < 4; ++j) {
        const unsigned w = q8(v[j].x, inv, 0) | (q8(v[j].y, inv, 0) << 8) | (q8(v[j].z, inv, 0) << 16) | (q8(v[j].w, inv, 0) << 24);
        *(unsigned*)(dq + j * 256 + lane * 4) = w;
    }
    if (lane == 0) *sq = qs;
}

__device__ __forceinline__ void norm1_rows(const Params& P, bool isctx, int row0, int nrows, char* smem) {
    float* sc = (float*)smem; float* sh = sc + DM;
    const int r = isctx ? 16 : row0 / SEQ;
    __syncthreads();
    for (int d = threadIdx.x; d < DM; d += 256) {
        float a = P.b_mod[DM + d], b = P.b_mod[d];
#pragma unroll
        for (int kc = 0; kc < MODP_KC; ++kc) { a += P.modp()[((size_t)kc * 17 + r) * NMOD + DM + d]; b += P.modp()[((size_t)kc * 17 + r) * NMOD + d]; }
        sc[d] = a; sh[d] = b;
    }
    __syncthreads();
    const int lane = threadIdx.x & 63, wid = threadIdx.x >> 6;
    const float* srcb = isctx ? P.ctx : P.x; bf16_t* dstb = isctx ? P.HC() : P.H();
    for (int i = wid; i < nrows; i += 8) {
        const int ra = row0 + i, rb = row0 + i + 4; const bool hb = (i + 4) < nrows;
        f32x4 va[4], vb[4];
        load_row4(srcb + (size_t)ra * DM, lane, va); if (hb) load_row4(srcb + (size_t)rb * DM, lane, vb);
        norm_row(va, P.n1, sc, sh, dstb + (size_t)ra * DM, lane);
        if (hb) norm_row(vb, P.n1, sc, sh, dstb + (size_t)rb * DM, lane);
    }
}
#define UB0(x) ((float)((x) & 0xffu))
#define UB1(x) ((float)(((x) >> 8) & 0xffu))
#define UB2(x) ((float)(((x) >> 16) & 0xffu))
#define UB3(x) ((float)((x) >> 24))
enum { MODE_INPROJ = 0, MODE_CTXKV = 1, MODE_AO1 = 2, MODE_MIX = 4 };

__device__ __forceinline__ void st8bf(bf16_t* p, const float* v) {
    u32x4 o; o.x = pk2(v[0], v[1]); o.y = pk2(v[2], v[3]); o.z = pk2(v[4], v[5]); o.w = pk2(v[6], v[7]);
    *(u32x4*)p = o;
}
__device__ __forceinline__ void st8bf_nt(bf16_t* p, const float* v) {
    u32x4 o; o.x = pk2(v[0], v[1]); o.y = pk2(v[2], v[3]); o.z = pk2(v[4], v[5]); o.w = pk2(v[6], v[7]);
    __builtin_nontemporal_store(o, (u32x4*)p);
}
__device__ __forceinline__ void st4bf(bf16_t* p, const float* v) {
    u32x2 o; o.x = pk2(v[0], v[1]); o.y = pk2(v[2], v[3]);
    *(u32x2*)p = o;
}
template <int MODE> __device__ __forceinline__ void epi8(const Params& P, int m, int n, const float* v, int aux) {
    if (MODE == MODE_INPROJ) {
        if (n < 1280) st8bf_nt(P.GB() + (size_t)m * 512 + (n - 768), v);
        else if (n < 1792) st8bf_nt(P.GC() + (size_t)m * 512 + (n - 1280), v);
        else if (n < 2304) st8bf_nt(P.U() + (size_t)m * 512 + (n - 1792), v);
        else {
            unsigned q[8];
#pragma unroll
            for (int j = 0; j < 8; ++j) q[j] = (unsigned)__builtin_rintf(255.f * sigmoidf_(v[j]));
            u32x2 w; w.x = q[0] | (q[1] << 8) | (q[2] << 16) | (q[3] << 24); w.y = q[4] | (q[5] << 8) | (q[6] << 16) | (q[7] << 24);
            unsigned char* gp = (n < 3328) ? (P.GA() + (size_t)m * DM + (n - 2304)) : (P.GV() + (size_t)m * DM + (n - 3328));
            __builtin_nontemporal_store(w, (u32x2*)gp);
        }
    } else if (MODE == MODE_CTXKV) {
        { const int b = m / CTXL, c = m % CTXL, kvh = n >> 6, d0 = n & 63;
          st8bf(P.Kc() + ((((size_t)((b * 2 + kvh) * 8 + (c >> 5)) * 4 + (d0 >> 4)) * 2 + ((d0 >> 3) & 1)) * 32 + (c & 31)) * 8, v); }
    } else if (MODE == MODE_AO1) {
        const u32x2 g = *(const u32x2*)((aux ? P.GV() : P.GA()) + (size_t)m * DM + n);
        u32x4 a = (u32x4){0u, 0u, 0u, 0u};
        if (aux) a = *(const u32x4*)(P.M1() + (size_t)m * DM + n);
        const float k255 = 1.f / 255.f;
        float o[8];
        o[0] = bf2f(a.x & 0xffff) + v[0] * (k255 * UB0(g.x)); o[1] = bf2f(a.x >> 16) + v[1] * (k255 * UB1(g.x));
        o[2] = bf2f(a.y & 0xffff) + v[2] * (k255 * UB2(g.x)); o[3] = bf2f(a.y >> 16) + v[3] * (k255 * UB3(g.x));
        o[4] = bf2f(a.z & 0xffff) + v[4] * (k255 * UB0(g.y)); o[5] = bf2f(a.z >> 16) + v[5] * (k255 * UB1(g.y));
        o[6] = bf2f(a.w & 0xffff) + v[6] * (k255 * UB2(g.y)); o[7] = bf2f(a.w >> 16) + v[7] * (k255 * UB3(g.y));
        st8bf((aux ? P.YG() : P.M1()) + (size_t)m * DM + n, o);
    } else if (MODE == MODE_MIX) {
        const int b = m / SEQ;
        const float* g1 = P.mod() + (size_t)b * NMOD + 2 * DM + n;
        const float* xr = P.x + (size_t)m * DM + n;
        const f32x4 x0 = *(const f32x4*)xr, x1 = *(const f32x4*)(xr + 4), g0 = *(const f32x4*)g1, g1v = *(const f32x4*)(g1 + 4);
        float o[8];
        o[0] = x0.x + g0.x * v[0]; o[1] = x0.y + g0.y * v[1]; o[2] = x0.z + g0.z * v[2]; o[3] = x0.w + g0.w * v[3];
        o[4] = x1.x + g1v.x * v[4]; o[5] = x1.y + g1v.y * v[5]; o[6] = x1.z + g1v.z * v[6]; o[7] = x1.w + g1v.w * v[7];
        st8bf(P.X1() + (size_t)m * DM + n, o);
    }
}
__device__ __forceinline__ void epi_rope(const Params& P, int m, int n, const float* lo, const float* hi) {
    const int d0 = n & 63;
    const int l = m % SEQ;
    const float *ct, *st;
    if (d0 < 16) { const int row = l >> 6; ct = P.rope() + row * 16 + d0; st = P.rope() + 512 + row * 16 + d0; }
    else { const int col = l & 63; ct = P.rope() + 1024 + col * 16 + (d0 - 32); st = P.rope() + 2048 + col * 16 + (d0 - 32); }
    float a[4], b[4];
    const float sc = (n < 512) ? 0.125f * 1.44269504088896f : 1.f;
#pragma unroll
    for (int j = 0; j < 4; ++j) { const float cc = ct[j], ss = st[j]; a[j] = (lo[j] * cc - hi[j] * ss) * sc; b[j] = (lo[j] * ss + hi[j] * cc) * sc; }
    if (n < 512) { st4bf(P.Q() + (size_t)m * 512 + n, a); st4bf(P.Q() + (size_t)m * 512 + n + 16, b); }
    else { const int bb = m / SEQ, kvh = (n - 512) >> 6;
        bf16_t* kp = P.K() + ((((size_t)((bb * 2 + kvh) * 64 + (l >> 5)) * 4 + (d0 >> 4)) * 2 + ((d0 >> 3) & 1)) * 32 + (l & 31)) * 8 + (d0 & 7);
        st4bf(kp, a); st4bf(kp + 512, b); }
}
__device__ __forceinline__ void epi_v4(const Params& P, int m, int dcol, const float* v, bool ctx) {
    const int kvh = dcol >> 6, dd = dcol & 63;
    if (!ctx) { const int b = m / SEQ, l = m % SEQ;
#pragma unroll
        for (int j = 0; j < 4; ++j) {
            const int kk = l & 31;
            P.VT()[(((((size_t)((b * 2 + kvh) * 64 + (l >> 5)) * 2 + (dd >> 5)) * 2 + (kk >> 4)) * 2 + ((kk >> 2) & 1)) * 32 + ((dd & 31) + j)) * 8 + 4 * ((kk >> 3) & 1) + (kk & 3)] = f2bf(v[j]); }
    } else { const int b = m / CTXL, cpos = m % CTXL;
#pragma unroll
        for (int j = 0; j < 4; ++j) {
            const int kk = cpos & 31;
            P.VcT()[(((((size_t)((b * 2 + kvh) * 8 + (cpos >> 5)) * 2 + (dd >> 5)) * 2 + (kk >> 4)) * 2 + ((kk >> 2) & 1)) * 32 + ((dd & 31) + j)) * 8 + 4 * ((kk >> 3) & 1) + (kk & 3)] = f2bf(v[j]); }
    }
}

constexpr int GEMM_LDS = 65536;
constexpr int RETR_LDS = 128 * 130 * 4;
__device__ __forceinline__ int lds_off(int row, int chunk) { return row * 128 + ((chunk ^ ((row >> 1) & 7)) << 4); }

__device__ __forceinline__ void mma_from_lds(const char* As, const char* Bs, f32x4 (&acc)[4][4], int wm, int wn, int fr, int fq, int sw) {
#pragma unroll
    for (int ks = 0; ks < 2; ++ks) {
        bf16x8 af[4], bfr[4];
        const int coff = ((ks * 4 + fq) ^ sw) << 4;
#pragma unroll
        for (int mt = 0; mt < 4; ++mt) af[mt] = *(const bf16x8*)(As + (wm * 64 + mt * 16 + fr) * 128 + coff);
#pragma unroll
        for (int nt = 0; nt < 4; ++nt) bfr[nt] = *(const bf16x8*)(Bs + (wn * 64 + nt * 16 + fr) * 128 + coff);
#pragma unroll
        for (int mt = 0; mt < 4; ++mt)
#pragma unroll
            for (int nt = 0; nt < 4; ++nt) acc[mt][nt] = __builtin_amdgcn_mfma_f32_16x16x32_bf16(bfr[nt], af[mt], acc[mt][nt], 0, 0, 0);
    }
}
template <int MT, int NST>
__device__ __forceinline__ void gemm_ring(const bf16_t* __restrict__ A, int lda, const bf16_t* __restrict__ Bt, int ldb, int K, int m0, int n0, bool perm, char* smem, f32x4 (&acc)[MT][4]) {
    constexpr int SA = 2048 * MT, SB = SA + 8192, GA = MT / 2, GL = GA + 2;
    const int tid = threadIdx.x, lane = tid & 63, wid = __builtin_amdgcn_readfirstlane(tid >> 6);
    const int wm = wid >> 1, wn = wid & 1, fr = lane & 15, fq = lane >> 4;
    const int c8 = ((lane & 3) ^ (3 * ((lane >> 4) & 1))) * 8;
    unsigned aoff[GA], boff[2];
#pragma unroll
    for (int i = 0; i < GA; ++i) aoff[i] = (unsigned)(((wid + 4 * i) * 16 + (lane >> 2)) * lda + c8) * 2u;
#pragma unroll
    for (int i = 0; i < 2; ++i) {
        const int row = (wid + 4 * i) * 16 + (lane >> 2);
        int brow = row;
        if (perm) { const int g = row >> 6, rr = row & 63, nn = rr >> 4, j = rr & 15; brow = 64 * g + 16 * (j >> 2) + 4 * nn + (j & 3); }
        boff[i] = (unsigned)(brow * ldb + c8) * 2u;
    }
    const char* Abase = (const char*)(A + (size_t)m0 * lda);
    const char* Bbase = (const char*)(Bt + (size_t)n0 * ldb);
#pragma unroll
    for (int i = 0; i < MT; ++i)
#pragma unroll
        for (int j = 0; j < 4; ++j) acc[i][j] = (f32x4){0.f, 0.f, 0.f, 0.f};
#define RSTAGE_(buf, k0) { char* sb_ = smem + (buf) * SB; const char* ab_ = Abase + (size_t)(k0) * 2; const char* bb_ = Bbase + (size_t)(k0) * 2; \
        _Pragma("unroll") for (int i = 0; i < GA; ++i) __builtin_amdgcn_global_load_lds((const unsigned*)(ab_ + aoff[i]), (unsigned*)(sb_ + (wid + 4 * i) * 1024), 16, 0, 0); \
        _Pragma("unroll") for (int i = 0; i < 2; ++i) __builtin_amdgcn_global_load_lds((const unsigned*)(bb_ + boff[i]), (unsigned*)(sb_ + SA + (wid + 4 * i) * 1024), 16, 0, 0); }
    const int nk = K / 32;
    asm volatile("s_waitcnt vmcnt(0)" ::: "memory");
#pragma unroll
    for (int s = 0; s < NST - 1; ++s) RSTAGE_(s, s * 32)
    const int coff = (fq ^ (3 * ((fr >> 2) & 1))) << 4;
    int cur = 0, nxt = NST - 1;
#pragma unroll 1
    for (int kt = 0; kt < nk; ++kt) {
        const int rem = nk - 1 - kt;
        if (rem >= NST - 2) asm volatile("s_waitcnt vmcnt(%0)" :: "n"(GL * (NST - 2)) : "memory");
        else if (NST == 4 && rem == 1) asm volatile("s_waitcnt vmcnt(%0)" :: "n"(GL) : "memory");
        else asm volatile("s_waitcnt vmcnt(0)" ::: "memory");
        __builtin_amdgcn_s_barrier();
        const char* As = smem + cur * SB;
        const char* Bs = As + SA;
        bf16x8 af[MT], bfr[4];
#pragma unroll
        for (int mt = 0; mt < MT; ++mt) af[mt] = *(const bf16x8*)(As + (wm * 16 * MT + mt * 16 + fr) * 64 + coff);
#pragma unroll
        for (int nt = 0; nt < 4; ++nt) bfr[nt] = *(const bf16x8*)(Bs + (wn * 64 + nt * 16 + fr) * 64 + coff);
        const bool more = (kt + NST - 1 < nk);
        char* sb_ = smem + nxt * SB; const char* ab_ = Abase + (size_t)((kt + NST - 1) * 32) * 2; const char* bb_ = Bbase + (size_t)((kt + NST - 1) * 32) * 2;
        __builtin_amdgcn_s_setprio(1);
#pragma unroll
        for (int mt = 0; mt < MT; ++mt) {
#pragma unroll
            for (int nt = 0; nt < 4; ++nt) acc[mt][nt] = __builtin_amdgcn_mfma_f32_16x16x32_bf16(bfr[nt], af[mt], acc[mt][nt], 0, 0, 0);
            if (more) {
                if (mt < GA) __builtin_amdgcn_global_load_lds((const unsigned*)(ab_ + aoff[mt]), (unsigned*)(sb_ + (wid + 4 * mt) * 1024), 16, 0, 0);
                else if (mt < GA + 2) __builtin_amdgcn_global_load_lds((const unsigned*)(bb_ + boff[mt - GA]), (unsigned*)(sb_ + SA + (wid + 4 * (mt - GA)) * 1024), 16, 0, 0);
            }
        }
        __builtin_amdgcn_s_setprio(0);
        cur = (cur + 1 == NST) ? 0 : cur + 1;
        nxt = (nxt + 1 == NST) ? 0 : nxt + 1;
    }
#undef RSTAGE_
    __syncthreads();
}

template <int MODE, int MT>
__device__ __forceinline__ void gemm_tile(const Params& P, const bf16_t* __restrict__ A, int lda, const bf16_t* __restrict__ Bt, int ldb, int K, int m0, int n0, bool perm, char* smem, int aux = 0) {
    const int lane = threadIdx.x & 63, wid = threadIdx.x >> 6;
    const int wm = wid >> 1, wn = wid & 1, fr = lane & 15, fq = lane >> 4;
    f32x4 acc[MT][4];
    gemm_ring<MT, (MT == 8 ? 3 : 4)>(A, lda, Bt, ldb, K, m0, n0, perm, smem, acc);
#pragma unroll
    for (int mt = 0; mt < MT; ++mt) {
        const int m = m0 + wm * 16 * MT + mt * 16 + fr;
        if (perm) {
            const int nb = n0 + wn * 64 + 16 * fq;
            if (MODE == MODE_INPROJ && n0 >= 2304) {
                unsigned q[16];
#pragma unroll
                for (int nt = 0; nt < 4; ++nt)
#pragma unroll
                    for (int r = 0; r < 4; ++r) q[4 * nt + r] = (unsigned)__builtin_rintf(255.f * sigmoidf_(acc[mt][nt][r]));
                u32x4 w;
                w.x = q[0] | (q[1] << 8) | (q[2] << 16) | (q[3] << 24); w.y = q[4] | (q[5] << 8) | (q[6] << 16) | (q[7] << 24);
                w.z = q[8] | (q[9] << 8) | (q[10] << 16) | (q[11] << 24); w.w = q[12] | (q[13] << 8) | (q[14] << 16) | (q[15] << 24);
                unsigned char* gp = (nb < 3328) ? (P.GA() + (size_t)m * DM + (nb - 2304)) : (P.GV() + (size_t)m * DM + (nb - 3328));
                __builtin_nontemporal_store(w, (u32x4*)gp);
            } else {
#pragma unroll
                for (int p = 0; p < 2; ++p) {
                    float v[8] = { acc[mt][2 * p][0], acc[mt][2 * p][1], acc[mt][2 * p][2], acc[mt][2 * p][3], acc[mt][2 * p + 1][0], acc[mt][2 * p + 1][1], acc[mt][2 * p + 1][2], acc[mt][2 * p + 1][3] };
                    epi8<MODE>(P, m, nb + 8 * p, v, aux);
                }
            }
        } else if (MODE == MODE_INPROJ && n0 < 640) {
#pragma unroll
            for (int p = 0; p < 2; ++p) {
                float lo[4] = { acc[mt][2 * p][0], acc[mt][2 * p][1], acc[mt][2 * p][2], acc[mt][2 * p][3] };
                float hi[4] = { acc[mt][2 * p + 1][0], acc[mt][2 * p + 1][1], acc[mt][2 * p + 1][2], acc[mt][2 * p + 1][3] };
                epi_rope(P, m, n0 + wn * 64 + 32 * p + 4 * fq, lo, hi);
            }
        } else if (MODE == MODE_INPROJ || MODE == MODE_CTXKV) {
            const int dbase = (MODE == MODE_INPROJ) ? (n0 - 640) : (n0 - 128);
#pragma unroll
            for (int nt = 0; nt < 4; ++nt) {
                float v[4] = { acc[mt][nt][0], acc[mt][nt][1], acc[mt][nt][2], acc[mt][nt][3] };
                epi_v4(P, m, dbase + wn * 64 + 16 * nt + 4 * fq, v, MODE == MODE_CTXKV);
            }
        }
        asm volatile("" ::: "memory"); __builtin_amdgcn_sched_barrier(0);
    }
}
__device__ __forceinline__ void tile_coords(int t, int ntm, int ntn, int& mt, int& nt) {
    const int per = 8 * ntn, g = t / per, r = t % per;
    mt = g * 8 + (r & 7); nt = r >> 3;
}
#define CEU(a, b) { const unsigned _t = (a) > (b) ? (a) : (b); (b) = (a) > (b) ? (b) : (a); (a) = _t; }
__device__ __forceinline__ void sort16_desc(unsigned (&v)[16]) {
    CEU(v[0], v[1]); CEU(v[2], v[3]); CEU(v[0], v[2]); CEU(v[1], v[3]); CEU(v[1], v[2]); CEU(v[4], v[5]);
    CEU(v[6], v[7]); CEU(v[4], v[6]); CEU(v[5], v[7]); CEU(v[5], v[6]); CEU(v[0], v[4]); CEU(v[2], v[6]);
    CEU(v[2], v[4]); CEU(v[1], v[5]); CEU(v[3], v[7]); CEU(v[3], v[5]); CEU(v[1], v[2]); CEU(v[3], v[4]);
    CEU(v[5], v[6]); CEU(v[8], v[9]); CEU(v[10], v[11]); CEU(v[8], v[10]); CEU(v[9], v[11]); CEU(v[9], v[10]);
    CEU(v[12], v[13]); CEU(v[14], v[15]); CEU(v[12], v[14]); CEU(v[13], v[15]); CEU(v[13], v[14]); CEU(v[8], v[12]);
    CEU(v[10], v[14]); CEU(v[10], v[12]); CEU(v[9], v[13]); CEU(v[11], v[15]); CEU(v[11], v[13]); CEU(v[9], v[10]);
    CEU(v[11], v[12]); CEU(v[13], v[14]); CEU(v[0], v[8]); CEU(v[4], v[12]); CEU(v[4], v[8]); CEU(v[2], v[10]);
    CEU(v[6], v[14]); CEU(v[6], v[10]); CEU(v[2], v[4]); CEU(v[6], v[8]); CEU(v[10], v[12]); CEU(v[1], v[9]);
    CEU(v[5], v[13]); CEU(v[5], v[9]); CEU(v[3], v[11]); CEU(v[7], v[15]); CEU(v[7], v[11]); CEU(v[3], v[5]);
    CEU(v[7], v[9]); CEU(v[11], v[13]); CEU(v[1], v[2]); CEU(v[3], v[4]); CEU(v[5], v[6]); CEU(v[7], v[8]);
    CEU(v[9], v[10]); CEU(v[11], v[12]); CEU(v[13], v[14]);
}
__device__ __forceinline__ void bitonic16_desc(unsigned (&v)[16]) {
    CEU(v[0], v[8]); CEU(v[1], v[9]); CEU(v[2], v[10]); CEU(v[3], v[11]); CEU(v[4], v[12]); CEU(v[5], v[13]);
    CEU(v[6], v[14]); CEU(v[7], v[15]); CEU(v[0], v[4]); CEU(v[1], v[5]); CEU(v[2], v[6]); CEU(v[3], v[7]);
    CEU(v[8], v[12]); CEU(v[9], v[13]); CEU(v[10], v[14]); CEU(v[11], v[15]); CEU(v[0], v[2]); CEU(v[1], v[3]);
    CEU(v[4], v[6]); CEU(v[5], v[7]); CEU(v[8], v[10]); CEU(v[9], v[11]); CEU(v[12], v[14]); CEU(v[13], v[15]);
    CEU(v[0], v[1]); CEU(v[2], v[3]); CEU(v[4], v[5]); CEU(v[6], v[7]); CEU(v[8], v[9]); CEU(v[10], v[11]);
    CEU(v[12], v[13]); CEU(v[14], v[15]);
}

__device__ __forceinline__ unsigned enc_key(float f) { const unsigned b = __float_as_uint(f); return b ^ ((unsigned)((int)b >> 31) | 0x80000000u); }
__device__ __forceinline__ float dec_key(unsigned k) { const unsigned b = (k & 0x80000000u) ? (k & 0x7fffffffu) : ~k; return __uint_as_float(b); }
__device__ __forceinline__ void topmerge16(unsigned (&top)[16], const unsigned (&L)[16]) {
#pragma unroll
    for (int i = 0; i < 16; ++i) top[i] = top[i] > L[15 - i] ? top[i] : L[15 - i];
    bitonic16_desc(top);
}
__device__ __forceinline__ unsigned cand_key(float a, float b, int i, int j) { return (enc_key(a + b) & ~0xFFu) | (unsigned)(i << 4) | (unsigned)j; }

__device__ __forceinline__ void peer_retrieve_item(const Params& P, int mtile, int h, char* smem) {
    const int tid = threadIdx.x, lane = tid & 63, wid = tid >> 6;
    const int wm = wid >> 1, wn = wid & 1, fr = lane & 15, fq = lane >> 4;
    const int sw = (fr >> 1) & 7;
    const int m0 = mtile * 128;
    unsigned T0[16], T1[16];
#pragma unroll 1
    for (int p = 0; p < 2; ++p) {
        const int hp = h * 2 + p;
        f32x4 acc[4][4];
        gemm_ring<4, 4>(P.H2(), DM, P.PwqT(), DM, DM, m0, hp * 128, false, smem, acc);
#pragma unroll
        for (int mt = 0; mt < 4; ++mt)
#pragma unroll
            for (int nt = 0; nt < 4; ++nt) {
                const int row = wm * 64 + mt * 16 + fr;
                u32x2 o; o.x = pk2(acc[mt][nt][0], acc[mt][nt][1]); o.y = pk2(acc[mt][nt][2], acc[mt][nt][3]);
                *(u32x2*)(smem + wn * 32768 + lds_off(row, 2 * nt + (fq >> 1)) + (fq & 1) * 8) = o;
            }
        {
            const int srow = tid >> 3, schunk = tid & 7;
            const bf16_t* kb = P.KeysB() + (size_t)hp * 128 * 128;
#pragma unroll
            for (int hf = 0; hf < 2; ++hf)
#pragma unroll
                for (int q = 0; q < 4; ++q) {
                    const int row = q * 32 + srow;
                    const u32x4 v = *(const u32x4*)(kb + (size_t)row * 128 + hf * 64 + schunk * 8);
                    *(u32x4*)(smem + hf * 32768 + 16384 + lds_off(row, schunk)) = v;
                }
        }
        __syncthreads();
#pragma unroll
        for (int i = 0; i < 4; ++i)
#pragma unroll
            for (int j = 0; j < 4; ++j) acc[i][j] = (f32x4){0.f, 0.f, 0.f, 0.f};
        mma_from_lds(smem, smem + 16384, acc, wm, wn, fr, fq, sw);
        mma_from_lds(smem + 32768, smem + 32768 + 16384, acc, wm, wn, fr, fq, sw);
        __syncthreads();
        float* sc = (float*)smem;
#pragma unroll
        for (int mt = 0; mt < 4; ++mt)
#pragma unroll
            for (int nt = 0; nt < 4; ++nt) {
                const int row = wm * 64 + mt * 16 + fr;
#pragma unroll
                for (int r = 0; r < 4; ++r) {
                    const int col = wn * 64 + nt * 16 + fq * 4 + r;
                    sc[row * 130 + wn * 65 + (col & 63)] = acc[mt][nt][r];
                }
            }
        __syncthreads();
        {
            const int row = tid >> 1, half = tid & 1;
            const float* rp = sc + row * 130 + half * 65;
            unsigned top[16];
#pragma unroll 1
            for (int g = 0; g < 4; ++g) {
                unsigned L[16];
#pragma unroll
                for (int j = 0; j < 16; ++j) { const int col = half * 64 + g * 16 + j; L[j] = (enc_key(rp[g * 16 + j]) & ~0x7Fu) | (unsigned)col; }
                sort16_desc(L);
                if (g == 0) {
#pragma unroll
                    for (int j = 0; j < 16; ++j) top[j] = L[j];
                } else topmerge16(top, L);
            }
            unsigned Bp[16];
#pragma unroll
            for (int j = 0; j < 16; ++j) Bp[j] = (unsigned)__shfl_xor((int)top[j], 1);
            topmerge16(top, Bp);
            if (p == 0) {
#pragma unroll
                for (int j = 0; j < 16; ++j) T0[j] = top[j];
            } else {
#pragma unroll
                for (int j = 0; j < 16; ++j) T1[j] = top[j];
            }
        }
        __syncthreads();
    }
    {
        const int row = tid >> 1;
        unsigned char* slot = (unsigned char*)smem + row * 32;
        if ((tid & 1) == 0) {
#pragma unroll
            for (int j = 0; j < 16; ++j) { slot[j] = (unsigned char)(T0[j] & 0x7Fu); slot[16 + j] = (unsigned char)(T1[j] & 0x7Fu); }
            float a[16], b[16];
#pragma unroll
            for (int j = 0; j < 16; ++j) { a[j] = dec_key(T0[j]); b[j] = dec_key(T1[j]); }
            unsigned LA[16], LB[16], LC[16];
#pragma unroll
            for (int j = 0; j < 16; ++j) LA[j] = cand_key(a[0], b[j], 0, j);
#pragma unroll
            for (int j = 0; j < 8; ++j) LB[j] = cand_key(a[1], b[j], 1, j);
#pragma unroll
            for (int j = 0; j < 8; ++j) LB[8 + j] = cand_key(a[15 - j], b[0], 15 - j, 0);
            LC[0] = cand_key(a[2], b[0], 2, 0); LC[1] = cand_key(a[2], b[1], 2, 1); LC[2] = cand_key(a[2], b[2], 2, 2); LC[3] = cand_key(a[2], b[3], 2, 3); LC[4] = cand_key(a[2], b[4], 2, 4);
            LC[5] = cand_key(a[3], b[0], 3, 0); LC[6] = cand_key(a[3], b[1], 3, 1); LC[7] = cand_key(a[3], b[2], 3, 2); LC[8] = cand_key(a[3], b[3], 3, 3);
            LC[9] = cand_key(a[4], b[0], 4, 0); LC[10] = cand_key(a[4], b[1], 4, 1); LC[11] = cand_key(a[4], b[2], 4, 2);
            LC[12] = cand_key(a[5], b[0], 5, 0); LC[13] = cand_key(a[5], b[1], 5, 1);
            LC[14] = cand_key(a[6], b[0], 6, 0); LC[15] = cand_key(a[6], b[1], 6, 1);
            const unsigned d0 = cand_key(a[7], b[0], 7, 0), d1 = cand_key(a[7], b[1], 7, 1);
            bitonic16_desc(LB);
            sort16_desc(LC);
            topmerge16(LA, LB);
            LC[15] = LC[15] > d0 ? LC[15] : d0; LC[14] = LC[14] > d1 ? LC[14] : d1;
            bitonic16_desc(LC);
            topmerge16(LA, LC);
            float e[16], den = 0.f; const float vmax = dec_key(LA[0]);
#pragma unroll
            for (int r = 0; r < 16; ++r) { e[r] = __expf(dec_key(LA[r]) - vmax); den += e[r]; }
            const float inv = 1.f / den;
            const int t = m0 + row;
            int* oi = P.sel_idx() + (size_t)t * 128 + h * 16; float* og = P.sel_g() + (size_t)t * 128 + h * 16;
#pragma unroll
            for (int r = 0; r < 16; ++r) {
                const int i = (LA[r] >> 4) & 15, j = LA[r] & 15;
                oi[r] = (int)slot[i] * 128 + (int)slot[16 + j];
                og[r] = e[r] * inv;
            }
        }
    }
    __syncthreads();
}
typedef float f32x16 __attribute__((ext_vector_type(16)));
struct AttnFrag { u32x4 k[4]; u32x4 v[2][2]; };
__device__ __forceinline__ void attn_load(const Params& P, int b, int kvh, int qb, int w, int blk, int r, int hh, AttnFrag& f) {
    const bf16_t* kp; const bf16_t* vp;
    if (blk < 9) {
        int kpos0 = (qb - 1) * 128 + 32 * (w + blk);
        if (kpos0 < 0 || kpos0 >= SEQ) kpos0 = 0;
        const size_t blkoff = (size_t)((b * 2 + kvh) * 64 + (kpos0 >> 5)) * 2048 + (hh * 32 + r) * 8;
        kp = P.K() + blkoff; vp = P.VT() + blkoff;
    } else {
        const size_t blkoff = (size_t)((b * 2 + kvh) * 8 + (blk - 9)) * 2048 + (hh * 32 + r) * 8;
        kp = P.Kc() + blkoff; vp = P.VcT() + blkoff;
    }
#pragma unroll
    for (int ks = 0; ks < 4; ++ks) f.k[ks] = *(const u32x4*)(kp + 512 * ks);
#pragma unroll
    for (int db = 0; db < 2; ++db)
#pragma unroll
        for (int s = 0; s < 2; ++s) f.v[db][s] = *(const u32x4*)(vp + 512 * (db * 2 + s));
}
__device__ __forceinline__ void attn_item(const Params& P, int item) {
    const int w = item & 3, kvh = (item >> 2) & 1, qb = (item >> 3) & 15, b = item >> 7;
    const int lane = threadIdx.x & 63, head = kvh * 4 + (int)(threadIdx.x >> 6), r = lane & 31, hh = lane >> 5;
    const int tok = b * SEQ + qb * 128 + 32 * w + r;
    bf16x8 qf[4];
    { const bf16_t* qp = P.Q() + (size_t)tok * 512 + head * 64 + 8 * hh;
#pragma unroll
      for (int ks = 0; ks < 4; ++ks) qf[ks] = *(const bf16x8*)(qp + 16 * ks); }
    f32x16 o0, o1;
#pragma unroll
    for (int i = 0; i < 16; ++i) { o0[i] = 0.f; o1[i] = 0.f; }
    float mrun = P.sink[head] * 1.44269504088896f, lrun = (hh == 0) ? 1.f : 0.f;
    AttnFrag cur, nxt;
    attn_load(P, b, kvh, qb, w, 0, r, hh, cur);
    for (int blk = 0; blk < 17; ++blk) {
        if (blk + 1 < 17) attn_load(P, b, kvh, qb, w, blk + 1, r, hh, nxt);
        int lo = 0, hi = 31;
        if (blk < 9) {
            const int kpos0 = (qb - 1) * 128 + 32 * (w + blk);
            if (kpos0 < 0 || kpos0 >= SEQ) lo = 64;
            else if (blk == 0) lo = r;
            else if (blk == 8) hi = r;
        }
        f32x16 s;
#pragma unroll
        for (int i = 0; i < 16; ++i) s[i] = 0.f;
#pragma unroll
        for (int ks = 0; ks < 4; ++ks) s = __builtin_amdgcn_mfma_f32_32x32x16_bf16(*(const bf16x8*)&cur.k[ks], qf[ks], s, 0, 0, 0);
        if (lo != 0 || hi != 31) {
#pragma unroll
            for (int i = 0; i < 16; ++i) { const int kk = (i & 3) + 8 * (i >> 2) + 4 * hh; const bool ok = (kk >= lo) && (kk <= hi); s[i] = ok ? s[i] : -3.0e38f; }
        }
        float mb = s[0];
#pragma unroll
        for (int i = 1; i < 16; ++i) mb = fmaxf(mb, s[i]);
        mb = fmaxf(mb, __shfl_xor(mb, 32));
        if (!__all(mb - mrun <= 8.f)) {
            const float mn = fmaxf(mrun, mb);
            const float alpha = __builtin_amdgcn_exp2f(mrun - mn);
            lrun *= alpha; mrun = mn;
#pragma unroll
            for (int i = 0; i < 16; ++i) { o0[i] *= alpha; o1[i] *= alpha; }
        }
        float ps = 0.f; float p[16];
#pragma unroll
        for (int i = 0; i < 16; ++i) { p[i] = __builtin_amdgcn_exp2f(s[i] - mrun); ps += p[i]; }
        lrun += ps;
        u32x4 pb[2];
        pb[0].x = pk2(p[0], p[1]); pb[0].y = pk2(p[2], p[3]); pb[0].z = pk2(p[4], p[5]); pb[0].w = pk2(p[6], p[7]);
        pb[1].x = pk2(p[8], p[9]); pb[1].y = pk2(p[10], p[11]); pb[1].z = pk2(p[12], p[13]); pb[1].w = pk2(p[14], p[15]);
#pragma unroll
        for (int sI = 0; sI < 2; ++sI) {
            const u32x4 va = cur.v[0][sI], vb = cur.v[1][sI];
            o0 = __builtin_amdgcn_mfma_f32_32x32x16_bf16(*(const bf16x8*)&va, *(const bf16x8*)&pb[sI], o0, 0, 0, 0);
            o1 = __builtin_amdgcn_mfma_f32_32x32x16_bf16(*(const bf16x8*)&vb, *(const bf16x8*)&pb[sI], o1, 0, 0, 0);
        }
        if (blk + 1 < 17) cur = nxt;
    }
    const float ltot = lrun + __shfl_xor(lrun, 32);
    const float inv = 1.f / ltot;
    bf16_t* op = P.AO() + (size_t)tok * 512 + head * 64 + 4 * hh;
#pragma unroll
    for (int g = 0; g < 4; ++g) {
        float t0[4] = { o0[4 * g] * inv, o0[4 * g + 1] * inv, o0[4 * g + 2] * inv, o0[4 * g + 3] * inv };
        float t1[4] = { o1[4 * g] * inv, o1[4 * g + 1] * inv, o1[4 * g + 2] * inv, o1[4 * g + 3] * inv };
        st4bf(op + 8 * g, t0); st4bf(op + 32 + 8 * g, t1);
    }
}

__device__ __forceinline__ void conv_range(const Params& P, size_t gtid, size_t gsize) {
    for (size_t idx = gtid; idx < (size_t)NTOK * 64; idx += gsize) {
        const int m = (int)(idx >> 6), c0 = (int)(idx & 63) * 8, l = m % SEQ;
        float cu[3][8];
#pragma unroll
        for (int t = 0; t < 3; ++t) {
            const int ll = l + t - 1;
            if (ll < 0 || ll >= SEQ) {
#pragma unroll
                for (int j = 0; j < 8; ++j) cu[t][j] = 0.f;
            } else {
                const u32x4 g = *(const u32x4*)(P.GC() + (size_t)(m + t - 1) * 512 + c0), u = *(const u32x4*)(P.U() + (size_t)(m + t - 1) * 512 + c0);
                cu[t][0] = bf2f(g.x & 0xffff) * bf2f(u.x & 0xffff); cu[t][1] = bf2f(g.x >> 16) * bf2f(u.x >> 16);
                cu[t][2] = bf2f(g.y & 0xffff) * bf2f(u.y & 0xffff); cu[t][3] = bf2f(g.y >> 16) * bf2f(u.y >> 16);
                cu[t][4] = bf2f(g.z & 0xffff) * bf2f(u.z & 0xffff); cu[t][5] = bf2f(g.z >> 16) * bf2f(u.z >> 16);
                cu[t][6] = bf2f(g.w & 0xffff) * bf2f(u.w & 0xffff); cu[t][7] = bf2f(g.w >> 16) * bf2f(u.w >> 16);
            }
        }
        const u32x4 gbv = *(const u32x4*)(P.GB() + (size_t)m * 512 + c0);
        const float gb[8] = { bf2f(gbv.x & 0xffff), bf2f(gbv.x >> 16), bf2f(gbv.y & 0xffff), bf2f(gbv.y >> 16), bf2f(gbv.z & 0xffff), bf2f(gbv.z >> 16), bf2f(gbv.w & 0xffff), bf2f(gbv.w >> 16) };
        float o[8];
#pragma unroll
        for (int j = 0; j < 8; ++j) o[j] = gb[j] * (P.conv_w[c0 + j] * cu[0][j] + P.conv_w[512 + c0 + j] * cu[1][j] + P.conv_w[1024 + c0 + j] * cu[2][j]);
        st8bf(P.CA() + (size_t)m * 512 + c0, o);
    }
}

__device__ __forceinline__ void unpack8(const u32x4 v, float* f) {
    f[0] = bf2f(v.x & 0xffff); f[1] = bf2f(v.x >> 16); f[2] = bf2f(v.y & 0xffff); f[3] = bf2f(v.y >> 16);
    f[4] = bf2f(v.z & 0xffff); f[5] = bf2f(v.z >> 16); f[6] = bf2f(v.w & 0xffff); f[7] = bf2f(v.w >> 16);
}
__device__ __forceinline__ float gelu_erf(float d) { return 0.5f * d * (1.f + erff(d * 0.70710678118654752f)); }
__device__ __forceinline__ int reduce64i(int (&part)[64], int lane) {
#pragma unroll
    for (int i = 0; i < 32; ++i) { auto r = __builtin_amdgcn_permlane32_swap((unsigned)part[i], (unsigned)part[32 + i], false, false); part[i] = (int)r[0] + (int)r[1]; }
#pragma unroll
    for (int i = 0; i < 16; ++i) { auto r = __builtin_amdgcn_permlane16_swap((unsigned)part[i], (unsigned)part[16 + i], false, false); part[i] = (int)r[0] + (int)r[1]; }
#define RSTAGE(N) { const bool up = (lane & N) != 0; _Pragma("unroll") for (int i = 0; i < N; ++i) { const int keep = up ? part[N + i] : part[i], send = up ? part[i] : part[N + i]; part[i] = keep + __shfl_xor(send, N); } }
    RSTAGE(8) RSTAGE(4) RSTAGE(2) RSTAGE(1)
#undef RSTAGE
    return part[0];
}
template <int HALF>
__device__ __forceinline__ void peer_uh_token(const Params& P, int t, int lane) {
    const u32x2 hq = *(const u32x2*)(P.H2q() + (size_t)t * DM + HALF * 512 + 8 * lane);
    const signed char* ub = P.Uq() + (size_t)HALF * NEXP * 512 + 8 * lane;
    const float sh = P.sh2()[t];
#pragma unroll 1
    for (int hf = 0; hf < 2; ++hf) {
        const int myidx = P.sel_idx()[(size_t)t * 128 + hf * 64 + lane];
        u32x2 rows[2][8];
        int part[64];
#define ULOAD(bt) { _Pragma("unroll") for (int q = 0; q < 8; ++q) { const int e = __builtin_amdgcn_readlane(myidx, (bt) * 8 + q); rows[(bt) & 1][q] = *(const u32x2*)(ub + (size_t)e * 512); } }
#define UDOT(bt) { _Pragma("unroll") for (int q = 0; q < 8; ++q) { const u32x2 a = rows[(bt) & 1][q]; \
        part[(bt) * 8 + q] = __builtin_amdgcn_sdot4((int)a.y, (int)hq.y, __builtin_amdgcn_sdot4((int)a.x, (int)hq.x, 0, false), false); } }
        ULOAD(0)
        ULOAD(1) UDOT(0)
        ULOAD(2) UDOT(1)
        ULOAD(3) UDOT(2)
        ULOAD(4) UDOT(3)
        ULOAD(5) UDOT(4)
        ULOAD(6) UDOT(5)
        ULOAD(7) UDOT(6)
        UDOT(7)
#undef ULOAD
#undef UDOT
        const int isum = reduce64i(part, lane);
        const size_t o = (size_t)t * 128 + hf * 64 + lane;
        if (HALF == 0) P.pd()[o] = isum;
        else P.cbuf()[o] = P.sel_g()[o] * gelu_erf((float)(isum + P.pd()[o]) * P.su()[myidx] * sh) * P.sv()[myidx];
    }
}
template <int HALF>
__device__ __forceinline__ void peer_vh_token(const Params& P, int t, int lane) {
    const int b = t / SEQ;
    float acc[8];
#pragma unroll
    for (int j = 0; j < 8; ++j) acc[j] = 0.f;
    const int idlo = P.sel_idx()[(size_t)t * 128 + lane], idhi = P.sel_idx()[(size_t)t * 128 + 64 + lane];
    const float clo = P.cbuf()[(size_t)t * 128 + lane], chi = P.cbuf()[(size_t)t * 128 + 64 + lane];
    const float cb = 128.f * wave_sum(clo + chi);
    const unsigned char* vb = P.Vq() + (size_t)HALF * NEXP * 512 + 8 * lane;
    u32x2 rows[2][8];
#define VLOAD(bt) { _Pragma("unroll") for (int q = 0; q < 8; ++q) { const int e = __builtin_amdgcn_readlane((bt) < 8 ? idlo : idhi, ((bt) & 7) * 8 + q); rows[(bt) & 1][q] = *(const u32x2*)(vb + (size_t)e * 512); } }
#define VCOMP(bt) { _Pragma("unroll") for (int q = 0; q < 8; ++q) { \
        const float ck = __uint_as_float(__builtin_amdgcn_readlane(__float_as_uint((bt) < 8 ? clo : chi), ((bt) & 7) * 8 + q)); const u32x2 x = rows[(bt) & 1][q]; \
        acc[0] += ck * UB0(x.x); acc[1] += ck * UB1(x.x); acc[2] += ck * UB2(x.x); acc[3] += ck * UB3(x.x); \
        acc[4] += ck * UB0(x.y); acc[5] += ck * UB1(x.y); acc[6] += ck * UB2(x.y); acc[7] += ck * UB3(x.y); \
        __builtin_amdgcn_sched_barrier(0); } }
    VLOAD(0)
    VLOAD(1) VCOMP(0)
    VLOAD(2) VCOMP(1)
    VLOAD(3) VCOMP(2)
    VLOAD(4) VCOMP(3)
    VLOAD(5) VCOMP(4)
    VLOAD(6) VCOMP(5)
    VLOAD(7) VCOMP(6)
    VLOAD(8) VCOMP(7)
    VLOAD(9) VCOMP(8)
    VLOAD(10) VCOMP(9)
    VLOAD(11) VCOMP(10)
    VLOAD(12) VCOMP(11)
    VLOAD(13) VCOMP(12)
    VLOAD(14) VCOMP(13)
    VLOAD(15) VCOMP(14)
    VCOMP(15)
#undef VLOAD
#undef VCOMP
    const int col0 = HALF * 512 + 8 * lane;
    float x2[8]; float ss = 0.f;
    { const u32x4 xw = *(const u32x4*)(P.X1() + (size_t)t * DM + col0);
      const float* g2 = P.mod() + (size_t)b * NMOD + 5 * DM + col0;
      const f32x4 ga = *(const f32x4*)g2, gb = *(const f32x4*)(g2 + 4);
      x2[0] = bf2f(xw.x & 0xffff) + ga.x * (acc[0] - cb); x2[1] = bf2f(xw.x >> 16) + ga.y * (acc[1] - cb);
      x2[2] = bf2f(xw.y & 0xffff) + ga.z * (acc[2] - cb); x2[3] = bf2f(xw.y >> 16) + ga.w * (acc[3] - cb);
      x2[4] = bf2f(xw.z & 0xffff) + gb.x * (acc[4] - cb); x2[5] = bf2f(xw.z >> 16) + gb.y * (acc[5] - cb);
      x2[6] = bf2f(xw.w & 0xffff) + gb.z * (acc[6] - cb); x2[7] = bf2f(xw.w >> 16) + gb.w * (acc[7] - cb); }
#pragma unroll
    for (int j = 0; j < 8; ++j) ss += x2[j] * x2[j];
    ss = wave_sum(ss);
    float* orow = P.out + (size_t)t * DM;
    if (HALF == 0) {
        *(f32x4*)(orow + col0) = (f32x4){ x2[0], x2[1], x2[2], x2[3] }; *(f32x4*)(orow + col0 + 4) = (f32x4){ x2[4], x2[5], x2[6], x2[7] };
        if (lane == 0) P.ssq()[t] = ss;
    } else {
        const float rstd = rsqrtf((ss + P.ssq()[t]) * (1.f / DM) + 1e-6f);
        const f32x4 fa = *(const f32x4*)(P.fg + col0), fb = *(const f32x4*)(P.fg + col0 + 4);
        *(f32x4*)(orow + col0) = (f32x4){ x2[0] * rstd * fa.x, x2[1] * rstd * fa.y, x2[2] * rstd * fa.z, x2[3] * rstd * fa.w };
        *(f32x4*)(orow + col0 + 4) = (f32x4){ x2[4] * rstd * fb.x, x2[5] * rstd * fb.y, x2[6] * rstd * fb.z, x2[7] * rstd * fb.w };
        const int c1 = 8 * lane;
        const f32x4 va = *(const f32x4*)(orow + c1), vb2 = *(const f32x4*)(orow + c1 + 4), ga = *(const f32x4*)(P.fg + c1), gb = *(const f32x4*)(P.fg + c1 + 4);
        *(f32x4*)(orow + c1) = (f32x4){ va.x * rstd * ga.x, va.y * rstd * ga.y, va.z * rstd * ga.z, va.w * rstd * ga.w };
        *(f32x4*)(orow + c1 + 4) = (f32x4){ vb2.x * rstd * gb.x, vb2.y * rstd * gb.y, vb2.z * rstd * gb.z, vb2.w * rstd * gb.w };
    }
}

#define XB_TMO      128
#define XB_XCNT(j)  (256  + 64 * (j))
#define XB_XSUB(j)  (1280 + 64 * (j))
#define XB_XGEN(j)  (2304 + 64 * (j))
#define XB_TOP      3328
#define XB_TOPGEN   3392
#define XCD_BAR_WORDS 3456
#define XB_SPIN_CAP (1u << 22)
#define LAS __attribute__((address_space(3)))
__device__ __forceinline__ unsigned xb_ld(unsigned* p)              { return __hip_atomic_load(p, __ATOMIC_RELAXED, __HIP_MEMORY_SCOPE_AGENT); }
__device__ __forceinline__ unsigned xb_add(unsigned* p, unsigned v) { return __hip_atomic_fetch_add(p, v, __ATOMIC_RELAXED, __HIP_MEMORY_SCOPE_AGENT); }
__device__ __forceinline__ unsigned xb_xcc_id() { return (unsigned)__builtin_amdgcn_s_getreg((3 << 11) | 20) & 0xFu; }
#define XB_SPIN(cond, bar) do { unsigned _sp = 0; while (cond) { __builtin_amdgcn_s_sleep(1); \
    if ((++_sp & 255u) == 0u) { if (xb_ld(&(bar)[XB_TMO])) break; if (_sp > XB_SPIN_CAP) { atomicAdd(&(bar)[XB_TMO], 1u); break; } } } } while (0)
struct XcdBarrier { unsigned* bar; unsigned x; volatile LAS unsigned* st; };
__device__ __forceinline__ XcdBarrier xcd_barrier_post(unsigned* bar, volatile LAS unsigned* st) {
    XcdBarrier b; b.bar = bar; b.x = xb_xcc_id(); b.st = st;
    if (threadIdx.x == 0) (void)xb_add(&bar[XB_XCNT(b.x)], 1u);
    return b;
}
__device__ __forceinline__ void xcd_barrier_complete(unsigned* bar, unsigned x, unsigned& nloc, unsigned& nx) {
    const unsigned G = gridDim.x * gridDim.y * gridDim.z;
    unsigned sum, cnt, mine, sp = 0u;
    for (;;) {
        sum = 0u; cnt = 0u; mine = 0u;
#pragma unroll
        for (unsigned j = 0; j < 16; ++j) { const unsigned c = xb_ld(&bar[XB_XCNT(j)]); sum += c; cnt += (c > 0u) ? 1u : 0u; mine = (j == x) ? c : mine; }
        if (sum == G) break;
        __builtin_amdgcn_s_sleep(1);
        if ((++sp & 255u) == 0u) { if (xb_ld(&bar[XB_TMO])) break; if (sp > XB_SPIN_CAP) { atomicAdd(&bar[XB_TMO], 1u); break; } }
    }
    nloc = mine > 0u ? mine : 1u; nx = cnt > 0u ? cnt : 1u;
}
__device__ __forceinline__ void xcd_barrier(const XcdBarrier& b) {
    asm volatile("s_waitcnt vmcnt(0)" ::: "memory");
    __syncthreads();
    if (threadIdx.x == 0) {
        unsigned* bar = b.bar;
        __builtin_amdgcn_s_waitcnt(0);
        unsigned nloc = b.st[0], nx = b.st[1];
        if (nloc == 0u) { xcd_barrier_complete(bar, b.x, nloc, nx); b.st[0] = nloc; b.st[1] = nx; }
        const unsigned old = xb_add(&bar[XB_XSUB(b.x)], 1u);
        const unsigned gen = old / nloc;
        if (old + 1u == (gen + 1u) * nloc) {
            __builtin_amdgcn_fence(__ATOMIC_RELEASE, "agent");
            asm volatile("s_waitcnt vmcnt(0)" ::: "memory");
            const unsigned og = xb_add(&bar[XB_TOP], 1u);
            const unsigned tg = og / nx;
            if (og + 1u == (tg + 1u) * nx) xb_add(&bar[XB_TOPGEN], 1u);
            else XB_SPIN(xb_ld(&bar[XB_TOPGEN]) == tg, bar);
            __builtin_amdgcn_fence(__ATOMIC_ACQUIRE, "agent");
            xb_add(&bar[XB_XGEN(b.x)], 1u);
            asm volatile("s_waitcnt vmcnt(0)" ::: "memory");
        } else {
            XB_SPIN(xb_ld(&bar[XB_XGEN(b.x)]) == gen, bar);
            __builtin_amdgcn_fence(__ATOMIC_ACQUIRE, "agent");
            asm volatile("s_waitcnt vmcnt(0)" ::: "memory");
        }
    }
    __syncthreads();
}

constexpr int NPHASE = 9;
template <int PH> __device__ __forceinline__ void run_phase(const Params& P, char* smem) {
    int tid_ = threadIdx.x; asm volatile("" : "+v"(tid_));
    const int bid = blockIdx.x, G = gridDim.x, tid = tid_;
    const size_t gtid = (size_t)bid * 256 + tid, gsize = (size_t)G * 256;
    if (PH == 0) {
        for (int it = bid; it < MODP_KC * 32; it += G) modp_item(P, it, smem);
        float (*tile)[65] = (float (*)[65])smem;
        for (int it = bid; it < 1088; it += G) transpose_tile(P.w_in, DM, PROJW, P.WinT(), it, tile);
        for (int it = bid; it < 128; it += G) transpose_tile(P.w_ao, 512, DM, P.WaoT(), it, tile);
        for (int it = bid; it < 128; it += G) transpose_tile(P.w_co, 512, DM, P.WcoT(), it, tile);
        for (int it = bid; it < 256; it += G) transpose_tile(P.w_mix, DM, DM, P.WmixT(), it, tile);
        for (int it = bid; it < 512; it += G) transpose_tile(P.pw_q, DM, 2048, P.PwqT(), it, tile);
        cvt_range(P.keys, P.KeysB(), (size_t)16 * 128 * 128 / 8, gtid, gsize);
        { const int lane = tid & 63, wid = tid >> 6;
          for (int r = bid * 4 + wid; r < NEXP; r += G * 4) {
              f32x4 va[4], vb[4];
              load_row16(P.pu + (size_t)r * DM, lane, va); load_row16(P.pv + (size_t)r * DM, lane, vb);
              quant_row(va, (unsigned char*)P.Uq() + (size_t)r * 512, P.su() + r, lane, 0);
              quant_row(vb, P.Vq() + (size_t)r * 512, P.sv() + r, lane, 128); } }
        rope_tab(P, (int)gtid, (int)gsize);
    } else if (PH == 1) {
        for (int i = (int)gtid; i < 17 * NMOD; i += (int)gsize) {
            float v = P.b_mod[i % NMOD];
#pragma unroll
            for (int kc = 0; kc < MODP_KC; ++kc) v += P.modp()[(size_t)kc * 17 * NMOD + i];
            P.mod()[i] = v;
        }
        if (NTOK % G == 0 && SEQ % (NTOK / G) == 0 && NCTX % G == 0) {
            norm1_rows(P, false, bid * (NTOK / G), NTOK / G, smem);
            norm1_rows(P, true, bid * (NCTX / G), NCTX / G, smem);
        } else {
            for (int it = bid; it < 1152; it += G) { const bool isctx = it >= 1024; norm1_rows(P, isctx, isctx ? (it - 1024) * 32 : it * 32, 32, smem); }
        }
    } else if (PH == 2) {
        for (int t = bid; t < 128 * 18 + 32; t += G) {
            if (t < 128 * 18) { int mt, nt; tile_coords(t, 128, 18, mt, nt); gemm_tile<MODE_INPROJ, 8>(P, P.H(), DM, P.WinT(), DM, DM, mt * 256, nt * 128, nt * 128 >= 768, smem); }
            else { const int u = t - 128 * 18, mt = u >> 1, nt = u & 1; gemm_tile<MODE_CTXKV, 8>(P, P.HC(), DM, P.WinT() + (size_t)512 * DM, DM, DM, mt * 256, nt * 128, nt == 0, smem); }
        }
    } else if (PH == 3) {
        const int nG = 128 * 16, nA = NB * 16 * 8;
        int tg = bid, ta = bid;
        bool gemm_turn = (bid & 1) == 0;
        while (tg < nG || ta < nA) {
            if ((gemm_turn && tg < nG) || ta >= nA) {
                int mt, nt; tile_coords(tg, 128, 16, mt, nt);
                gemm_tile<MODE_INPROJ, 8>(P, P.H(), DM, P.WinT(), DM, DM, mt * 256, (18 + nt) * 128, true, smem);
                tg += G;
            } else { attn_item(P, ta); ta += G; }
            gemm_turn = !gemm_turn;
        }
        conv_range(P, gtid, gsize);
    } else if (PH == 4) {
        for (int t = bid; t < 128 * 8; t += G) { int mt, nt; tile_coords(t, 128, 8, mt, nt); gemm_tile<MODE_AO1, 8>(P, P.AO(), 512, P.WaoT(), 512, 512, mt * 256, nt * 128, true, smem, 0); }
        for (int t = bid; t < 128 * 8; t += G) { int mt, nt; tile_coords(t, 128, 8, mt, nt); gemm_tile<MODE_AO1, 8>(P, P.CA(), 512, P.WcoT(), 512, 512, mt * 256, nt * 128, true, smem, 1); }
    } else if (PH == 5) {
        for (int t = bid; t < 128 * 8; t += G) { int mt, nt; tile_coords(t, 128, 8, mt, nt); gemm_tile<MODE_MIX, 8>(P, P.YG(), DM, P.WmixT(), DM, DM, mt * 256, nt * 128, true, smem); }
    } else if (PH == 6) {
        const int lane = tid & 63, wid = tid >> 6;
        float* sc = (float*)smem; float* sh = sc + DM;
        for (int it = bid; it < NTOK / 64; it += G) {
            const int row0 = it * 64, b = row0 / SEQ;
            __syncthreads();
            for (int d = tid; d < DM; d += 256) { sc[d] = P.mod()[(size_t)b * NMOD + 4 * DM + d]; sh[d] = P.mod()[(size_t)b * NMOD + 3 * DM + d]; }
            __syncthreads();
            for (int i = wid; i < 64; i += 8) {
                const int ra = row0 + i, rb = ra + 4;
                f32x4 va[4], vb[4];
                load_row4_bf(P.X1() + (size_t)ra * DM, lane, va); load_row4_bf(P.X1() + (size_t)rb * DM, lane, vb);
                norm_row_q(va, P.n2, sc, sh, P.H2() + (size_t)ra * DM, P.H2q() + (size_t)ra * DM, P.sh2() + ra, lane);
                norm_row_q(vb, P.n2, sc, sh, P.H2() + (size_t)rb * DM, P.H2q() + (size_t)rb * DM, P.sh2() + rb, lane);
            }
        }
    } else if (PH == 7) {
        for (int it = bid; it < 256 * 8; it += G) peer_retrieve_item(P, it >> 3, it & 7, smem);
    } else if (PH == 8) {
        const int lane = tid & 63, wid = tid >> 6;
        for (int t = bid * 4 + wid; t < NTOK; t += G * 4) peer_uh_token<0>(P, t, lane);
        asm volatile("s_waitcnt vmcnt(0)" ::: "memory");
        for (int t = bid * 4 + wid; t < NTOK; t += G * 4) peer_uh_token<1>(P, t, lane);
    } else if (PH == 9) {
        const int lane = tid & 63, wid = tid >> 6;
        for (int t = bid * 4 + wid; t < NTOK; t += G * 4) peer_vh_token<0>(P, t, lane);
        asm volatile("s_waitcnt vmcnt(0)" ::: "memory");
        for (int t = bid * 4 + wid; t < NTOK; t += G * 4) peer_vh_token<1>(P, t, lane);
    }
}
#ifndef REP0
#define REP0 1
#endif
#ifndef REP1
#define REP1 1
#endif
#ifndef REP2
#define REP2 1
#endif
#ifndef REP3
#define REP3 1
#endif
#ifndef REP4
#define REP4 1
#endif
#ifndef REP5
#define REP5 1
#endif
#ifndef REP6
#define REP6 1
#endif
#ifndef REP7
#define REP7 1
#endif
#ifndef REP8
#define REP8 1
#endif
#ifndef REP9
#define REP9 1
#endif
#ifndef REP10
#define REP10 1
#endif
constexpr int MEGA_LDS = 3 * (2048 * 8 + 8192);
__global__ void __launch_bounds__(256, 2) k_mega(Params P) {
    extern __shared__ __attribute__((aligned(16))) char smem[];
    volatile LAS unsigned* st = (volatile LAS unsigned*)(smem + MEGA_LDS);
    if (threadIdx.x < 4) st[threadIdx.x] = 0u;
    __syncthreads();
    const XcdBarrier bar = xcd_barrier_post(P.bar(), st);
#define PHASE_SYNC(k) for (int rep = 0; rep < REP##k; ++rep) { run_phase<k>(P, smem); xcd_barrier(bar); }
    PHASE_SYNC(0) PHASE_SYNC(1) PHASE_SYNC(2) PHASE_SYNC(3) PHASE_SYNC(4) PHASE_SYNC(5) PHASE_SYNC(6) PHASE_SYNC(7)
    PHASE_SYNC(8)
    run_phase<9>(P, smem);
}


extern "C" void kernel_launch(void* const* d_in, const int* in_sizes, int n_in, void* d_out, int out_size, void* d_ws, size_t ws_size, hipStream_t stream) {
    Params P{};
    P.x = (const float*)d_in[0]; P.c = (const float*)d_in[1]; P.ctx = (const float*)d_in[2]; P.c_ctx = (const float*)d_in[3];
    P.w_mod = (const float*)d_in[4]; P.b_mod = (const float*)d_in[5]; P.n1 = (const float*)d_in[6]; P.n2 = (const float*)d_in[7];
    P.w_in = (const float*)d_in[8]; P.sink = (const float*)d_in[9]; P.conv_w = (const float*)d_in[10]; P.w_ao = (const float*)d_in[11];
    P.w_co = (const float*)d_in[12]; P.w_mix = (const float*)d_in[13]; P.pw_q = (const float*)d_in[14]; P.keys = (const float*)d_in[15];
    P.pu = (const float*)d_in[16]; P.pv = (const float*)d_in[17]; P.fg = (const float*)d_in[18];
    P.out = (float*)d_out;
    P.ws = (char*)d_ws;
    if (WS_NEED > ws_size) { fprintf(stderr, "kernel_launch: workspace too small: need %zu have %zu\n", (size_t)WS_NEED, ws_size); return; }

    static int grid_blocks = 0;
    if (!grid_blocks) {
        int dev = 0, cus = 0, per_cu = 0;
        (void)hipGetDevice(&dev);
        (void)hipDeviceGetAttribute(&cus, hipDeviceAttributeMultiprocessorCount, dev);
        (void)hipFuncSetAttribute((const void*)k_mega, hipFuncAttributeMaxDynamicSharedMemorySize, MEGA_LDS + 16);
        (void)hipOccupancyMaxActiveBlocksPerMultiprocessor(&per_cu, (const void*)k_mega, 256, MEGA_LDS + 16);
        if (per_cu > 2) per_cu = 2;
        if (per_cu < 1) { fprintf(stderr, "kernel_launch: occupancy query returned %d\n", per_cu); per_cu = 1; }
        grid_blocks = cus * per_cu;
    }
    (void)hipMemsetAsync(P.bar(), 0, (size_t)XCD_BAR_WORDS * 4, stream);
    void* args[] = { &P };
    hipError_t e = hipLaunchCooperativeKernel((const void*)k_mega, dim3(grid_blocks), dim3(256), args, MEGA_LDS + 16, stream);
    if (e != hipSuccess) fprintf(stderr, "cooperative launch failed: %s (grid %d)\n", hipGetErrorString(e), grid_blocks);
}
```

```cpp
#include <hip/hip_runtime.h>
#include <cstdio>
#include <cstdint>

typedef unsigned short bf16_t;
typedef short bf16x8 __attribute__((ext_vector_type(8)));
typedef float f32x4 __attribute__((ext_vector_type(4)));
typedef unsigned u32x4 __attribute__((ext_vector_type(4)));
typedef unsigned u32x2 __attribute__((ext_vector_type(2)));
typedef int i32x4 __attribute__((ext_vector_type(4)));

constexpr int DM = 1024, NB = 16, SEQ = 2048, NTOK = NB * SEQ, CTXL = 256, NCTX = NB * CTXL;
constexpr int PROJW = 4352;
constexpr int NMOD = 6 * DM;
constexpr int NEXP = 16384;

__device__ __forceinline__ float bf2f(bf16_t x) { return __uint_as_float(((unsigned)x) << 16); }
__device__ __forceinline__ bf16_t f2bf(float f) {
    unsigned u = __float_as_uint(f);
    u += 0x7fffu + ((u >> 16) & 1u);
    return (bf16_t)(u >> 16);
}
__device__ __forceinline__ unsigned pk2(float lo, float hi) { unsigned r; asm("v_cvt_pk_bf16_f32 %0, %1, %2" : "=v"(r) : "v"(lo), "v"(hi)); return r; }
__device__ __forceinline__ float sigmoidf_(float x) { return 1.f / (1.f + __expf(-x)); }
__device__ __forceinline__ float wave_sum(float v) {
#pragma unroll
    for (int o = 1; o < 64; o <<= 1) v += __shfl_xor(v, o);
    return v;
}

__device__ __forceinline__ float wave_max(float v) {
#pragma unroll
    for (int o = 1; o < 64; o <<= 1) v = fmaxf(v, __shfl_xor(v, o));
    return v;
}
__device__ __forceinline__ unsigned q8(float x, float inv, int bias) {
    int q = (int)rintf(x * inv); q = q > 127 ? 127 : (q < -127 ? -127 : q);
    return (unsigned)((q + bias) & 0xff);
}
__device__ __forceinline__ void load_row16(const float* src, int lane, f32x4 (&v)[4]) {
#pragma unroll
    for (int j = 0; j < 4; ++j) v[j] = *(const f32x4*)(src + 16 * lane + 4 * j);
}
__device__ __forceinline__ void quant_row(f32x4 (&v)[4], unsigned char* dst, float* scale_out, int lane, int bias) {
    float amax = 0.f;
#pragma unroll
    for (int j = 0; j < 4; ++j) amax = fmaxf(amax, fmaxf(fmaxf(fabsf(v[j].x), fabsf(v[j].y)), fmaxf(fabsf(v[j].z), fabsf(v[j].w))));
    amax = wave_max(amax);
    const float sc = amax > 0.f ? amax * (1.f / 127.f) : 1.f, inv = 1.f / sc;
    u32x4 w;
    w.x = q8(v[0].x, inv, bias) | (q8(v[0].y, inv, bias) << 8) | (q8(v[0].z, inv, bias) << 16) | (q8(v[0].w, inv, bias) << 24);
    w.y = q8(v[1].x, inv, bias) | (q8(v[1].y, inv, bias) << 8) | (q8(v[1].z, inv, bias) << 16) | (q8(v[1].w, inv, bias) << 24);
    w.z = q8(v[2].x, inv, bias) | (q8(v[2].y, inv, bias) << 8) | (q8(v[2].z, inv, bias) << 16) | (q8(v[2].w, inv, bias) << 24);
    w.w = q8(v[3].x, inv, bias) | (q8(v[3].y, inv, bias) << 8) | (q8(v[3].z, inv, bias) << 16) | (q8(v[3].w, inv, bias) << 24);
    *(u32x4*)(dst + (size_t)(lane >> 5) * ((size_t)NEXP * 512) + 16 * (lane & 31)) = w;
    if (lane == 0) *scale_out = sc;
}

__device__ __forceinline__ unsigned q4(float x, float inv) { int q = (int)rintf(x * inv); q = q > 7 ? 7 : (q < -7 ? -7 : q); return (unsigned)q & 0xfu; }
__device__ __forceinline__ void quant_row_u4(f32x4 (&v)[4], unsigned char* dst, float* scale_out, int lane) {
    float amax = 0.f, ss = 0.f;
#pragma unroll
    for (int j = 0; j < 4; ++j) {
        amax = fmaxf(amax, fmaxf(fmaxf(fabsf(v[j].x), fabsf(v[j].y)), fmaxf(fabsf(v[j].z), fabsf(v[j].w))));
        ss += v[j].x * v[j].x + v[j].y * v[j].y + v[j].z * v[j].z + v[j].w * v[j].w;
    }
    amax = wave_max(amax); ss = wave_sum(ss);
    const float step = fminf(amax * (1.f / 7.f), 0.36f * sqrtf(ss * (1.f / DM)));
    const float sc = step > 0.f ? step : 1.f, inv = 1.f / sc;
    u32x2 w;
    w.x = q4(v[0].x, inv) | (q4(v[0].y, inv) << 4) | (q4(v[0].z, inv) << 8) | (q4(v[0].w, inv) << 12) | (q4(v[1].x, inv) << 16) | (q4(v[1].y, inv) << 20) | (q4(v[1].z, inv) << 24) | (q4(v[1].w, inv) << 28);
    w.y = q4(v[2].x, inv) | (q4(v[2].y, inv) << 4) | (q4(v[2].z, inv) << 8) | (q4(v[2].w, inv) << 12) | (q4(v[3].x, inv) << 16) | (q4(v[3].y, inv) << 20) | (q4(v[3].z, inv) << 24) | (q4(v[3].w, inv) << 28);
    *(u32x2*)(dst + 8 * lane) = w;
    if (lane == 0) *scale_out = sc;
}

__device__ __forceinline__ unsigned qf4(float x, float inv) {
    const float a = fabsf(x) * inv;
    const unsigned c = (unsigned)(a > 0.25f) + (unsigned)(a > 0.75f) + (unsigned)(a > 1.25f) + (unsigned)(a > 1.75f) + (unsigned)(a > 2.5f) + (unsigned)(a > 3.5f) + (unsigned)(a > 5.f);
    return c | (x < 0.f ? 8u : 0u);
}
__device__ __forceinline__ void quant_row_v4(f32x4 (&v)[4], unsigned char* dst, float* scale_out, int lane) {
    float amax = 0.f, ss = 0.f;
#pragma unroll
    for (int j = 0; j < 4; ++j) {
        amax = fmaxf(amax, fmaxf(fmaxf(fabsf(v[j].x), fabsf(v[j].y)), fmaxf(fabsf(v[j].z), fabsf(v[j].w))));
        ss += v[j].x * v[j].x + v[j].y * v[j].y + v[j].z * v[j].z + v[j].w * v[j].w;
    }
    amax = wave_max(amax); ss = wave_sum(ss);
    const float step = fminf(amax * (1.f / 6.f), 0.5f * sqrtf(ss * (1.f / DM)));
    const float sc = step > 0.f ? step : 1.f, inv = 1.f / sc;
    u32x2 w;
    w.x = qf4(v[0].x, inv) | (qf4(v[0].y, inv) << 4) | (qf4(v[0].z, inv) << 8) | (qf4(v[0].w, inv) << 12) | (qf4(v[1].x, inv) << 16) | (qf4(v[1].y, inv) << 20) | (qf4(v[1].z, inv) << 24) | (qf4(v[1].w, inv) << 28);
    w.y = qf4(v[2].x, inv) | (qf4(v[2].y, inv) << 4) | (qf4(v[2].z, inv) << 8) | (qf4(v[2].w, inv) << 12) | (qf4(v[3].x, inv) << 16) | (qf4(v[3].y, inv) << 20) | (qf4(v[3].z, inv) << 24) | (qf4(v[3].w, inv) << 28);
    *(u32x2*)(dst + 8 * lane) = w;
    if (lane == 0) *scale_out = sc;
}

__device__ __forceinline__ void quant_row_v4m(f32x4 (&v)[4], unsigned char* dst, float* scale_out, int lane) {
    float amax = 0.f, ss = 0.f;
#pragma unroll
    for (int j = 0; j < 4; ++j) {
        amax = fmaxf(amax, fmaxf(fmaxf(fabsf(v[j].x), fabsf(v[j].y)), fmaxf(fabsf(v[j].z), fabsf(v[j].w))));
        ss += v[j].x * v[j].x + v[j].y * v[j].y + v[j].z * v[j].z + v[j].w * v[j].w;
    }
    amax = wave_max(amax); ss = wave_sum(ss);
    const float step = fminf(amax * (1.f / 6.f), 0.5f * sqrtf(ss * (1.f / DM)));
    const float sc = step > 0.f ? step : 1.f, inv = 1.f / sc;
#pragma unroll
    for (int m = 0; m < 16; ++m) {
        const unsigned c = qf4(v[m >> 2][m & 3], inv);
        const unsigned by = c | ((unsigned)__shfl_down((int)c, 1) << 4);
        const unsigned w = by | ((unsigned)__shfl_down((int)by, 2) << 8) | ((unsigned)__shfl_down((int)by, 4) << 16) | ((unsigned)__shfl_down((int)by, 6) << 24);
        if ((lane & 7) == 0) *(unsigned*)(dst + 32 * m + (lane >> 1)) = w;
    }
    if (lane == 0) *scale_out = sc;
}

constexpr size_t al256(size_t x) { return (x + 255) & ~(size_t)255; }
constexpr int MODP_KC = 16;
constexpr int XCD_BAR_WORDS_C = 3456;
constexpr size_t O_modp = 0;
constexpr size_t O_mod = O_modp + al256((size_t)MODP_KC * 17 * NMOD * 4);
constexpr size_t O_rope = O_mod + al256((size_t)17 * NMOD * 4);
constexpr size_t O_WinT = O_rope + al256(3072 * 4);
constexpr size_t O_WaoT = O_WinT + al256((size_t)PROJW * DM * 2);
constexpr size_t O_WcoT = O_WaoT + al256((size_t)DM * 512 * 2);
constexpr size_t O_WmixT = O_WcoT + al256((size_t)DM * 512 * 2);
constexpr size_t O_PwqT = O_WmixT + al256((size_t)DM * DM * 2);
constexpr size_t O_KeysB = O_PwqT + al256((size_t)2048 * DM * 2);
constexpr size_t O_Uq = O_KeysB + al256((size_t)16 * 128 * 128 * 2);
constexpr size_t O_Vq = O_Uq + al256((size_t)NEXP * DM);
constexpr size_t O_su = O_Vq + al256((size_t)NEXP * DM);
constexpr size_t O_sv = O_su + al256((size_t)NEXP * 4);
constexpr size_t O_sh2 = O_sv + al256((size_t)NEXP * 4);
constexpr size_t O_HC = O_sh2 + al256((size_t)NTOK * 4);
constexpr size_t O_regA = O_HC + al256((size_t)NCTX * DM * 2);
constexpr size_t O_H = O_regA, O_YG = O_regA, O_H2 = O_regA;
constexpr size_t O_regB = O_regA + al256((size_t)NTOK * DM * 2);
constexpr size_t O_Q = O_regB;
constexpr size_t O_K = O_Q + al256((size_t)NTOK * 512 * 2);
constexpr size_t O_VT = O_K + al256((size_t)NTOK * 128 * 2);
constexpr size_t O_Kc = O_VT + al256((size_t)NTOK * 128 * 2);
constexpr size_t O_VcT = O_Kc + al256((size_t)NCTX * 128 * 2);
constexpr size_t O_regC = O_VcT + al256((size_t)NCTX * 128 * 2);
constexpr size_t O_GB = O_regC;
constexpr size_t O_GC = O_GB + al256((size_t)NTOK * 512 * 2);
constexpr size_t O_U = O_GC + al256((size_t)NTOK * 512 * 2);
constexpr size_t O_M1 = O_regC, O_cbuf = O_regC, O_pd = O_regC + (size_t)NTOK * 128 * 4, O_ssq = O_regC + (size_t)2 * NTOK * 128 * 4;
constexpr size_t O_regD = O_U + al256((size_t)NTOK * 512 * 2);
constexpr size_t O_GA = O_regD;
constexpr size_t O_GV = O_GA + al256((size_t)NTOK * DM);
constexpr size_t O_H8 = O_regD + al256((size_t)NTOK * DM * 2);
constexpr size_t O_W8 = O_H8 + al256((size_t)NTOK * DM);
constexpr size_t O_sh1 = O_W8 + al256((size_t)2048 * DM);
constexpr size_t O_X1 = O_regD;
constexpr size_t O_AO = O_sh1 + al256((size_t)NTOK * 4);
constexpr size_t O_H2q = O_AO;
constexpr size_t O_CA = O_AO + al256((size_t)NTOK * 512 * 2);
constexpr size_t O_bar = O_CA + al256((size_t)NTOK * 512 * 2);
constexpr int WAMAX_WORDS = 4096;
constexpr size_t WS_NEED = O_bar + al256((size_t)(XCD_BAR_WORDS_C + WAMAX_WORDS) * 4);
constexpr size_t O_sel_idx = O_regB;
constexpr size_t O_sel_g = O_sel_idx + al256((size_t)NTOK * 128 * 4);
static_assert(O_sel_g + (size_t)NTOK * 128 * 4 <= O_regC, "late buffers overflow region B");
static_assert(O_ssq + (size_t)NTOK * 4 <= O_regD, "region C overflow");

struct Params {
    const float *x, *c, *ctx, *c_ctx, *w_mod, *b_mod, *n1, *n2, *w_in, *sink, *conv_w, *w_ao, *w_co, *w_mix, *pw_q, *keys, *pu, *pv, *fg;
    float* out;
    char* ws;
#define WSF(T, name) __host__ __device__ __forceinline__ T* name() const { return (T*)(ws + O_##name); }
    WSF(float, modp) WSF(float, mod) WSF(float, rope)
    WSF(bf16_t, WinT) WSF(bf16_t, WaoT) WSF(bf16_t, WcoT) WSF(bf16_t, WmixT) WSF(signed char, PwqT) WSF(bf16_t, KeysB)
    WSF(bf16_t, H) WSF(bf16_t, HC) WSF(bf16_t, Q) WSF(bf16_t, K) WSF(bf16_t, VT) WSF(bf16_t, Kc) WSF(bf16_t, VcT) WSF(bf16_t, GB) WSF(bf16_t, GC) WSF(bf16_t, U)
    WSF(bf16_t, AO) WSF(bf16_t, CA) WSF(bf16_t, M1) WSF(bf16_t, YG) WSF(signed char, H2) WSF(bf16_t, X1)
    WSF(unsigned char, GA) WSF(unsigned char, GV) WSF(signed char, H8) WSF(signed char, W8) WSF(float, sh1) WSF(unsigned char, Vq) WSF(signed char, Uq) WSF(signed char, H2q)
    WSF(int, sel_idx) WSF(float, sel_g) WSF(unsigned, bar) WSF(float, su) WSF(float, sv) WSF(float, sh2) WSF(float, cbuf) WSF(float, ssq) WSF(int, pd)
#undef WSF
};

__device__ __forceinline__ void modp_item(const Params& P, int item, char* smem) {
    float (*s)[64] = (float (*)[64])smem;
    const int kc = item >> 5, nc = item & 31;
    __syncthreads();
    for (int i = threadIdx.x; i < 17 * 64; i += 256) {
        const int r = i >> 6, k = i & 63;
        const float v = (r < 16) ? P.c[r * DM + kc * 64 + k] : P.c_ctx[kc * 64 + k];
        s[r][k] = v / (1.f + __expf(-v));
    }
    __syncthreads();
    if (threadIdx.x < 192) {
        const int n = nc * 192 + threadIdx.x;
        float acc[17];
#pragma unroll
        for (int r = 0; r < 17; ++r) acc[r] = 0.f;
#pragma unroll 8
        for (int k = 0; k < 64; ++k) {
            const float w = P.w_mod[(size_t)(kc * 64 + k) * NMOD + n];
#pragma unroll
            for (int r = 0; r < 17; ++r) acc[r] += s[r][k] * w;
        }
#pragma unroll
        for (int r = 0; r < 17; ++r) P.modp()[((size_t)kc * 17 + r) * NMOD + n] = acc[r];
    }
}
__device__ __forceinline__ void cvt_range(const float* src, bf16_t* dst, size_t n8, size_t gtid, size_t gsize) {
    for (size_t i = gtid; i < n8; i += gsize) {
        const f32x4 a = *(const f32x4*)(src + i * 8), b = *(const f32x4*)(src + i * 8 + 4);
        u32x4 o; o.x = pk2(a.x, a.y); o.y = pk2(a.z, a.w); o.z = pk2(b.x, b.y); o.w = pk2(b.z, b.w);
        *(u32x4*)(dst + i * 8) = o;
    }
}
__device__ __forceinline__ void rope_tab(const Params& P, int gtid, int gsize) {
    for (int i = gtid; i < 1536; i += gsize) {
        int pos, f; bool isc;
        if (i < 512) { pos = i / 16; f = i % 16; isc = false; } else { pos = (i - 512) / 16; f = (i - 512) % 16; isc = true; }
        const float inv = exp2f(-(float)f * (13.287712379549449f / 16.f));
        const float ang = (float)pos * inv;
        const float cv = cosf(ang), sv = sinf(ang);
        if (!isc) { P.rope()[pos * 16 + f] = cv; P.rope()[512 + pos * 16 + f] = sv; }
        else { P.rope()[1024 + pos * 16 + f] = cv; P.rope()[2048 + pos * 16 + f] = sv; }
    }
}
__device__ __forceinline__ void colmax_tile(const float* W, int K, int N, unsigned* amax, int item, float (*tile)[65], int c0 = 0, int ncols = 0) {
    const int ntn = (ncols ? ncols : N) / 64, kt = item / ntn, nt = item % ntn, k0 = kt * 64, n0 = nt * 64;
    W += c0;
    const int tx = threadIdx.x & 63, ty = threadIdx.x >> 6;
    __syncthreads();
#pragma unroll
    for (int i = 0; i < 16; ++i) { const int k = i * 4 + ty; tile[k][tx] = fabsf(W[(size_t)(k0 + k) * N + n0 + tx]); }
    __syncthreads();
    if (ty == 0) { float m = 0.f;
#pragma unroll 8
        for (int k = 0; k < 64; ++k) m = fmaxf(m, tile[k][tx]);
        atomicMax(amax + n0 + tx, __float_as_uint(m)); }
}
__device__ __forceinline__ void transpose_tile_i8(const float* W, int K, int N, signed char* Wt, const unsigned* amax, int item, float (*tile)[65], int c0 = 0, int ncols = 0) {
    const int ntn = (ncols ? ncols : N) / 64, kt = item / ntn, nt = item % ntn, k0 = kt * 64, n0 = nt * 64;
    W += c0;
    const int tx = threadIdx.x & 63, ty = threadIdx.x >> 6;
    __syncthreads();
#pragma unroll
    for (int i = 0; i < 16; ++i) { const int k = i * 4 + ty; tile[k][tx] = W[(size_t)(k0 + k) * N + n0 + tx]; }
    __syncthreads();
    {
        const int n = threadIdx.x >> 2, kq = (threadIdx.x & 3) * 16;
        const float am = __uint_as_float(amax[n0 + n]), inv = am > 0.f ? 127.f / am : 0.f;
        unsigned w[4];
#pragma unroll
        for (int j = 0; j < 4; ++j) {
            unsigned x = 0;
#pragma unroll
            for (int b = 0; b < 4; ++b) { int q = (int)rintf(tile[kq + 4 * j + b][n] * inv); q = q > 127 ? 127 : (q < -127 ? -127 : q); x |= ((unsigned)q & 0xffu) << (8 * b); }
            w[j] = x;
        }
        *(u32x4*)(Wt + (size_t)(n0 + n) * K + k0 + kq) = (u32x4){ w[0], w[1], w[2], w[3] };
    }
}
__device__ __forceinline__ void transpose_tile(const float* W, int K, int N, bf16_t* Wt, int item, float (*tile)[65]) {
    const int ntn = N / 64, kt = item / ntn, nt = item % ntn, k0 = kt * 64, n0 = nt * 64;
    const int tx = threadIdx.x & 63, ty = threadIdx.x >> 6;
    __syncthreads();
#pragma unroll
    for (int i = 0; i < 16; ++i) { const int k = i * 4 + ty; tile[k][tx] = W[(size_t)(k0 + k) * N + n0 + tx]; }
    __syncthreads();
#pragma unroll
    for (int i = 0; i < 16; ++i) { const int n = i * 4 + ty; Wt[(size_t)(n0 + n) * K + k0 + tx] = f2bf(tile[tx][n]); }
}

__device__ __forceinline__ void load_row4_bf(const bf16_t* xr, int lane, f32x4 (&v)[4]) {
#pragma unroll
    for (int j = 0; j < 4; ++j) { const u32x2 w = *(const u32x2*)(xr + j * 256 + lane * 4);
        v[j].x = bf2f(w.x & 0xffff); v[j].y = bf2f(w.x >> 16); v[j].z = bf2f(w.y & 0xffff); v[j].w = bf2f(w.y >> 16); }
}
__device__ __forceinline__ void load_row4(const float* xr, int lane, f32x4 (&v)[4]) {
#pragma unroll
    for (int j = 0; j < 4; ++j) v[j] = __builtin_nontemporal_load((const f32x4*)(xr + j * 256 + lane * 4));
}
__device__ __forceinline__ void norm_row(f32x4 (&v)[4], const f32x4 (&gm)[4], const f32x4 (&shv)[4], bf16_t* dst, int lane, signed char* dst8 = nullptr, float* s8 = nullptr) {
    float s = 0.f;
#pragma unroll
    for (int j = 0; j < 4; ++j) s += v[j].x * v[j].x + v[j].y * v[j].y + v[j].z * v[j].z + v[j].w * v[j].w;
    s = wave_sum(s);
    const float rstd = rsqrtf(s * (1.f / DM) + 1e-6f);
#pragma unroll
    for (int j = 0; j < 4; ++j) {
        const int d = j * 256 + lane * 4;
        const float y0 = v[j].x * rstd * gm[j].x + shv[j].x;
        const float y1 = v[j].y * rstd * gm[j].y + shv[j].y;
        const float y2 = v[j].z * rstd * gm[j].z + shv[j].z;
        const float y3 = v[j].w * rstd * gm[j].w + shv[j].w;
        u32x2 o; o.x = pk2(y0, y1); o.y = pk2(y2, y3);
        *(u32x2*)(dst + d) = o;
        v[j] = (f32x4){ y0, y1, y2, y3 };
    }
    if (dst8) {
        float amax = 0.f;
#pragma unroll
        for (int j = 0; j < 4; ++j) amax = fmaxf(amax, fmaxf(fmaxf(fabsf(v[j].x), fabsf(v[j].y)), fmaxf(fabsf(v[j].z), fabsf(v[j].w))));
        amax = wave_max(amax);
        const float qs = amax > 0.f ? amax * (1.f / 127.f) : 1.f, inv = 1.f / qs;
#pragma unroll
        for (int j = 0; j < 4; ++j)
            *(unsigned*)(dst8 + j * 256 + lane * 4) = q8(v[j].x, inv, 0) | (q8(v[j].y, inv, 0) << 8) | (q8(v[j].z, inv, 0) << 16) | (q8(v[j].w, inv, 0) << 24);
        if (lane == 0) *s8 = qs;
    }
}

__device__ __forceinline__ void norm_row_q(f32x4 (&v)[4], const f32x4 (&gm)[4], const f32x4 (&shv)[4], signed char* dst, signed char* dq, float* sq, int lane) {
    float s = 0.f;
#pragma unroll
    for (int j = 0; j < 4; ++j) s += v[j].x * v[j].x + v[j].y * v[j].y + v[j].z * v[j].z + v[j].w * v[j].w;
    s = wave_sum(s);
    const float rstd = rsqrtf(s * (1.f / DM) + 1e-6f);
    float amax = 0.f;
#pragma unroll
    for (int j = 0; j < 4; ++j) {
        v[j].x = v[j].x * rstd * gm[j].x + shv[j].x;
        v[j].y = v[j].y * rstd * gm[j].y + shv[j].y;
        v[j].z = v[j].z * rstd * gm[j].z + shv[j].z;
        v[j].w = v[j].w * rstd * gm[j].w + shv[j].w;
        amax = fmaxf(amax, fmaxf(fmaxf(fabsf(v[j].x), fabsf(v[j].y)), fmaxf(fabsf(v[j].z), fabsf(v[j].w))));
    }
    amax = wave_max(amax);
    const float qs = amax > 0.f ? amax * (1.f / 119.f) : 1.f, inv = 1.f / qs;
    {
        const float inv7 = inv * (127.f / 119.f);
#pragma unroll
        for (int j = 0; j < 4; ++j)
            *(unsigned*)(dst + j * 256 + lane * 4) = q8(v[j].x, inv7, 0) | (q8(v[j].y, inv7, 0) << 8) | (q8(v[j].z, inv7, 0) << 16) | (q8(v[j].w, inv7, 0) << 24);
    }
    unsigned hi[2] = {0u, 0u}, lo[2] = {0u, 0u};
#pragma unroll
    for (int j = 0; j < 4; ++j) {
        const float e[4] = { v[j].x, v[j].y, v[j].z, v[j].w };
#pragma unroll
        for (int i = 0; i < 4; ++i) {
            int q = (int)rintf(e[i] * inv); q = q > 119 ? 119 : (q < -119 ? -119 : q);
            const int l = ((q + 8) & 15) - 8, h = (q - l) >> 4;
            const int sh = ((4 * j + i) & 7) * 4;
            lo[j >> 1] |= ((unsigned)l & 0xfu) << sh; hi[j >> 1] |= ((unsigned)h & 0xfu) << sh;
        }
    }
    *(u32x2*)(dq + 8 * lane) = (u32x2){ hi[0], hi[1] };
    *(u32x2*)(dq + 512 + 8 * lane) = (u32x2){ lo[0], lo[1] };
    if (lane == 0) *sq = qs;
}

__device__ __forceinline__ void norm1_rows(const Params& P, bool isctx, int row0, int nrows, char* smem) {
    float* sc = (float*)smem; float* sh = sc + DM;
    const int r = isctx ? 16 : row0 / SEQ;
    __syncthreads();
    { const int d = threadIdx.x * 4;
      f32x4 a = *(const f32x4*)(P.b_mod + DM + d), b = *(const f32x4*)(P.b_mod + d);
#pragma unroll 4
      for (int kc = 0; kc < MODP_KC; ++kc) { a += *(const f32x4*)(P.modp() + ((size_t)kc * 17 + r) * NMOD + DM + d); b += *(const f32x4*)(P.modp() + ((size_t)kc * 17 + r) * NMOD + d); }
      *(f32x4*)(sc + d) = a; *(f32x4*)(sh + d) = b; }
    __syncthreads();
    const int lane = threadIdx.x & 63, wid = threadIdx.x >> 6;
    const float* srcb = isctx ? P.ctx : P.x; bf16_t* dstb = isctx ? P.HC() : P.H();
    f32x4 gm[4], shv[4];
#pragma unroll
    for (int j = 0; j < 4; ++j) { const int d = j * 256 + lane * 4; const f32x4 gg = *(const f32x4*)(P.n1 + d), s1 = *(const f32x4*)(sc + d);
        gm[j] = (f32x4){ gg.x * (1.f + s1.x), gg.y * (1.f + s1.y), gg.z * (1.f + s1.z), gg.w * (1.f + s1.w) }; shv[j] = *(const f32x4*)(sh + d); }
    for (int i = wid; i < nrows; i += 8) {
        const int ra = row0 + i, rb = row0 + i + 4; const bool hb = (i + 4) < nrows;
        f32x4 va[4], vb[4];
        load_row4(srcb + (size_t)ra * DM, lane, va); if (hb) load_row4(srcb + (size_t)rb * DM, lane, vb);
        norm_row(va, gm, shv, dstb + (size_t)ra * DM, lane, isctx ? nullptr : P.H8() + (size_t)ra * DM, P.sh1() + ra);
        if (hb) norm_row(vb, gm, shv, dstb + (size_t)rb * DM, lane, isctx ? nullptr : P.H8() + (size_t)rb * DM, P.sh1() + rb);
    }
}
#define UB0(x) ((float)((x) & 0xffu))
#define UB1(x) ((float)(((x) >> 8) & 0xffu))
#define UB2(x) ((float)(((x) >> 16) & 0xffu))
#define UB3(x) ((float)((x) >> 24))
enum { MODE_INPROJ = 0, MODE_CTXKV = 1, MODE_AO1 = 2, MODE_MIX = 4 };

__device__ __forceinline__ void st8bf(bf16_t* p, const float* v) {
    u32x4 o; o.x = pk2(v[0], v[1]); o.y = pk2(v[2], v[3]); o.z = pk2(v[4], v[5]); o.w = pk2(v[6], v[7]);
    *(u32x4*)p = o;
}
__device__ __forceinline__ void st8bf_nt(bf16_t* p, const float* v) {
    u32x4 o; o.x = pk2(v[0], v[1]); o.y = pk2(v[2], v[3]); o.z = pk2(v[4], v[5]); o.w = pk2(v[6], v[7]);
    __builtin_nontemporal_store(o, (u32x4*)p);
}
__device__ __forceinline__ void st4bf(bf16_t* p, const float* v) {
    u32x2 o; o.x = pk2(v[0], v[1]); o.y = pk2(v[2], v[3]);
    *(u32x2*)p = o;
}
template <int MODE> __device__ __forceinline__ void epi8(const Params& P, int m, int n, const float* v, int aux) {
    if (MODE == MODE_INPROJ) {
        if (n < 1280) st8bf_nt(P.GB() + (size_t)m * 512 + (n - 768), v);
        else if (n < 1792) st8bf_nt(P.GC() + (size_t)m * 512 + (n - 1280), v);
        else if (n < 2304) st8bf_nt(P.U() + (size_t)m * 512 + (n - 1792), v);
        else {
            unsigned q[8];
#pragma unroll
            for (int j = 0; j < 8; ++j) q[j] = (unsigned)__builtin_rintf(255.f * sigmoidf_(v[j]));
            u32x2 w; w.x = q[0] | (q[1] << 8) | (q[2] << 16) | (q[3] << 24); w.y = q[4] | (q[5] << 8) | (q[6] << 16) | (q[7] << 24);
            unsigned char* gp = (n < 3328) ? (P.GA() + (size_t)m * DM + (n - 2304)) : (P.GV() + (size_t)m * DM + (n - 3328));
            __builtin_nontemporal_store(w, (u32x2*)gp);
        }
    } else if (MODE == MODE_CTXKV) {
        { const int b = m / CTXL, c = m % CTXL, kvh = n >> 6, d0 = n & 63;
          st8bf(P.Kc() + ((((size_t)((b * 2 + kvh) * 8 + (c >> 5)) * 4 + (d0 >> 4)) * 2 + ((d0 >> 3) & 1)) * 32 + (c & 31)) * 8, v); }
    } else if (MODE == MODE_AO1) {
        const u32x2 g = *(const u32x2*)((aux ? P.GV() : P.GA()) + (size_t)m * DM + n);
        u32x4 a = (u32x4){0u, 0u, 0u, 0u};
        if (aux) a = *(const u32x4*)(P.M1() + (size_t)m * DM + n);
        const float k255 = 1.f / 255.f;
        float o[8];
        o[0] = bf2f(a.x & 0xffff) + v[0] * (k255 * UB0(g.x)); o[1] = bf2f(a.x >> 16) + v[1] * (k255 * UB1(g.x));
        o[2] = bf2f(a.y & 0xffff) + v[2] * (k255 * UB2(g.x)); o[3] = bf2f(a.y >> 16) + v[3] * (k255 * UB3(g.x));
        o[4] = bf2f(a.z & 0xffff) + v[4] * (k255 * UB0(g.y)); o[5] = bf2f(a.z >> 16) + v[5] * (k255 * UB1(g.y));
        o[6] = bf2f(a.w & 0xffff) + v[6] * (k255 * UB2(g.y)); o[7] = bf2f(a.w >> 16) + v[7] * (k255 * UB3(g.y));
        st8bf((aux ? P.YG() : P.M1()) + (size_t)m * DM + n, o);
    } else if (MODE == MODE_MIX) {
        const int b = m / SEQ;
        const float* g1 = P.mod() + (size_t)b * NMOD + 2 * DM + n;
        const float* xr = P.x + (size_t)m * DM + n;
        const f32x4 x0 = *(const f32x4*)xr, x1 = *(const f32x4*)(xr + 4), g0 = *(const f32x4*)g1, g1v = *(const f32x4*)(g1 + 4);
        float o[8];
        o[0] = x0.x + g0.x * v[0]; o[1] = x0.y + g0.y * v[1]; o[2] = x0.z + g0.z * v[2]; o[3] = x0.w + g0.w * v[3];
        o[4] = x1.x + g1v.x * v[4]; o[5] = x1.y + g1v.y * v[5]; o[6] = x1.z + g1v.z * v[6]; o[7] = x1.w + g1v.w * v[7];
        st8bf(P.X1() + (size_t)m * DM + n, o);
    }
}
__device__ __forceinline__ void epi_rope(const Params& P, int m, int n, const float* lo, const float* hi) {
    const int d0 = n & 63;
    const int l = m % SEQ;
    const float *ct, *st;
    if (d0 < 16) { const int row = l >> 6; ct = P.rope() + row * 16 + d0; st = P.rope() + 512 + row * 16 + d0; }
    else { const int col = l & 63; ct = P.rope() + 1024 + col * 16 + (d0 - 32); st = P.rope() + 2048 + col * 16 + (d0 - 32); }
    float a[4], b[4];
    const float sc = (n < 512) ? 0.125f * 1.44269504088896f : 1.f;
#pragma unroll
    for (int j = 0; j < 4; ++j) { const float cc = ct[j], ss = st[j]; a[j] = (lo[j] * cc - hi[j] * ss) * sc; b[j] = (lo[j] * ss + hi[j] * cc) * sc; }
    if (n < 512) { st4bf(P.Q() + (size_t)m * 512 + n, a); st4bf(P.Q() + (size_t)m * 512 + n + 16, b); }
    else { const int bb = m / SEQ, kvh = (n - 512) >> 6;
        bf16_t* kp = P.K() + ((((size_t)((bb * 2 + kvh) * 64 + (l >> 5)) * 4 + (d0 >> 4)) * 2 + ((d0 >> 3) & 1)) * 32 + (l & 31)) * 8 + (d0 & 7);
        st4bf(kp, a); st4bf(kp + 512, b); }
}
__device__ __forceinline__ void epi_v4(const Params& P, int m, int dcol, const float* v, bool ctx) {
    const int kvh = dcol >> 6, dd = dcol & 63;
    if (!ctx) { const int b = m / SEQ, l = m % SEQ;
#pragma unroll
        for (int j = 0; j < 4; ++j) {
            const int kk = l & 31;
            P.VT()[(((((size_t)((b * 2 + kvh) * 64 + (l >> 5)) * 2 + (dd >> 5)) * 2 + (kk >> 4)) * 2 + ((kk >> 2) & 1)) * 32 + ((dd & 31) + j)) * 8 + 4 * ((kk >> 3) & 1) + (kk & 3)] = f2bf(v[j]); }
    } else { const int b = m / CTXL, cpos = m % CTXL;
#pragma unroll
        for (int j = 0; j < 4; ++j) {
            const int kk = cpos & 31;
            P.VcT()[(((((size_t)((b * 2 + kvh) * 8 + (cpos >> 5)) * 2 + (dd >> 5)) * 2 + (kk >> 4)) * 2 + ((kk >> 2) & 1)) * 32 + ((dd & 31) + j)) * 8 + 4 * ((kk >> 3) & 1) + (kk & 3)] = f2bf(v[j]); }
    }
}

constexpr int GEMM_LDS = 65536;
constexpr int RETR_LDS = 128 * 136 * 4;
__device__ __forceinline__ int lds_off(int row, int chunk) { return row * 128 + ((chunk ^ ((row >> 1) & 7)) << 4); }

__device__ __forceinline__ void mma_from_lds(const char* As, const char* Bs, f32x4 (&acc)[4][4], int wm, int wn, int fr, int fq, int sw) {
#pragma unroll
    for (int ks = 0; ks < 2; ++ks) {
        bf16x8 af[4], bfr[4];
        const int coff = ((ks * 4 + fq) ^ sw) << 4;
#pragma unroll
        for (int mt = 0; mt < 4; ++mt) af[mt] = *(const bf16x8*)(As + (wm * 64 + mt * 16 + fr) * 128 + coff);
#pragma unroll
        for (int nt = 0; nt < 4; ++nt) bfr[nt] = *(const bf16x8*)(Bs + (wn * 64 + nt * 16 + fr) * 128 + coff);
#pragma unroll
        for (int mt = 0; mt < 4; ++mt)
#pragma unroll
            for (int nt = 0; nt < 4; ++nt) acc[mt][nt] = __builtin_amdgcn_mfma_f32_16x16x32_bf16(bfr[nt], af[mt], acc[mt][nt], 0, 0, 0);
    }
}
template <int MT, int NST, bool I8 = false>
__device__ __forceinline__ void gemm_ring(const bf16_t* __restrict__ A, int lda, const bf16_t* __restrict__ Bt, int ldb, int K, int m0, int n0, bool perm, char* smem, f32x4 (&acc)[MT][4]) {
    constexpr int SA = 2048 * MT, SB = SA + 8192, GA = MT / 2, GL = GA + 2;
    const int tid = threadIdx.x, lane = tid & 63, wid = __builtin_amdgcn_readfirstlane(tid >> 6);
    const int wm = wid >> 1, wn = wid & 1, fr = lane & 15, fq = lane >> 4;
    const int c8 = ((lane & 3) ^ (3 * ((lane >> 4) & 1))) * 8;
    unsigned aoff[GA], boff[2];
#pragma unroll
    for (int i = 0; i < GA; ++i) aoff[i] = (unsigned)(((wid + 4 * i) * 16 + (lane >> 2)) * lda + c8) * 2u;
#pragma unroll
    for (int i = 0; i < 2; ++i) {
        const int row = (wid + 4 * i) * 16 + (lane >> 2);
        int brow = row;
        if (perm) { const int g = row >> 6, rr = row & 63, nn = rr >> 4, j = rr & 15; brow = 64 * g + 16 * (j >> 2) + 4 * nn + (j & 3); }
        boff[i] = (unsigned)(brow * ldb + c8) * 2u;
    }
    const char* Abase = (const char*)(A + (size_t)m0 * lda);
    const char* Bbase = (const char*)(Bt + (size_t)n0 * ldb);
#pragma unroll
    for (int i = 0; i < MT; ++i)
#pragma unroll
        for (int j = 0; j < 4; ++j) acc[i][j] = (f32x4){0.f, 0.f, 0.f, 0.f};
#define RSTAGE_(buf, k0) { char* sb_ = smem + (buf) * SB; const char* ab_ = Abase + (size_t)(k0) * 2; const char* bb_ = Bbase + (size_t)(k0) * 2; \
        _Pragma("unroll") for (int i = 0; i < GA; ++i) __builtin_amdgcn_global_load_lds((const unsigned*)(ab_ + aoff[i]), (unsigned*)(sb_ + (wid + 4 * i) * 1024), 16, 0, 0); \
        _Pragma("unroll") for (int i = 0; i < 2; ++i) __builtin_amdgcn_global_load_lds((const unsigned*)(bb_ + boff[i]), (unsigned*)(sb_ + SA + (wid + 4 * i) * 1024), 16, 0, 0); }
    const int nk = K / 32;
    asm volatile("s_waitcnt vmcnt(0)" ::: "memory");
#pragma unroll
    for (int s = 0; s < NST - 1; ++s) RSTAGE_(s, s * 32)
    const int coff = (fq ^ (3 * ((fr >> 2) & 1))) << 4;
    int cur = 0, nxt = NST - 1;
#pragma unroll 1
    for (int kt = 0; kt < nk; ++kt) {
        const int rem = nk - 1 - kt;
        if (rem >= NST - 2) asm volatile("s_waitcnt vmcnt(%0)" :: "n"(GL * (NST - 2)) : "memory");
        else if (NST == 4 && rem == 1) asm volatile("s_waitcnt vmcnt(%0)" :: "n"(GL) : "memory");
        else asm volatile("s_waitcnt vmcnt(0)" ::: "memory");
        __builtin_amdgcn_s_barrier();
        const char* As = smem + cur * SB;
        const char* Bs = As + SA;
        bf16x8 af[MT], bfr[4];
#pragma unroll
        for (int mt = 0; mt < MT; ++mt) af[mt] = *(const bf16x8*)(As + (wm * 16 * MT + mt * 16 + fr) * 64 + coff);
#pragma unroll
        for (int nt = 0; nt < 4; ++nt) bfr[nt] = *(const bf16x8*)(Bs + (wn * 64 + nt * 16 + fr) * 64 + coff);
        const bool more = (kt + NST - 1 < nk);
        char* sb_ = smem + nxt * SB; const char* ab_ = Abase + (size_t)((kt + NST - 1) * 32) * 2; const char* bb_ = Bbase + (size_t)((kt + NST - 1) * 32) * 2;
        __builtin_amdgcn_s_setprio(1);
#pragma unroll
        for (int mt = 0; mt < MT; ++mt) {
#pragma unroll
            for (int nt = 0; nt < 4; ++nt) {
                if (I8) acc[mt][nt] = __builtin_bit_cast(f32x4, __builtin_amdgcn_mfma_i32_16x16x64_i8(__builtin_bit_cast(i32x4, bfr[nt]), __builtin_bit_cast(i32x4, af[mt]), __builtin_bit_cast(i32x4, acc[mt][nt]), 0, 0, 0));
                else acc[mt][nt] = __builtin_amdgcn_mfma_f32_16x16x32_bf16(bfr[nt], af[mt], acc[mt][nt], 0, 0, 0);
            }
            if (more) {
                if (mt < GA) __builtin_amdgcn_global_load_lds((const unsigned*)(ab_ + aoff[mt]), (unsigned*)(sb_ + (wid + 4 * mt) * 1024), 16, 0, 0);
                else if (mt < GA + 2) __builtin_amdgcn_global_load_lds((const unsigned*)(bb_ + boff[mt - GA]), (unsigned*)(sb_ + SA + (wid + 4 * (mt - GA)) * 1024), 16, 0, 0);
            }
        }
        __builtin_amdgcn_s_setprio(0);
        cur = (cur + 1 == NST) ? 0 : cur + 1;
        nxt = (nxt + 1 == NST) ? 0 : nxt + 1;
    }
#undef RSTAGE_
    __syncthreads();
}

__device__ __forceinline__ void gemm_ring_qh(const signed char* __restrict__ A, const signed char* __restrict__ Bt, int m0, char* smem, i32x4 (&acc0)[4][4], i32x4 (&acc1)[4][4]) {
    constexpr int SA = 8192, SB = SA + 16384, NST = 3, GL = 6;
    const int tid = threadIdx.x, lane = tid & 63, wid = __builtin_amdgcn_readfirstlane(tid >> 6);
    const int wm = wid >> 1, wn = wid & 1, fr = lane & 15, fq = lane >> 4;
    const int c16 = ((lane & 3) ^ (3 * ((lane >> 4) & 1))) * 16;
    unsigned aoff[2], boff[4];
#pragma unroll
    for (int i = 0; i < 2; ++i) aoff[i] = (unsigned)(((wid + 4 * i) * 16 + (lane >> 2)) * DM + c16);
#pragma unroll
    for (int i = 0; i < 4; ++i) boff[i] = (unsigned)(((wid + 4 * i) * 16 + (lane >> 2)) * DM + c16);
    const char* Abase = (const char*)(A + (size_t)m0 * DM);
    const char* Bbase = (const char*)Bt;
#pragma unroll
    for (int i = 0; i < 4; ++i)
#pragma unroll
        for (int j = 0; j < 4; ++j) { acc0[i][j] = (i32x4){0, 0, 0, 0}; acc1[i][j] = (i32x4){0, 0, 0, 0}; }
    const int nk = DM / 64;
    asm volatile("s_waitcnt vmcnt(0)" ::: "memory");
#pragma unroll
    for (int s = 0; s < NST - 1; ++s) {
        char* sb_ = smem + s * SB; const char* ab_ = Abase + s * 64; const char* bb_ = Bbase + s * 64;
#pragma unroll
        for (int i = 0; i < 2; ++i) __builtin_amdgcn_global_load_lds((const unsigned*)(ab_ + aoff[i]), (unsigned*)(sb_ + (wid + 4 * i) * 1024), 16, 0, 0);
#pragma unroll
        for (int i = 0; i < 4; ++i) __builtin_amdgcn_global_load_lds((const unsigned*)(bb_ + boff[i]), (unsigned*)(sb_ + SA + (wid + 4 * i) * 1024), 16, 0, 0);
    }
    const int coff = (fq ^ (3 * ((fr >> 2) & 1))) << 4;
    int cur = 0, nxt = NST - 1;
#pragma unroll 1
    for (int kt = 0; kt < nk; ++kt) {
        if (nk - 1 - kt >= NST - 2) asm volatile("s_waitcnt vmcnt(%0)" :: "n"(GL * (NST - 2)) : "memory");
        else asm volatile("s_waitcnt vmcnt(0)" ::: "memory");
        __builtin_amdgcn_s_barrier();
        const char* As = smem + cur * SB;
        const char* Bs = As + SA;
        i32x4 af[4], b0[4], b1[4];
#pragma unroll
        for (int mt = 0; mt < 4; ++mt) af[mt] = *(const i32x4*)(As + (wm * 64 + mt * 16 + fr) * 64 + coff);
#pragma unroll
        for (int nt = 0; nt < 4; ++nt) { b0[nt] = *(const i32x4*)(Bs + (wn * 64 + nt * 16 + fr) * 64 + coff); b1[nt] = *(const i32x4*)(Bs + (128 + wn * 64 + nt * 16 + fr) * 64 + coff); }
        const bool more = (kt + NST - 1 < nk);
        char* sb_ = smem + nxt * SB; const char* ab_ = Abase + (kt + NST - 1) * 64; const char* bb_ = Bbase + (kt + NST - 1) * 64;
        __builtin_amdgcn_s_setprio(1);
#pragma unroll
        for (int mt = 0; mt < 4; ++mt) {
#pragma unroll
            for (int nt = 0; nt < 4; ++nt) {
                acc0[mt][nt] = __builtin_amdgcn_mfma_i32_16x16x64_i8(b0[nt], af[mt], acc0[mt][nt], 0, 0, 0);
                acc1[mt][nt] = __builtin_amdgcn_mfma_i32_16x16x64_i8(b1[nt], af[mt], acc1[mt][nt], 0, 0, 0);
            }
            if (more) {
                if (mt < 2) __builtin_amdgcn_global_load_lds((const unsigned*)(ab_ + aoff[mt]), (unsigned*)(sb_ + (wid + 4 * mt) * 1024), 16, 0, 0);
                __builtin_amdgcn_global_load_lds((const unsigned*)(bb_ + boff[mt]), (unsigned*)(sb_ + SA + (wid + 4 * mt) * 1024), 16, 0, 0);
            }
        }
        __builtin_amdgcn_s_setprio(0);
        cur = (cur + 1 == NST) ? 0 : cur + 1;
        nxt = (nxt + 1 == NST) ? 0 : nxt + 1;
    }
    __syncthreads();
}

template <int MODE, int MT, bool I8 = false>
__device__ __forceinline__ void gemm_tile(const Params& P, const bf16_t* __restrict__ A, int lda, const bf16_t* __restrict__ Bt, int ldb, int K, int m0, int n0, bool perm, char* smem, int aux = 0) {
    const int lane = threadIdx.x & 63, wid = threadIdx.x >> 6;
    const int wm = wid >> 1, wn = wid & 1, fr = lane & 15, fq = lane >> 4;
    f32x4 acc[MT][4];
    gemm_ring<MT, (MT == 8 ? 3 : 4), I8>(A, lda, Bt, ldb, K, m0, n0, perm, smem, acc);
    float cs[16];
    if (I8) { const unsigned* wg = P.bar() + XCD_BAR_WORDS_C + 2048 + (n0 - 2304) + wn * 64 + 16 * fq;
#pragma unroll
        for (int q4 = 0; q4 < 4; ++q4) { const u32x4 w = *(const u32x4*)(wg + 4 * q4);
            cs[4 * q4] = __uint_as_float(w.x) * (1.f / 127.f); cs[4 * q4 + 1] = __uint_as_float(w.y) * (1.f / 127.f); cs[4 * q4 + 2] = __uint_as_float(w.z) * (1.f / 127.f); cs[4 * q4 + 3] = __uint_as_float(w.w) * (1.f / 127.f); } }
    f32x4 xq[2][4];
    float rsq[MT];
    if (I8 && MODE == MODE_INPROJ) {
#pragma unroll
        for (int mt = 0; mt < MT; ++mt) rsq[mt] = P.sh1()[m0 + wm * 16 * MT + mt * 16 + fr]; }
    char* xst = smem + 2 * (2048 * MT + 8192) + wid * 4352;
    const float* xcol = P.x + (size_t)(m0 + wm * 16 * MT + (lane >> 4)) * DM + n0 + wn * 64 + 4 * (lane & 15);
    if (MODE == MODE_MIX) {
#pragma unroll
        for (int q4 = 0; q4 < 4; ++q4) xq[0][q4] = __builtin_nontemporal_load((const f32x4*)(xcol + (size_t)(4 * q4) * DM)); }
    f32x4 g1v[4];
    if (MODE == MODE_MIX) { const float* g1 = P.mod() + (size_t)(m0 / SEQ) * NMOD + 2 * DM + n0 + wn * 64 + 16 * fq;
#pragma unroll
        for (int q4 = 0; q4 < 4; ++q4) g1v[q4] = *(const f32x4*)(g1 + 4 * q4); }
#pragma unroll
    for (int mt = 0; mt < MT; ++mt) {
        const int m = m0 + wm * 16 * MT + mt * 16 + fr;
        if (MODE == MODE_MIX) {
#pragma unroll
            for (int q4 = 0; q4 < 4; ++q4) *(f32x4*)(xst + (4 * q4 + (lane >> 4)) * 272 + (lane & 15) * 16) = xq[mt & 1][q4];
            if (mt + 1 < MT) {
#pragma unroll
                for (int q4 = 0; q4 < 4; ++q4) xq[(mt + 1) & 1][q4] = __builtin_nontemporal_load((const f32x4*)(xcol + (size_t)(16 * (mt + 1) + 4 * q4) * DM)); }
#pragma unroll
            for (int q4 = 0; q4 < 4; ++q4) xq[mt & 1][q4] = *(const f32x4*)(xst + fr * 272 + fq * 64 + q4 * 16);
        }
        if (perm) {
            const int nb = n0 + wn * 64 + 16 * fq;
            if (MODE == MODE_INPROJ && n0 >= 2304) {
                const float rs8 = I8 ? rsq[mt] : 1.f;
                unsigned q[16];
#pragma unroll
                for (int nt = 0; nt < 4; ++nt)
#pragma unroll
                    for (int r = 0; r < 4; ++r) {
                        const float z = I8 ? (float)__builtin_bit_cast(i32x4, acc[mt][nt])[r] * (rs8 * cs[4 * nt + r]) : acc[mt][nt][r];
                        q[4 * nt + r] = (unsigned)__builtin_rintf(255.f * sigmoidf_(z)); }
                u32x4 w;
                w.x = q[0] | (q[1] << 8) | (q[2] << 16) | (q[3] << 24); w.y = q[4] | (q[5] << 8) | (q[6] << 16) | (q[7] << 24);
                w.z = q[8] | (q[9] << 8) | (q[10] << 16) | (q[11] << 24); w.w = q[12] | (q[13] << 8) | (q[14] << 16) | (q[15] << 24);
                unsigned char* gp = (nb < 3328) ? (P.GA() + (size_t)m * DM + (nb - 2304)) : (P.GV() + (size_t)m * DM + (nb - 3328));
                __builtin_nontemporal_store(w, (u32x4*)gp);
            } else {
#pragma unroll
                for (int p = 0; p < 2; ++p) {
                    float v[8] = { acc[mt][2 * p][0], acc[mt][2 * p][1], acc[mt][2 * p][2], acc[mt][2 * p][3], acc[mt][2 * p + 1][0], acc[mt][2 * p + 1][1], acc[mt][2 * p + 1][2], acc[mt][2 * p + 1][3] };
                    if (MODE == MODE_MIX) {
                        const f32x4 x0 = xq[mt & 1][2 * p], x1 = xq[mt & 1][2 * p + 1], ga_ = g1v[2 * p], gb_ = g1v[2 * p + 1];
                        float o[8] = { x0.x + ga_.x * v[0], x0.y + ga_.y * v[1], x0.z + ga_.z * v[2], x0.w + ga_.w * v[3], x1.x + gb_.x * v[4], x1.y + gb_.y * v[5], x1.z + gb_.z * v[6], x1.w + gb_.w * v[7] };
                        st8bf(P.X1() + (size_t)m * DM + nb + 8 * p, o);
                    } else epi8<MODE>(P, m, nb + 8 * p, v, aux);
                }
            }
        } else if (MODE == MODE_INPROJ && n0 < 640) {
#pragma unroll
            for (int p = 0; p < 2; ++p) {
                float lo[4] = { acc[mt][2 * p][0], acc[mt][2 * p][1], acc[mt][2 * p][2], acc[mt][2 * p][3] };
                float hi[4] = { acc[mt][2 * p + 1][0], acc[mt][2 * p + 1][1], acc[mt][2 * p + 1][2], acc[mt][2 * p + 1][3] };
                epi_rope(P, m, n0 + wn * 64 + 32 * p + 4 * fq, lo, hi);
            }
        } else if (MODE == MODE_INPROJ || MODE == MODE_CTXKV) {
            const int dbase = (MODE == MODE_INPROJ) ? (n0 - 640) : (n0 - 128);
#pragma unroll
            for (int nt = 0; nt < 4; ++nt) {
                float v[4] = { acc[mt][nt][0], acc[mt][nt][1], acc[mt][nt][2], acc[mt][nt][3] };
                epi_v4(P, m, dbase + wn * 64 + 16 * nt + 4 * fq, v, MODE == MODE_CTXKV);
            }
        }
        asm volatile("" ::: "memory"); __builtin_amdgcn_sched_barrier(0);
    }
}
__device__ __forceinline__ void gemm_ring_ao(const bf16_t* __restrict__ A1, const bf16_t* __restrict__ B1, const bf16_t* __restrict__ A2, const bf16_t* __restrict__ B2,
                                              int m0, int n0, char* smem, f32x4 (&acc1)[4][4], f32x4 (&acc2)[4][4]) {
    constexpr int MT = 4, NST = 4, SA = 2048 * MT, SB = SA + 8192, GA = 2, GL = GA + 2, LD = 512, KS = 16;
    const int tid = threadIdx.x, lane = tid & 63, wid = __builtin_amdgcn_readfirstlane(tid >> 6);
    const int wm = wid >> 1, wn = wid & 1, fr = lane & 15, fq = lane >> 4;
    const int c8 = ((lane & 3) ^ (3 * ((lane >> 4) & 1))) * 8;
    unsigned aoff[GA], boff[2];
#pragma unroll
    for (int i = 0; i < GA; ++i) aoff[i] = (unsigned)(((wid + 4 * i) * 16 + (lane >> 2)) * LD + c8) * 2u;
#pragma unroll
    for (int i = 0; i < 2; ++i) {
        const int row = (wid + 4 * i) * 16 + (lane >> 2);
        const int g = row >> 6, rr = row & 63, nn = rr >> 4, j = rr & 15; const int brow = 64 * g + 16 * (j >> 2) + 4 * nn + (j & 3);
        boff[i] = (unsigned)(brow * LD + c8) * 2u;
    }
    const char* Ab1 = (const char*)(A1 + (size_t)m0 * LD); const char* Bb1 = (const char*)(B1 + (size_t)n0 * LD);
    const char* Ab2 = (const char*)(A2 + (size_t)m0 * LD); const char* Bb2 = (const char*)(B2 + (size_t)n0 * LD);
#pragma unroll
    for (int i = 0; i < MT; ++i)
#pragma unroll
        for (int j = 0; j < 4; ++j) { acc1[i][j] = (f32x4){0.f, 0.f, 0.f, 0.f}; acc2[i][j] = (f32x4){0.f, 0.f, 0.f, 0.f}; }
    const int nk = 2 * KS;
    asm volatile("s_waitcnt vmcnt(0)" ::: "memory");
#pragma unroll
    for (int s = 0; s < NST - 1; ++s) {
        char* sb_ = smem + s * SB; const char* ab_ = Ab1 + (size_t)(s * 32) * 2; const char* bb_ = Bb1 + (size_t)(s * 32) * 2;
#pragma unroll
        for (int i = 0; i < GA; ++i) __builtin_amdgcn_global_load_lds((const unsigned*)(ab_ + aoff[i]), (unsigned*)(sb_ + (wid + 4 * i) * 1024), 16, 0, 0);
#pragma unroll
        for (int i = 0; i < 2; ++i) __builtin_amdgcn_global_load_lds((const unsigned*)(bb_ + boff[i]), (unsigned*)(sb_ + SA + (wid + 4 * i) * 1024), 16, 0, 0);
    }
    const int coff = (fq ^ (3 * ((fr >> 2) & 1))) << 4;
    int cur = 0, nxt = NST - 1;
#define AO_STEP(ACC) { \
        const int rem = nk - 1 - kt; \
        if (rem >= NST - 2) asm volatile("s_waitcnt vmcnt(%0)" :: "n"(GL * (NST - 2)) : "memory"); \
        else if (rem == 1) asm volatile("s_waitcnt vmcnt(%0)" :: "n"(GL) : "memory"); \
        else asm volatile("s_waitcnt vmcnt(0)" ::: "memory"); \
        __builtin_amdgcn_s_barrier(); \
        const char* As = smem + cur * SB; \
        const char* Bs = As + SA; \
        bf16x8 af[MT], bfr[4]; \
        _Pragma("unroll") for (int mt = 0; mt < MT; ++mt) af[mt] = *(const bf16x8*)(As + (wm * 16 * MT + mt * 16 + fr) * 64 + coff); \
        _Pragma("unroll") for (int nt = 0; nt < 4; ++nt) bfr[nt] = *(const bf16x8*)(Bs + (wn * 64 + nt * 16 + fr) * 64 + coff); \
        const int kn = kt + NST - 1; \
        const bool more = kn < nk; \
        char* sb_ = smem + nxt * SB; \
        const char* ab_ = (kn < KS ? Ab1 + (size_t)(kn * 32) * 2 : Ab2 + (size_t)((kn - KS) * 32) * 2); \
        const char* bb_ = (kn < KS ? Bb1 + (size_t)(kn * 32) * 2 : Bb2 + (size_t)((kn - KS) * 32) * 2); \
        __builtin_amdgcn_s_setprio(1); \
        _Pragma("unroll") for (int mt = 0; mt < MT; ++mt) { \
            _Pragma("unroll") for (int nt = 0; nt < 4; ++nt) ACC[mt][nt] = __builtin_amdgcn_mfma_f32_16x16x32_bf16(bfr[nt], af[mt], ACC[mt][nt], 0, 0, 0); \
            if (more) { \
                if (mt < GA) __builtin_amdgcn_global_load_lds((const unsigned*)(ab_ + aoff[mt]), (unsigned*)(sb_ + (wid + 4 * mt) * 1024), 16, 0, 0); \
                else __builtin_amdgcn_global_load_lds((const unsigned*)(bb_ + boff[mt - GA]), (unsigned*)(sb_ + SA + (wid + 4 * (mt - GA)) * 1024), 16, 0, 0); \
            } \
        } \
        __builtin_amdgcn_s_setprio(0); \
        cur = (cur + 1 == NST) ? 0 : cur + 1; \
        nxt = (nxt + 1 == NST) ? 0 : nxt + 1; }
    int kt = 0;
#pragma unroll 1
    for (; kt < KS; ++kt) AO_STEP(acc1)
#pragma unroll 1
    for (; kt < nk; ++kt) AO_STEP(acc2)
#undef AO_STEP
    __syncthreads();
}
__device__ __forceinline__ void gemm_tile_ao(const Params& P, int m0, int n0, char* smem) {
    const int lane = threadIdx.x & 63, wid = threadIdx.x >> 6;
    const int wm = wid >> 1, wn = wid & 1, fr = lane & 15, fq = lane >> 4;
    f32x4 a1[4][4], a2[4][4];
    gemm_ring_ao(P.AO(), P.WaoT(), P.CA(), P.WcoT(), m0, n0, smem, a1, a2);
    const float k255 = 1.f / 255.f;
    u32x4 gaq[4], gvq[4];
#pragma unroll
    for (int mt = 0; mt < 4; ++mt) { const int m = m0 + wm * 64 + mt * 16 + fr, nb = n0 + wn * 64 + 16 * fq;
        gaq[mt] = *(const u32x4*)(P.GA() + (size_t)m * DM + nb); gvq[mt] = *(const u32x4*)(P.GV() + (size_t)m * DM + nb); }
#pragma unroll
    for (int mt = 0; mt < 4; ++mt) {
        const int m = m0 + wm * 64 + mt * 16 + fr, nb = n0 + wn * 64 + 16 * fq;
        const u32x4 ga = gaq[mt], gv = gvq[mt];
        const unsigned gaw[4] = { ga.x, ga.y, ga.z, ga.w }, gvw[4] = { gv.x, gv.y, gv.z, gv.w };
        float o[16];
#pragma unroll
        for (int nt = 0; nt < 4; ++nt) {
            o[4 * nt + 0] = (k255 * UB0(gaw[nt])) * a1[mt][nt][0] + (k255 * UB0(gvw[nt])) * a2[mt][nt][0];
            o[4 * nt + 1] = (k255 * UB1(gaw[nt])) * a1[mt][nt][1] + (k255 * UB1(gvw[nt])) * a2[mt][nt][1];
            o[4 * nt + 2] = (k255 * UB2(gaw[nt])) * a1[mt][nt][2] + (k255 * UB2(gvw[nt])) * a2[mt][nt][2];
            o[4 * nt + 3] = (k255 * UB3(gaw[nt])) * a1[mt][nt][3] + (k255 * UB3(gvw[nt])) * a2[mt][nt][3];
        }
        st8bf(P.YG() + (size_t)m * DM + nb, o); st8bf(P.YG() + (size_t)m * DM + nb + 8, o + 8);
        asm volatile("" ::: "memory"); __builtin_amdgcn_sched_barrier(0);
    }
}
__device__ __forceinline__ void tile_coords(int t, int ntm, int ntn, int& mt, int& nt) {
    const int per = 8 * ntn, g = t / per, r = t % per;
    mt = g * 8 + (r & 7); nt = r >> 3;
}
#define CEU(a, b) { const unsigned _t = (a) > (b) ? (a) : (b); (b) = (a) > (b) ? (b) : (a); (a) = _t; }
__device__ __forceinline__ void sort16_desc(unsigned (&v)[16]) {
    CEU(v[0], v[1]); CEU(v[2], v[3]); CEU(v[0], v[2]); CEU(v[1], v[3]); CEU(v[1], v[2]); CEU(v[4], v[5]);
    CEU(v[6], v[7]); CEU(v[4], v[6]); CEU(v[5], v[7]); CEU(v[5], v[6]); CEU(v[0], v[4]); CEU(v[2], v[6]);
    CEU(v[2], v[4]); CEU(v[1], v[5]); CEU(v[3], v[7]); CEU(v[3], v[5]); CEU(v[1], v[2]); CEU(v[3], v[4]);
    CEU(v[5], v[6]); CEU(v[8], v[9]); CEU(v[10], v[11]); CEU(v[8], v[10]); CEU(v[9], v[11]); CEU(v[9], v[10]);
    CEU(v[12], v[13]); CEU(v[14], v[15]); CEU(v[12], v[14]); CEU(v[13], v[15]); CEU(v[13], v[14]); CEU(v[8], v[12]);
    CEU(v[10], v[14]); CEU(v[10], v[12]); CEU(v[9], v[13]); CEU(v[11], v[15]); CEU(v[11], v[13]); CEU(v[9], v[10]);
    CEU(v[11], v[12]); CEU(v[13], v[14]); CEU(v[0], v[8]); CEU(v[4], v[12]); CEU(v[4], v[8]); CEU(v[2], v[10]);
    CEU(v[6], v[14]); CEU(v[6], v[10]); CEU(v[2], v[4]); CEU(v[6], v[8]); CEU(v[10], v[12]); CEU(v[1], v[9]);
    CEU(v[5], v[13]); CEU(v[5], v[9]); CEU(v[3], v[11]); CEU(v[7], v[15]); CEU(v[7], v[11]); CEU(v[3], v[5]);
    CEU(v[7], v[9]); CEU(v[11], v[13]); CEU(v[1], v[2]); CEU(v[3], v[4]); CEU(v[5], v[6]); CEU(v[7], v[8]);
    CEU(v[9], v[10]); CEU(v[11], v[12]); CEU(v[13], v[14]);
}
__device__ __forceinline__ void bitonic16_desc(unsigned (&v)[16]) {
    CEU(v[0], v[8]); CEU(v[1], v[9]); CEU(v[2], v[10]); CEU(v[3], v[11]); CEU(v[4], v[12]); CEU(v[5], v[13]);
    CEU(v[6], v[14]); CEU(v[7], v[15]); CEU(v[0], v[4]); CEU(v[1], v[5]); CEU(v[2], v[6]); CEU(v[3], v[7]);
    CEU(v[8], v[12]); CEU(v[9], v[13]); CEU(v[10], v[14]); CEU(v[11], v[15]); CEU(v[0], v[2]); CEU(v[1], v[3]);
    CEU(v[4], v[6]); CEU(v[5], v[7]); CEU(v[8], v[10]); CEU(v[9], v[11]); CEU(v[12], v[14]); CEU(v[13], v[15]);
    CEU(v[0], v[1]); CEU(v[2], v[3]); CEU(v[4], v[5]); CEU(v[6], v[7]); CEU(v[8], v[9]); CEU(v[10], v[11]);
    CEU(v[12], v[13]); CEU(v[14], v[15]);
}

__device__ __forceinline__ unsigned enc_key(float f) { const unsigned b = __float_as_uint(f); return b ^ ((unsigned)((int)b >> 31) | 0x80000000u); }
__device__ __forceinline__ float dec_key(unsigned k) { const unsigned b = (k & 0x80000000u) ? (k & 0x7fffffffu) : ~k; return __uint_as_float(b); }
__device__ __forceinline__ void topmerge16(unsigned (&top)[16], const unsigned (&L)[16]) {
#pragma unroll
    for (int i = 0; i < 16; ++i) top[i] = top[i] > L[15 - i] ? top[i] : L[15 - i];
    bitonic16_desc(top);
}
__device__ __forceinline__ unsigned cand_key(float a, float b, int i, int j) { return (enc_key(a + b) & ~0xFFu) | (unsigned)(i << 4) | (unsigned)j; }

__device__ __forceinline__ void peer_retrieve_item(const Params& P, int mtile, int h, char* smem) {
    const int tid = threadIdx.x, lane = tid & 63, wid = tid >> 6;
    const int wm = wid >> 1, wn = wid & 1, fr = lane & 15, fq = lane >> 4;
    const int sw = (fr >> 1) & 7;
    const int m0 = mtile * 128;
    unsigned T0[16], T1[16];
    u32x2 qh0[4][4], qh1[4][4];
    {
        i32x4 accq0[4][4], accq1[4][4];
        gemm_ring_qh(P.H2(), P.PwqT() + (size_t)h * 256 * DM, m0, smem, accq0, accq1);
        const unsigned* wam = P.bar() + XCD_BAR_WORDS_C + h * 256 + wn * 64 + fq * 4;
#pragma unroll
        for (int j = 0; j < 4; ++j) {
            const u32x4 w0 = *(const u32x4*)(wam + j * 16), w1 = *(const u32x4*)(wam + 128 + j * 16);
            const float c0[4] = { __uint_as_float(w0.x) * (1.f / 127.f), __uint_as_float(w0.y) * (1.f / 127.f), __uint_as_float(w0.z) * (1.f / 127.f), __uint_as_float(w0.w) * (1.f / 127.f) };
            const float c1[4] = { __uint_as_float(w1.x) * (1.f / 127.f), __uint_as_float(w1.y) * (1.f / 127.f), __uint_as_float(w1.z) * (1.f / 127.f), __uint_as_float(w1.w) * (1.f / 127.f) };
#pragma unroll
            for (int i = 0; i < 4; ++i) {
                const float st = P.sh2()[m0 + wm * 64 + i * 16 + fr] * (119.f / 127.f);
                qh0[i][j].x = pk2((float)accq0[i][j][0] * (st * c0[0]), (float)accq0[i][j][1] * (st * c0[1])); qh0[i][j].y = pk2((float)accq0[i][j][2] * (st * c0[2]), (float)accq0[i][j][3] * (st * c0[3]));
                qh1[i][j].x = pk2((float)accq1[i][j][0] * (st * c1[0]), (float)accq1[i][j][1] * (st * c1[1])); qh1[i][j].y = pk2((float)accq1[i][j][2] * (st * c1[2]), (float)accq1[i][j][3] * (st * c1[3]));
            }
        }
    }
#pragma unroll 1
    for (int p = 0; p < 2; ++p) {
        const int hp = h * 2 + p;
        f32x4 acc[4][4];
        u32x2 qh[4][4];
        if (p == 0) {
#pragma unroll
            for (int i = 0; i < 4; ++i)
#pragma unroll
                for (int j = 0; j < 4; ++j) qh[i][j] = qh0[i][j];
        } else {
#pragma unroll
            for (int i = 0; i < 4; ++i)
#pragma unroll
                for (int j = 0; j < 4; ++j) qh[i][j] = qh1[i][j];
        }
#pragma unroll
        for (int mt = 0; mt < 4; ++mt)
#pragma unroll
            for (int nt = 0; nt < 4; ++nt) {
                const int row = wm * 64 + mt * 16 + fr;
                *(u32x2*)(smem + wn * 32768 + lds_off(row, 2 * nt + (fq >> 1)) + (fq & 1) * 8) = qh[mt][nt];
            }
        {
            const int srow = tid >> 3, schunk = tid & 7;
            const bf16_t* kb = P.KeysB() + (size_t)hp * 128 * 128;
#pragma unroll
            for (int hf = 0; hf < 2; ++hf)
#pragma unroll
                for (int q = 0; q < 4; ++q) {
                    const int row = q * 32 + srow;
                    const u32x4 v = *(const u32x4*)(kb + (size_t)row * 128 + hf * 64 + schunk * 8);
                    *(u32x4*)(smem + hf * 32768 + 16384 + lds_off(row, schunk)) = v;
                }
        }
        __syncthreads();
#pragma unroll
        for (int i = 0; i < 4; ++i)
#pragma unroll
            for (int j = 0; j < 4; ++j) acc[i][j] = (f32x4){0.f, 0.f, 0.f, 0.f};
        mma_from_lds(smem, smem + 16384, acc, wm, wn, fr, fq, sw);
        mma_from_lds(smem + 32768, smem + 32768 + 16384, acc, wm, wn, fr, fq, sw);
        __syncthreads();
        float* sc = (float*)smem;
#pragma unroll
        for (int mt = 0; mt < 4; ++mt)
#pragma unroll
            for (int nt = 0; nt < 4; ++nt) {
                const int row = wm * 64 + mt * 16 + fr;
                *(f32x4*)(sc + row * 136 + wn * 68 + nt * 16 + fq * 4) = acc[mt][nt];
            }
        __syncthreads();
        {
            const int row = tid >> 1, half = tid & 1;
            const float* rp = sc + row * 136 + half * 68;
            unsigned top[16];
#pragma unroll 1
            for (int g = 0; g < 4; ++g) {
                unsigned L[16];
#pragma unroll
                for (int k4 = 0; k4 < 4; ++k4) { const f32x4 q = *(const f32x4*)(rp + g * 16 + 4 * k4); const int col = half * 64 + g * 16 + 4 * k4;
                    L[4 * k4] = (enc_key(q.x) & ~0x7Fu) | (unsigned)col; L[4 * k4 + 1] = (enc_key(q.y) & ~0x7Fu) | (unsigned)(col + 1);
                    L[4 * k4 + 2] = (enc_key(q.z) & ~0x7Fu) | (unsigned)(col + 2); L[4 * k4 + 3] = (enc_key(q.w) & ~0x7Fu) | (unsigned)(col + 3); }
                sort16_desc(L);
                if (g == 0) {
#pragma unroll
                    for (int j = 0; j < 16; ++j) top[j] = L[j];
                } else topmerge16(top, L);
            }
            unsigned Bp[16];
#pragma unroll
            for (int j = 0; j < 16; ++j) Bp[j] = (unsigned)__shfl_xor((int)top[j], 1);
            topmerge16(top, Bp);
            if (p == 0) {
#pragma unroll
                for (int j = 0; j < 16; ++j) T0[j] = top[j];
            } else {
#pragma unroll
                for (int j = 0; j < 16; ++j) T1[j] = top[j];
            }
        }
        __syncthreads();
    }
    {
        const int row = tid >> 1;
        unsigned char* slot = (unsigned char*)smem + row * 32;
        if ((tid & 1) == 0) {
#pragma unroll
            for (int j = 0; j < 16; ++j) { slot[j] = (unsigned char)(T0[j] & 0x7Fu); slot[16 + j] = (unsigned char)(T1[j] & 0x7Fu); }
            float a[16], b[16];
#pragma unroll
            for (int j = 0; j < 16; ++j) { a[j] = dec_key(T0[j]); b[j] = dec_key(T1[j]); }
            unsigned LA[16], LB[16], LC[16];
#pragma unroll
            for (int j = 0; j < 16; ++j) LA[j] = cand_key(a[0], b[j], 0, j);
#pragma unroll
            for (int j = 0; j < 8; ++j) LB[j] = cand_key(a[1], b[j], 1, j);
#pragma unroll
            for (int j = 0; j < 8; ++j) LB[8 + j] = cand_key(a[15 - j], b[0], 15 - j, 0);
            LC[0] = cand_key(a[2], b[0], 2, 0); LC[1] = cand_key(a[2], b[1], 2, 1); LC[2] = cand_key(a[2], b[2], 2, 2); LC[3] = cand_key(a[2], b[3], 2, 3); LC[4] = cand_key(a[2], b[4], 2, 4);
            LC[5] = cand_key(a[3], b[0], 3, 0); LC[6] = cand_key(a[3], b[1], 3, 1); LC[7] = cand_key(a[3], b[2], 3, 2); LC[8] = cand_key(a[3], b[3], 3, 3);
            LC[9] = cand_key(a[4], b[0], 4, 0); LC[10] = cand_key(a[4], b[1], 4, 1); LC[11] = cand_key(a[4], b[2], 4, 2);
            LC[12] = cand_key(a[5], b[0], 5, 0); LC[13] = cand_key(a[5], b[1], 5, 1);
            LC[14] = cand_key(a[6], b[0], 6, 0); LC[15] = cand_key(a[6], b[1], 6, 1);
            const unsigned d0 = cand_key(a[7], b[0], 7, 0), d1 = cand_key(a[7], b[1], 7, 1);
            bitonic16_desc(LB);
            sort16_desc(LC);
            topmerge16(LA, LB);
            LC[15] = LC[15] > d0 ? LC[15] : d0; LC[14] = LC[14] > d1 ? LC[14] : d1;
            bitonic16_desc(LC);
            topmerge16(LA, LC);
            float e[16], den = 0.f; const float vmax = dec_key(LA[0]);
#pragma unroll
            for (int r = 0; r < 16; ++r) { e[r] = __expf(dec_key(LA[r]) - vmax); den += e[r]; }
            const float inv = 1.f / den;
            const int t = m0 + row;
            int* oi = P.sel_idx() + (size_t)t * 128 + h * 16; float* og = P.sel_g() + (size_t)t * 128 + h * 16;
#pragma unroll
            for (int r = 0; r < 16; ++r) {
                const int i = (LA[r] >> 4) & 15, j = LA[r] & 15;
                oi[r] = (int)slot[i] * 128 + (int)slot[16 + j];
                og[r] = e[r] * inv;
            }
        }
    }
    __syncthreads();
}
typedef float f32x16 __attribute__((ext_vector_type(16)));
struct AttnFrag { u32x4 k[4]; u32x4 v[2][2]; };
__device__ __forceinline__ void attn_load(const Params& P, int b, int kvh, int qb, int w, int blk, int r, int hh, AttnFrag& f) {
    const bf16_t* kp; const bf16_t* vp;
    if (blk < 9) {
        int kpos0 = (qb - 1) * 128 + 32 * (w + blk);
        if (kpos0 < 0 || kpos0 >= SEQ) kpos0 = 0;
        const size_t blkoff = (size_t)((b * 2 + kvh) * 64 + (kpos0 >> 5)) * 2048 + (hh * 32 + r) * 8;
        kp = P.K() + blkoff; vp = P.VT() + blkoff;
    } else {
        const size_t blkoff = (size_t)((b * 2 + kvh) * 8 + (blk - 9)) * 2048 + (hh * 32 + r) * 8;
        kp = P.Kc() + blkoff; vp = P.VcT() + blkoff;
    }
#pragma unroll
    for (int ks = 0; ks < 4; ++ks) f.k[ks] = *(const u32x4*)(kp + 512 * ks);
#pragma unroll
    for (int db = 0; db < 2; ++db)
#pragma unroll
        for (int s = 0; s < 2; ++s) f.v[db][s] = *(const u32x4*)(vp + 512 * (db * 2 + s));
}
__device__ __forceinline__ void attn_item(const Params& P, int item) {
    const int w = item & 3, kvh = (item >> 2) & 1, qb = (item >> 3) & 15, b = item >> 7;
    const int lane = threadIdx.x & 63, head = kvh * 4 + (int)(threadIdx.x >> 6), r = lane & 31, hh = lane >> 5;
    const int tok = b * SEQ + qb * 128 + 32 * w + r;
    bf16x8 qf[4];
    { const bf16_t* qp = P.Q() + (size_t)tok * 512 + head * 64 + 8 * hh;
#pragma unroll
      for (int ks = 0; ks < 4; ++ks) qf[ks] = *(const bf16x8*)(qp + 16 * ks); }
    f32x16 o0, o1;
#pragma unroll
    for (int i = 0; i < 16; ++i) { o0[i] = 0.f; o1[i] = 0.f; }
    float mrun = P.sink[head] * 1.44269504088896f, lrun = (hh == 0) ? 1.f : 0.f;
    AttnFrag cur, nxt;
    attn_load(P, b, kvh, qb, w, 0, r, hh, cur);
    for (int blk = 0; blk < 17; ++blk) {
        if (blk + 1 < 17) attn_load(P, b, kvh, qb, w, blk + 1, r, hh, nxt);
        int lo = 0, hi = 31;
        if (blk < 9) {
            const int kpos0 = (qb - 1) * 128 + 32 * (w + blk);
            if (kpos0 < 0 || kpos0 >= SEQ) lo = 64;
            else if (blk == 0) lo = r;
            else if (blk == 8) hi = r;
        }
        f32x16 s;
#pragma unroll
        for (int i = 0; i < 16; ++i) s[i] = 0.f;
#pragma unroll
        for (int ks = 0; ks < 4; ++ks) s = __builtin_amdgcn_mfma_f32_32x32x16_bf16(*(const bf16x8*)&cur.k[ks], qf[ks], s, 0, 0, 0);
        if (lo != 0 || hi != 31) {
#pragma unroll
            for (int i = 0; i < 16; ++i) { const int kk = (i & 3) + 8 * (i >> 2) + 4 * hh; const bool ok = (kk >= lo) && (kk <= hi); s[i] = ok ? s[i] : -3.0e38f; }
        }
        float mb = s[0];
#pragma unroll
        for (int i = 1; i < 16; ++i) mb = fmaxf(mb, s[i]);
        mb = fmaxf(mb, __shfl_xor(mb, 32));
        if (!__all(mb - mrun <= 8.f)) {
            const float mn = fmaxf(mrun, mb);
            const float alpha = __builtin_amdgcn_exp2f(mrun - mn);
            lrun *= alpha; mrun = mn;
#pragma unroll
            for (int i = 0; i < 16; ++i) { o0[i] *= alpha; o1[i] *= alpha; }
        }
        float ps = 0.f; float p[16];
#pragma unroll
        for (int i = 0; i < 16; ++i) { p[i] = __builtin_amdgcn_exp2f(s[i] - mrun); ps += p[i]; }
        lrun += ps;
        u32x4 pb[2];
        pb[0].x = pk2(p[0], p[1]); pb[0].y = pk2(p[2], p[3]); pb[0].z = pk2(p[4], p[5]); pb[0].w = pk2(p[6], p[7]);
        pb[1].x = pk2(p[8], p[9]); pb[1].y = pk2(p[10], p[11]); pb[1].z = pk2(p[12], p[13]); pb[1].w = pk2(p[14], p[15]);
#pragma unroll
        for (int sI = 0; sI < 2; ++sI) {
            const u32x4 va = cur.v[0][sI], vb = cur.v[1][sI];
            o0 = __builtin_amdgcn_mfma_f32_32x32x16_bf16(*(const bf16x8*)&va, *(const bf16x8*)&pb[sI], o0, 0, 0, 0);
            o1 = __builtin_amdgcn_mfma_f32_32x32x16_bf16(*(const bf16x8*)&vb, *(const bf16x8*)&pb[sI], o1, 0, 0, 0);
        }
        if (blk + 1 < 17) cur = nxt;
    }
    const float ltot = lrun + __shfl_xor(lrun, 32);
    const float inv = 1.f / ltot;
    bf16_t* op = P.AO() + (size_t)tok * 512 + head * 64 + 4 * hh;
#pragma unroll
    for (int g = 0; g < 4; ++g) {
        float t0[4] = { o0[4 * g] * inv, o0[4 * g + 1] * inv, o0[4 * g + 2] * inv, o0[4 * g + 3] * inv };
        float t1[4] = { o1[4 * g] * inv, o1[4 * g + 1] * inv, o1[4 * g + 2] * inv, o1[4 * g + 3] * inv };
        st4bf(op + 8 * g, t0); st4bf(op + 32 + 8 * g, t1);
    }
}

__device__ __forceinline__ void conv_gcu(const Params& P, int m, int c0, float (&o)[8]) {
    const u32x4 g = *(const u32x4*)(P.GC() + (size_t)m * 512 + c0), u = *(const u32x4*)(P.U() + (size_t)m * 512 + c0);
    o[0] = bf2f(g.x & 0xffff) * bf2f(u.x & 0xffff); o[1] = bf2f(g.x >> 16) * bf2f(u.x >> 16);
    o[2] = bf2f(g.y & 0xffff) * bf2f(u.y & 0xffff); o[3] = bf2f(g.y >> 16) * bf2f(u.y >> 16);
    o[4] = bf2f(g.z & 0xffff) * bf2f(u.z & 0xffff); o[5] = bf2f(g.z >> 16) * bf2f(u.z >> 16);
    o[6] = bf2f(g.w & 0xffff) * bf2f(u.w & 0xffff); o[7] = bf2f(g.w >> 16) * bf2f(u.w >> 16);
}
__device__ __forceinline__ void conv_range(const Params& P, size_t gtid, size_t gsize) {
    for (size_t idx = gtid; idx < (size_t)(NTOK / 16) * 64; idx += gsize) {
        const int run = (int)(idx >> 6), c0 = (int)(idx & 63) * 8, m0 = run * 16, l0 = m0 % SEQ;
        float w0[8], w1[8], w2[8];
#pragma unroll
        for (int j = 0; j < 8; ++j) { w0[j] = P.conv_w[c0 + j]; w1[j] = P.conv_w[512 + c0 + j]; w2[j] = P.conv_w[1024 + c0 + j]; }
        float prev[8], cur[8], nxt[8];
        if (l0 == 0) {
#pragma unroll
            for (int j = 0; j < 8; ++j) prev[j] = 0.f;
        } else conv_gcu(P, m0 - 1, c0, prev);
        conv_gcu(P, m0, c0, cur);
#pragma unroll 4
        for (int i = 0; i < 16; ++i) {
            const int m = m0 + i;
            if (l0 + i + 1 >= SEQ) {
#pragma unroll
                for (int j = 0; j < 8; ++j) nxt[j] = 0.f;
            } else conv_gcu(P, m + 1, c0, nxt);
            const u32x4 gbv = *(const u32x4*)(P.GB() + (size_t)m * 512 + c0);
            const float gb[8] = { bf2f(gbv.x & 0xffff), bf2f(gbv.x >> 16), bf2f(gbv.y & 0xffff), bf2f(gbv.y >> 16), bf2f(gbv.z & 0xffff), bf2f(gbv.z >> 16), bf2f(gbv.w & 0xffff), bf2f(gbv.w >> 16) };
            float o[8];
#pragma unroll
            for (int j = 0; j < 8; ++j) { o[j] = gb[j] * (w0[j] * prev[j] + w1[j] * cur[j] + w2[j] * nxt[j]); prev[j] = cur[j]; cur[j] = nxt[j]; }
            st8bf(P.CA() + (size_t)m * 512 + c0, o);
        }
    }
}

__device__ __forceinline__ void unpack8(const u32x4 v, float* f) {
    f[0] = bf2f(v.x & 0xffff); f[1] = bf2f(v.x >> 16); f[2] = bf2f(v.y & 0xffff); f[3] = bf2f(v.y >> 16);
    f[4] = bf2f(v.z & 0xffff); f[5] = bf2f(v.z >> 16); f[6] = bf2f(v.w & 0xffff); f[7] = bf2f(v.w >> 16);
}
__device__ __forceinline__ float gelu_erf(float d) { return 0.5f * d * (1.f + erff(d * 0.70710678118654752f)); }
__device__ __forceinline__ int reduce64i(int (&part)[64], int lane) {
#pragma unroll
    for (int i = 0; i < 32; ++i) { auto r = __builtin_amdgcn_permlane32_swap((unsigned)part[i], (unsigned)part[32 + i], false, false); part[i] = (int)r[0] + (int)r[1]; }
#pragma unroll
    for (int i = 0; i < 16; ++i) { auto r = __builtin_amdgcn_permlane16_swap((unsigned)part[i], (unsigned)part[16 + i], false, false); part[i] = (int)r[0] + (int)r[1]; }
#define RSTAGE(N) { const bool up = (lane & N) != 0; _Pragma("unroll") for (int i = 0; i < N; ++i) { const int keep = up ? part[N + i] : part[i], send = up ? part[i] : part[N + i]; part[i] = keep + __shfl_xor(send, N); } }
    RSTAGE(8) RSTAGE(4) RSTAGE(2) RSTAGE(1)
#undef RSTAGE
    return part[0];
}
__device__ __forceinline__ int reduce32i(int (&part)[32], int lane) {
#pragma unroll
    for (int i = 0; i < 16; ++i) { auto r = __builtin_amdgcn_permlane16_swap((unsigned)part[i], (unsigned)part[16 + i], false, false); part[i] = (int)r[0] + (int)r[1]; }
#define RSTAGE(N) { const bool up = (lane & N) != 0; _Pragma("unroll") for (int i = 0; i < N; ++i) { const int keep = up ? part[N + i] : part[i], send = up ? part[i] : part[N + i]; part[i] = keep + __shfl_xor(send, N); } }
    RSTAGE(8) RSTAGE(4) RSTAGE(2) RSTAGE(1)
#undef RSTAGE
    return part[0];
}
__device__ __forceinline__ void peer_u_token(const Params& P, int t, int lane) {
    const int l32 = lane & 31, hsel = lane >> 5;
    const u32x4 hh = *(const u32x4*)(P.H2q() + (size_t)t * DM + 16 * l32), hl = *(const u32x4*)(P.H2q() + (size_t)t * DM + 512 + 16 * l32);
    const unsigned char* ub = (const unsigned char*)P.Uq() + 16 * l32;
    const float sh = P.sh2()[t];
#pragma unroll 1
    for (int hf = 0; hf < 2; ++hf) {
        const int myidx = P.sel_idx()[(size_t)t * 128 + hf * 64 + lane];
        u32x4 rows[3][4];
        int part[32];
#define SB __builtin_amdgcn_sched_barrier(0);
#define ULOAD(bt) { _Pragma("unroll") for (int q = 0; q < 4; ++q) { const int e0 = __builtin_amdgcn_readlane(myidx, 2 * ((bt) * 4 + q)), e1 = __builtin_amdgcn_readlane(myidx, 2 * ((bt) * 4 + q) + 1); \
        const int e = hsel ? e1 : e0; rows[(bt) % 3][q] = *(const u32x4*)(ub + (size_t)e * 512); } SB }
#define UDOT(bt) { _Pragma("unroll") for (int q = 0; q < 4; ++q) { const u32x4 a = rows[(bt) % 3][q]; \
        const int t1 = __builtin_amdgcn_sdot8((int)a.w, (int)hh.w, __builtin_amdgcn_sdot8((int)a.z, (int)hh.z, __builtin_amdgcn_sdot8((int)a.y, (int)hh.y, __builtin_amdgcn_sdot8((int)a.x, (int)hh.x, 0, false), false), false), false); \
        const int t2 = __builtin_amdgcn_sdot8((int)a.w, (int)hl.w, __builtin_amdgcn_sdot8((int)a.z, (int)hl.z, __builtin_amdgcn_sdot8((int)a.y, (int)hl.y, __builtin_amdgcn_sdot8((int)a.x, (int)hl.x, 0, false), false), false), false); \
        part[(bt) * 4 + q] = t1 * 16 + t2; } SB }
        ULOAD(0) ULOAD(1)
        ULOAD(2) UDOT(0)
        ULOAD(3) UDOT(1)
        ULOAD(4) UDOT(2)
        ULOAD(5) UDOT(3)
        ULOAD(6) UDOT(4)
        ULOAD(7) UDOT(5)
        UDOT(6)
        UDOT(7)
#undef SB
#undef ULOAD
#undef UDOT
        const int isum = reduce32i(part, lane);
        const int slot = 2 * l32 + hsel;
        const int eidx = __shfl(myidx, slot);
        const size_t o = (size_t)t * 128 + hf * 64 + slot;
        P.cbuf()[o] = P.sel_g()[o] * gelu_erf((float)isum * P.su()[eidx] * sh) * P.sv()[eidx];
    }
}
typedef float f32x2 __attribute__((ext_vector_type(2)));
typedef int i32x8 __attribute__((ext_vector_type(8)));
typedef int i32x2v __attribute__((ext_vector_type(2)));
__device__ __forceinline__ unsigned f2f8(float x) { return (unsigned)__builtin_amdgcn_cvt_pk_fp8_f32(x, x, 0, false) & 0xffu; }
__device__ __forceinline__ void peer_v_phase(const Params& P, int t0, int tstep, int lane, char* wl) {
    if (t0 >= NTOK) return;
    unsigned char* c8 = (unsigned char*)(wl + 16384);
    const unsigned char* vb = P.Vq();
    int l32 = lane & 31, hsel = lane >> 5;
#define VGATHER(idv, ch) { _Pragma("unroll") for (int i = 0; i < 16; ++i) { const int s0 = 32 * ((ch) & 1) + 2 * i; \
        const int e0 = __builtin_amdgcn_readlane(idv, s0), e1 = __builtin_amdgcn_readlane(idv, s0 + 1); const int e = hsel ? e1 : e0, x = 2 * i + hsel; \
        __builtin_amdgcn_global_load_lds((const unsigned*)(vb + (size_t)e * 512 + ((l32 ^ x) << 4)), (unsigned*)(wl + i * 1024), 16, 0, 0); } }
    int t = t0;
    f32x4 fgv[4];
#pragma unroll
    for (int q = 0; q < 4; ++q) fgv[q] = *(const f32x4*)(P.fg + 256 * q + 4 * lane);
    int idlo = P.sel_idx()[(size_t)t * 128 + lane], idhi = P.sel_idx()[(size_t)t * 128 + 64 + lane];
    float clo = P.cbuf()[(size_t)t * 128 + lane], chi = P.cbuf()[(size_t)t * 128 + 64 + lane];
    c8[lane] = (unsigned char)f2f8(clo * 64.f); c8[64 + lane] = (unsigned char)f2f8(chi * 64.f);
    VGATHER(idlo, 0)
#pragma unroll 1
    for (;;) {
        const int tn = t + tstep; const bool more = tn < NTOK;
        const int b = t / SEQ;
        int ln_ = lane; asm volatile("" : "+v"(ln_));
        l32 = ln_ & 31; hsel = ln_ >> 5;
        const int j16 = ln_ & 15, g = ln_ >> 4, rg = j16 >> 2;
        const int a0 = j16 * 512 + (g & 1) * 8, a1 = (16 + j16) * 512 + (g & 1) * 8, gh = g >> 1;
        const bool lo = (rg == gh), hi = (rg == 2 + gh);
        int idlo_n = 0, idhi_n = 0; float clo_n = 0.f, chi_n = 0.f;
        if (more) { idlo_n = P.sel_idx()[(size_t)tn * 128 + lane]; idhi_n = P.sel_idx()[(size_t)tn * 128 + 64 + lane]; clo_n = P.cbuf()[(size_t)tn * 128 + lane]; chi_n = P.cbuf()[(size_t)tn * 128 + 64 + lane]; }
        u32x2 xw[4]; f32x4 g2v[4];
#pragma unroll
        for (int q = 0; q < 4; ++q) { xw[q] = *(const u32x2*)(P.X1() + (size_t)t * DM + 256 * q + 4 * lane); g2v[q] = *(const f32x4*)(P.mod() + (size_t)b * NMOD + 5 * DM + 256 * q + 4 * lane); }
        float acc[16];
#pragma unroll
        for (int m = 0; m < 16; ++m) acc[m] = 0.f;
#pragma unroll 1
        for (int ch = 0; ch < 4; ++ch) {
            const i32x4 cw = *(const i32x4*)(c8 + 32 * ch + 16 * (g & 1));
            const i32x8 av = { lo ? cw.x : 0, lo ? cw.y : 0, lo ? cw.z : 0, lo ? cw.w : 0, hi ? cw.x : 0, hi ? cw.y : 0, hi ? cw.z : 0, hi ? cw.w : 0 };
            asm volatile("s_waitcnt vmcnt(0)" ::: "memory");
#pragma unroll
            for (int m = 0; m < 16; ++m) {
                const int cc = 2 * m + gh;
                const i32x2v t0r = __builtin_amdgcn_ds_read_tr4_b64_v2i32((__attribute__((address_space(3))) i32x2v*)(wl + a0 + (((cc ^ j16) & 31) << 4)));
                const i32x2v t1r = __builtin_amdgcn_ds_read_tr4_b64_v2i32((__attribute__((address_space(3))) i32x2v*)(wl + a1 + (((cc ^ (16 + j16)) & 31) << 4)));
                const i32x8 bv = { t0r.x, t0r.y, t1r.x, t1r.y, 0, 0, 0, 0 };
                f32x4 d = { 0.f, 0.f, 0.f, 0.f };
                d = __builtin_amdgcn_mfma_scale_f32_16x16x128_f8f6f4(av, bv, d, 0, 4, 0, 0x7f7f7f7f, 0, 0x7f7f7f7f);
                acc[m] += d[0];
                if ((m & 3) == 3) __builtin_amdgcn_sched_barrier(0);
            }
            asm volatile("s_waitcnt lgkmcnt(0)" ::: "memory");
            if (ch < 3) { const int idv = (ch == 0) ? idlo : idhi; VGATHER(idv, ch + 1) }
            else if (more) { c8[lane] = (unsigned char)f2f8(clo_n * 64.f); c8[64 + lane] = (unsigned char)f2f8(chi_n * 64.f); VGATHER(idlo_n, 0) }
        }
        float x2[16]; float ss = 0.f;
        { const unsigned xr[8] = { xw[0].x, xw[0].y, xw[1].x, xw[1].y, xw[2].x, xw[2].y, xw[3].x, xw[3].y };
#pragma unroll
          for (int m = 0; m < 16; ++m) { const float x1 = (m & 1) ? bf2f(xr[m >> 1] >> 16) : bf2f(xr[m >> 1] & 0xffff); x2[m] = x1 + g2v[m >> 2][m & 3] * (acc[m] * (1.f / 64.f)); ss += x2[m] * x2[m]; } }
        ss = wave_sum(ss);
        const float rstd = rsqrtf(ss * (1.f / DM) + 1e-6f);
        float* orow = P.out + (size_t)t * DM + 4 * lane;
#pragma unroll
        for (int q = 0; q < 4; ++q)
            __builtin_nontemporal_store((f32x4){ x2[4 * q] * rstd * fgv[q].x, x2[4 * q + 1] * rstd * fgv[q].y, x2[4 * q + 2] * rstd * fgv[q].z, x2[4 * q + 3] * rstd * fgv[q].w }, (f32x4*)(orow + 256 * q));
        if (!more) break;
        t = tn; idlo = idlo_n; idhi = idhi_n; clo = clo_n; chi = chi_n;
    }
#undef VGATHER
}

#define XB_TMO      128
#define XB_XCNT(j)  (256  + 64 * (j))
#define XB_XSUB(j)  (1280 + 64 * (j))
#define XB_XGEN(j)  (2304 + 64 * (j))
#define XB_TOP      3328
#define XB_TOPGEN   3392
#define XCD_BAR_WORDS 3456
#define XB_SPIN_CAP (1u << 22)
#define LAS __attribute__((address_space(3)))
__device__ __forceinline__ unsigned xb_ld(unsigned* p)              { return __hip_atomic_load(p, __ATOMIC_RELAXED, __HIP_MEMORY_SCOPE_AGENT); }
__device__ __forceinline__ unsigned xb_add(unsigned* p, unsigned v) { return __hip_atomic_fetch_add(p, v, __ATOMIC_RELAXED, __HIP_MEMORY_SCOPE_AGENT); }
__device__ __forceinline__ unsigned xb_xcc_id() { return (unsigned)__builtin_amdgcn_s_getreg((3 << 11) | 20) & 0xFu; }
#define XB_SPIN(cond, bar) do { unsigned _sp = 0; while (cond) { __builtin_amdgcn_s_sleep(1); \
    if ((++_sp & 255u) == 0u) { if (xb_ld(&(bar)[XB_TMO])) break; if (_sp > XB_SPIN_CAP) { atomicAdd(&(bar)[XB_TMO], 1u); break; } } } } while (0)
struct XcdBarrier { unsigned* bar; unsigned x; volatile LAS unsigned* st; };
__device__ __forceinline__ XcdBarrier xcd_barrier_post(unsigned* bar, volatile LAS unsigned* st) {
    XcdBarrier b; b.bar = bar; b.x = xb_xcc_id(); b.st = st;
    if (threadIdx.x == 0) (void)xb_add(&bar[XB_XCNT(b.x)], 1u);
    return b;
}
__device__ __forceinline__ void xcd_barrier_complete(unsigned* bar, unsigned x, unsigned& nloc, unsigned& nx) {
    const unsigned G = gridDim.x * gridDim.y * gridDim.z;
    unsigned sum, cnt, mine, sp = 0u;
    for (;;) {
        sum = 0u; cnt = 0u; mine = 0u;
#pragma unroll
        for (unsigned j = 0; j < 16; ++j) { const unsigned c = xb_ld(&bar[XB_XCNT(j)]); sum += c; cnt += (c > 0u) ? 1u : 0u; mine = (j == x) ? c : mine; }
        if (sum == G) break;
        __builtin_amdgcn_s_sleep(1);
        if ((++sp & 255u) == 0u) { if (xb_ld(&bar[XB_TMO])) break; if (sp > XB_SPIN_CAP) { atomicAdd(&bar[XB_TMO], 1u); break; } }
    }
    nloc = mine > 0u ? mine : 1u; nx = cnt > 0u ? cnt : 1u;
}
__device__ __forceinline__ void xcd_barrier(const XcdBarrier& b) {
    asm volatile("s_waitcnt vmcnt(0)" ::: "memory");
    __syncthreads();
    if (threadIdx.x == 0) {
        unsigned* bar = b.bar;
        __builtin_amdgcn_s_waitcnt(0);
        unsigned nloc = b.st[0], nx = b.st[1];
        if (nloc == 0u) { xcd_barrier_complete(bar, b.x, nloc, nx); b.st[0] = nloc; b.st[1] = nx; }
        const unsigned old = xb_add(&bar[XB_XSUB(b.x)], 1u);
        const unsigned gen = old / nloc;
        if (old + 1u == (gen + 1u) * nloc) {
            __builtin_amdgcn_fence(__ATOMIC_RELEASE, "agent");
            asm volatile("s_waitcnt vmcnt(0)" ::: "memory");
            const unsigned og = xb_add(&bar[XB_TOP], 1u);
            const unsigned tg = og / nx;
            if (og + 1u == (tg + 1u) * nx) xb_add(&bar[XB_TOPGEN], 1u);
            else XB_SPIN(xb_ld(&bar[XB_TOPGEN]) == tg, bar);
            __builtin_amdgcn_fence(__ATOMIC_ACQUIRE, "agent");
            xb_add(&bar[XB_XGEN(b.x)], 1u);
            asm volatile("s_waitcnt vmcnt(0)" ::: "memory");
        } else {
            XB_SPIN(xb_ld(&bar[XB_XGEN(b.x)]) == gen, bar);
            __builtin_amdgcn_fence(__ATOMIC_ACQUIRE, "agent");
            asm volatile("s_waitcnt vmcnt(0)" ::: "memory");
        }
    }
    __syncthreads();
}

constexpr int NPHASE = 9;
template <int PH> __device__ __forceinline__ void run_phase(const Params& P, char* smem) {
    int tid_ = threadIdx.x; asm volatile("" : "+v"(tid_));
    const int bid = blockIdx.x, G = gridDim.x, tid = tid_;
    const size_t gtid = (size_t)bid * 256 + tid, gsize = (size_t)G * 256;
    if (PH == 0) {
        for (int it = bid; it < MODP_KC * 32; it += G) modp_item(P, it, smem);
        float (*tile)[65] = (float (*)[65])smem;
        for (int it = bid; it < 2112; it += G) {
            if (it < 1088) { if ((it % 68) * 64 >= 2304) colmax_tile(P.w_in, DM, PROJW, P.bar() + XCD_BAR_WORDS + 2048, (it / 68) * 32 + (it % 68) - 36, tile, 2304, 2048);
                             else transpose_tile(P.w_in, DM, PROJW, P.WinT(), it, tile); }
            else if (it < 1216) transpose_tile(P.w_ao, 512, DM, P.WaoT(), it - 1088, tile);
            else if (it < 1344) transpose_tile(P.w_co, 512, DM, P.WcoT(), it - 1216, tile);
            else if (it < 1600) transpose_tile(P.w_mix, DM, DM, P.WmixT(), it - 1344, tile);
            else colmax_tile(P.pw_q, DM, 2048, P.bar() + XCD_BAR_WORDS, it - 1600, tile);
        }
        cvt_range(P.keys, P.KeysB(), (size_t)16 * 128 * 128 / 8, gtid, gsize);
        { const int lane = tid & 63, wid = tid >> 6;
          for (int r = bid * 4 + wid; r < NEXP; r += G * 4) {
              f32x4 va[4], vb[4];
              load_row4(P.pu + (size_t)r * DM, lane, va); load_row4(P.pv + (size_t)r * DM, lane, vb);
              quant_row_u4(va, (unsigned char*)P.Uq() + (size_t)r * 512, P.su() + r, lane);
              quant_row_v4m(vb, P.Vq() + (size_t)r * 512, P.sv() + r, lane); } }
        rope_tab(P, (int)(gsize - 1 - gtid), (int)gsize);
    } else if (PH == 1) {
        for (int i = (int)gtid; i < 17 * NMOD; i += (int)gsize) {
            float v = P.b_mod[i % NMOD];
#pragma unroll
            for (int kc = 0; kc < MODP_KC; ++kc) v += P.modp()[(size_t)kc * 17 * NMOD + i];
            P.mod()[i] = v;
        }
        for (int it = bid; it < 512; it += G) transpose_tile_i8(P.pw_q, DM, 2048, P.PwqT(), P.bar() + XCD_BAR_WORDS, it, (float (*)[65])smem);
        for (int it = bid; it < 512; it += G) transpose_tile_i8(P.w_in, DM, PROJW, P.W8(), P.bar() + XCD_BAR_WORDS + 2048, it, (float (*)[65])smem, 2304, 2048);
        if (NTOK % G == 0 && SEQ % (NTOK / G) == 0 && NCTX % G == 0) {
            norm1_rows(P, false, bid * (NTOK / G), NTOK / G, smem);
            norm1_rows(P, true, bid * (NCTX / G), NCTX / G, smem);
        } else {
            for (int it = bid; it < 1152; it += G) { const bool isctx = it >= 1024; norm1_rows(P, isctx, isctx ? (it - 1024) * 32 : it * 32, 32, smem); }
        }
    } else if (PH == 2) {
        for (int t = bid; t < 128 * 18 + 32; t += G) {
            if (t < 128 * 18) { int mt, nt; tile_coords(t, 128, 18, mt, nt); gemm_tile<MODE_INPROJ, 8>(P, P.H(), DM, P.WinT(), DM, DM, mt * 256, nt * 128, nt * 128 >= 768, smem); }
            else { const int u = t - 128 * 18, mt = u >> 1, nt = u & 1; gemm_tile<MODE_CTXKV, 8>(P, P.HC(), DM, P.WinT() + (size_t)512 * DM, DM, DM, mt * 256, nt * 128, nt == 0, smem); }
        }
    } else if (PH == 3) {
        const int nG = 128 * 16, nA = NB * 16 * 8;
        int tg = bid, ta = bid;
        bool gemm_turn = (bid & 1) == 0;
        while (tg < nG || ta < nA) {
            if ((gemm_turn && tg < nG) || ta >= nA) {
                int mt, nt; tile_coords(tg, 128, 16, mt, nt);
                gemm_tile<MODE_INPROJ, 8, true>(P, (const bf16_t*)P.H8(), 512, (const bf16_t*)P.W8() - (size_t)2304 * 512, 512, 512, mt * 256, (18 + nt) * 128, true, smem);
                tg += G;
            } else { attn_item(P, ta); ta += G; }
            gemm_turn = !gemm_turn;
        }
        conv_range(P, gtid, gsize);
    } else if (PH == 4) {
        for (int t = bid; t < 256 * 8; t += G) { int mt, nt; tile_coords(t, 256, 8, mt, nt); gemm_tile_ao(P, mt * 128, nt * 128, smem); }
    } else if (PH == 5) {
        for (int t = bid; t < 128 * 8; t += G) { int mt, nt; tile_coords(t, 128, 8, mt, nt); gemm_tile<MODE_MIX, 8>(P, P.YG(), DM, P.WmixT(), DM, DM, mt * 256, nt * 128, true, smem); }
    } else if (PH == 6) {
        const int lane = tid & 63, wid = tid >> 6;
        for (int it = bid; it < NTOK / 64; it += G) {
            const int row0 = it * 64, b = row0 / SEQ;
            f32x4 gm[4], shv[4];
#pragma unroll
            for (int j = 0; j < 4; ++j) { const int d = j * 256 + lane * 4;
                const f32x4 gg = *(const f32x4*)(P.n2 + d), s1 = *(const f32x4*)(P.mod() + (size_t)b * NMOD + 4 * DM + d);
                gm[j] = (f32x4){ gg.x * (1.f + s1.x), gg.y * (1.f + s1.y), gg.z * (1.f + s1.z), gg.w * (1.f + s1.w) }; shv[j] = *(const f32x4*)(P.mod() + (size_t)b * NMOD + 3 * DM + d); }
            for (int i = wid; i < 64; i += 8) {
                const int ra = row0 + i, rb = ra + 4;
                f32x4 va[4], vb[4];
                load_row4_bf(P.X1() + (size_t)ra * DM, lane, va); load_row4_bf(P.X1() + (size_t)rb * DM, lane, vb);
                norm_row_q(va, gm, shv, P.H2() + (size_t)ra * DM, P.H2q() + (size_t)ra * DM, P.sh2() + ra, lane);
                norm_row_q(vb, gm, shv, P.H2() + (size_t)rb * DM, P.H2q() + (size_t)rb * DM, P.sh2() + rb, lane);
            }
        }
    } else if (PH == 7) {
        for (int it = bid; it < 256 * 8; it += G) peer_retrieve_item(P, it >> 3, it & 7, smem);
    } else if (PH == 8) {
        const int lane = tid & 63, wid = tid >> 6;
        for (int t = bid * 4 + wid; t < NTOK; t += G * 4) peer_u_token(P, t, lane);
    } else if (PH == 9) {
        const int lane = tid & 63, wid = tid >> 6;
        peer_v_phase(P, bid * 4 + wid, G * 4, lane, smem + wid * 16640);
    }
}
#ifndef REP0
#define REP0 1
#endif
#ifndef REP1
#define REP1 1
#endif
#ifndef REP2
#define REP2 1
#endif
#ifndef REP3
#define REP3 1
#endif
#ifndef REP4
#define REP4 1
#endif
#ifndef REP5
#define REP5 1
#endif
#ifndef REP6
#define REP6 1
#endif
#ifndef REP7
#define REP7 1
#endif
#ifndef REP8
#define REP8 1
#endif
#ifndef REP9
#define REP9 1
#endif
#ifndef REP10
#define REP10 1
#endif
constexpr int MEGA_LDS = 3 * (2048 * 8 + 8192);
__global__ void __launch_bounds__(256, 2) k_mega(Params P) {
    extern __shared__ __attribute__((aligned(16))) char smem[];
    volatile LAS unsigned* st = (volatile LAS unsigned*)(smem + MEGA_LDS);
    if (threadIdx.x < 4) st[threadIdx.x] = 0u;
    __syncthreads();
    const XcdBarrier bar = xcd_barrier_post(P.bar(), st);
#define PHASE_SYNC(k) for (int rep = 0; rep < REP##k; ++rep) { run_phase<k>(P, smem); xcd_barrier(bar); }
    PHASE_SYNC(0) PHASE_SYNC(1) PHASE_SYNC(2) PHASE_SYNC(3) PHASE_SYNC(4) PHASE_SYNC(5) PHASE_SYNC(6) PHASE_SYNC(7)
    PHASE_SYNC(8)
    run_phase<9>(P, smem);
}


extern "C" void kernel_launch(void* const* d_in, const int* in_sizes, int n_in, void* d_out, int out_size, void* d_ws, size_t ws_size, hipStream_t stream) {
    Params P{};
    P.x = (const float*)d_in[0]; P.c = (const float*)d_in[1]; P.ctx = (const float*)d_in[2]; P.c_ctx = (const float*)d_in[3];
    P.w_mod = (const float*)d_in[4]; P.b_mod = (const float*)d_in[5]; P.n1 = (const float*)d_in[6]; P.n2 = (const float*)d_in[7];
    P.w_in = (const float*)d_in[8]; P.sink = (const float*)d_in[9]; P.conv_w = (const float*)d_in[10]; P.w_ao = (const float*)d_in[11];
    P.w_co = (const float*)d_in[12]; P.w_mix = (const float*)d_in[13]; P.pw_q = (const float*)d_in[14]; P.keys = (const float*)d_in[15];
    P.pu = (const float*)d_in[16]; P.pv = (const float*)d_in[17]; P.fg = (const float*)d_in[18];
    P.out = (float*)d_out;
    P.ws = (char*)d_ws;
    if (WS_NEED > ws_size) { fprintf(stderr, "kernel_launch: workspace too small: need %zu have %zu\n", (size_t)WS_NEED, ws_size); return; }

    static int grid_blocks = 0;
    if (!grid_blocks) {
        int dev = 0, cus = 0, per_cu = 0;
        (void)hipGetDevice(&dev);
        (void)hipDeviceGetAttribute(&cus, hipDeviceAttributeMultiprocessorCount, dev);
        (void)hipFuncSetAttribute((const void*)k_mega, hipFuncAttributeMaxDynamicSharedMemorySize, MEGA_LDS + 16);
        (void)hipOccupancyMaxActiveBlocksPerMultiprocessor(&per_cu, (const void*)k_mega, 256, MEGA_LDS + 16);
        if (per_cu > 2) per_cu = 2;
        if (per_cu < 1) { fprintf(stderr, "kernel_launch: occupancy query returned %d\n", per_cu); per_cu = 1; }
        grid_blocks = cus * per_cu;
    }
    (void)hipMemsetAsync(P.bar(), 0, (size_t)(XCD_BAR_WORDS + WAMAX_WORDS) * 4, stream);
    void* args[] = { &P };
    hipError_t e = hipLaunchCooperativeKernel((const void*)k_mega, dim3(grid_blocks), dim3(256), args, MEGA_LDS + 16, stream);
    if (e != hipSuccess) fprintf(stderr, "cooperative launch failed: %s (grid %d)\n", hipGetErrorString(e), grid_blocks);
}
```
